# Optimizing an MI355X kernel written in HIP

```python
import math
import jax, jax.numpy as jnp
from jax import lax
import numpy as np

D_MODEL = 1024
BATCH = 2
SEQ = 8192
DEPTH = 2

HEAD_DIM = 64
Q_BLOCK = 128
NSA_HEADS = 8
NSA_KV_HEADS = 2
CMP_LEN = 32
CMP_STRIDE = 16
CMP_HIDDEN = 256
SLC_LEN = 64
SLC_TOPN = 16
NSA_WINDOW = 512
FORCE_SCORE = 1e4
SB_HEADS = 4
SWA_HEADS = 4
SWA_KV_HEADS = 2
SWA_WINDOW = 128
NUM_BUCKETS = 32
MAX_DISTANCE = 128
N_BIAS_HEADS = NSA_HEADS + SWA_HEADS
D_FF = 2816
NORM_EPS = 1e-6
NEG_INF = -1e30
N_BRANCHES = 3

SPLIT_SIZES = (
    NSA_HEADS * HEAD_DIM,
    NSA_KV_HEADS * HEAD_DIM, NSA_KV_HEADS * HEAD_DIM,
    NSA_KV_HEADS * HEAD_DIM, NSA_KV_HEADS * HEAD_DIM,
    NSA_KV_HEADS * HEAD_DIM, NSA_KV_HEADS * HEAD_DIM,
    3 * NSA_HEADS,
    SB_HEADS * HEAD_DIM, SB_HEADS * HEAD_DIM, SB_HEADS * HEAD_DIM,
    SWA_HEADS * HEAD_DIM, SWA_KV_HEADS * HEAD_DIM, SWA_KV_HEADS * HEAD_DIM,
    N_BRANCHES * D_MODEL,
)
D_IN = sum(SPLIT_SIZES)
SPLIT_POINTS = tuple(int(p) for p in np.cumsum(SPLIT_SIZES)[:-1])

kernel_name = "hybrid_nsa_stickbreak_swasink_macaron"


def rms_norm(x, w):
    xf = x.astype(jnp.float32)
    y = xf * lax.rsqrt(jnp.mean(xf * xf, axis=-1, keepdims=True) + NORM_EPS)
    return (y * w.astype(jnp.float32)).astype(x.dtype)


def swiglu(x, w_gate, w_up, w_down):
    return (jax.nn.silu(x @ w_gate) * (x @ w_up)) @ w_down


def t5_bucket(dist):
    max_exact = NUM_BUCKETS // 2
    d = jnp.maximum(dist, 0)
    df = jnp.maximum(d, 1).astype(jnp.float32)
    large = max_exact + (jnp.log(df / max_exact) / math.log(MAX_DISTANCE / max_exact)
                         * (NUM_BUCKETS - max_exact)).astype(jnp.int32)
    large = jnp.minimum(large, NUM_BUCKETS - 1)
    return jnp.where(d < max_exact, d, large)


def masked_softmax(logits, mask):
    p = jax.nn.softmax(jnp.where(mask, logits, NEG_INF), axis=-1)
    return p * mask


def nsa_attention(q, k_cmp, v_cmp, k_slc, v_slc, k_win, v_win, gate_logits,
                  q_norm, k_norm, cmp_pos, cmp_k_w1, cmp_k_w2, cmp_v_w1, cmp_v_w2, bias_table):
    B, S = q.shape[0], q.shape[1]
    G, R, Dh = NSA_KV_HEADS, NSA_HEADS // NSA_KV_HEADS, HEAD_DIM
    scale = Dh ** -0.5
    qg = rms_norm(q, q_norm).reshape(B, S, G, R, Dh).transpose(0, 2, 3, 1, 4)
    gates = jax.nn.sigmoid(gate_logits.astype(jnp.float32)).reshape(B, S, 3, G, R)

    n_cmp = (S - CMP_LEN) // CMP_STRIDE + 1
    cmp_idx = np.arange(n_cmp)[:, None] * CMP_STRIDE + np.arange(CMP_LEN)[None, :]
    cmp_end = jnp.asarray(cmp_idx[:, -1], jnp.int32)

    def compress(t, w1, w2):
        blocks = t[:, cmp_idx] + cmp_pos[:, None, :]
        blocks = blocks.transpose(0, 3, 1, 2, 4).reshape(B, G, n_cmp, CMP_LEN * Dh)
        return jax.nn.silu(blocks @ w1) @ w2

    kc = rms_norm(compress(k_cmp, cmp_k_w1, cmp_k_w2), k_norm)
    vc = compress(v_cmp, cmp_v_w1, cmp_v_w2)

    n_slc = S // SLC_LEN
    slc_start = np.arange(n_slc) * SLC_LEN
    overlap = jnp.asarray((cmp_idx[:, :1] < slc_start[None, :] + SLC_LEN)
                          & (cmp_idx[:, -1:] >= slc_start[None, :]), jnp.float32)
    top_n = min(SLC_TOPN, n_slc)
    ks = rms_norm(k_slc, k_norm).transpose(0, 2, 1, 3).reshape(B, G, n_slc, SLC_LEN, Dh)
    vs = v_slc.transpose(0, 2, 1, 3).reshape(B, G, n_slc, SLC_LEN, Dh)

    pad = ((0, 0), (0, 0), (NSA_WINDOW, 0), (0, 0))
    kw = jnp.pad(rms_norm(k_win, k_norm).transpose(0, 2, 1, 3), pad)
    vw = jnp.pad(v_win.transpose(0, 2, 1, 3), pad)

    head_bias = bias_table[:, :NSA_HEADS].T.reshape(G, R, NUM_BUCKETS).astype(jnp.float32)
    b_idx = jnp.arange(B)[:, None, None, None]
    g_idx = jnp.arange(G)[None, :, None, None]
    g5 = jnp.arange(G)[None, :, None, None, None]
    r5 = jnp.arange(R)[None, None, :, None, None]
    slc_ids = jnp.arange(n_slc)[None, :]

    def block(i):
        q0 = i * Q_BLOCK
        t = q0 + jnp.arange(Q_BLOCK)
        qb = lax.dynamic_slice_in_dim(qg, q0, Q_BLOCK, axis=3)

        dist_c = t[:, None] - cmp_end[None, :]
        s_c = (jnp.einsum('bgrqd,bgnd->bgrqn', qb, kc).astype(jnp.float32) * scale
               + head_bias[:, :, t5_bucket(dist_c)])
        p_c = masked_softmax(s_c, dist_c >= 0)
        o_c = jnp.einsum('bgrqn,bgnd->bgrqd', p_c.astype(vc.dtype), vc)

        imp = jnp.einsum('bgrqn,nj->bgqj', p_c, overlap)
        cur = (t // SLC_LEN)[:, None]
        forced = (slc_ids == 0) | (slc_ids == cur) | (slc_ids == cur - 1)
        score = jnp.where(forced, FORCE_SCORE, jnp.where(slc_ids <= cur, imp, -1.0))
        _, sel = lax.top_k(score, top_n)
        kg = ks[b_idx, g_idx, sel].reshape(B, G, Q_BLOCK, top_n * SLC_LEN, Dh)
        vg = vs[b_idx, g_idx, sel].reshape(B, G, Q_BLOCK, top_n * SLC_LEN, Dh)
        pos = (sel[..., None] * SLC_LEN + jnp.arange(SLC_LEN)).reshape(B, G, Q_BLOCK, top_n * SLC_LEN)
        dist_s = t[None, None, :, None] - pos
        s_s = (jnp.einsum('bgrqd,bgqkd->bgrqk', qb, kg).astype(jnp.float32) * scale
               + head_bias[g5, r5, t5_bucket(dist_s)[:, :, None]])
        p_s = masked_softmax(s_s, (dist_s >= 0)[:, :, None])
        o_s = jnp.einsum('bgrqk,bgqkd->bgrqd', p_s.astype(vg.dtype), vg)

        kb = lax.dynamic_slice_in_dim(kw, q0, Q_BLOCK + NSA_WINDOW, axis=2)
        vb = lax.dynamic_slice_in_dim(vw, q0, Q_BLOCK + NSA_WINDOW, axis=2)
        key_pos = q0 - NSA_WINDOW + jnp.arange(Q_BLOCK + NSA_WINDOW)
        dist_w = t[:, None] - key_pos[None, :]
        mask_w = (dist_w >= 0) & (dist_w < NSA_WINDOW) & (key_pos[None, :] >= 0)
        s_w = (jnp.einsum('bgrqd,bgkd->bgrqk', qb, kb).astype(jnp.float32) * scale
               + head_bias[:, :, t5_bucket(dist_w)])
        p_w = masked_softmax(s_w, mask_w)
        o_w = jnp.einsum('bgrqk,bgkd->bgrqd', p_w.astype(vb.dtype), vb)

        g = lax.dynamic_slice_in_dim(gates, q0, Q_BLOCK, axis=1).transpose(2, 0, 3, 4, 1)[..., None]
        return (g[0] * o_c + g[1] * o_s + g[2] * o_w).astype(q.dtype)

    o = lax.map(block, jnp.arange(S // Q_BLOCK))
    return o.transpose(1, 0, 4, 2, 3, 5).reshape(B, S, NSA_HEADS * Dh)


def stick_breaking_attention(q, k, v):
    B, S = q.shape[0], q.shape[1]
    scale = HEAD_DIM ** -0.5
    qh = q.transpose(0, 2, 1, 3)
    kh = k.transpose(0, 2, 1, 3)
    vh = v.transpose(0, 2, 1, 3)
    key_pos = jnp.arange(S)

    def block(i):
        q0 = i * Q_BLOCK
        t = q0 + jnp.arange(Q_BLOCK)
        qb = lax.dynamic_slice_in_dim(qh, q0, Q_BLOCK, axis=2)
        z = jnp.einsum('bhqd,bhkd->bhqk', qb, kh).astype(jnp.float32) * scale
        mask = key_pos[None, :] < t[:, None]
        log_fail = jnp.where(mask, jax.nn.log_sigmoid(-z), 0.0)
        after = lax.cumsum(log_fail, axis=3, reverse=True) - log_fail
        w = jnp.where(mask, jnp.exp(jax.nn.log_sigmoid(z) + after), 0.0)
        return jnp.einsum('bhqk,bhkd->bhqd', w.astype(vh.dtype), vh)

    o = lax.map(block, jnp.arange(S // Q_BLOCK))
    return o.transpose(1, 0, 3, 2, 4).reshape(B, S, SB_HEADS * HEAD_DIM)


def swa_sink_attention(q, k, v, q_norm, k_norm, sinks, bias_table):
    B, S = q.shape[0], q.shape[1]
    G, R, Dh = SWA_KV_HEADS, SWA_HEADS // SWA_KV_HEADS, HEAD_DIM
    scale = Dh ** -0.5
    qg = rms_norm(q, q_norm).reshape(B, S, G, R, Dh).transpose(0, 2, 3, 1, 4)
    pad = ((0, 0), (0, 0), (SWA_WINDOW, 0), (0, 0))
    kp = jnp.pad(rms_norm(k, k_norm).transpose(0, 2, 1, 3), pad)
    vp = jnp.pad(v.transpose(0, 2, 1, 3), pad)
    head_bias = bias_table[:, NSA_HEADS:].T.reshape(G, R, NUM_BUCKETS).astype(jnp.float32)
    sink = sinks.astype(jnp.float32).reshape(1, G, R, 1, 1)

    def block(i):
        q0 = i * Q_BLOCK
        t = q0 + jnp.arange(Q_BLOCK)
        qb = lax.dynamic_slice_in_dim(qg, q0, Q_BLOCK, axis=3)
        kb = lax.dynamic_slice_in_dim(kp, q0, Q_BLOCK + SWA_WINDOW, axis=2)
        vb = lax.dynamic_slice_in_dim(vp, q0, Q_BLOCK + SWA_WINDOW, axis=2)
        key_pos = q0 - SWA_WINDOW + jnp.arange(Q_BLOCK + SWA_WINDOW)
        dist = t[:, None] - key_pos[None, :]
        mask = (dist >= 0) & (dist < SWA_WINDOW) & (key_pos[None, :] >= 0)
        s = (jnp.einsum('bgrqd,bgkd->bgrqk', qb, kb).astype(jnp.float32) * scale
             + head_bias[:, :, t5_bucket(dist)])
        s = jnp.where(mask, s, NEG_INF)
        m = jnp.maximum(jnp.max(s, axis=-1, keepdims=True), sink)
        e = jnp.exp(s - m)
        p = e / (jnp.sum(e, axis=-1, keepdims=True) + jnp.exp(sink - m))
        return jnp.einsum('bgrqk,bgkd->bgrqd', p.astype(vb.dtype), vb)

    o = lax.map(block, jnp.arange(S // Q_BLOCK))
    return o.transpose(1, 0, 4, 2, 3, 5).reshape(B, S, SWA_HEADS * Dh)


def setup_inputs(seed: int = 0) -> dict:
    key = jax.random.key(seed)
    ks = jax.random.split(key, 32)
    L, D, F = DEPTH, D_MODEL, D_FF

    def w(k, shape, fan_in):
        return jax.random.normal(k, shape, jnp.float32) * fan_in ** -0.5

    def gain(k, shape):
        return 1.0 + 0.02 * jax.random.normal(k, shape, jnp.float32)

    return {
        "x": jax.random.normal(ks[0], (BATCH, SEQ, D), jnp.float32),
        "rel_bias": 0.5 * jax.random.normal(ks[1], (NUM_BUCKETS, N_BIAS_HEADS), jnp.float32),
        "ffn1_norm": gain(ks[2], (L, D)),
        "ffn1_w_gate": w(ks[3], (L, D, F), D),
        "ffn1_w_up": w(ks[4], (L, D, F), D),
        "ffn1_w_down": w(ks[5], (L, F, D), F),
        "mix_norm": gain(ks[6], (L, D)),
        "w_in": w(ks[7], (L, D, D_IN), D),
        "nsa_q_norm": gain(ks[8], (L, HEAD_DIM)),
        "nsa_k_norm": gain(ks[9], (L, HEAD_DIM)),
        "nsa_cmp_pos": 0.5 * jax.random.normal(ks[10], (L, CMP_LEN, HEAD_DIM), jnp.float32),
        "nsa_cmp_k_w1": w(ks[11], (L, CMP_LEN * HEAD_DIM, CMP_HIDDEN), CMP_LEN * HEAD_DIM),
        "nsa_cmp_k_w2": w(ks[12], (L, CMP_HIDDEN, HEAD_DIM), CMP_HIDDEN),
        "nsa_cmp_v_w1": w(ks[13], (L, CMP_LEN * HEAD_DIM, CMP_HIDDEN), CMP_LEN * HEAD_DIM),
        "nsa_cmp_v_w2": w(ks[14], (L, CMP_HIDDEN, HEAD_DIM), CMP_HIDDEN),
        "swa_q_norm": gain(ks[15], (L, HEAD_DIM)),
        "swa_k_norm": gain(ks[16], (L, HEAD_DIM)),
        "swa_sinks": jax.random.normal(ks[17], (L, SWA_HEADS), jnp.float32),
        "w_up_nsa": w(ks[18], (L, NSA_HEADS * HEAD_DIM, D), NSA_HEADS * HEAD_DIM),
        "w_up_sb": w(ks[19], (L, SB_HEADS * HEAD_DIM, D), SB_HEADS * HEAD_DIM),
        "w_up_swa": w(ks[20], (L, SWA_HEADS * HEAD_DIM, D), SWA_HEADS * HEAD_DIM),
        "w_out": w(ks[21], (L, D, D), D),
        "ffn2_norm": gain(ks[22], (L, D)),
        "ffn2_w_gate": w(ks[23], (L, D, F), D),
        "ffn2_w_up": w(ks[24], (L, D, F), D),
        "ffn2_w_down": w(ks[25], (L, F, D), F),
    }


def reference(x, rel_bias, ffn1_norm, ffn1_w_gate, ffn1_w_up, ffn1_w_down, mix_norm, w_in,
              nsa_q_norm, nsa_k_norm, nsa_cmp_pos, nsa_cmp_k_w1, nsa_cmp_k_w2, nsa_cmp_v_w1,
              nsa_cmp_v_w2, swa_q_norm, swa_k_norm, swa_sinks, w_up_nsa, w_up_sb, w_up_swa, w_out,
              ffn2_norm, ffn2_w_gate, ffn2_w_up, ffn2_w_down):
    B, S = x.shape[0], x.shape[1]

    def heads(t, n):
        return t.reshape(B, S, n, HEAD_DIM)

    for l in range(DEPTH):
        h = rms_norm(x, ffn1_norm[l])
        x = x + 0.5 * swiglu(h, ffn1_w_gate[l], ffn1_w_up[l], ffn1_w_down[l])

        h = rms_norm(x, mix_norm[l])
        (nq, nkc, nvc, nks, nvs, nkw, nvw, ngate, sq, sk, sv, wq, wk, wv, bgate) = jnp.split(
            h @ w_in[l], SPLIT_POINTS, axis=-1)
        y_nsa = nsa_attention(heads(nq, NSA_HEADS), heads(nkc, NSA_KV_HEADS), heads(nvc, NSA_KV_HEADS),
                              heads(nks, NSA_KV_HEADS), heads(nvs, NSA_KV_HEADS),
                              heads(nkw, NSA_KV_HEADS), heads(nvw, NSA_KV_HEADS), ngate,
                              nsa_q_norm[l], nsa_k_norm[l], nsa_cmp_pos[l], nsa_cmp_k_w1[l],
                              nsa_cmp_k_w2[l], nsa_cmp_v_w1[l], nsa_cmp_v_w2[l], rel_bias)
        y_sb = stick_breaking_attention(heads(sq, SB_HEADS), heads(sk, SB_HEADS), heads(sv, SB_HEADS))
        y_swa = swa_sink_attention(heads(wq, SWA_HEADS), heads(wk, SWA_KV_HEADS), heads(wv, SWA_KV_HEADS),
                                   swa_q_norm[l], swa_k_norm[l], swa_sinks[l], rel_bias)

        g = jax.nn.sigmoid(bgate.astype(jnp.float32)).reshape(B, S, N_BRANCHES, D_MODEL).astype(x.dtype)
        merged = (g[:, :, 0] * (y_nsa @ w_up_nsa[l]) + g[:, :, 1] * (y_sb @ w_up_sb[l])
                  + g[:, :, 2] * (y_swa @ w_up_swa[l]))
        x = x + merged @ w_out[l]

        h = rms_norm(x, ffn2_norm[l])
        x = x + 0.5 * swiglu(h, ffn2_w_gate[l], ffn2_w_up[l], ffn2_w_down[l])
    return x
```

```cpp
#include <hip/hip_runtime.h>
#include <stdint.h>

typedef unsigned short bf16_t;
__device__ __forceinline__ float bf2f(bf16_t v) { return __uint_as_float(((unsigned)v) << 16); }
__device__ __forceinline__ bf16_t f2bf(float f) { unsigned u = __float_as_uint(f); return (bf16_t)((u + 0x7fffu + ((u >> 16) & 1u)) >> 16); }

constexpr int NB = 2, S = 8192, M = NB * S, D = 1024, F = 2816, HD = 64, DIN = 5656;
constexpr int NCMP = 511, NSLC = 128;
constexpr float LOG2E = 1.4426950408889634f;
constexpr float C2 = 0.125f * LOG2E;
constexpr float EPS = 1e-6f;

constexpr size_t MiB = 1u << 20;
constexpr size_t OFF_CTL = 0;
constexpr size_t OFF_SSQ = 1 * MiB;
constexpr size_t OFF_XB = 2 * MiB;
constexpr size_t OFF_A = 34 * MiB;
constexpr size_t OFF_B = 130 * MiB;
constexpr size_t OFF_Q16 = 162 * MiB;
constexpr size_t OFF_KV = 194 * MiB;
constexpr size_t KV2 = 4 * MiB, KV4 = 8 * MiB;
constexpr size_t OFF_KCMP = OFF_KV, OFF_VCMP = OFF_KCMP + KV2, OFF_KSLC = OFF_VCMP + KV2, OFF_VSLCT = OFF_KSLC + KV2,
                 OFF_KWIN = OFF_VSLCT + KV2, OFF_VWINT = OFF_KWIN + KV2, OFF_WK = OFF_VWINT + KV2, OFF_WVT = OFF_WK + KV2,
                 OFF_SBK = OFF_WVT + KV2, OFF_SBVT = OFF_SBK + KV4;
constexpr size_t OFF_SMALL = OFF_SBVT + KV4;
constexpr size_t OFF_NGATE = OFF_SMALL;
constexpr size_t OFF_KCN = OFF_NGATE + 2 * MiB;
constexpr size_t OFF_VCT = OFF_KCN + MiB / 4;
constexpr size_t OFF_HID = OFF_VCT + MiB / 4;
constexpr size_t OFF_BIASC = OFF_HID + 4 * MiB;
constexpr size_t WS_END = OFF_BIASC + MiB;

__device__ const unsigned char T5B[128] = {
    0, 1, 2, 3, 4, 5, 6, 7, 8, 9, 10, 11, 12, 13, 14, 15, 16, 16, 16, 17, 17, 18, 18, 18, 19, 19, 19, 20, 20, 20, 20, 21, 21, 21, 21, 22, 22, 22, 22, 22, 23, 23, 23, 23, 23, 23, 24, 24, 24, 24, 24, 24, 25, 25, 25, 25, 25, 25, 25, 26, 26, 26, 26, 26, 26, 26, 26, 27, 27, 27, 27, 27, 27, 27, 27, 27, 27, 28, 28, 28, 28, 28, 28, 28, 28, 28, 28, 29, 29, 29, 29, 29, 29, 29, 29, 29, 29, 29, 29, 30, 30, 30, 30, 30, 30, 30, 30, 30, 30, 30, 30, 30, 30, 31, 31, 31, 31, 31, 31, 31, 31, 31, 31, 31, 31, 31, 31, 31};
__device__ __forceinline__ int t5b(int dist) { return dist >= 128 ? 31 : (int)T5B[dist < 0 ? 0 : dist]; }

__device__ __forceinline__ float wave_sum(float v) {
#pragma unroll
    for (int o = 1; o < 64; o <<= 1) v += __shfl_xor(v, o);
    return v;
}
__device__ __forceinline__ float wave_max(float v) {
#pragma unroll
    for (int o = 1; o < 64; o <<= 1) v = fmaxf(v, __shfl_xor(v, o));
    return v;
}
__device__ __forceinline__ float sigmoidf_(float x) { return 1.f / (1.f + __expf(-x)); }
__device__ __forceinline__ float siluf_(float x) { return x / (1.f + __expf(-x)); }

__global__ void k_prep(const float* __restrict__ xin, float* X, bf16_t* XB, float* SSQ) {
    const int row = blockIdx.x * 4 + (threadIdx.x >> 6), lane = threadIdx.x & 63;
    float ss = 0.f;
    for (int j = 0; j < 16; ++j) {
        const int c = j * 64 + lane; const float v = xin[(size_t)row * D + c];
        if (X != xin) X[(size_t)row * D + c] = v;
        XB[(size_t)row * D + c] = f2bf(v); ss += v * v;
    }
    ss = wave_sum(ss);
    if (lane < 16) SSQ[(size_t)row * 16 + lane] = lane == 0 ? ss : 0.f;
}

struct GArgs {
    const bf16_t* A; int amode; int lda;
    const float* B0; const float* B1; const float* B2; int ldb;
    const float* wn; const float* ssq;
    int M, N, K;
    float* Cf; bf16_t* Cb; int ldc; float alpha;
    const bf16_t* g0; const bf16_t* g1; const bf16_t* g2;
    const float* bias;
};
template <int MODE> __global__ void __launch_bounds__(256) k_gemm(GArgs g) {
    __shared__ float As[16][68];
    __shared__ float Bs[16][68];
    __shared__ float Bs2[MODE == 0 ? 16 : 1][68];
    const int tid = threadIdx.x, tx = tid & 15, ty = tid >> 4;
    const int m0 = blockIdx.y * 64, n0 = blockIdx.x * 64;
    float acc[4][4], acc2[4][4];
#pragma unroll
    for (int i = 0; i < 4; ++i)
#pragma unroll
        for (int j = 0; j < 4; ++j) { acc[i][j] = 0.f; acc2[i][j] = 0.f; }
    for (int k0 = 0; k0 < g.K; k0 += 16) {
        if (MODE == 3 && (k0 == 512 || k0 == 768)) {
#pragma unroll
            for (int i = 0; i < 4; ++i)
#pragma unroll
                for (int j = 0; j < 4; ++j) {
                    const size_t o = (size_t)(m0 + ty * 4 + i) * D + n0 + tx * 4 + j;
                    const float num = bf2f(k0 == 512 ? g.g0[o] : g.g1[o]), den = bf2f(k0 == 512 ? g.g1[o] : g.g2[o]);
                    acc[i][j] *= num / den;
                }
        }
        {
            const int r = tid >> 2, kk = (tid & 3) * 4;
#pragma unroll
            for (int q = 0; q < 4; ++q) {
                const int m = m0 + r, k = k0 + kk + q; float v;
                if (g.amode == 0) v = bf2f(g.A[(size_t)m * g.lda + k]);
                else { const int b = m / S, s = m % S, hd = k >> 6, d = k & 63; v = bf2f(g.A[(((size_t)b * 16 + hd) * S + s) * 64 + d]); }
                As[kk + q][r] = v;
            }
        }
        {
            const int kr = tid >> 4, nn = (tid & 15) * 4; const int k = k0 + kr;
            const float* Bp = g.B0; int kb = k;
            if (MODE == 3) { if (k >= 768) { Bp = g.B2; kb = k - 768; } else if (k >= 512) { Bp = g.B1; kb = k - 512; } }
            const float w = g.wn ? g.wn[k] : 1.f;
#pragma unroll
            for (int q = 0; q < 4; ++q) {
                const int n = n0 + nn + q;
                Bs[kr][nn + q] = (n < g.N) ? w * Bp[(size_t)kb * g.ldb + n] : 0.f;
                if (MODE == 0) Bs2[kr][nn + q] = (n < g.N) ? w * g.B1[(size_t)kb * g.ldb + n] : 0.f;
            }
        }
        __syncthreads();
#pragma unroll
        for (int kk = 0; kk < 16; ++kk) {
            float a[4], b[4], b2[4];
#pragma unroll
            for (int i = 0; i < 4; ++i) a[i] = As[kk][ty * 4 + i];
#pragma unroll
            for (int j = 0; j < 4; ++j) { b[j] = Bs[kk][tx * 4 + j]; if (MODE == 0) b2[j] = Bs2[kk][tx * 4 + j]; }
#pragma unroll
            for (int i = 0; i < 4; ++i)
#pragma unroll
                for (int j = 0; j < 4; ++j) { acc[i][j] += a[i] * b[j]; if (MODE == 0) acc2[i][j] += a[i] * b2[j]; }
        }
        __syncthreads();
    }
#pragma unroll
    for (int i = 0; i < 4; ++i) {
        const int m = m0 + ty * 4 + i;
        float r = 1.f;
        if (g.ssq) { float s = 0.f; for (int q = 0; q < 16; ++q) s += g.ssq[(size_t)m * 16 + q]; r = rsqrtf(s * (1.f / D) + EPS); }
#pragma unroll
        for (int j = 0; j < 4; ++j) {
            const int n = n0 + tx * 4 + j; if (n >= g.N) continue;
            const size_t o = (size_t)m * g.ldc + n;
            if (MODE == 0) g.Cb[o] = f2bf(siluf_(r * acc[i][j]) * (r * acc2[i][j]));
            else if (MODE == 1) g.Cf[o] += g.alpha * acc[i][j];
            else if (MODE == 2) g.Cf[o] = r * acc[i][j];
            else if (MODE == 3) g.Cb[o] = f2bf(acc[i][j] * bf2f(g.g2[(size_t)m * D + n]));
            else if (MODE == 4) g.Cf[o] = siluf_(acc[i][j] + g.bias[n]);
        }
    }
}

struct XArgs {
    const float* T; int col0, ncols;
    const float *nsa_qn, *nsa_kn, *swa_qn, *swa_kn;
    unsigned char* ws;
};
__global__ void k_win_xform(XArgs a) {
    const int nsl = (a.ncols + 63) / 64;
    const int gw = blockIdx.x * 4 + (threadIdx.x >> 6), lane = threadIdx.x & 63;
    const int m = gw / nsl, sl = gw % nsl;
    if (m >= M) return;
    const int c0 = a.col0 + sl * 64;
    const int b = m / S, s = m % S;
    const bool valid = (sl * 64 + lane) < a.ncols;
    const float v = valid ? a.T[(size_t)m * a.ncols + sl * 64 + lane] : 0.f;
    auto rms = [&](const float* w) { const float ss = wave_sum(v * v); return v * rsqrtf(ss * (1.f / 64.f) + EPS) * w[lane]; };
    bf16_t* Q16 = (bf16_t*)(a.ws + OFF_Q16);
    auto kdst = [&](size_t off, int nh, int h) { return (bf16_t*)(a.ws + off) + (((size_t)b * nh + h) * S + s) * 64 + lane; };
    auto vtdst = [&](size_t off, int nh, int h) { return (bf16_t*)(a.ws + off) + (((size_t)b * nh + h) * 64 + lane) * S + s; };
    if (c0 < 512) { const int h = c0 / 64; Q16[(((size_t)b * 16 + h) * S + s) * 64 + lane] = f2bf(rms(a.nsa_qn) * C2); }
    else if (c0 < 640) { *kdst(OFF_KCMP, 2, (c0 - 512) / 64) = f2bf(v); }
    else if (c0 < 768) { *kdst(OFF_VCMP, 2, (c0 - 640) / 64) = f2bf(v); }
    else if (c0 < 896) { *kdst(OFF_KSLC, 2, (c0 - 768) / 64) = f2bf(rms(a.nsa_kn)); }
    else if (c0 < 1024) { *vtdst(OFF_VSLCT, 2, (c0 - 896) / 64) = f2bf(v); }
    else if (c0 < 1152) { *kdst(OFF_KWIN, 2, (c0 - 1024) / 64) = f2bf(rms(a.nsa_kn)); }
    else if (c0 < 1280) { *vtdst(OFF_VWINT, 2, (c0 - 1152) / 64) = f2bf(v); }
    else if (c0 < 1304) { if (lane < 24) ((float*)(a.ws + OFF_NGATE))[(size_t)m * 24 + lane] = sigmoidf_(v); }
    else if (c0 < 1560) { const int h = (c0 - 1304) / 64; Q16[(((size_t)b * 16 + 8 + h) * S + s) * 64 + lane] = f2bf(v * C2); }
    else if (c0 < 1816) { *kdst(OFF_SBK, 4, (c0 - 1560) / 64) = f2bf(v); }
    else if (c0 < 2072) { *vtdst(OFF_SBVT, 4, (c0 - 1816) / 64) = f2bf(v); }
    else if (c0 < 2328) { const int h = (c0 - 2072) / 64; Q16[(((size_t)b * 16 + 12 + h) * S + s) * 64 + lane] = f2bf(rms(a.swa_qn) * C2); }
    else if (c0 < 2456) { *kdst(OFF_WK, 2, (c0 - 2328) / 64) = f2bf(rms(a.swa_kn)); }
    else if (c0 < 2584) { *vtdst(OFF_WVT, 2, (c0 - 2456) / 64) = f2bf(v); }
    else { const int idx = c0 - 2584 + lane, br = idx / D, ch = idx % D; ((bf16_t*)(a.ws + OFF_A))[((size_t)br * M + m) * D + ch] = f2bf(sigmoidf_(v)); }
}

__global__ void k_cmp_bias(const float* pos, const float* w1k, const float* w1v, float* biasc) {
    const int kv = blockIdx.x, j = threadIdx.x; const float* w1 = kv ? w1v : w1k;
    float s = 0.f; for (int k = 0; k < 2048; ++k) s += pos[k] * w1[(size_t)k * 256 + j];
    biasc[kv * 256 + j] = s;
}
__global__ void k_cmp2(const float* hid, const float* w2k, const float* w2v, const float* knorm, bf16_t* KCN, bf16_t* VCT) {
    const int gw = blockIdx.x * 4 + (threadIdx.x >> 6), lane = threadIdx.x & 63;
    const int kv = gw / 2048, R = gw % 2048, grp = R / 512, n = R % 512;
    const float* h = hid + ((size_t)kv * 2048 + R) * 256; const float* w2 = kv ? w2v : w2k;
    float s = 0.f; for (int k = 0; k < 256; ++k) s += h[k] * w2[k * 64 + lane];
    if (n >= NCMP) s = 0.f;
    if (kv == 0) { const float ss = wave_sum(s * s); KCN[((size_t)grp * 512 + n) * 64 + lane] = f2bf(s * rsqrtf(ss * (1.f / 64.f) + EPS) * knorm[lane]); }
    else VCT[((size_t)grp * 64 + lane) * 512 + n] = f2bf(s);
}

__global__ void __launch_bounds__(256) k_nsa(unsigned char* ws, const float* rel_bias) {
    __shared__ float q[4][64];
    __shared__ float sc[4][512];
    __shared__ float ss[4][1024];
    __shared__ float imp[128];
    __shared__ float scoreS[128];
    __shared__ int sel[16];
    __shared__ float red[4][2];
    const int tid = threadIdx.x, lane = tid & 63, w = tid >> 6;
    const int t = blockIdx.x % S, g = (blockIdx.x / S) % 2, b = blockIdx.x / (2 * S);
    const int grp = b * 2 + g, h = g * 4 + w;
    bf16_t* Q16 = (bf16_t*)(ws + OFF_Q16);
    const bf16_t* KCN = (const bf16_t*)(ws + OFF_KCN); const bf16_t* VCT = (const bf16_t*)(ws + OFF_VCT);
    const bf16_t* KS = (const bf16_t*)(ws + OFF_KSLC) + (size_t)grp * S * 64; const bf16_t* VST = (const bf16_t*)(ws + OFF_VSLCT) + (size_t)grp * 64 * S;
    const bf16_t* KW = (const bf16_t*)(ws + OFF_KWIN) + (size_t)grp * S * 64; const bf16_t* VWT = (const bf16_t*)(ws + OFF_VWINT) + (size_t)grp * 64 * S;
    const float* NG = (const float*)(ws + OFF_NGATE) + (size_t)(b * S + t) * 24;
    const size_t qoff = (((size_t)b * 16 + h) * S + t) * 64 + lane;
    q[w][lane] = bf2f(Q16[qoff]);
    __syncthreads();
    const int nvalid = t >= 31 ? (t - 31) / 16 + 1 : 0;
    for (int n = tid; n < 512; n += 256) {
        if (n < nvalid) {
            float d0 = 0.f, d1 = 0.f, d2 = 0.f, d3 = 0.f;
            for (int d = 0; d < 64; ++d) { const float kv = bf2f(KCN[((size_t)grp * 512 + n) * 64 + d]); d0 += q[0][d] * kv; d1 += q[1][d] * kv; d2 += q[2][d] * kv; d3 += q[3][d] * kv; }
            const int bk = t5b(t - (16 * n + 31));
            sc[0][n] = d0 + rel_bias[bk * 12 + g * 4 + 0] * LOG2E; sc[1][n] = d1 + rel_bias[bk * 12 + g * 4 + 1] * LOG2E;
            sc[2][n] = d2 + rel_bias[bk * 12 + g * 4 + 2] * LOG2E; sc[3][n] = d3 + rel_bias[bk * 12 + g * 4 + 3] * LOG2E;
        } else { sc[0][n] = 0.f; sc[1][n] = 0.f; sc[2][n] = 0.f; sc[3][n] = 0.f; }
    }
    __syncthreads();
    {
        float mx = -INFINITY; for (int n = lane; n < nvalid; n += 64) mx = fmaxf(mx, sc[w][n]);
        mx = wave_max(mx);
        float sm = 0.f; for (int n = lane; n < nvalid; n += 64) { const float e = exp2f(sc[w][n] - mx); sc[w][n] = e; sm += e; }
        sm = wave_sum(sm);
        const float inv = nvalid > 0 ? 1.f / sm : 0.f;
        for (int n = lane; n < 512; n += 64) sc[w][n] = n < nvalid ? sc[w][n] * inv : 0.f;
    }
    __syncthreads();
    float o_c = 0.f;
    for (int n = 0; n < nvalid; ++n) o_c += sc[w][n] * bf2f(VCT[((size_t)grp * 64 + lane) * 512 + n]);
    const int cur = t / 64;
    if (tid < 128) {
        const int j = tid; float s = 0.f;
        for (int n = 4 * j - 1; n <= 4 * j + 3; ++n) if (n >= 0 && n < NCMP) s += sc[0][n] + sc[1][n] + sc[2][n] + sc[3][n];
        imp[j] = s;
        const bool forced = (j == 0) || (j == cur) || (j == cur - 1);
        scoreS[j] = forced ? 1e4f : (j <= cur ? s : -1.0f);
    }
    __syncthreads();
    if (tid < 128) {
        const int j = tid; const float sj = scoreS[j]; int rank = 0;
        for (int k = 0; k < 128; ++k) { const float sk = scoreS[k]; rank += (sk > sj) || (sk == sj && k < j); }
        if (rank < 16) sel[rank] = j;
    }
    __syncthreads();
    float o_s = 0.f;
    {
        float mx = -INFINITY;
        for (int i = 0; i < 16; ++i) {
            const int j = sel[i]; const int pos = j * 64 + lane; float s = -INFINITY;
            if (j <= cur && pos <= t) {
                float d0 = 0.f; for (int d = 0; d < 64; ++d) d0 += q[w][d] * bf2f(KS[(size_t)pos * 64 + d]);
                s = d0 + rel_bias[t5b(t - pos) * 12 + h] * LOG2E;
            }
            ss[w][i * 64 + lane] = s; mx = fmaxf(mx, s);
        }
        mx = wave_max(mx);
        float sm = 0.f;
        for (int i = 0; i < 16; ++i) { const float s = ss[w][i * 64 + lane]; const float e = (s == -INFINITY) ? 0.f : exp2f(s - mx); ss[w][i * 64 + lane] = e; sm += e; }
        sm = wave_sum(sm);
        for (int i = 0; i < 16; ++i) { const int j = sel[i]; if (j > cur) continue;
            for (int k = 0; k < 64; ++k) { const float p = ss[w][i * 64 + k]; if (p != 0.f) o_s += p * bf2f(VST[(size_t)lane * S + j * 64 + k]); } }
        o_s /= sm;
    }
    float o_w = 0.f;
    {
        const int lo = t - 511; float mx = -INFINITY;
        for (int c = 0; c < 8; ++c) {
            const int pos = lo + c * 64 + lane; float s = -INFINITY;
            if (pos >= 0) { float d0 = 0.f; for (int d = 0; d < 64; ++d) d0 += q[w][d] * bf2f(KW[(size_t)pos * 64 + d]); s = d0 + rel_bias[t5b(t - pos) * 12 + h] * LOG2E; }
            ss[w][c * 64 + lane] = s; mx = fmaxf(mx, s);
        }
        mx = wave_max(mx);
        float sm = 0.f;
        for (int c = 0; c < 8; ++c) { const float s = ss[w][c * 64 + lane]; const float e = (s == -INFINITY) ? 0.f : exp2f(s - mx); ss[w][c * 64 + lane] = e; sm += e; }
        sm = wave_sum(sm);
        for (int k = 0; k < 512; ++k) { const int pos = lo + k; if (pos < 0) continue; o_w += ss[w][k] * bf2f(VWT[(size_t)lane * S + pos]); }
        o_w /= sm;
    }
    const float out = NG[h] * o_c + NG[8 + h] * o_s + NG[16 + h] * o_w;
    Q16[qoff] = f2bf(out);
}

__global__ void __launch_bounds__(256) k_sb(unsigned char* ws) {
    __shared__ float qs[4][64];
    const int lane = threadIdx.x & 63, w = threadIdx.x >> 6;
    const int gw = blockIdx.x * 4 + w; const int t = gw % S, h = (gw / S) % 4, b = gw / (4 * S);
    bf16_t* Q16 = (bf16_t*)(ws + OFF_Q16);
    const bf16_t* K = (const bf16_t*)(ws + OFF_SBK) + ((size_t)b * 4 + h) * S * 64; const bf16_t* VT = (const bf16_t*)(ws + OFF_SBVT) + ((size_t)b * 4 + h) * 64 * S;
    const size_t qoff = (((size_t)b * 16 + 8 + h) * S + t) * 64 + lane;
    qs[w][lane] = bf2f(Q16[qoff]);
    __syncthreads();
    float carry = 0.f, o = 0.f;
    for (int hi = t; hi > 0; hi -= 64) {
        const int pos = hi - 64 + lane; const bool ok = pos >= 0;
        float z = 0.f;
        if (ok) for (int d = 0; d < 64; ++d) z += qs[w][d] * bf2f(K[(size_t)pos * 64 + d]);
        const float sp = fmaxf(z, 0.f) + log2f(1.f + exp2f(-fabsf(z)));
        const float lf = ok ? -sp : 0.f; const float ls = z + lf;
        float suf = lf;
#pragma unroll
        for (int o2 = 1; o2 < 64; o2 <<= 1) { const float tmp = __shfl_down(suf, o2); if (lane + o2 < 64) suf += tmp; }
        const float after = carry + suf - lf;
        const float wgt = ok ? exp2f(ls + after) : 0.f;
        for (int L = 0; L < 64; ++L) { const float wl = __shfl(wgt, L); const int p = hi - 64 + L; if (p >= 0) o += wl * bf2f(VT[(size_t)lane * S + p]); }
        carry += __shfl(suf, 0);
    }
    Q16[qoff] = f2bf(o);
}

__global__ void __launch_bounds__(256) k_swa(unsigned char* ws, const float* rel_bias, const float* sinks) {
    __shared__ float qs[4][64];
    __shared__ float es[4][128];
    const int lane = threadIdx.x & 63, w = threadIdx.x >> 6;
    const int gw = blockIdx.x * 4 + w; const int t = gw % S, h = (gw / S) % 4, b = gw / (4 * S), g = h / 2;
    bf16_t* Q16 = (bf16_t*)(ws + OFF_Q16);
    const bf16_t* K = (const bf16_t*)(ws + OFF_WK) + ((size_t)b * 2 + g) * S * 64; const bf16_t* VT = (const bf16_t*)(ws + OFF_WVT) + ((size_t)b * 2 + g) * 64 * S;
    const size_t qoff = (((size_t)b * 16 + 12 + h) * S + t) * 64 + lane;
    qs[w][lane] = bf2f(Q16[qoff]);
    __syncthreads();
    const float sink = sinks[h] * LOG2E;
    float mx = sink; const int lo = t - 127;
    for (int c = 0; c < 2; ++c) {
        const int pos = lo + c * 64 + lane; float s = -INFINITY;
        if (pos >= 0) { float d0 = 0.f; for (int d = 0; d < 64; ++d) d0 += qs[w][d] * bf2f(K[(size_t)pos * 64 + d]); s = d0 + rel_bias[t5b(t - pos) * 12 + 8 + h] * LOG2E; }
        es[w][c * 64 + lane] = s; mx = fmaxf(mx, s);
    }
    mx = wave_max(mx);
    float sm = 0.f;
    for (int c = 0; c < 2; ++c) { const float s = es[w][c * 64 + lane]; const float e = (s == -INFINITY) ? 0.f : exp2f(s - mx); es[w][c * 64 + lane] = e; sm += e; }
    sm = wave_sum(sm) + exp2f(sink - mx);
    float o = 0.f;
    for (int k = 0; k < 128; ++k) { const int pos = lo + k; if (pos < 0) continue; o += es[w][k] * bf2f(VT[(size_t)lane * S + pos]); }
    Q16[qoff] = f2bf(o / sm);
}

extern "C" void kernel_launch(void* const* d_in, const int* in_sizes, int n_in, void* d_out, int out_size, void* d_ws, size_t ws_size, hipStream_t stream) {
    if (ws_size < WS_END || n_in != 26) return;
    const float* x = (const float*)d_in[0]; const float* rel_bias = (const float*)d_in[1];
    float* X = (float*)d_out; unsigned char* ws = (unsigned char*)d_ws;
    bf16_t* XB = (bf16_t*)(ws + OFF_XB); float* SSQ = (float*)(ws + OFF_SSQ);
    bf16_t* H = (bf16_t*)(ws + OFF_A); bf16_t* GATES = (bf16_t*)(ws + OFF_A);
    float* T = (float*)(ws + OFF_B); bf16_t* MERGED = (bf16_t*)(ws + OFF_B);
    bf16_t* Q16 = (bf16_t*)(ws + OFF_Q16);
    k_prep<<<M / 4, 256, 0, stream>>>(x, X, XB, SSQ);
    auto ffn = [&](const float* nw, const float* wg, const float* wu, const float* wd) {
        GArgs g{}; g.A = XB; g.amode = 0; g.lda = D; g.B0 = wg; g.B1 = wu; g.ldb = F; g.wn = nw; g.ssq = SSQ; g.M = M; g.N = F; g.K = D; g.Cb = H; g.ldc = F;
        k_gemm<0><<<dim3(F / 64, M / 64), 256, 0, stream>>>(g);
        GArgs d{}; d.A = H; d.amode = 0; d.lda = F; d.B0 = wd; d.ldb = D; d.M = M; d.N = D; d.K = F; d.Cf = X; d.ldc = D; d.alpha = 0.5f;
        k_gemm<1><<<dim3(D / 64, M / 64), 256, 0, stream>>>(d);
        k_prep<<<M / 4, 256, 0, stream>>>(X, X, XB, SSQ);
    };
    for (int l = 0; l < 2; ++l) {
        ffn((const float*)d_in[2] + (size_t)l * D, (const float*)d_in[3] + (size_t)l * D * F, (const float*)d_in[4] + (size_t)l * D * F, (const float*)d_in[5] + (size_t)l * F * D);
        const float* win = (const float*)d_in[7] + (size_t)l * D * DIN; const float* mixn = (const float*)d_in[6] + (size_t)l * D;
        const int c0s[13] = {0, 512, 1024, 1280, 1304, 1816, 2328, 2584, 3096, 3608, 4120, 4632, 5144};
        const int ncs[13] = {512, 512, 256, 24, 512, 512, 256, 512, 512, 512, 512, 512, 512};
        for (int c = 0; c < 13; ++c) {
            GArgs g{}; g.A = XB; g.amode = 0; g.lda = D; g.B0 = win + c0s[c]; g.ldb = DIN; g.wn = mixn; g.ssq = SSQ; g.M = M; g.N = ncs[c]; g.K = D; g.Cf = T; g.ldc = ncs[c];
            k_gemm<2><<<dim3((ncs[c] + 63) / 64, M / 64), 256, 0, stream>>>(g);
            XArgs xa{}; xa.T = T; xa.col0 = c0s[c]; xa.ncols = ncs[c]; xa.nsa_qn = (const float*)d_in[8] + l * 64; xa.nsa_kn = (const float*)d_in[9] + l * 64;
            xa.swa_qn = (const float*)d_in[15] + l * 64; xa.swa_kn = (const float*)d_in[16] + l * 64; xa.ws = ws;
            const int nsl = (ncs[c] + 63) / 64;
            k_win_xform<<<(M * nsl + 3) / 4, 256, 0, stream>>>(xa);
        }
        const float* w1k = (const float*)d_in[11] + (size_t)l * 2048 * 256; const float* w1v = (const float*)d_in[13] + (size_t)l * 2048 * 256;
        const float* w2k = (const float*)d_in[12] + (size_t)l * 256 * 64; const float* w2v = (const float*)d_in[14] + (size_t)l * 256 * 64;
        float* BIASC = (float*)(ws + OFF_BIASC); float* HID = (float*)(ws + OFF_HID);
        k_cmp_bias<<<2, 256, 0, stream>>>((const float*)d_in[10] + (size_t)l * 2048, w1k, w1v, BIASC);
        for (int kv = 0; kv < 2; ++kv) {
            GArgs g{}; g.A = (const bf16_t*)(ws + (kv ? OFF_VCMP : OFF_KCMP)); g.amode = 0; g.lda = 1024; g.B0 = kv ? w1v : w1k; g.ldb = 256; g.M = 2048; g.N = 256; g.K = 2048;
            g.Cf = HID + (size_t)kv * 2048 * 256; g.ldc = 256; g.bias = BIASC + kv * 256;
            k_gemm<4><<<dim3(4, 32), 256, 0, stream>>>(g);
        }
        k_cmp2<<<4096 / 4, 256, 0, stream>>>(HID, w2k, w2v, (const float*)d_in[9] + l * 64, (bf16_t*)(ws + OFF_KCN), (bf16_t*)(ws + OFF_VCT));
        k_nsa<<<NB * 2 * S, 256, 0, stream>>>(ws, rel_bias);
        k_sb<<<NB * 4 * S / 4, 256, 0, stream>>>(ws);
        k_swa<<<NB * 4 * S / 4, 256, 0, stream>>>(ws, rel_bias, (const float*)d_in[17] + l * 4);
        {
            GArgs g{}; g.A = Q16; g.amode = 1; g.B0 = (const float*)d_in[18] + (size_t)l * 512 * D; g.B1 = (const float*)d_in[19] + (size_t)l * 256 * D; g.B2 = (const float*)d_in[20] + (size_t)l * 256 * D;
            g.ldb = D; g.M = M; g.N = D; g.K = D; g.Cb = MERGED; g.ldc = D; g.g0 = GATES; g.g1 = GATES + (size_t)M * D; g.g2 = GATES + (size_t)2 * M * D;
            k_gemm<3><<<dim3(D / 64, M / 64), 256, 0, stream>>>(g);
            GArgs o{}; o.A = MERGED; o.amode = 0; o.lda = D; o.B0 = (const float*)d_in[21] + (size_t)l * D * D; o.ldb = D; o.M = M; o.N = D; o.K = D; o.Cf = X; o.ldc = D; o.alpha = 1.f;
            k_gemm<1><<<dim3(D / 64, M / 64), 256, 0, stream>>>(o);
            k_prep<<<M / 4, 256, 0, stream>>>(X, X, XB, SSQ);
        }
        ffn((const float*)d_in[22] + (size_t)l * D, (const float*)d_in[23] + (size_t)l * D * F, (const float*)d_in[24] + (size_t)l * D * F, (const float*)d_in[25] + (size_t)l * F * D);
    }
}
```

```cpp
#include <hip/hip_runtime.h>
#include <hip/hip_cooperative_groups.h>
#include <stdint.h>
#include <cstdio>
namespace cg = cooperative_groups;
#define VB_SETUP const int tid = threadIdx.x & 255, vhalf = threadIdx.x >> 8; const int vb0 = blockIdx.x * 2 + vhalf, nvb = gridDim.x * 2; char* lds = lds_base + vhalf * 32768; (void)tid; (void)lds; (void)vb0; (void)nvb

typedef unsigned short bf16_t;
__device__ __forceinline__ float bf2f(bf16_t v) { return __uint_as_float(((unsigned)v) << 16); }
__device__ __forceinline__ bf16_t f2bf(float f) { unsigned u = __float_as_uint(f); return (bf16_t)((u + 0x7fffu + ((u >> 16) & 1u)) >> 16); }

constexpr int NB = 2, S = 8192, M = NB * S, D = 1024, F = 2816, HD = 64, DIN = 5656;
constexpr int NCMP = 511, NSLC = 128;
constexpr float LOG2E = 1.4426950408889634f;
constexpr float C2 = 0.125f * LOG2E;
constexpr float EPS = 1e-6f;

constexpr size_t MiB = 1u << 20;
constexpr size_t OFF_CTL = 0;
constexpr size_t OFF_SSQ = 1 * MiB;
constexpr size_t OFF_XB = 2 * MiB;
constexpr size_t OFF_A = 34 * MiB;
constexpr size_t OFF_B = 130 * MiB;
constexpr size_t OFF_Q16 = 162 * MiB;
constexpr size_t OFF_KV = 194 * MiB;
constexpr size_t KV2 = 4 * MiB, KV4 = 8 * MiB;
constexpr size_t OFF_KCMP = OFF_KV, OFF_VCMP = OFF_KCMP + KV2, OFF_KSLC = OFF_VCMP + KV2, OFF_VSLCT = OFF_KSLC + KV2,
                 OFF_KWIN = OFF_VSLCT + KV2, OFF_VWINT = OFF_KWIN + KV2, OFF_WK = OFF_VWINT + KV2, OFF_WVT = OFF_WK + KV2,
                 OFF_SBK = OFF_WVT + KV2, OFF_SBVT = OFF_SBK + KV4;
constexpr size_t OFF_SMALL = OFF_SBVT + KV4;
constexpr size_t OFF_NGATE = OFF_SMALL;
constexpr size_t OFF_KCN = OFF_NGATE + 2 * MiB;
constexpr size_t OFF_VCT = OFF_KCN + MiB / 4;
constexpr size_t OFF_HID = OFF_VCT + MiB / 4;
constexpr size_t OFF_BIASC = OFF_HID + 4 * MiB;
constexpr size_t WS_END = OFF_BIASC + MiB;

__device__ const unsigned char T5B[128] = {
    0, 1, 2, 3, 4, 5, 6, 7, 8, 9, 10, 11, 12, 13, 14, 15, 16, 16, 16, 17, 17, 18, 18, 18, 19, 19, 19, 20, 20, 20, 20, 21, 21, 21, 21, 22, 22, 22, 22, 22, 23, 23, 23, 23, 23, 23, 24, 24, 24, 24, 24, 24, 25, 25, 25, 25, 25, 25, 25, 26, 26, 26, 26, 26, 26, 26, 26, 27, 27, 27, 27, 27, 27, 27, 27, 27, 27, 28, 28, 28, 28, 28, 28, 28, 28, 28, 28, 29, 29, 29, 29, 29, 29, 29, 29, 29, 29, 29, 29, 30, 30, 30, 30, 30, 30, 30, 30, 30, 30, 30, 30, 30, 30, 31, 31, 31, 31, 31, 31, 31, 31, 31, 31, 31, 31, 31, 31, 31};
__device__ __forceinline__ int t5b(int dist) { return dist >= 128 ? 31 : (int)T5B[dist < 0 ? 0 : dist]; }

__device__ __forceinline__ float wave_sum(float v) {
#pragma unroll
    for (int o = 1; o < 64; o <<= 1) v += __shfl_xor(v, o);
    return v;
}
__device__ __forceinline__ float wave_max(float v) {
#pragma unroll
    for (int o = 1; o < 64; o <<= 1) v = fmaxf(v, __shfl_xor(v, o));
    return v;
}
__device__ __forceinline__ float sigmoidf_(float x) { return 1.f / (1.f + __expf(-x)); }
__device__ __forceinline__ float siluf_(float x) { return x / (1.f + __expf(-x)); }

__device__ __forceinline__ void ph_prep(char* lds_base, const float* xin, float* X, bf16_t* XB, float* SSQ) {
    VB_SETUP;
    for (int item = vb0; item < M / 4; item += nvb) {
    const int row = item * 4 + (tid >> 6), lane = tid & 63;
    float ss = 0.f;
    for (int j = 0; j < 16; ++j) {
        const int c = j * 64 + lane; const float v = xin[(size_t)row * D + c];
        if (X != xin) X[(size_t)row * D + c] = v;
        XB[(size_t)row * D + c] = f2bf(v); ss += v * v;
    }
    ss = wave_sum(ss);
    if (lane < 16) SSQ[(size_t)row * 16 + lane] = lane == 0 ? ss : 0.f;
    }
}

struct GArgs {
    const bf16_t* A; int amode; int lda;
    const float* B0; const float* B1; const float* B2; int ldb;
    const float* wn; const float* ssq;
    int M, N, K;
    float* Cf; bf16_t* Cb; int ldc; float alpha;
    const bf16_t* g0; const bf16_t* g1; const bf16_t* g2;
    const float* bias;
};
template <int MODE> __device__ __forceinline__ void ph_gemm(char* lds_base, const GArgs& g) {
    VB_SETUP;
    typedef float row68[68];
    row68* As = (row68*)lds; row68* Bs = (row68*)(lds + 16 * 68 * 4); row68* Bs2 = (row68*)(lds + 32 * 68 * 4);
    const int tx = tid & 15, ty = tid >> 4;
    const int gx = (g.N + 63) / 64, nitems = gx * (g.M / 64);
    for (int item = vb0; item < nitems; item += nvb) {
    const int m0 = (item / gx) * 64, n0 = (item % gx) * 64;
    float acc[4][4], acc2[4][4];
#pragma unroll
    for (int i = 0; i < 4; ++i)
#pragma unroll
        for (int j = 0; j < 4; ++j) { acc[i][j] = 0.f; acc2[i][j] = 0.f; }
    for (int k0 = 0; k0 < g.K; k0 += 16) {
        if (MODE == 3 && (k0 == 512 || k0 == 768)) {
#pragma unroll
            for (int i = 0; i < 4; ++i)
#pragma unroll
                for (int j = 0; j < 4; ++j) {
                    const size_t o = (size_t)(m0 + ty * 4 + i) * D + n0 + tx * 4 + j;
                    const float num = bf2f(k0 == 512 ? g.g0[o] : g.g1[o]), den = bf2f(k0 == 512 ? g.g1[o] : g.g2[o]);
                    acc[i][j] *= num / den;
                }
        }
        {
            const int r = tid >> 2, kk = (tid & 3) * 4;
#pragma unroll
            for (int q = 0; q < 4; ++q) {
                const int m = m0 + r, k = k0 + kk + q; float v;
                if (g.amode == 0) v = bf2f(g.A[(size_t)m * g.lda + k]);
                else { const int b = m / S, s = m % S, hd = k >> 6, d = k & 63; v = bf2f(g.A[(((size_t)b * 16 + hd) * S + s) * 64 + d]); }
                As[kk + q][r] = v;
            }
        }
        {
            const int kr = tid >> 4, nn = (tid & 15) * 4; const int k = k0 + kr;
            const float* Bp = g.B0; int kb = k;
            if (MODE == 3) { if (k >= 768) { Bp = g.B2; kb = k - 768; } else if (k >= 512) { Bp = g.B1; kb = k - 512; } }
            const float w = g.wn ? g.wn[k] : 1.f;
#pragma unroll
            for (int q = 0; q < 4; ++q) {
                const int n = n0 + nn + q;
                Bs[kr][nn + q] = (n < g.N) ? w * Bp[(size_t)kb * g.ldb + n] : 0.f;
                if (MODE == 0) Bs2[kr][nn + q] = (n < g.N) ? w * g.B1[(size_t)kb * g.ldb + n] : 0.f;
            }
        }
        __syncthreads();
#pragma unroll 2
        for (int kk = 0; kk < 16; ++kk) {
            float a[4], b[4], b2[4];
#pragma unroll
            for (int i = 0; i < 4; ++i) a[i] = As[kk][ty * 4 + i];
#pragma unroll
            for (int j = 0; j < 4; ++j) { b[j] = Bs[kk][tx * 4 + j]; if (MODE == 0) b2[j] = Bs2[kk][tx * 4 + j]; }
#pragma unroll
            for (int i = 0; i < 4; ++i)
#pragma unroll
                for (int j = 0; j < 4; ++j) { acc[i][j] += a[i] * b[j]; if (MODE == 0) acc2[i][j] += a[i] * b2[j]; }
        }
        __syncthreads();
    }
#pragma unroll
    for (int i = 0; i < 4; ++i) {
        const int m = m0 + ty * 4 + i;
        float r = 1.f;
        if (g.ssq) { float s = 0.f; for (int q = 0; q < 16; ++q) s += g.ssq[(size_t)m * 16 + q]; r = rsqrtf(s * (1.f / D) + EPS); }
#pragma unroll
        for (int j = 0; j < 4; ++j) {
            const int n = n0 + tx * 4 + j; if (n >= g.N) continue;
            const size_t o = (size_t)m * g.ldc + n;
            if (MODE == 0) g.Cb[o] = f2bf(siluf_(r * acc[i][j]) * (r * acc2[i][j]));
            else if (MODE == 1) g.Cf[o] += g.alpha * acc[i][j];
            else if (MODE == 2) g.Cf[o] = r * acc[i][j];
            else if (MODE == 3) g.Cb[o] = f2bf(acc[i][j] * bf2f(g.g2[(size_t)m * D + n]));
            else if (MODE == 4) g.Cf[o] = siluf_(acc[i][j] + g.bias[n]);
        }
    }
    __syncthreads();
    }
}

struct XArgs {
    const float* T; int col0, ncols;
    const float *nsa_qn, *nsa_kn, *swa_qn, *swa_kn;
    unsigned char* ws;
};
__device__ __forceinline__ void ph_xform(char* lds_base, const XArgs& a) {
    VB_SETUP;
    const int nsl = (a.ncols + 63) / 64;
    for (int item = vb0; item < (M * nsl + 3) / 4; item += nvb) {
    const int gw = item * 4 + (tid >> 6), lane = tid & 63;
    const int m = gw / nsl, sl = gw % nsl;
    if (m >= M) continue;
    const int c0 = a.col0 + sl * 64;
    const int b = m / S, s = m % S;
    const bool valid = (sl * 64 + lane) < a.ncols;
    const float v = valid ? a.T[(size_t)m * a.ncols + sl * 64 + lane] : 0.f;
    auto rms = [&](const float* w) { const float ss = wave_sum(v * v); return v * rsqrtf(ss * (1.f / 64.f) + EPS) * w[lane]; };
    bf16_t* Q16 = (bf16_t*)(a.ws + OFF_Q16);
    auto kdst = [&](size_t off, int nh, int h) { return (bf16_t*)(a.ws + off) + (((size_t)b * nh + h) * S + s) * 64 + lane; };
    auto vtdst = [&](size_t off, int nh, int h) { return (bf16_t*)(a.ws + off) + (((size_t)b * nh + h) * 64 + lane) * S + s; };
    if (c0 < 512) { const int h = c0 / 64; Q16[(((size_t)b * 16 + h) * S + s) * 64 + lane] = f2bf(rms(a.nsa_qn) * C2); }
    else if (c0 < 640) { *kdst(OFF_KCMP, 2, (c0 - 512) / 64) = f2bf(v); }
    else if (c0 < 768) { *kdst(OFF_VCMP, 2, (c0 - 640) / 64) = f2bf(v); }
    else if (c0 < 896) { *kdst(OFF_KSLC, 2, (c0 - 768) / 64) = f2bf(rms(a.nsa_kn)); }
    else if (c0 < 1024) { *vtdst(OFF_VSLCT, 2, (c0 - 896) / 64) = f2bf(v); }
    else if (c0 < 1152) { *kdst(OFF_KWIN, 2, (c0 - 1024) / 64) = f2bf(rms(a.nsa_kn)); }
    else if (c0 < 1280) { *vtdst(OFF_VWINT, 2, (c0 - 1152) / 64) = f2bf(v); }
    else if (c0 < 1304) { if (lane < 24) ((float*)(a.ws + OFF_NGATE))[(size_t)m * 24 + lane] = sigmoidf_(v); }
    else if (c0 < 1560) { const int h = (c0 - 1304) / 64; Q16[(((size_t)b * 16 + 8 + h) * S + s) * 64 + lane] = f2bf(v * C2); }
    else if (c0 < 1816) { *kdst(OFF_SBK, 4, (c0 - 1560) / 64) = f2bf(v); }
    else if (c0 < 2072) { *vtdst(OFF_SBVT, 4, (c0 - 1816) / 64) = f2bf(v); }
    else if (c0 < 2328) { const int h = (c0 - 2072) / 64; Q16[(((size_t)b * 16 + 12 + h) * S + s) * 64 + lane] = f2bf(rms(a.swa_qn) * C2); }
    else if (c0 < 2456) { *kdst(OFF_WK, 2, (c0 - 2328) / 64) = f2bf(rms(a.swa_kn)); }
    else if (c0 < 2584) { *vtdst(OFF_WVT, 2, (c0 - 2456) / 64) = f2bf(v); }
    else { const int idx = c0 - 2584 + lane, br = idx / D, ch = idx % D; ((bf16_t*)(a.ws + OFF_A))[((size_t)br * M + m) * D + ch] = f2bf(sigmoidf_(v)); }
    }
}

__device__ __forceinline__ void ph_cmp_bias(char* lds_base, const float* pos, const float* w1k, const float* w1v, float* biasc) {
    VB_SETUP;
    for (int item = vb0; item < 2; item += nvb) {
    const int kv = item, j = tid; const float* w1 = kv ? w1v : w1k;
    float s = 0.f; for (int k = 0; k < 2048; ++k) s += pos[k] * w1[(size_t)k * 256 + j];
    biasc[kv * 256 + j] = s;
    }
}
__device__ __forceinline__ void ph_cmp2(char* lds_base, const float* hid, const float* w2k, const float* w2v, const float* knorm, bf16_t* KCN, bf16_t* VCT) {
    VB_SETUP;
    for (int item = vb0; item < 1024; item += nvb) {
    const int gw = item * 4 + (tid >> 6), lane = tid & 63;
    const int kv = gw / 2048, R = gw % 2048, grp = R / 512, n = R % 512;
    const float* h = hid + ((size_t)kv * 2048 + R) * 256; const float* w2 = kv ? w2v : w2k;
    float s = 0.f; for (int k = 0; k < 256; ++k) s += h[k] * w2[k * 64 + lane];
    if (n >= NCMP) s = 0.f;
    if (kv == 0) { const float ss = wave_sum(s * s); KCN[((size_t)grp * 512 + n) * 64 + lane] = f2bf(s * rsqrtf(ss * (1.f / 64.f) + EPS) * knorm[lane]); }
    else VCT[((size_t)grp * 64 + lane) * 512 + n] = f2bf(s);
    }
}

__device__ __forceinline__ void ph_nsa(char* lds_base, unsigned char* ws, const float* rel_bias) {
    VB_SETUP;
    typedef float row64[64]; typedef float row512[512]; typedef float row1024[1024];
    row64* q = (row64*)lds; row512* sc = (row512*)(lds + 1024); row1024* ss = (row1024*)(lds + 1024 + 8192);
    float* imp = (float*)(lds + 1024 + 8192 + 16384); float* scoreS = imp + 128; int* sel = (int*)(scoreS + 128);
    const int lane = tid & 63, w = tid >> 6;
    for (int item = vb0; item < NB * 2 * S; item += nvb) {
    const int t = item % S, g = (item / S) % 2, b = item / (2 * S);
    const int grp = b * 2 + g, h = g * 4 + w;
    bf16_t* Q16 = (bf16_t*)(ws + OFF_Q16);
    const bf16_t* KCN = (const bf16_t*)(ws + OFF_KCN); const bf16_t* VCT = (const bf16_t*)(ws + OFF_VCT);
    const bf16_t* KS = (const bf16_t*)(ws + OFF_KSLC) + (size_t)grp * S * 64; const bf16_t* VST = (const bf16_t*)(ws + OFF_VSLCT) + (size_t)grp * 64 * S;
    const bf16_t* KW = (const bf16_t*)(ws + OFF_KWIN) + (size_t)grp * S * 64; const bf16_t* VWT = (const bf16_t*)(ws + OFF_VWINT) + (size_t)grp * 64 * S;
    const float* NG = (const float*)(ws + OFF_NGATE) + (size_t)(b * S + t) * 24;
    const size_t qoff = (((size_t)b * 16 + h) * S + t) * 64 + lane;
    q[w][lane] = bf2f(Q16[qoff]);
    __syncthreads();
    const int nvalid = t >= 31 ? (t - 31) / 16 + 1 : 0;
    for (int n = tid; n < 512; n += 256) {
        if (n < nvalid) {
            float d0 = 0.f, d1 = 0.f, d2 = 0.f, d3 = 0.f;
            _Pragma("unroll 4") for (int d = 0; d < 64; ++d) { const float kv = bf2f(KCN[((size_t)grp * 512 + n) * 64 + d]); d0 += q[0][d] * kv; d1 += q[1][d] * kv; d2 += q[2][d] * kv; d3 += q[3][d] * kv; }
            const int bk = t5b(t - (16 * n + 31));
            sc[0][n] = d0 + rel_bias[bk * 12 + g * 4 + 0] * LOG2E; sc[1][n] = d1 + rel_bias[bk * 12 + g * 4 + 1] * LOG2E;
            sc[2][n] = d2 + rel_bias[bk * 12 + g * 4 + 2] * LOG2E; sc[3][n] = d3 + rel_bias[bk * 12 + g * 4 + 3] * LOG2E;
        } else { sc[0][n] = 0.f; sc[1][n] = 0.f; sc[2][n] = 0.f; sc[3][n] = 0.f; }
    }
    __syncthreads();
    {
        float mx = -INFINITY; for (int n = lane; n < nvalid; n += 64) mx = fmaxf(mx, sc[w][n]);
        mx = wave_max(mx);
        float sm = 0.f; for (int n = lane; n < nvalid; n += 64) { const float e = exp2f(sc[w][n] - mx); sc[w][n] = e; sm += e; }
        sm = wave_sum(sm);
        const float inv = nvalid > 0 ? 1.f / sm : 0.f;
        for (int n = lane; n < 512; n += 64) sc[w][n] = n < nvalid ? sc[w][n] * inv : 0.f;
    }
    __syncthreads();
    float o_c = 0.f;
    for (int n = 0; n < nvalid; ++n) o_c += sc[w][n] * bf2f(VCT[((size_t)grp * 64 + lane) * 512 + n]);
    const int cur = t / 64;
    if (tid < 128) {
        const int j = tid; float s = 0.f;
        for (int n = 4 * j - 1; n <= 4 * j + 3; ++n) if (n >= 0 && n < NCMP) s += sc[0][n] + sc[1][n] + sc[2][n] + sc[3][n];
        imp[j] = s;
        const bool forced = (j == 0) || (j == cur) || (j == cur - 1);
        scoreS[j] = forced ? 1e4f : (j <= cur ? s : -1.0f);
    }
    __syncthreads();
    if (tid < 128) {
        const int j = tid; const float sj = scoreS[j]; int rank = 0;
        for (int k = 0; k < 128; ++k) { const float sk = scoreS[k]; rank += (sk > sj) || (sk == sj && k < j); }
        if (rank < 16) sel[rank] = j;
    }
    __syncthreads();
    float o_s = 0.f;
    {
        float mx = -INFINITY;
        for (int i = 0; i < 16; ++i) {
            const int j = sel[i]; const int pos = j * 64 + lane; float s = -INFINITY;
            if (j <= cur && pos <= t) {
                float d0 = 0.f; _Pragma("unroll 4") for (int d = 0; d < 64; ++d) d0 += q[w][d] * bf2f(KS[(size_t)pos * 64 + d]);
                s = d0 + rel_bias[t5b(t - pos) * 12 + h] * LOG2E;
            }
            ss[w][i * 64 + lane] = s; mx = fmaxf(mx, s);
        }
        mx = wave_max(mx);
        float sm = 0.f;
        for (int i = 0; i < 16; ++i) { const float s = ss[w][i * 64 + lane]; const float e = (s == -INFINITY) ? 0.f : exp2f(s - mx); ss[w][i * 64 + lane] = e; sm += e; }
        sm = wave_sum(sm);
        for (int i = 0; i < 16; ++i) { const int j = sel[i]; if (j > cur) continue;
            for (int k = 0; k < 64; ++k) { const float p = ss[w][i * 64 + k]; if (p != 0.f) o_s += p * bf2f(VST[(size_t)lane * S + j * 64 + k]); } }
        o_s /= sm;
    }
    float o_w = 0.f;
    {
        const int lo = t - 511; float mx = -INFINITY;
        for (int c = 0; c < 8; ++c) {
            const int pos = lo + c * 64 + lane; float s = -INFINITY;
            if (pos >= 0) { float d0 = 0.f; _Pragma("unroll 4") for (int d = 0; d < 64; ++d) d0 += q[w][d] * bf2f(KW[(size_t)pos * 64 + d]); s = d0 + rel_bias[t5b(t - pos) * 12 + h] * LOG2E; }
            ss[w][c * 64 + lane] = s; mx = fmaxf(mx, s);
        }
        mx = wave_max(mx);
        float sm = 0.f;
        for (int c = 0; c < 8; ++c) { const float s = ss[w][c * 64 + lane]; const float e = (s == -INFINITY) ? 0.f : exp2f(s - mx); ss[w][c * 64 + lane] = e; sm += e; }
        sm = wave_sum(sm);
        for (int k = 0; k < 512; ++k) { const int pos = lo + k; if (pos < 0) continue; o_w += ss[w][k] * bf2f(VWT[(size_t)lane * S + pos]); }
        o_w /= sm;
    }
    const float out = NG[h] * o_c + NG[8 + h] * o_s + NG[16 + h] * o_w;
    Q16[qoff] = f2bf(out);
    __syncthreads();
    }
}

__device__ __forceinline__ void ph_sb(char* lds_base, unsigned char* ws) {
    VB_SETUP;
    typedef float row64[64]; row64* qs = (row64*)lds;
    const int lane = tid & 63, w = tid >> 6;
    for (int item = vb0; item < NB * 4 * S / 4; item += nvb) {
    const int gw = item * 4 + w; const int t = gw % S, h = (gw / S) % 4, b = gw / (4 * S);
    bf16_t* Q16 = (bf16_t*)(ws + OFF_Q16);
    const bf16_t* K = (const bf16_t*)(ws + OFF_SBK) + ((size_t)b * 4 + h) * S * 64; const bf16_t* VT = (const bf16_t*)(ws + OFF_SBVT) + ((size_t)b * 4 + h) * 64 * S;
    const size_t qoff = (((size_t)b * 16 + 8 + h) * S + t) * 64 + lane;
    qs[w][lane] = bf2f(Q16[qoff]);
    __syncthreads();
    float carry = 0.f, o = 0.f;
    for (int hi = t; hi > 0; hi -= 64) {
        const int pos = hi - 64 + lane; const bool ok = pos >= 0;
        float z = 0.f;
        if (ok) _Pragma("unroll 4") for (int d = 0; d < 64; ++d) z += qs[w][d] * bf2f(K[(size_t)pos * 64 + d]);
        const float sp = fmaxf(z, 0.f) + log2f(1.f + exp2f(-fabsf(z)));
        const float lf = ok ? -sp : 0.f; const float ls = z + lf;
        float suf = lf;
#pragma unroll
        for (int o2 = 1; o2 < 64; o2 <<= 1) { const float tmp = __shfl_down(suf, o2); if (lane + o2 < 64) suf += tmp; }
        const float after = carry + suf - lf;
        const float wgt = ok ? exp2f(ls + after) : 0.f;
        for (int L = 0; L < 64; ++L) { const float wl = __shfl(wgt, L); const int p = hi - 64 + L; if (p >= 0) o += wl * bf2f(VT[(size_t)lane * S + p]); }
        carry += __shfl(suf, 0);
    }
    Q16[qoff] = f2bf(o);
    __syncthreads();
    }
}

__device__ __forceinline__ void ph_swa(char* lds_base, unsigned char* ws, const float* rel_bias, const float* sinks) {
    VB_SETUP;
    typedef float row64[64]; typedef float row128[128]; row64* qs = (row64*)lds; row128* es = (row128*)(lds + 1024);
    const int lane = tid & 63, w = tid >> 6;
    for (int item = vb0; item < NB * 4 * S / 4; item += nvb) {
    const int gw = item * 4 + w; const int t = gw % S, h = (gw / S) % 4, b = gw / (4 * S), g = h / 2;
    bf16_t* Q16 = (bf16_t*)(ws + OFF_Q16);
    const bf16_t* K = (const bf16_t*)(ws + OFF_WK) + ((size_t)b * 2 + g) * S * 64; const bf16_t* VT = (const bf16_t*)(ws + OFF_WVT) + ((size_t)b * 2 + g) * 64 * S;
    const size_t qoff = (((size_t)b * 16 + 12 + h) * S + t) * 64 + lane;
    qs[w][lane] = bf2f(Q16[qoff]);
    __syncthreads();
    const float sink = sinks[h] * LOG2E;
    float mx = sink; const int lo = t - 127;
    for (int c = 0; c < 2; ++c) {
        const int pos = lo + c * 64 + lane; float s = -INFINITY;
        if (pos >= 0) { float d0 = 0.f; _Pragma("unroll 4") for (int d = 0; d < 64; ++d) d0 += qs[w][d] * bf2f(K[(size_t)pos * 64 + d]); s = d0 + rel_bias[t5b(t - pos) * 12 + 8 + h] * LOG2E; }
        es[w][c * 64 + lane] = s; mx = fmaxf(mx, s);
    }
    mx = wave_max(mx);
    float sm = 0.f;
    for (int c = 0; c < 2; ++c) { const float s = es[w][c * 64 + lane]; const float e = (s == -INFINITY) ? 0.f : exp2f(s - mx); es[w][c * 64 + lane] = e; sm += e; }
    sm = wave_sum(sm) + exp2f(sink - mx);
    float o = 0.f;
    for (int k = 0; k < 128; ++k) { const int pos = lo + k; if (pos < 0) continue; o += es[w][k] * bf2f(VT[(size_t)lane * S + pos]); }
    Q16[qoff] = f2bf(o / sm);
    __syncthreads();
    }
}


struct Params { const float* in[26]; float* out; unsigned char* ws; };
constexpr int LDS_BYTES = 147456;

__global__ void __launch_bounds__(512) mega_fwd(Params p) {
    extern __shared__ __attribute__((aligned(16))) char lds_base[];
    cg::grid_group grid = cg::this_grid();
    unsigned char* ws = p.ws; float* X = p.out;
    bf16_t* XB = (bf16_t*)(ws + OFF_XB); float* SSQ = (float*)(ws + OFF_SSQ);
    bf16_t* H = (bf16_t*)(ws + OFF_A); bf16_t* GATES = (bf16_t*)(ws + OFF_A);
    float* T = (float*)(ws + OFF_B); bf16_t* MERGED = (bf16_t*)(ws + OFF_B);
    bf16_t* Q16 = (bf16_t*)(ws + OFF_Q16);
    const float* rel_bias = p.in[1];
#define GSYNC() grid.sync()
    ph_prep(lds_base, p.in[0], X, XB, SSQ); GSYNC();
    for (int l = 0; l < 2; ++l) {
        for (int f = 0; f < 2; ++f) {
            if (f == 1) {
                const float* win = p.in[7] + (size_t)l * D * DIN; const float* mixn = p.in[6] + (size_t)l * D;
                const float* w1k = p.in[11] + (size_t)l * 2048 * 256; const float* w1v = p.in[13] + (size_t)l * 2048 * 256;
                const float* w2k = p.in[12] + (size_t)l * 256 * 64; const float* w2v = p.in[14] + (size_t)l * 256 * 64;
                float* BIASC = (float*)(ws + OFF_BIASC); float* HID = (float*)(ws + OFF_HID);
                ph_cmp_bias(lds_base, p.in[10] + (size_t)l * 2048, w1k, w1v, BIASC);
                for (int c = 0; c < 13; ++c) {
                    const int c0 = c < 2 ? c * 512 : c == 2 ? 1024 : c == 3 ? 1280 : c == 4 ? 1304 : c == 5 ? 1816 : c == 6 ? 2328 : 2584 + (c - 7) * 512;
                    const int nc = (c == 2 || c == 6) ? 256 : c == 3 ? 24 : 512;
                    GArgs g{}; g.A = XB; g.amode = 0; g.lda = D; g.B0 = win + c0; g.ldb = DIN; g.wn = mixn; g.ssq = SSQ; g.M = M; g.N = nc; g.K = D; g.Cf = T; g.ldc = nc;
                    ph_gemm<2>(lds_base, g); GSYNC();
                    XArgs xa{}; xa.T = T; xa.col0 = c0; xa.ncols = nc; xa.nsa_qn = p.in[8] + l * 64; xa.nsa_kn = p.in[9] + l * 64;
                    xa.swa_qn = p.in[15] + l * 64; xa.swa_kn = p.in[16] + l * 64; xa.ws = ws;
                    ph_xform(lds_base, xa); GSYNC();
                }
                for (int kv = 0; kv < 2; ++kv) {
                    GArgs g{}; g.A = (const bf16_t*)(ws + (kv ? OFF_VCMP : OFF_KCMP)); g.amode = 0; g.lda = 1024; g.B0 = kv ? w1v : w1k; g.ldb = 256; g.M = 2048; g.N = 256; g.K = 2048;
                    g.Cf = HID + (size_t)kv * 2048 * 256; g.ldc = 256; g.bias = BIASC + kv * 256;
                    ph_gemm<4>(lds_base, g);
                }
                GSYNC();
                ph_cmp2(lds_base, HID, w2k, w2v, p.in[9] + l * 64, (bf16_t*)(ws + OFF_KCN), (bf16_t*)(ws + OFF_VCT)); GSYNC();
                ph_nsa(lds_base, ws, rel_bias);
                ph_sb(lds_base, ws);
                ph_swa(lds_base, ws, rel_bias, p.in[17] + l * 4);
                GSYNC();
                {
                    GArgs g{}; g.A = Q16; g.amode = 1; g.B0 = p.in[18] + (size_t)l * 512 * D; g.B1 = p.in[19] + (size_t)l * 256 * D; g.B2 = p.in[20] + (size_t)l * 256 * D;
                    g.ldb = D; g.M = M; g.N = D; g.K = D; g.Cb = MERGED; g.ldc = D; g.g0 = GATES; g.g1 = GATES + (size_t)M * D; g.g2 = GATES + (size_t)2 * M * D;
                    ph_gemm<3>(lds_base, g); GSYNC();
                    GArgs o{}; o.A = MERGED; o.amode = 0; o.lda = D; o.B0 = p.in[21] + (size_t)l * D * D; o.ldb = D; o.M = M; o.N = D; o.K = D; o.Cf = X; o.ldc = D; o.alpha = 1.f;
                    ph_gemm<1>(lds_base, o); GSYNC();
                    ph_prep(lds_base, X, X, XB, SSQ); GSYNC();
                }
            }
            for (int ff = (f == 0 ? 0 : 1); ff <= (f == 0 ? 0 : 1); ++ff) {
                const int base = ff == 0 ? 2 : 22;
                GArgs g{}; g.A = XB; g.amode = 0; g.lda = D; g.B0 = p.in[base + 1] + (size_t)l * D * F; g.B1 = p.in[base + 2] + (size_t)l * D * F; g.ldb = F; g.wn = p.in[base] + (size_t)l * D; g.ssq = SSQ;
                g.M = M; g.N = F; g.K = D; g.Cb = H; g.ldc = F;
                ph_gemm<0>(lds_base, g); GSYNC();
                GArgs d{}; d.A = H; d.amode = 0; d.lda = F; d.B0 = p.in[base + 3] + (size_t)l * F * D; d.ldb = D; d.M = M; d.N = D; d.K = F; d.Cf = X; d.ldc = D; d.alpha = 0.5f;
                ph_gemm<1>(lds_base, d); GSYNC();
                ph_prep(lds_base, X, X, XB, SSQ); GSYNC();
            }
        }
    }
}

extern "C" void kernel_launch(void* const* d_in, const int* in_sizes, int n_in, void* d_out, int out_size, void* d_ws, size_t ws_size, hipStream_t stream) {
    static int grid_blocks = 0;
    if (grid_blocks == 0) {
        if (ws_size < WS_END || n_in != 26) { fprintf(stderr, "kernel_launch: bad sizes (ws %zu)\n", ws_size); grid_blocks = -1; return; }
        int dev = 0, cus = 0, per_cu = 0;
        hipGetDevice(&dev); hipDeviceGetAttribute(&cus, hipDeviceAttributeMultiprocessorCount, dev);
        hipFuncSetAttribute((const void*)mega_fwd, hipFuncAttributeMaxDynamicSharedMemorySize, LDS_BYTES);
        hipOccupancyMaxActiveBlocksPerMultiprocessor(&per_cu, (const void*)mega_fwd, 512, LDS_BYTES);
        if (per_cu < 1) { fprintf(stderr, "kernel_launch: occupancy query says %d\n", per_cu); per_cu = 1; }
        grid_blocks = cus * (per_cu > 1 ? 1 : per_cu);
        (void)hipGetLastError();
    }
    if (grid_blocks < 0) return;
    Params p{}; for (int i = 0; i < 26; ++i) p.in[i] = (const float*)d_in[i]; p.out = (float*)d_out; p.ws = (unsigned char*)d_ws;
    void* args[] = {&p};
    hipError_t e = hipLaunchCooperativeKernel((void*)mega_fwd, dim3(grid_blocks), dim3(512), args, LDS_BYTES, stream);
    if (e != hipSuccess) fprintf(stderr, "cooperative launch failed: %s (grid %d)\n", hipGetErrorString(e), grid_blocks);
}
```

```cpp
#include <hip/hip_runtime.h>
#include <hip/hip_cooperative_groups.h>
#include <stdint.h>
#include <cstdio>
namespace cg = cooperative_groups;
#define VB_SETUP int tidx_ = threadIdx.x; asm volatile("" : "+v"(tidx_)); const int tid = tidx_ & 255, vhalf = tidx_ >> 8; const int vb0 = blockIdx.x * 2 + vhalf, nvb = gridDim.x * 2; char* lds = lds_base + vhalf * 32768; (void)tid; (void)lds; (void)vb0; (void)nvb
#define LAS __attribute__((address_space(3)))

typedef unsigned short bf16_t;
typedef short bf16x8 __attribute__((ext_vector_type(8)));
typedef float f32x4 __attribute__((ext_vector_type(4)));
typedef unsigned u32x4 __attribute__((ext_vector_type(4)));
__device__ __forceinline__ float bf2f(bf16_t v) { return __uint_as_float(((unsigned)v) << 16); }
__device__ __forceinline__ bf16_t f2bf(float f) { unsigned u = __float_as_uint(f); return (bf16_t)((u + 0x7fffu + ((u >> 16) & 1u)) >> 16); }
__device__ __forceinline__ unsigned pk2(float lo, float hi) { return (unsigned)f2bf(lo) | ((unsigned)f2bf(hi) << 16); }

constexpr int NB = 2, S = 8192, M = NB * S, D = 1024, F = 2816, HD = 64, DIN = 5656;
constexpr int NCMP = 511, NSLC = 128;
constexpr float LOG2E = 1.4426950408889634f;
constexpr float C2 = 0.125f * LOG2E;
constexpr float EPS = 1e-6f;

constexpr size_t MiB = 1u << 20;
constexpr size_t OFF_CTL = 0;
constexpr size_t OFF_SSQ = 1 * MiB;
constexpr size_t OFF_XB = 2 * MiB;
constexpr size_t OFF_A = 34 * MiB;
constexpr size_t OFF_MIXW = 130 * MiB;
constexpr size_t OFF_BT_IN = OFF_MIXW, OFF_BT_C1 = OFF_MIXW + 12 * MiB, OFF_BT_M = OFF_MIXW + 14 * MiB, OFF_BT_O = OFF_MIXW + 16 * MiB;
constexpr size_t OFF_Q16 = 148 * MiB;
constexpr size_t OFF_KV = 180 * MiB;
constexpr size_t KV2 = 4 * MiB, KV4 = 8 * MiB;
constexpr size_t OFF_KCMP = OFF_KV, OFF_VCMP = OFF_KCMP + KV2, OFF_KSLC = OFF_VCMP + KV2, OFF_VSLCT = OFF_KSLC + KV2,
                 OFF_KWIN = OFF_VSLCT + KV2, OFF_VWINT = OFF_KWIN + KV2, OFF_WK = OFF_VWINT + KV2, OFF_WVT = OFF_WK + KV2,
                 OFF_SBK = OFF_WVT + KV2, OFF_SBVT = OFF_SBK + KV4;
constexpr size_t OFF_MERGED = OFF_KV;
constexpr size_t OFF_FFN1W = OFF_Q16, OFF_FFN2W = OFF_KV + 32 * MiB;
constexpr size_t FFNW_D = 11 * MiB;
constexpr size_t OFF_SMALL = 229 * MiB;
constexpr size_t OFF_NGATE = OFF_SMALL;
constexpr size_t OFF_KCN = OFF_NGATE + 2 * MiB;
constexpr size_t OFF_VCT = OFF_KCN + MiB / 4;
constexpr size_t OFF_HID = OFF_VCT + MiB / 4;
constexpr size_t OFF_BIASC = OFF_HID + 4 * MiB;
constexpr size_t WS_END = OFF_BIASC + MiB;
static_assert(OFF_SBVT + KV4 <= OFF_FFN2W + 17 * MiB && OFF_FFN2W + 17 * MiB <= OFF_SMALL, "ws map");

__device__ const unsigned char T5B[128] = {
    0, 1, 2, 3, 4, 5, 6, 7, 8, 9, 10, 11, 12, 13, 14, 15, 16, 16, 16, 17, 17, 18, 18, 18, 19, 19, 19, 20, 20, 20, 20, 21, 21, 21, 21, 22, 22, 22, 22, 22, 23, 23, 23, 23, 23, 23, 24, 24, 24, 24, 24, 24, 25, 25, 25, 25, 25, 25, 25, 26, 26, 26, 26, 26, 26, 26, 26, 27, 27, 27, 27, 27, 27, 27, 27, 27, 27, 28, 28, 28, 28, 28, 28, 28, 28, 28, 28, 29, 29, 29, 29, 29, 29, 29, 29, 29, 29, 29, 29, 30, 30, 30, 30, 30, 30, 30, 30, 30, 30, 30, 30, 30, 30, 31, 31, 31, 31, 31, 31, 31, 31, 31, 31, 31, 31, 31, 31, 31};
__device__ __forceinline__ int t5b(int dist) { return dist >= 128 ? 31 : (int)T5B[dist < 0 ? 0 : dist]; }

__device__ __forceinline__ float wave_sum(float v) {
#pragma unroll
    for (int o = 1; o < 64; o <<= 1) v += __shfl_xor(v, o);
    return v;
}
__device__ __forceinline__ float wave_max(float v) {
#pragma unroll
    for (int o = 1; o < 64; o <<= 1) v = fmaxf(v, __shfl_xor(v, o));
    return v;
}
__device__ __forceinline__ float sigmoidf_(float x) { return 1.f / (1.f + __expf(-x)); }
__device__ __forceinline__ float siluf_(float x) { return x / (1.f + __expf(-x)); }
__device__ __forceinline__ float fast_sigmoid(float x) { return __builtin_amdgcn_rcpf(1.f + __builtin_amdgcn_exp2f(-x * LOG2E)); }

__device__ __forceinline__ void ph_prep(char* lds_base, const float* xin, float* X, bf16_t* XB, float* SSQ) {
    VB_SETUP;
    for (int item = vb0; item < M / 4; item += nvb) {
    const int row = item * 4 + (tid >> 6), lane = tid & 63;
    float ss = 0.f;
    for (int j = 0; j < 16; ++j) {
        const int c = j * 64 + lane; const float v = xin[(size_t)row * D + c];
        if (X != xin) X[(size_t)row * D + c] = v;
        XB[(size_t)row * D + c] = f2bf(v); ss += v * v;
    }
    ss = wave_sum(ss);
    if (lane < 16) SSQ[(size_t)row * 16 + lane] = lane == 0 ? ss : 0.f;
    }
}

namespace pg8 {
constexpr int BM = 256, BK = 64, HALF = 128, HTB = HALF * BK * 2, STAGE_BYTES = 8 * HTB, NXCD = 8, WGM = 8;
__host__ __device__ __forceinline__ int lds_byte(int r, int c) { const int st = (r >> 4) * 2 + (c >> 5), rr = r & 15, cc = c & 31, ob = rr * 64 + cc * 2; return st * 1024 + (ob ^ (((ob >> 9) & 1) << 5)); }
__host__ __device__ __forceinline__ void stage_rc(int b, int& R, int& C) { const int st = b / 1024, sb = b % 1024, swz = sb ^ (((sb >> 9) & 1) << 5); R = (st >> 1) * 16 + swz / 64; C = (st & 1) * 32 + (swz % 64) / 2; }
__host__ __device__ __forceinline__ int perm32(int rho) { const int n = rho >> 4, i = rho & 15; return 8 * (i >> 2) + 4 * n + (i & 3); }
struct Unit { int pm, pn; };
struct StaticOrder {
    int nM, nN, nwg, G, c;
    __device__ void init(int M_, int N_, int G_, int c_) { nM = M_ / BM; nN = N_ / BM; nwg = nM * nN; G = G_; c = c_; }
    __device__ bool next(int i, Unit& u) const {
        const long L = (long)i * G + c; if (L >= nwg) return false;
        int wgid = (int)L; { const int q = nwg / NXCD, r = nwg % NXCD, xcd = wgid % NXCD, off = wgid / NXCD; wgid = (xcd < r ? xcd * (q + 1) : r * (q + 1) + (xcd - r) * q) + off; }
        const int nig = WGM * nN, gid = wgid / nig, fm = gid * WGM, gsz = (nM - fm) < WGM ? (nM - fm) : WGM;
        u.pm = fm + ((wgid % nig) % gsz); u.pn = (wgid % nig) / gsz; return true;
    }
};
struct Ops {
    const char* A; const char* Bt; unsigned lda_b, ldb_b; size_t a_kstep; int nt;
    int a_mode;
    __device__ __forceinline__ const char* a_base(const Unit& u) const {
        if (a_mode == 1) return A + (size_t)(u.pm >> 5) * (16ull * S * 128) + (size_t)(u.pm & 31) * (256 * 128);
        if (a_mode == 2) return A + (size_t)u.pn * KV2 + (size_t)u.pm * 256 * lda_b;
        return A + (size_t)u.pm * 256 * lda_b;
    }
    __device__ __forceinline__ const char* b_base(const Unit& u) const { return Bt + (size_t)u.pn * 256 * ldb_b; }
};

template <class Epi, class Sched>
__device__ __forceinline__ void gemm_phase(LAS unsigned char* lds, const Ops& G, const Sched& S_, const Epi& E) {
    int tid_ = threadIdx.x; asm volatile("" : "+v"(tid_));
    const int tid = tid_, wid = __builtin_amdgcn_readfirstlane(tid >> 6), lane = tid & 63, wr = wid >> 2, wc = wid & 3, fr = lane & 15, fq = lane >> 4;
    const int nt = G.nt;
    unsigned voffA[2], voffB[2];
#pragma unroll
    for (int i = 0; i < 2; ++i) { int R, C; stage_rc(tid * 16 + i * 8192, R, C); const int Rb = Epi::PERM ? ((R & ~31) + perm32(R & 31)) : R;
        voffA[i] = (unsigned)R * G.lda_b + (unsigned)C * 2u; voffB[i] = (unsigned)Rb * G.ldb_b + (unsigned)C * 2u; }
    const size_t kstepA = G.a_kstep, kstepB = (size_t)(BK * 2);
    const size_t hstepA = (size_t)HALF * G.lda_b, hstepB = (size_t)HALF * G.ldb_b;
    const unsigned ldsw = (unsigned)wid * 1024u;
    const int aoff = lds_byte(wr * 64 + fr, fq * 8), boff = lds_byte(wc * 32 + fr, fq * 8);
#define PG8_SA(b, h) (((b) * 2 + (h)) * HTB)
#define PG8_SB(b, h) ((4 + (b) * 2 + (h)) * HTB)
#define PG8_STAGE(bufoff, gbase, voff) do { _Pragma("unroll") for (int _i = 0; _i < 2; ++_i) \
        __builtin_amdgcn_global_load_lds((const unsigned*)((const char*)(gbase) + (voff)[_i]), (LAS unsigned*)(lds + (bufoff) + ldsw + _i * 8192), 16, 0, 0); } while (0)
#define PG8_LDA(dst, b, h) do { _Pragma("unroll") for (int m = 0; m < 4; ++m) _Pragma("unroll") for (int k = 0; k < 2; ++k) dst[m][k] = *(const LAS bf16x8*)(lds + PG8_SA(b, h) + aoff + m * 2048 + k * 1024); } while (0)
#define PG8_LDB(dst, b, h) do { _Pragma("unroll") for (int n = 0; n < 2; ++n) _Pragma("unroll") for (int k = 0; k < 2; ++k) dst[n][k] = *(const LAS bf16x8*)(lds + PG8_SB(b, h) + boff + n * 2048 + k * 1024); } while (0)
#define PG8_MMA(ai, bj, At, Bt) do { __builtin_amdgcn_s_setprio(1); _Pragma("unroll") for (int m = 0; m < 4; ++m) _Pragma("unroll") for (int n = 0; n < 2; ++n) _Pragma("unroll") for (int k = 0; k < 2; ++k) \
        acc[ai][bj][m][n] = __builtin_amdgcn_mfma_f32_16x16x32_bf16(Bt[n][k], At[m][k], acc[ai][bj][m][n], 0, 0, 0); __builtin_amdgcn_s_setprio(0); } while (0)
#define PG8_WAIT_V(n) asm volatile("s_waitcnt vmcnt(" #n ")" ::: "memory")
#define PG8_WAIT_L(n) asm volatile("s_waitcnt lgkmcnt(" #n ")" ::: "memory")
#define PG8_BAR __builtin_amdgcn_s_barrier()
#define PG8_SCHED __builtin_amdgcn_sched_barrier(0)
    Unit cur, nxt; int ui = 0;
    if (!S_.next(0, cur)) return;
    f32x4 acc[2][2][4][2];
#pragma unroll
    for (int a = 0; a < 2; ++a)
#pragma unroll
        for (int b = 0; b < 2; ++b)
#pragma unroll
            for (int m = 0; m < 4; ++m)
#pragma unroll
                for (int n = 0; n < 2; ++n) acc[a][b][m][n] = (f32x4){0.f, 0.f, 0.f, 0.f};
    bf16x8 At[4][2], B0[2][2], B1[2][2];
    const char* cA = G.a_base(cur); const char* cB = G.b_base(cur);
    PG8_STAGE(PG8_SB(0, 0), cB, voffB); PG8_STAGE(PG8_SB(0, 1), cB + hstepB, voffB); PG8_STAGE(PG8_SA(0, 0), cA, voffA); PG8_STAGE(PG8_SA(0, 1), cA + hstepA, voffA);
    if (wr == 1) PG8_BAR;
    PG8_WAIT_V(2); PG8_BAR;
    PG8_STAGE(PG8_SB(1, 0), cB + kstepB, voffB); PG8_STAGE(PG8_SA(1, 0), cA + kstepA, voffA); PG8_STAGE(PG8_SB(1, 1), cB + hstepB + kstepB, voffB);
    PG8_WAIT_V(6); PG8_BAR;
    for (;;) {
        const bool has_next = S_.next(ui + 1, nxt);
        const char* nA = has_next ? G.a_base(nxt) : cA; const char* nB = has_next ? G.b_base(nxt) : cB;
        for (int t = 0; t < nt; t += 2) {
            const bool last = (t == nt - 2);
            const char* a1 = cA + (size_t)(t + 1) * kstepA;
            const char* a2 = last ? nA : cA + (size_t)(t + 2) * kstepA; const char* b2 = last ? nB : cB + (size_t)(t + 2) * kstepB;
            const char* a3 = a2 + kstepA; const char* b3 = b2 + kstepB;
            if constexpr (Epi::KHOOK) E.khook(acc, cur, t, wr, wc, fr, fq);
            PG8_LDB(B0, 0, 0); PG8_LDB(B1, 0, 1); PG8_SCHED; PG8_LDA(At, 0, 0); PG8_STAGE(PG8_SA(1, 1), a1 + hstepA, voffA);
            PG8_WAIT_V(8); PG8_WAIT_L(0); PG8_BAR; PG8_MMA(0, 0, At, B0); PG8_MMA(0, 1, At, B1); PG8_BAR; PG8_SCHED;
            PG8_LDA(At, 0, 1); PG8_STAGE(PG8_SB(0, 0), b2, voffB); PG8_STAGE(PG8_SB(0, 1), b2 + hstepB, voffB); PG8_STAGE(PG8_SA(0, 0), a2, voffA);
            PG8_WAIT_V(8); PG8_WAIT_L(0); PG8_BAR; PG8_MMA(1, 0, At, B0); PG8_MMA(1, 1, At, B1); PG8_BAR; PG8_SCHED;
            PG8_LDB(B0, 1, 0); PG8_LDB(B1, 1, 1); PG8_SCHED; PG8_LDA(At, 1, 0); PG8_STAGE(PG8_SA(0, 1), a2 + hstepA, voffA);
            PG8_WAIT_V(8); PG8_WAIT_L(0); PG8_BAR; PG8_MMA(0, 0, At, B0); PG8_MMA(0, 1, At, B1); PG8_BAR; PG8_SCHED;
            PG8_LDA(At, 1, 1); PG8_STAGE(PG8_SB(1, 0), b3, voffB); PG8_STAGE(PG8_SB(1, 1), b3 + hstepB, voffB); PG8_STAGE(PG8_SA(1, 0), a3, voffA);
            PG8_WAIT_V(8); PG8_WAIT_L(0); PG8_BAR; PG8_MMA(1, 0, At, B0); PG8_MMA(1, 1, At, B1); PG8_BAR; PG8_SCHED;
        }
        if (wr == 0) PG8_BAR;
        E(acc, cur, wr, wc, fr, fq);
        if (!has_next) break;
#pragma unroll
        for (int a = 0; a < 2; ++a)
#pragma unroll
            for (int b = 0; b < 2; ++b)
#pragma unroll
                for (int m = 0; m < 4; ++m)
#pragma unroll
                    for (int n = 0; n < 2; ++n) acc[a][b][m][n] = (f32x4){0.f, 0.f, 0.f, 0.f};
        cur = nxt; cA = nA; cB = nB; ++ui;
        if (wr == 1) PG8_BAR;
    }
    PG8_WAIT_V(0);
    PG8_BAR;
#undef PG8_SA
#undef PG8_SB
#undef PG8_STAGE
#undef PG8_LDA
#undef PG8_LDB
#undef PG8_MMA
#undef PG8_WAIT_V
#undef PG8_WAIT_L
#undef PG8_BAR
#undef PG8_SCHED
}

__device__ __forceinline__ float rstd_of(const float* ssq, int row) {
    const f32x4* p = (const f32x4*)(ssq + (size_t)row * 16); const f32x4 a = p[0], b = p[1], c = p[2], d = p[3];
    const float s = ((a[0] + a[1]) + (a[2] + a[3])) + ((b[0] + b[1]) + (b[2] + b[3])) + ((c[0] + c[1]) + (c[2] + c[3])) + ((d[0] + d[1]) + (d[2] + d[3]));
    return rsqrtf(s * (1.f / D) + EPS);
}
__device__ __forceinline__ float silu_fast(float x) { return x * __builtin_amdgcn_rcpf(1.f + __builtin_amdgcn_exp2f(-x * LOG2E)); }

struct EpiFfnUp {
    static constexpr bool PERM = true, KHOOK = false;
    bf16_t* H; const float* ssq;
    __device__ __forceinline__ void operator()(const f32x4 (&acc)[2][2][4][2], const Unit& u, int wr, int wc, int fr, int fq) const {
#pragma unroll
        for (int ai = 0; ai < 2; ++ai)
#pragma unroll
            for (int m = 0; m < 4; ++m) {
                const int row = u.pm * BM + ai * HALF + wr * 64 + m * 16 + fr; const float r = rstd_of(ssq, row);
                float h[8];
#pragma unroll
                for (int n = 0; n < 2; ++n)
#pragma unroll
                    for (int j = 0; j < 4; ++j) h[n * 4 + j] = silu_fast(r * acc[ai][0][m][n][j]) * (r * acc[ai][1][m][n][j]);
                u32x4 w; w.x = pk2(h[0], h[1]); w.y = pk2(h[2], h[3]); w.z = pk2(h[4], h[5]); w.w = pk2(h[6], h[7]);
                *(u32x4*)(H + (size_t)row * F + u.pn * 128 + wc * 32 + fq * 8) = w;
                asm volatile("" ::: "memory");
            }
    }
};
struct EpiResid {
    static constexpr bool PERM = true, KHOOK = false;
    float* X; bf16_t* XB; float* ssq; float alpha;
    __device__ __forceinline__ void operator()(const f32x4 (&acc)[2][2][4][2], const Unit& u, int wr, int wc, int fr, int fq) const {
#pragma unroll
        for (int ai = 0; ai < 2; ++ai)
#pragma unroll
            for (int m = 0; m < 4; ++m) {
                const int row = u.pm * BM + ai * HALF + wr * 64 + m * 16 + fr; float ss = 0.f;
#pragma unroll
                for (int bj = 0; bj < 2; ++bj) {
                    const size_t o = (size_t)row * D + u.pn * BM + bj * HALF + wc * 32 + fq * 8;
                    f32x4 x0 = *(const f32x4*)(X + o), x1 = *(const f32x4*)(X + o + 4);
                    x0 += acc[ai][bj][m][0] * alpha; x1 += acc[ai][bj][m][1] * alpha;
                    *(f32x4*)(X + o) = x0; *(f32x4*)(X + o + 4) = x1;
                    u32x4 w; w.x = pk2(x0[0], x0[1]); w.y = pk2(x0[2], x0[3]); w.z = pk2(x1[0], x1[1]); w.w = pk2(x1[2], x1[3]);
                    *(u32x4*)(XB + o) = w;
                    ss += (x0[0] * x0[0] + x0[1] * x0[1]) + (x0[2] * x0[2] + x0[3] * x0[3]) + (x1[0] * x1[0] + x1[1] * x1[1]) + (x1[2] * x1[2] + x1[3] * x1[3]);
                }
                ss += __shfl_xor(ss, 16); ss += __shfl_xor(ss, 32);
                if (fq == 0) ssq[(size_t)row * 16 + u.pn * 4 + wc] = ss;
                asm volatile("" ::: "memory");
            }
    }
};
__host__ __device__ __forceinline__ int win_slot_col(int slot) {
    if (slot < 8) return 64 * slot;
    if (slot < 20) return 512 + 64 * (slot - 8);
    if (slot < 40) return 1304 + 64 * (slot - 20);
    if (slot < 88) return 2584 + 64 * (slot - 40);
    if (slot == 88) return 1280;
    return -1;
}
struct EpiWin {
    static constexpr bool PERM = true, KHOOK = false;
    unsigned char* ws; const float* ssq; const float *nsa_qn, *nsa_kn, *swa_qn, *swa_kn;
    __device__ __forceinline__ void operator()(const f32x4 (&acc)[2][2][4][2], const Unit& u, int wr, int wc, int fr, int fq) const {
        const int slot = u.pn * 4 + wc;
        if (slot >= 89) return;
        int kind = 0; const float* nw = nullptr; float scale = 1.f; bf16_t* dst = nullptr; int nh = 2, h = 0;
        if (slot < 8) { nw = nsa_qn; scale = C2; dst = (bf16_t*)(ws + OFF_Q16); nh = 16; h = slot; }
        else if (slot < 10) { dst = (bf16_t*)(ws + OFF_KCMP); h = slot - 8; }
        else if (slot < 12) { dst = (bf16_t*)(ws + OFF_VCMP); h = slot - 10; }
        else if (slot < 14) { nw = nsa_kn; dst = (bf16_t*)(ws + OFF_KSLC); h = slot - 12; }
        else if (slot < 16) { kind = 1; dst = (bf16_t*)(ws + OFF_VSLCT); h = slot - 14; }
        else if (slot < 18) { nw = nsa_kn; dst = (bf16_t*)(ws + OFF_KWIN); h = slot - 16; }
        else if (slot < 20) { kind = 1; dst = (bf16_t*)(ws + OFF_VWINT); h = slot - 18; }
        else if (slot < 24) { scale = C2; dst = (bf16_t*)(ws + OFF_Q16); nh = 16; h = 8 + slot - 20; }
        else if (slot < 28) { dst = (bf16_t*)(ws + OFF_SBK); nh = 4; h = slot - 24; }
        else if (slot < 32) { kind = 1; dst = (bf16_t*)(ws + OFF_SBVT); nh = 4; h = slot - 28; }
        else if (slot < 36) { nw = swa_qn; scale = C2; dst = (bf16_t*)(ws + OFF_Q16); nh = 16; h = 12 + slot - 32; }
        else if (slot < 38) { nw = swa_kn; dst = (bf16_t*)(ws + OFF_WK); h = slot - 36; }
        else if (slot < 40) { kind = 1; dst = (bf16_t*)(ws + OFF_WVT); h = slot - 38; }
        else if (slot < 88) { kind = 2; dst = (bf16_t*)(ws + OFF_A) + (size_t)((slot - 40) >> 4) * M * D + ((slot - 40) & 15) * 64; }
        else { kind = 3; }
#pragma unroll
        for (int ai = 0; ai < 2; ++ai)
#pragma unroll
            for (int m = 0; m < 4; ++m) {
                const int row = u.pm * BM + ai * HALF + wr * 64 + m * 16 + fr; const float r = rstd_of(ssq, row);
                const int b = row / S, s = row % S;
                float v[2][2][4]; float ss = 0.f;
#pragma unroll
                for (int bj = 0; bj < 2; ++bj)
#pragma unroll
                    for (int n = 0; n < 2; ++n)
#pragma unroll
                        for (int j = 0; j < 4; ++j) { const float x = r * acc[ai][bj][m][n][j]; v[bj][n][j] = x; ss += x * x; }
                float rn = scale;
                if (nw) { ss += __shfl_xor(ss, 16); ss += __shfl_xor(ss, 32); rn = rsqrtf(ss * (1.f / 64.f) + EPS) * scale; }
#pragma unroll
                for (int bj = 0; bj < 2; ++bj)
#pragma unroll
                    for (int n = 0; n < 2; ++n) {
                        f32x4 wv = (f32x4){1.f, 1.f, 1.f, 1.f}; if (nw) wv = *(const f32x4*)(nw + 32 * bj + 8 * fq + 4 * n);
#pragma unroll
                        for (int j = 0; j < 4; ++j) v[bj][n][j] *= rn * wv[j];
                    }
                if (kind == 0) {
                    bf16_t* o = dst + (((size_t)b * nh + h) * S + s) * 64 + 8 * fq;
#pragma unroll
                    for (int bj = 0; bj < 2; ++bj) { u32x4 pw; pw.x = pk2(v[bj][0][0], v[bj][0][1]); pw.y = pk2(v[bj][0][2], v[bj][0][3]); pw.z = pk2(v[bj][1][0], v[bj][1][1]); pw.w = pk2(v[bj][1][2], v[bj][1][3]);
                        *(u32x4*)(o + 32 * bj) = pw; }
                } else if (kind == 1) {
                    bf16_t* o = dst + ((size_t)b * nh + h) * 64 * S + s;
#pragma unroll
                    for (int bj = 0; bj < 2; ++bj)
#pragma unroll
                        for (int n = 0; n < 2; ++n)
#pragma unroll
                            for (int j = 0; j < 4; ++j) o[(size_t)(32 * bj + 8 * fq + 4 * n + j) * S] = f2bf(v[bj][n][j]);
                } else if (kind == 2) {
                    bf16_t* o = dst + (size_t)row * D + 8 * fq;
#pragma unroll
                    for (int bj = 0; bj < 2; ++bj) { u32x4 pw; pw.x = pk2(fast_sigmoid(v[bj][0][0]), fast_sigmoid(v[bj][0][1])); pw.y = pk2(fast_sigmoid(v[bj][0][2]), fast_sigmoid(v[bj][0][3]));
                        pw.z = pk2(fast_sigmoid(v[bj][1][0]), fast_sigmoid(v[bj][1][1])); pw.w = pk2(fast_sigmoid(v[bj][1][2]), fast_sigmoid(v[bj][1][3])); *(u32x4*)(o + 32 * bj) = pw; }
                } else {
                    float* o = (float*)(ws + OFF_NGATE) + (size_t)row * 24;
#pragma unroll
                    for (int n = 0; n < 2; ++n)
#pragma unroll
                        for (int j = 0; j < 4; ++j) { const int d = 8 * fq + 4 * n + j; if (d < 24) o[d] = fast_sigmoid(v[0][n][j]); }
                }
                asm volatile("" ::: "memory");
            }
    }
};
struct EpiCmp1 {
    static constexpr bool PERM = true, KHOOK = false;
    float* HID; const float* bias;
    __device__ __forceinline__ void operator()(const f32x4 (&acc)[2][2][4][2], const Unit& u, int wr, int wc, int fr, int fq) const {
#pragma unroll
        for (int ai = 0; ai < 2; ++ai)
#pragma unroll
            for (int m = 0; m < 4; ++m) {
                const int row = u.pm * BM + ai * HALF + wr * 64 + m * 16 + fr;
#pragma unroll
                for (int bj = 0; bj < 2; ++bj)
#pragma unroll
                    for (int n = 0; n < 2; ++n) {
                        const int col = bj * HALF + wc * 32 + fq * 8 + 4 * n; const f32x4 bv = *(const f32x4*)(bias + u.pn * 256 + col);
                        f32x4 o;
#pragma unroll
                        for (int j = 0; j < 4; ++j) o[j] = silu_fast(acc[ai][bj][m][n][j] + bv[j]);
                        *(f32x4*)(HID + ((size_t)u.pn * 2048 + row) * 256 + col) = o;
                    }
                asm volatile("" ::: "memory");
            }
    }
};
struct EpiMerge {
    static constexpr bool PERM = true, KHOOK = true;
    const bf16_t* G0; const bf16_t* G1; const bf16_t* G2; bf16_t* OUT;
    __device__ __forceinline__ void khook(f32x4 (&acc)[2][2][4][2], const Unit& u, int t, int wr, int wc, int fr, int fq) const {
        if (t != 8 && t != 12) return;
        const bf16_t* NUM = t == 8 ? G0 : G1; const bf16_t* DEN = t == 8 ? G1 : G2;
#pragma unroll
        for (int ai = 0; ai < 2; ++ai)
#pragma unroll
            for (int m = 0; m < 4; ++m) {
                const int row = u.pm * BM + ai * HALF + wr * 64 + m * 16 + fr;
#pragma unroll
                for (int bj = 0; bj < 2; ++bj) {
                    const size_t o = (size_t)row * D + u.pn * BM + bj * HALF + wc * 32 + fq * 8;
                    const u32x4 nu = *(const u32x4*)(NUM + o), de = *(const u32x4*)(DEN + o);
#pragma unroll
                    for (int q = 0; q < 4; ++q) {
                        const float n0 = __uint_as_float(nu[q] << 16), n1 = __uint_as_float(nu[q] & 0xffff0000u), d0 = __uint_as_float(de[q] << 16), d1 = __uint_as_float(de[q] & 0xffff0000u);
                        acc[ai][bj][m][q >> 1][(q & 1) * 2] *= n0 * __builtin_amdgcn_rcpf(d0); acc[ai][bj][m][q >> 1][(q & 1) * 2 + 1] *= n1 * __builtin_amdgcn_rcpf(d1);
                    }
                }
                asm volatile("" : "+v"(acc[ai][0][m][0]), "+v"(acc[ai][0][m][1]), "+v"(acc[ai][1][m][0]), "+v"(acc[ai][1][m][1]) :: "memory");
            }
    }
    __device__ __forceinline__ void operator()(const f32x4 (&acc)[2][2][4][2], const Unit& u, int wr, int wc, int fr, int fq) const {
#pragma unroll
        for (int ai = 0; ai < 2; ++ai)
#pragma unroll
            for (int m = 0; m < 4; ++m) {
                const int row = u.pm * BM + ai * HALF + wr * 64 + m * 16 + fr;
#pragma unroll
                for (int bj = 0; bj < 2; ++bj) {
                    const size_t o = (size_t)row * D + u.pn * BM + bj * HALF + wc * 32 + fq * 8;
                    const u32x4 ge = *(const u32x4*)(G2 + o); u32x4 pw;
#pragma unroll
                    for (int q = 0; q < 4; ++q) {
                        const float g0 = __uint_as_float(ge[q] << 16), g1 = __uint_as_float(ge[q] & 0xffff0000u);
                        pw[q] = pk2(acc[ai][bj][m][q >> 1][(q & 1) * 2] * g0, acc[ai][bj][m][q >> 1][(q & 1) * 2 + 1] * g1);
                    }
                    *(u32x4*)(OUT + o) = pw;
                }
                asm volatile("" ::: "memory");
            }
    }
};
}

__device__ __forceinline__ void conv_item(const float* W, int ldw, int col0, int nvalid, int ksrc, const float* wn, bf16_t* Bt, size_t ldbt, int row0, int kofs, LAS float* scr, int lane) {
    const int n_ = lane & 31;
#pragma unroll 8
    for (int i = 0; i < 32; ++i) { const int kk = 2 * i + (lane >> 5); float v = 0.f; if (n_ < nvalid) { v = W[(size_t)(ksrc + kk) * ldw + col0 + n_]; if (wn) v *= wn[ksrc + kk]; } scr[kk * 33 + n_] = v; }
    asm volatile("s_waitcnt lgkmcnt(0)" ::: "memory");
    const int c = lane & 7;
#pragma unroll
    for (int j = 0; j < 4; ++j) { const int n = (lane >> 3) + 8 * j; const LAS float* s = scr + (8 * c) * 33 + n;
        u32x4 o; o.x = pk2(s[0 * 33], s[1 * 33]); o.y = pk2(s[2 * 33], s[3 * 33]); o.z = pk2(s[4 * 33], s[5 * 33]); o.w = pk2(s[6 * 33], s[7 * 33]);
        *(u32x4*)(Bt + (size_t)(row0 + n) * ldbt + kofs + 8 * c) = o; }
    asm volatile("s_waitcnt lgkmcnt(0)" ::: "memory");
}
struct ConvCtx { LAS unsigned char* ldsr; LAS float* scr; int gw, ngw, lane; };
#define CONV_LAUNDER ConvCtx c = c_; { int t_ = threadIdx.x; asm volatile("" : "+v"(t_)); c.lane = t_ & 63; const int wv_ = __builtin_amdgcn_readfirstlane(t_ >> 6); c.gw = blockIdx.x * 8 + wv_; c.scr = (LAS float*)(c.ldsr + wv_ * 8448); }
__device__ __forceinline__ void conv_ffn(const ConvCtx& c_, const float* nw, const float* wg, const float* wu, const float* wd, unsigned char* dstbase) {
    CONV_LAUNDER;
    bf16_t* GU = (bf16_t*)dstbase; bf16_t* DN = (bf16_t*)(dstbase + FFNW_D);
    constexpr int I_GU = 176 * 16, I_D = 32 * 44;
    for (int it = c.gw; it < I_GU + I_D; it += c.ngw) {
        if (it < I_GU) { const int rb = it / 16, kb = it % 16, tile = rb >> 3, r32 = rb & 7, bj = r32 >> 2, cc = (r32 & 3) * 32;
            conv_item(bj ? wu : wg, F, tile * 128 + cc, 32, kb * 64, nw, GU, D, rb * 32, kb * 64, c.scr, c.lane); }
        else { const int r = it - I_GU, rb = r / 44, kb = r % 44; conv_item(wd, D, rb * 32, 32, kb * 64, nullptr, DN, F, rb * 32, kb * 64, c.scr, c.lane); }
    }
}
struct MixW { const float *mixn, *win, *w1k, *w1v, *ua, *ub, *uc, *wo, *pos; };
__device__ __forceinline__ void conv_mix(const ConvCtx& c_, const MixW& w, unsigned char* ws) {
    CONV_LAUNDER;
    bf16_t* BIN = (bf16_t*)(ws + OFF_BT_IN); bf16_t* BC1 = (bf16_t*)(ws + OFF_BT_C1); bf16_t* BM_ = (bf16_t*)(ws + OFF_BT_M); bf16_t* BO = (bf16_t*)(ws + OFF_BT_O);
    constexpr int I_IN = 184 * 16, I_C1 = 16 * 32, I_M = 32 * 16, I_O = 32 * 16, I_B = 8;
    for (int it = c.gw; it < I_IN + I_C1 + I_M + I_O + I_B; it += c.ngw) {
        int r = it;
        if (r < I_IN) { const int rb = r / 16, kb = r % 16, tile = rb >> 3, r32 = rb & 7, bj = r32 >> 2, slot = tile * 4 + (r32 & 3);
            const int sc = pg8::win_slot_col(slot); int nvalid = sc < 0 ? 0 : 32; if (slot == 88) nvalid = bj == 0 ? 24 : 0;
            conv_item(w.win, DIN, sc + 32 * bj, nvalid, kb * 64, w.mixn, BIN, D, rb * 32, kb * 64, c.scr, c.lane); continue; }
        r -= I_IN;
        if (r < I_C1) { const int rb = r / 32, kb = r % 32; conv_item(rb >= 8 ? w.w1v : w.w1k, 256, (rb & 7) * 32, 32, kb * 64, nullptr, BC1, 2048, rb * 32, kb * 64, c.scr, c.lane); continue; }
        r -= I_C1;
        if (r < I_M) { const int rb = r / 16, kb = r % 16;
            if (kb < 8) conv_item(w.ua, D, rb * 32, 32, kb * 64, nullptr, BM_, D, rb * 32, kb * 64, c.scr, c.lane);
            else if (kb < 12) conv_item(w.ub, D, rb * 32, 32, (kb - 8) * 64, nullptr, BM_, D, rb * 32, kb * 64, c.scr, c.lane);
            else conv_item(w.uc, D, rb * 32, 32, (kb - 12) * 64, nullptr, BM_, D, rb * 32, kb * 64, c.scr, c.lane);
            continue; }
        r -= I_M;
        if (r < I_O) { const int rb = r / 16, kb = r % 16; conv_item(w.wo, D, rb * 32, 32, kb * 64, nullptr, BO, D, rb * 32, kb * 64, c.scr, c.lane); continue; }
        r -= I_O;
        { const int kv = r >> 2, j = (r & 3) * 64 + c.lane; const float* w1 = kv ? w.w1v : w.w1k; float s = 0.f;
          for (int k = 0; k < 2048; ++k) s += w.pos[k] * w1[(size_t)k * 256 + j];
          ((float*)(ws + OFF_BIASC))[kv * 256 + j] = s; }
    }
}

__device__ __forceinline__ void ph_cmp2(char* lds_base, const float* hid, const float* w2k, const float* w2v, const float* knorm, bf16_t* KCN, bf16_t* VCT) {
    VB_SETUP;
    for (int item = vb0; item < 1024; item += nvb) {
    const int gw = item * 4 + (tid >> 6), lane = tid & 63;
    const int kv = gw / 2048, R = gw % 2048, grp = R / 512, n = R % 512;
    const float* h = hid + ((size_t)kv * 2048 + R) * 256; const float* w2 = kv ? w2v : w2k;
    float s = 0.f; for (int k = 0; k < 256; ++k) s += h[k] * w2[k * 64 + lane];
    if (n >= NCMP) s = 0.f;
    if (kv == 0) { const float ss = wave_sum(s * s); KCN[((size_t)grp * 512 + n) * 64 + lane] = f2bf(s * rsqrtf(ss * (1.f / 64.f) + EPS) * knorm[lane]); }
    else VCT[((size_t)grp * 64 + lane) * 512 + n] = f2bf(s);
    }
}

__device__ __forceinline__ void ph_nsa(char* lds_base, unsigned char* ws, const float* rel_bias) {
    VB_SETUP;
    typedef float row64[64]; typedef float row512[512]; typedef float row1024[1024];
    row64* q = (row64*)lds; row512* sc = (row512*)(lds + 1024); row1024* ss = (row1024*)(lds + 1024 + 8192);
    float* imp = (float*)(lds + 1024 + 8192 + 16384); float* scoreS = imp + 128; int* sel = (int*)(scoreS + 128);
    const int lane = tid & 63, w = tid >> 6;
    for (int item = vb0; item < NB * 2 * S; item += nvb) {
    const int t = item % S, g = (item / S) % 2, b = item / (2 * S);
    const int grp = b * 2 + g, h = g * 4 + w;
    bf16_t* Q16 = (bf16_t*)(ws + OFF_Q16);
    const bf16_t* KCN = (const bf16_t*)(ws + OFF_KCN); const bf16_t* VCT = (const bf16_t*)(ws + OFF_VCT);
    const bf16_t* KS = (const bf16_t*)(ws + OFF_KSLC) + (size_t)grp * S * 64; const bf16_t* VST = (const bf16_t*)(ws + OFF_VSLCT) + (size_t)grp * 64 * S;
    const bf16_t* KW = (const bf16_t*)(ws + OFF_KWIN) + (size_t)grp * S * 64; const bf16_t* VWT = (const bf16_t*)(ws + OFF_VWINT) + (size_t)grp * 64 * S;
    const float* NG = (const float*)(ws + OFF_NGATE) + (size_t)(b * S + t) * 24;
    const size_t qoff = (((size_t)b * 16 + h) * S + t) * 64 + lane;
    q[w][lane] = bf2f(Q16[qoff]);
    __syncthreads();
    const int nvalid = t >= 31 ? (t - 31) / 16 + 1 : 0;
    for (int n = tid; n < 512; n += 256) {
        if (n < nvalid) {
            float d0 = 0.f, d1 = 0.f, d2 = 0.f, d3 = 0.f;
            _Pragma("unroll 4") for (int d = 0; d < 64; ++d) { const float kv = bf2f(KCN[((size_t)grp * 512 + n) * 64 + d]); d0 += q[0][d] * kv; d1 += q[1][d] * kv; d2 += q[2][d] * kv; d3 += q[3][d] * kv; }
            const int bk = t5b(t - (16 * n + 31));
            sc[0][n] = d0 + rel_bias[bk * 12 + g * 4 + 0] * LOG2E; sc[1][n] = d1 + rel_bias[bk * 12 + g * 4 + 1] * LOG2E;
            sc[2][n] = d2 + rel_bias[bk * 12 + g * 4 + 2] * LOG2E; sc[3][n] = d3 + rel_bias[bk * 12 + g * 4 + 3] * LOG2E;
        } else { sc[0][n] = 0.f; sc[1][n] = 0.f; sc[2][n] = 0.f; sc[3][n] = 0.f; }
    }
    __syncthreads();
    {
        float mx = -INFINITY; for (int n = lane; n < nvalid; n += 64) mx = fmaxf(mx, sc[w][n]);
        mx = wave_max(mx);
        float sm = 0.f; for (int n = lane; n < nvalid; n += 64) { const float e = exp2f(sc[w][n] - mx); sc[w][n] = e; sm += e; }
        sm = wave_sum(sm);
        const float inv = nvalid > 0 ? 1.f / sm : 0.f;
        for (int n = lane; n < 512; n += 64) sc[w][n] = n < nvalid ? sc[w][n] * inv : 0.f;
    }
    __syncthreads();
    float o_c = 0.f;
    for (int n = 0; n < nvalid; ++n) o_c += sc[w][n] * bf2f(VCT[((size_t)grp * 64 + lane) * 512 + n]);
    const int cur = t / 64;
    if (tid < 128) {
        const int j = tid; float s = 0.f;
        for (int n = 4 * j - 1; n <= 4 * j + 3; ++n) if (n >= 0 && n < NCMP) s += sc[0][n] + sc[1][n] + sc[2][n] + sc[3][n];
        imp[j] = s;
        const bool forced = (j == 0) || (j == cur) || (j == cur - 1);
        scoreS[j] = forced ? 1e4f : (j <= cur ? s : -1.0f);
    }
    __syncthreads();
    if (tid < 128) {
        const int j = tid; const float sj = scoreS[j]; int rank = 0;
        for (int k = 0; k < 128; ++k) { const float sk = scoreS[k]; rank += (sk > sj) || (sk == sj && k < j); }
        if (rank < 16) sel[rank] = j;
    }
    __syncthreads();
    float o_s = 0.f;
    {
        float mx = -INFINITY;
        for (int i = 0; i < 16; ++i) {
            const int j = sel[i]; const int pos = j * 64 + lane; float s = -INFINITY;
            if (j <= cur && pos <= t) {
                float d0 = 0.f; _Pragma("unroll 4") for (int d = 0; d < 64; ++d) d0 += q[w][d] * bf2f(KS[(size_t)pos * 64 + d]);
                s = d0 + rel_bias[t5b(t - pos) * 12 + h] * LOG2E;
            }
            ss[w][i * 64 + lane] = s; mx = fmaxf(mx, s);
        }
        mx = wave_max(mx);
        float sm = 0.f;
        for (int i = 0; i < 16; ++i) { const float s = ss[w][i * 64 + lane]; const float e = (s == -INFINITY) ? 0.f : exp2f(s - mx); ss[w][i * 64 + lane] = e; sm += e; }
        sm = wave_sum(sm);
        for (int i = 0; i < 16; ++i) { const int j = sel[i]; if (j > cur) continue;
            for (int k = 0; k < 64; ++k) { const float p = ss[w][i * 64 + k]; if (p != 0.f) o_s += p * bf2f(VST[(size_t)lane * S + j * 64 + k]); } }
        o_s /= sm;
    }
    float o_w = 0.f;
    {
        const int lo = t - 511; float mx = -INFINITY;
        for (int c = 0; c < 8; ++c) {
            const int pos = lo + c * 64 + lane; float s = -INFINITY;
            if (pos >= 0) { float d0 = 0.f; _Pragma("unroll 4") for (int d = 0; d < 64; ++d) d0 += q[w][d] * bf2f(KW[(size_t)pos * 64 + d]); s = d0 + rel_bias[t5b(t - pos) * 12 + h] * LOG2E; }
            ss[w][c * 64 + lane] = s; mx = fmaxf(mx, s);
        }
        mx = wave_max(mx);
        float sm = 0.f;
        for (int c = 0; c < 8; ++c) { const float s = ss[w][c * 64 + lane]; const float e = (s == -INFINITY) ? 0.f : exp2f(s - mx); ss[w][c * 64 + lane] = e; sm += e; }
        sm = wave_sum(sm);
        for (int k = 0; k < 512; ++k) { const int pos = lo + k; if (pos < 0) continue; o_w += ss[w][k] * bf2f(VWT[(size_t)lane * S + pos]); }
        o_w /= sm;
    }
    const float out = NG[h] * o_c + NG[8 + h] * o_s + NG[16 + h] * o_w;
    Q16[qoff] = f2bf(out);
    __syncthreads();
    }
}

__device__ __forceinline__ void ph_sb(char* lds_base, unsigned char* ws) {
    VB_SETUP;
    typedef float row64[64]; row64* qs = (row64*)lds;
    const int lane = tid & 63, w = tid >> 6;
    for (int item = vb0; item < NB * 4 * S / 4; item += nvb) {
    const int gw = item * 4 + w; const int t = gw % S, h = (gw / S) % 4, b = gw / (4 * S);
    bf16_t* Q16 = (bf16_t*)(ws + OFF_Q16);
    const bf16_t* K = (const bf16_t*)(ws + OFF_SBK) + ((size_t)b * 4 + h) * S * 64; const bf16_t* VT = (const bf16_t*)(ws + OFF_SBVT) + ((size_t)b * 4 + h) * 64 * S;
    const size_t qoff = (((size_t)b * 16 + 8 + h) * S + t) * 64 + lane;
    qs[w][lane] = bf2f(Q16[qoff]);
    __syncthreads();
    float carry = 0.f, o = 0.f;
    for (int hi = t; hi > 0; hi -= 64) {
        const int pos = hi - 64 + lane; const bool ok = pos >= 0;
        float z = 0.f;
        if (ok) _Pragma("unroll 4") for (int d = 0; d < 64; ++d) z += qs[w][d] * bf2f(K[(size_t)pos * 64 + d]);
        const float sp = fmaxf(z, 0.f) + log2f(1.f + exp2f(-fabsf(z)));
        const float lf = ok ? -sp : 0.f; const float ls = z + lf;
        float suf = lf;
#pragma unroll
        for (int o2 = 1; o2 < 64; o2 <<= 1) { const float tmp = __shfl_down(suf, o2); if (lane + o2 < 64) suf += tmp; }
        const float after = carry + suf - lf;
        const float wgt = ok ? exp2f(ls + after) : 0.f;
        for (int L = 0; L < 64; ++L) { const float wl = __shfl(wgt, L); const int p = hi - 64 + L; if (p >= 0) o += wl * bf2f(VT[(size_t)lane * S + p]); }
        carry += __shfl(suf, 0);
    }
    Q16[qoff] = f2bf(o);
    __syncthreads();
    }
}

__device__ __forceinline__ void ph_swa(char* lds_base, unsigned char* ws, const float* rel_bias, const float* sinks) {
    VB_SETUP;
    typedef float row64[64]; typedef float row128[128]; row64* qs = (row64*)lds; row128* es = (row128*)(lds + 1024);
    const int lane = tid & 63, w = tid >> 6;
    for (int item = vb0; item < NB * 4 * S / 4; item += nvb) {
    const int gw = item * 4 + w; const int t = gw % S, h = (gw / S) % 4, b = gw / (4 * S), g = h / 2;
    bf16_t* Q16 = (bf16_t*)(ws + OFF_Q16);
    const bf16_t* K = (const bf16_t*)(ws + OFF_WK) + ((size_t)b * 2 + g) * S * 64; const bf16_t* VT = (const bf16_t*)(ws + OFF_WVT) + ((size_t)b * 2 + g) * 64 * S;
    const size_t qoff = (((size_t)b * 16 + 12 + h) * S + t) * 64 + lane;
    qs[w][lane] = bf2f(Q16[qoff]);
    __syncthreads();
    const float sink = sinks[h] * LOG2E;
    float mx = sink; const int lo = t - 127;
    for (int c = 0; c < 2; ++c) {
        const int pos = lo + c * 64 + lane; float s = -INFINITY;
        if (pos >= 0) { float d0 = 0.f; _Pragma("unroll 4") for (int d = 0; d < 64; ++d) d0 += qs[w][d] * bf2f(K[(size_t)pos * 64 + d]); s = d0 + rel_bias[t5b(t - pos) * 12 + 8 + h] * LOG2E; }
        es[w][c * 64 + lane] = s; mx = fmaxf(mx, s);
    }
    mx = wave_max(mx);
    float sm = 0.f;
    for (int c = 0; c < 2; ++c) { const float s = es[w][c * 64 + lane]; const float e = (s == -INFINITY) ? 0.f : exp2f(s - mx); es[w][c * 64 + lane] = e; sm += e; }
    sm = wave_sum(sm) + exp2f(sink - mx);
    float o = 0.f;
    for (int k = 0; k < 128; ++k) { const int pos = lo + k; if (pos < 0) continue; o += es[w][k] * bf2f(VT[(size_t)lane * S + pos]); }
    Q16[qoff] = f2bf(o / sm);
    __syncthreads();
    }
}


struct Params { const float* in[26]; float* out; unsigned char* ws; };
__device__ __forceinline__ MixW mixw_of(const Params& p, int l) { MixW w; w.mixn = p.in[6] + (size_t)l * D; w.win = p.in[7] + (size_t)l * D * DIN; w.w1k = p.in[11] + (size_t)l * 2048 * 256; w.w1v = p.in[13] + (size_t)l * 2048 * 256;
    w.ua = p.in[18] + (size_t)l * 512 * D; w.ub = p.in[19] + (size_t)l * 256 * D; w.uc = p.in[20] + (size_t)l * 256 * D; w.wo = p.in[21] + (size_t)l * D * D; w.pos = p.in[10] + (size_t)l * 2048; return w; }
constexpr int LDS_BYTES = 147456;

__global__ void __launch_bounds__(512) mega_fwd(Params p) {
    extern __shared__ __attribute__((aligned(16))) char lds_base[];
    cg::grid_group grid = cg::this_grid();
    unsigned char* ws = p.ws; float* X = p.out;
    bf16_t* XB = (bf16_t*)(ws + OFF_XB); float* SSQ = (float*)(ws + OFF_SSQ);
    bf16_t* H = (bf16_t*)(ws + OFF_A); bf16_t* GATES = (bf16_t*)(ws + OFF_A);
    bf16_t* MERGED = (bf16_t*)(ws + OFF_MERGED);
    const float* rel_bias = p.in[1];
    LAS unsigned char* ldsr = (LAS unsigned char*)lds_base;
    ConvCtx cc; cc.ldsr = ldsr; cc.scr = nullptr; cc.gw = 0; cc.ngw = gridDim.x * 8; cc.lane = 0;
    const int G_ = gridDim.x, bid = blockIdx.x;
#define GSYNC() grid.sync()
#define FFN_SRC(l, base) p.in[base] + (size_t)(l) * D, p.in[(base) + 1] + (size_t)(l) * D * F, p.in[(base) + 2] + (size_t)(l) * D * F, p.in[(base) + 3] + (size_t)(l) * F * D
    conv_ffn(cc, FFN_SRC(0, 2), ws + OFF_FFN1W);
    conv_mix(cc, mixw_of(p, 0), ws);
    __syncthreads();
    ph_prep(lds_base, p.in[0], X, XB, SSQ);
    GSYNC();
    for (int l = 0; l < 2; ++l) {
        for (int f = 0; f < 2; ++f) {
            if (f == 1) {
                {
                    pg8::Ops g; g.A = (const char*)XB; g.Bt = (const char*)(ws + OFF_BT_IN); g.lda_b = D * 2; g.ldb_b = D * 2; g.a_kstep = 128; g.nt = D / 64; g.a_mode = 0;
                    pg8::StaticOrder so; so.init(M, 5888, G_, bid);
                    pg8::EpiWin E{ws, SSQ, p.in[8] + l * 64, p.in[9] + l * 64, p.in[15] + l * 64, p.in[16] + l * 64};
                    pg8::gemm_phase(ldsr, g, so, E);
                }
                GSYNC();
                {
                    pg8::Ops g; g.A = (const char*)(ws + OFF_KCMP); g.Bt = (const char*)(ws + OFF_BT_C1); g.lda_b = 2048; g.ldb_b = 4096; g.a_kstep = 128; g.nt = 32; g.a_mode = 2;
                    pg8::StaticOrder so; so.init(2048, 512, G_, bid);
                    pg8::EpiCmp1 E{(float*)(ws + OFF_HID), (const float*)(ws + OFF_BIASC)};
                    pg8::gemm_phase(ldsr, g, so, E);
                }
                GSYNC();
                ph_cmp2(lds_base, (const float*)(ws + OFF_HID), p.in[12] + (size_t)l * 256 * 64, p.in[14] + (size_t)l * 256 * 64, p.in[9] + l * 64, (bf16_t*)(ws + OFF_KCN), (bf16_t*)(ws + OFF_VCT));
                GSYNC();
                ph_nsa(lds_base, ws, rel_bias);
                ph_sb(lds_base, ws);
                ph_swa(lds_base, ws, rel_bias, p.in[17] + l * 4);
                GSYNC();
                {
                    conv_ffn(cc, FFN_SRC(l, 22), ws + OFF_FFN2W);
                    __syncthreads();
                    pg8::Ops g; g.A = (const char*)(ws + OFF_Q16); g.Bt = (const char*)(ws + OFF_BT_M); g.lda_b = 128; g.ldb_b = D * 2; g.a_kstep = (size_t)S * 128; g.nt = 16; g.a_mode = 1;
                    pg8::StaticOrder so; so.init(M, D, G_, bid);
                    pg8::EpiMerge E{GATES, GATES + (size_t)M * D, GATES + (size_t)2 * M * D, MERGED};
                    pg8::gemm_phase(ldsr, g, so, E);
                }
                GSYNC();
                {
                    if (l == 0) { conv_ffn(cc, FFN_SRC(1, 2), ws + OFF_FFN1W); __syncthreads(); }
                    pg8::Ops g; g.A = (const char*)MERGED; g.Bt = (const char*)(ws + OFF_BT_O); g.lda_b = D * 2; g.ldb_b = D * 2; g.a_kstep = 128; g.nt = 16; g.a_mode = 0;
                    pg8::StaticOrder so; so.init(M, D, G_, bid);
                    pg8::EpiResid E{X, XB, SSQ, 1.0f};
                    pg8::gemm_phase(ldsr, g, so, E);
                }
                GSYNC();
            }
            {
                unsigned char* wbase = ws + (f == 0 ? OFF_FFN1W : OFF_FFN2W);
                {
                    if (f == 1 && l == 0) { conv_mix(cc, mixw_of(p, 1), ws); __syncthreads(); }
                    pg8::Ops g; g.A = (const char*)XB; g.Bt = (const char*)wbase; g.lda_b = D * 2; g.ldb_b = D * 2; g.a_kstep = 128; g.nt = 16; g.a_mode = 0;
                    pg8::StaticOrder so; so.init(M, 2 * F, G_, bid);
                    pg8::EpiFfnUp E{H, SSQ};
                    pg8::gemm_phase(ldsr, g, so, E);
                }
                GSYNC();
                {
                    pg8::Ops g; g.A = (const char*)H; g.Bt = (const char*)(wbase + FFNW_D); g.lda_b = F * 2; g.ldb_b = F * 2; g.a_kstep = 128; g.nt = F / 64; g.a_mode = 0;
                    pg8::StaticOrder so; so.init(M, D, G_, bid);
                    pg8::EpiResid E{X, XB, SSQ, 0.5f};
                    pg8::gemm_phase(ldsr, g, so, E);
                }
                GSYNC();
            }
        }
    }
}

extern "C" void kernel_launch(void* const* d_in, const int* in_sizes, int n_in, void* d_out, int out_size, void* d_ws, size_t ws_size, hipStream_t stream) {
    static int grid_blocks = 0;
    if (grid_blocks == 0) {
        if (ws_size < WS_END || n_in != 26) { fprintf(stderr, "kernel_launch: bad sizes (ws %zu)\n", ws_size); grid_blocks = -1; return; }
        int dev = 0, cus = 0, per_cu = 0;
        (void)hipGetDevice(&dev); (void)hipDeviceGetAttribute(&cus, hipDeviceAttributeMultiprocessorCount, dev);
        (void)hipFuncSetAttribute((const void*)mega_fwd, hipFuncAttributeMaxDynamicSharedMemorySize, LDS_BYTES);
        (void)hipOccupancyMaxActiveBlocksPerMultiprocessor(&per_cu, (const void*)mega_fwd, 512, LDS_BYTES);
        if (per_cu < 1) { fprintf(stderr, "kernel_launch: occupancy query says %d\n", per_cu); per_cu = 1; }
        grid_blocks = cus * (per_cu > 1 ? 1 : per_cu);
        (void)hipGetLastError();
    }
    if (grid_blocks < 0) return;
    Params p{}; for (int i = 0; i < 26; ++i) p.in[i] = (const float*)d_in[i]; p.out = (float*)d_out; p.ws = (unsigned char*)d_ws;
    void* args[] = {&p};
    hipError_t e = hipLaunchCooperativeKernel((void*)mega_fwd, dim3(grid_blocks), dim3(512), args, LDS_BYTES, stream);
    if (e != hipSuccess) fprintf(stderr, "cooperative launch failed: %s (grid %d)\n", hipGetErrorString(e), grid_blocks);
}
```

```cpp
#include <hip/hip_runtime.h>
#include <hip/hip_cooperative_groups.h>
#include <stdint.h>
#include <cstdio>
namespace cg = cooperative_groups;
__device__ __forceinline__ int lane_id() { return (int)__builtin_amdgcn_mbcnt_hi(~0u, __builtin_amdgcn_mbcnt_lo(~0u, 0u)); }
#define MYTID() (wave_s * 64 + lane_id())
#define VB_SETUP int tidx_ = tid_in; asm volatile("" : "+v"(tidx_)); const int tid = tidx_ & 255, vhalf = tidx_ >> 8; const int vb0 = blockIdx.x * 2 + vhalf, nvb = gridDim.x * 2; char* lds = lds_base + vhalf * 32768; (void)tid; (void)lds; (void)vb0; (void)nvb
#define LAS __attribute__((address_space(3)))

typedef unsigned short bf16_t;
typedef short bf16x8 __attribute__((ext_vector_type(8)));
typedef float f32x4 __attribute__((ext_vector_type(4)));
typedef unsigned u32x4 __attribute__((ext_vector_type(4)));
__device__ __forceinline__ float bf2f(bf16_t v) { return __uint_as_float(((unsigned)v) << 16); }
__device__ __forceinline__ bf16_t f2bf(float f) { unsigned u = __float_as_uint(f); return (bf16_t)((u + 0x7fffu + ((u >> 16) & 1u)) >> 16); }
__device__ __forceinline__ unsigned pk2(float lo, float hi) { return (unsigned)f2bf(lo) | ((unsigned)f2bf(hi) << 16); }

__host__ __device__ __forceinline__ int vperm16(int k) { return 8 * ((k >> 2) & 1) + 4 * (k >> 3) + (k & 3); }
__device__ __forceinline__ size_t vt_pos(int s) { return (size_t)((s & ~15) + vperm16(s & 15)); }
constexpr int NB = 2, S = 8192, M = NB * S, D = 1024, F = 2816, HD = 64, DIN = 5656;
constexpr int NCMP = 511, NSLC = 128;
constexpr float LOG2E = 1.4426950408889634f;
constexpr float C2 = 0.125f * LOG2E;
constexpr float EPS = 1e-6f;

constexpr size_t MiB = 1u << 20;
constexpr size_t OFF_CTL = 0;
constexpr size_t OFF_SSQ = 1 * MiB;
constexpr size_t OFF_XB = 2 * MiB;
constexpr size_t OFF_A = 34 * MiB;
constexpr size_t OFF_MIXW = 130 * MiB;
constexpr size_t OFF_BT_IN = OFF_MIXW, OFF_BT_C1 = OFF_MIXW + 12 * MiB, OFF_BT_M = OFF_MIXW + 14 * MiB, OFF_BT_O = OFF_MIXW + 16 * MiB;
constexpr size_t OFF_Q16 = 148 * MiB;
constexpr size_t OFF_KV = 180 * MiB;
constexpr size_t KV2 = 4 * MiB, KV4 = 8 * MiB;
constexpr size_t OFF_KCMP = OFF_KV, OFF_VCMP = OFF_KCMP + KV2, OFF_KSLC = OFF_VCMP + KV2, OFF_VSLCT = OFF_KSLC + KV2,
                 OFF_KWIN = OFF_VSLCT + KV2, OFF_VWINT = OFF_KWIN + KV2, OFF_WK = OFF_VWINT + KV2, OFF_WVT = OFF_WK + KV2,
                 OFF_SBK = OFF_WVT + KV2, OFF_SBVT = OFF_SBK + KV4;
constexpr size_t OFF_MERGED = OFF_KV;
constexpr size_t OFF_FFN1W = OFF_Q16, OFF_FFN2W = OFF_KV + 32 * MiB;
constexpr size_t FFNW_D = 11 * MiB;
constexpr size_t OFF_SMALL = 229 * MiB;
constexpr size_t OFF_NGATE = OFF_SMALL;
constexpr size_t OFF_KCN = OFF_NGATE + 2 * MiB;
constexpr size_t OFF_VCT = OFF_KCN + MiB / 4;
constexpr size_t OFF_HID = OFF_VCT + MiB / 4;
constexpr size_t OFF_BIASC = OFF_HID + 4 * MiB;
constexpr size_t WS_END = OFF_BIASC + MiB;
static_assert(OFF_SBVT + KV4 <= OFF_FFN2W + 17 * MiB && OFF_FFN2W + 17 * MiB <= OFF_SMALL, "ws map");

__device__ const unsigned char T5B[128] = {
    0, 1, 2, 3, 4, 5, 6, 7, 8, 9, 10, 11, 12, 13, 14, 15, 16, 16, 16, 17, 17, 18, 18, 18, 19, 19, 19, 20, 20, 20, 20, 21, 21, 21, 21, 22, 22, 22, 22, 22, 23, 23, 23, 23, 23, 23, 24, 24, 24, 24, 24, 24, 25, 25, 25, 25, 25, 25, 25, 26, 26, 26, 26, 26, 26, 26, 26, 27, 27, 27, 27, 27, 27, 27, 27, 27, 27, 28, 28, 28, 28, 28, 28, 28, 28, 28, 28, 29, 29, 29, 29, 29, 29, 29, 29, 29, 29, 29, 29, 30, 30, 30, 30, 30, 30, 30, 30, 30, 30, 30, 30, 30, 30, 31, 31, 31, 31, 31, 31, 31, 31, 31, 31, 31, 31, 31, 31, 31};
__device__ __forceinline__ int t5b(int dist) { return dist >= 128 ? 31 : (int)T5B[dist < 0 ? 0 : dist]; }

__device__ __forceinline__ float wave_sum(float v) {
#pragma unroll
    for (int o = 1; o < 64; o <<= 1) v += __shfl_xor(v, o);
    return v;
}
__device__ __forceinline__ float wave_max(float v) {
#pragma unroll
    for (int o = 1; o < 64; o <<= 1) v = fmaxf(v, __shfl_xor(v, o));
    return v;
}
__device__ __forceinline__ float sigmoidf_(float x) { return 1.f / (1.f + __expf(-x)); }
__device__ __forceinline__ float siluf_(float x) { return x / (1.f + __expf(-x)); }
__device__ __forceinline__ float fast_sigmoid(float x) { return __builtin_amdgcn_rcpf(1.f + __builtin_amdgcn_exp2f(-x * LOG2E)); }

__device__ __forceinline__ void ph_prep(char* lds_base, int tid_in, const float* xin, float* X, bf16_t* XB, float* SSQ) {
    VB_SETUP;
    for (int item = vb0; item < M / 4; item += nvb) {
    const int row = item * 4 + (tid >> 6), lane = tid & 63;
    float ss = 0.f;
    for (int j = 0; j < 16; ++j) {
        const int c = j * 64 + lane; const float v = xin[(size_t)row * D + c];
        if (X != xin) X[(size_t)row * D + c] = v;
        XB[(size_t)row * D + c] = f2bf(v); ss += v * v;
    }
    ss = wave_sum(ss);
    if (lane < 16) SSQ[(size_t)row * 16 + lane] = lane == 0 ? ss : 0.f;
    }
}

namespace pg8 {
constexpr int BM = 256, BK = 64, HALF = 128, HTB = HALF * BK * 2, STAGE_BYTES = 8 * HTB, NXCD = 8, WGM = 8;
__host__ __device__ __forceinline__ int lds_byte(int r, int c) { const int st = (r >> 4) * 2 + (c >> 5), rr = r & 15, cc = c & 31, ob = rr * 64 + cc * 2; return st * 1024 + (ob ^ (((ob >> 9) & 1) << 5)); }
__host__ __device__ __forceinline__ void stage_rc(int b, int& R, int& C) { const int st = b / 1024, sb = b % 1024, swz = sb ^ (((sb >> 9) & 1) << 5); R = (st >> 1) * 16 + swz / 64; C = (st & 1) * 32 + (swz % 64) / 2; }
__host__ __device__ __forceinline__ int perm32(int rho) { const int n = rho >> 4, i = rho & 15; return 8 * (i >> 2) + 4 * n + (i & 3); }
struct Unit { int pm, pn; };
struct StaticOrder {
    int nM, nN, nwg, G, c;
    __device__ void init(int M_, int N_, int G_, int c_) { nM = M_ / BM; nN = N_ / BM; nwg = nM * nN; G = G_; c = c_; }
    __device__ bool next(int i, Unit& u) const {
        const long L = (long)i * G + c; if (L >= nwg) return false;
        int wgid = (int)L; { const int q = nwg / NXCD, r = nwg % NXCD, xcd = wgid % NXCD, off = wgid / NXCD; wgid = (xcd < r ? xcd * (q + 1) : r * (q + 1) + (xcd - r) * q) + off; }
        const int nig = WGM * nN, gid = wgid / nig, fm = gid * WGM, gsz = (nM - fm) < WGM ? (nM - fm) : WGM;
        u.pm = fm + ((wgid % nig) % gsz); u.pn = (wgid % nig) / gsz; return true;
    }
};
struct Ops {
    const char* A; const char* Bt; unsigned lda_b, ldb_b; size_t a_kstep; int nt;
    int a_mode;
    __device__ __forceinline__ const char* a_base(const Unit& u) const {
        if (a_mode == 1) return A + (size_t)(u.pm >> 5) * (16ull * S * 128) + (size_t)(u.pm & 31) * (256 * 128);
        if (a_mode == 2) return A + (size_t)u.pn * KV2 + (size_t)u.pm * 256 * lda_b;
        return A + (size_t)u.pm * 256 * lda_b;
    }
    __device__ __forceinline__ const char* b_base(const Unit& u) const { return Bt + (size_t)u.pn * 256 * ldb_b; }
};

template <class Epi, class Sched>
__device__ __forceinline__ void gemm_phase(LAS unsigned char* lds, int tid_in, const Ops& G, const Sched& S_, const Epi& E) {
    int tid_ = tid_in; asm volatile("" : "+v"(tid_));
    const int tid = tid_, wid = __builtin_amdgcn_readfirstlane(tid >> 6), lane = tid & 63, wr = wid >> 2, wc = wid & 3, fr = lane & 15, fq = lane >> 4;
    const int nt = G.nt;
    unsigned voffA[2], voffB[2];
#pragma unroll
    for (int i = 0; i < 2; ++i) { int R, C; stage_rc(tid * 16 + i * 8192, R, C); const int Rb = Epi::PERM ? ((R & ~31) + perm32(R & 31)) : R;
        voffA[i] = (unsigned)R * G.lda_b + (unsigned)C * 2u; voffB[i] = (unsigned)Rb * G.ldb_b + (unsigned)C * 2u; }
    const size_t kstepA = G.a_kstep, kstepB = (size_t)(BK * 2);
    const size_t hstepA = (size_t)HALF * G.lda_b, hstepB = (size_t)HALF * G.ldb_b;
    const unsigned ldsw = (unsigned)wid * 1024u;
    const int aoff = lds_byte(wr * 64 + fr, fq * 8), boff = lds_byte(wc * 32 + fr, fq * 8);
#define PG8_SA(b, h) (((b) * 2 + (h)) * HTB)
#define PG8_SB(b, h) ((4 + (b) * 2 + (h)) * HTB)
#define PG8_STAGE(bufoff, gbase, voff) do { _Pragma("unroll") for (int _i = 0; _i < 2; ++_i) \
        __builtin_amdgcn_global_load_lds((const unsigned*)((const char*)(gbase) + (voff)[_i]), (LAS unsigned*)(lds + (bufoff) + ldsw + _i * 8192), 16, 0, 0); } while (0)
#define PG8_LDA(dst, b, h) do { _Pragma("unroll") for (int m = 0; m < 4; ++m) _Pragma("unroll") for (int k = 0; k < 2; ++k) dst[m][k] = *(const LAS bf16x8*)(lds + PG8_SA(b, h) + aoff + m * 2048 + k * 1024); } while (0)
#define PG8_LDB(dst, b, h) do { _Pragma("unroll") for (int n = 0; n < 2; ++n) _Pragma("unroll") for (int k = 0; k < 2; ++k) dst[n][k] = *(const LAS bf16x8*)(lds + PG8_SB(b, h) + boff + n * 2048 + k * 1024); } while (0)
#define PG8_MMA(ai, bj, At, Bt) do { __builtin_amdgcn_s_setprio(1); _Pragma("unroll") for (int m = 0; m < 4; ++m) _Pragma("unroll") for (int n = 0; n < 2; ++n) _Pragma("unroll") for (int k = 0; k < 2; ++k) \
        acc[ai][bj][m][n] = __builtin_amdgcn_mfma_f32_16x16x32_bf16(Bt[n][k], At[m][k], acc[ai][bj][m][n], 0, 0, 0); __builtin_amdgcn_s_setprio(0); } while (0)
#define PG8_WAIT_V(n) asm volatile("s_waitcnt vmcnt(" #n ")" ::: "memory")
#define PG8_WAIT_L(n) asm volatile("s_waitcnt lgkmcnt(" #n ")" ::: "memory")
#define PG8_BAR __builtin_amdgcn_s_barrier()
#define PG8_SCHED __builtin_amdgcn_sched_barrier(0)
    Unit cur, nxt; int ui = 0;
    if (!S_.next(0, cur)) return;
    f32x4 acc[2][2][4][2];
#pragma unroll
    for (int a = 0; a < 2; ++a)
#pragma unroll
        for (int b = 0; b < 2; ++b)
#pragma unroll
            for (int m = 0; m < 4; ++m)
#pragma unroll
                for (int n = 0; n < 2; ++n) acc[a][b][m][n] = (f32x4){0.f, 0.f, 0.f, 0.f};
    bf16x8 At[4][2], B0[2][2], B1[2][2];
    const char* cA = G.a_base(cur); const char* cB = G.b_base(cur);
    PG8_STAGE(PG8_SB(0, 0), cB, voffB); PG8_STAGE(PG8_SB(0, 1), cB + hstepB, voffB); PG8_STAGE(PG8_SA(0, 0), cA, voffA); PG8_STAGE(PG8_SA(0, 1), cA + hstepA, voffA);
    if (wr == 1) PG8_BAR;
    PG8_WAIT_V(2); PG8_BAR;
    PG8_STAGE(PG8_SB(1, 0), cB + kstepB, voffB); PG8_STAGE(PG8_SA(1, 0), cA + kstepA, voffA); PG8_STAGE(PG8_SB(1, 1), cB + hstepB + kstepB, voffB);
    PG8_WAIT_V(6); PG8_BAR;
    for (;;) {
        const bool has_next = S_.next(ui + 1, nxt);
        const char* nA = has_next ? G.a_base(nxt) : cA; const char* nB = has_next ? G.b_base(nxt) : cB;
        for (int t = 0; t < nt; t += 2) {
            const bool last = (t == nt - 2);
            const char* a1 = cA + (size_t)(t + 1) * kstepA;
            const char* a2 = last ? nA : cA + (size_t)(t + 2) * kstepA; const char* b2 = last ? nB : cB + (size_t)(t + 2) * kstepB;
            const char* a3 = a2 + kstepA; const char* b3 = b2 + kstepB;
            if constexpr (Epi::KHOOK) E.khook(acc, cur, t, wr, wc, fr, fq);
            PG8_LDB(B0, 0, 0); PG8_LDB(B1, 0, 1); PG8_SCHED; PG8_LDA(At, 0, 0); PG8_STAGE(PG8_SA(1, 1), a1 + hstepA, voffA);
            PG8_WAIT_V(8); PG8_WAIT_L(0); PG8_BAR; PG8_MMA(0, 0, At, B0); PG8_MMA(0, 1, At, B1); PG8_BAR; PG8_SCHED;
            PG8_LDA(At, 0, 1); PG8_STAGE(PG8_SB(0, 0), b2, voffB); PG8_STAGE(PG8_SB(0, 1), b2 + hstepB, voffB); PG8_STAGE(PG8_SA(0, 0), a2, voffA);
            PG8_WAIT_V(8); PG8_WAIT_L(0); PG8_BAR; PG8_MMA(1, 0, At, B0); PG8_MMA(1, 1, At, B1); PG8_BAR; PG8_SCHED;
            PG8_LDB(B0, 1, 0); PG8_LDB(B1, 1, 1); PG8_SCHED; PG8_LDA(At, 1, 0); PG8_STAGE(PG8_SA(0, 1), a2 + hstepA, voffA);
            PG8_WAIT_V(8); PG8_WAIT_L(0); PG8_BAR; PG8_MMA(0, 0, At, B0); PG8_MMA(0, 1, At, B1); PG8_BAR; PG8_SCHED;
            PG8_LDA(At, 1, 1); PG8_STAGE(PG8_SB(1, 0), b3, voffB); PG8_STAGE(PG8_SB(1, 1), b3 + hstepB, voffB); PG8_STAGE(PG8_SA(1, 0), a3, voffA);
            PG8_WAIT_V(8); PG8_WAIT_L(0); PG8_BAR; PG8_MMA(1, 0, At, B0); PG8_MMA(1, 1, At, B1); PG8_BAR; PG8_SCHED;
        }
        if (wr == 0) PG8_BAR;
        E(acc, cur, wr, wc, fr, fq);
        if (!has_next) break;
#pragma unroll
        for (int a = 0; a < 2; ++a)
#pragma unroll
            for (int b = 0; b < 2; ++b)
#pragma unroll
                for (int m = 0; m < 4; ++m)
#pragma unroll
                    for (int n = 0; n < 2; ++n) acc[a][b][m][n] = (f32x4){0.f, 0.f, 0.f, 0.f};
        cur = nxt; cA = nA; cB = nB; ++ui;
        if (wr == 1) PG8_BAR;
    }
    PG8_WAIT_V(0);
    PG8_BAR;
#undef PG8_SA
#undef PG8_SB
#undef PG8_STAGE
#undef PG8_LDA
#undef PG8_LDB
#undef PG8_MMA
#undef PG8_WAIT_V
#undef PG8_WAIT_L
#undef PG8_BAR
#undef PG8_SCHED
}

__device__ __forceinline__ float rstd_of(const float* ssq, int row) {
    const f32x4* p = (const f32x4*)(ssq + (size_t)row * 16); const f32x4 a = p[0], b = p[1], c = p[2], d = p[3];
    const float s = ((a[0] + a[1]) + (a[2] + a[3])) + ((b[0] + b[1]) + (b[2] + b[3])) + ((c[0] + c[1]) + (c[2] + c[3])) + ((d[0] + d[1]) + (d[2] + d[3]));
    return rsqrtf(s * (1.f / D) + EPS);
}
__device__ __forceinline__ float silu_fast(float x) { return x * __builtin_amdgcn_rcpf(1.f + __builtin_amdgcn_exp2f(-x * LOG2E)); }

struct EpiFfnUp {
    static constexpr bool PERM = true, KHOOK = false;
    bf16_t* H; const float* ssq;
    __device__ __forceinline__ void operator()(const f32x4 (&acc)[2][2][4][2], const Unit& u, int wr, int wc, int fr, int fq) const {
#pragma unroll
        for (int ai = 0; ai < 2; ++ai)
#pragma unroll
            for (int m = 0; m < 4; ++m) {
                const int row = u.pm * BM + ai * HALF + wr * 64 + m * 16 + fr; const float r = rstd_of(ssq, row);
                float h[8];
#pragma unroll
                for (int n = 0; n < 2; ++n)
#pragma unroll
                    for (int j = 0; j < 4; ++j) h[n * 4 + j] = silu_fast(r * acc[ai][0][m][n][j]) * (r * acc[ai][1][m][n][j]);
                u32x4 w; w.x = pk2(h[0], h[1]); w.y = pk2(h[2], h[3]); w.z = pk2(h[4], h[5]); w.w = pk2(h[6], h[7]);
                *(u32x4*)(H + (size_t)row * F + u.pn * 128 + wc * 32 + fq * 8) = w;
                asm volatile("" ::: "memory");
            }
    }
};
struct EpiResid {
    static constexpr bool PERM = true, KHOOK = false;
    float* X; bf16_t* XB; float* ssq; float alpha;
    __device__ __forceinline__ void operator()(const f32x4 (&acc)[2][2][4][2], const Unit& u, int wr, int wc, int fr, int fq) const {
#pragma unroll
        for (int ai = 0; ai < 2; ++ai)
#pragma unroll
            for (int m = 0; m < 4; ++m) {
                const int row = u.pm * BM + ai * HALF + wr * 64 + m * 16 + fr; float ss = 0.f;
#pragma unroll
                for (int bj = 0; bj < 2; ++bj) {
                    const size_t o = (size_t)row * D + u.pn * BM + bj * HALF + wc * 32 + fq * 8;
                    f32x4 x0 = *(const f32x4*)(X + o), x1 = *(const f32x4*)(X + o + 4);
                    x0 += acc[ai][bj][m][0] * alpha; x1 += acc[ai][bj][m][1] * alpha;
                    *(f32x4*)(X + o) = x0; *(f32x4*)(X + o + 4) = x1;
                    u32x4 w; w.x = pk2(x0[0], x0[1]); w.y = pk2(x0[2], x0[3]); w.z = pk2(x1[0], x1[1]); w.w = pk2(x1[2], x1[3]);
                    *(u32x4*)(XB + o) = w;
                    ss += (x0[0] * x0[0] + x0[1] * x0[1]) + (x0[2] * x0[2] + x0[3] * x0[3]) + (x1[0] * x1[0] + x1[1] * x1[1]) + (x1[2] * x1[2] + x1[3] * x1[3]);
                }
                ss += __shfl_xor(ss, 16); ss += __shfl_xor(ss, 32);
                if (fq == 0) ssq[(size_t)row * 16 + u.pn * 4 + wc] = ss;
                asm volatile("" ::: "memory");
            }
    }
};
__host__ __device__ __forceinline__ int win_slot_col(int slot) {
    if (slot < 8) return 64 * slot;
    if (slot < 20) return 512 + 64 * (slot - 8);
    if (slot < 40) return 1304 + 64 * (slot - 20);
    if (slot < 88) return 2584 + 64 * (slot - 40);
    if (slot == 88) return 1280;
    return -1;
}
struct EpiWin {
    static constexpr bool PERM = true, KHOOK = false;
    unsigned char* ws; const float* ssq; const float *nsa_qn, *nsa_kn, *swa_qn, *swa_kn;
    __device__ __forceinline__ void operator()(const f32x4 (&acc)[2][2][4][2], const Unit& u, int wr, int wc, int fr, int fq) const {
        const int slot = u.pn * 4 + wc;
        if (slot >= 89) return;
        int kind = 0; const float* nw = nullptr; float scale = 1.f; bf16_t* dst = nullptr; int nh = 2, h = 0;
        if (slot < 8) { nw = nsa_qn; scale = C2; dst = (bf16_t*)(ws + OFF_Q16); nh = 16; h = slot; }
        else if (slot < 10) { dst = (bf16_t*)(ws + OFF_KCMP); h = slot - 8; }
        else if (slot < 12) { dst = (bf16_t*)(ws + OFF_VCMP); h = slot - 10; }
        else if (slot < 14) { nw = nsa_kn; dst = (bf16_t*)(ws + OFF_KSLC); h = slot - 12; }
        else if (slot < 16) { kind = 1; dst = (bf16_t*)(ws + OFF_VSLCT); h = slot - 14; }
        else if (slot < 18) { nw = nsa_kn; dst = (bf16_t*)(ws + OFF_KWIN); h = slot - 16; }
        else if (slot < 20) { kind = 1; dst = (bf16_t*)(ws + OFF_VWINT); h = slot - 18; }
        else if (slot < 24) { scale = C2; dst = (bf16_t*)(ws + OFF_Q16); nh = 16; h = 8 + slot - 20; }
        else if (slot < 28) { dst = (bf16_t*)(ws + OFF_SBK); nh = 4; h = slot - 24; }
        else if (slot < 32) { kind = 1; dst = (bf16_t*)(ws + OFF_SBVT); nh = 4; h = slot - 28; }
        else if (slot < 36) { nw = swa_qn; scale = C2; dst = (bf16_t*)(ws + OFF_Q16); nh = 16; h = 12 + slot - 32; }
        else if (slot < 38) { nw = swa_kn; dst = (bf16_t*)(ws + OFF_WK); h = slot - 36; }
        else if (slot < 40) { kind = 1; dst = (bf16_t*)(ws + OFF_WVT); h = slot - 38; }
        else if (slot < 88) { kind = 2; dst = (bf16_t*)(ws + OFF_A) + (size_t)((slot - 40) >> 4) * M * D + ((slot - 40) & 15) * 64; }
        else { kind = 3; }
#pragma unroll
        for (int ai = 0; ai < 2; ++ai)
#pragma unroll
            for (int m = 0; m < 4; ++m) {
                const int row = u.pm * BM + ai * HALF + wr * 64 + m * 16 + fr; const float r = rstd_of(ssq, row);
                const int b = row / S, s = row % S;
                float v[2][2][4]; float ss = 0.f;
#pragma unroll
                for (int bj = 0; bj < 2; ++bj)
#pragma unroll
                    for (int n = 0; n < 2; ++n)
#pragma unroll
                        for (int j = 0; j < 4; ++j) { const float x = r * acc[ai][bj][m][n][j]; v[bj][n][j] = x; ss += x * x; }
                float rn = scale;
                if (nw) { ss += __shfl_xor(ss, 16); ss += __shfl_xor(ss, 32); rn = rsqrtf(ss * (1.f / 64.f) + EPS) * scale; }
#pragma unroll
                for (int bj = 0; bj < 2; ++bj)
#pragma unroll
                    for (int n = 0; n < 2; ++n) {
                        f32x4 wv = (f32x4){1.f, 1.f, 1.f, 1.f}; if (nw) wv = *(const f32x4*)(nw + 32 * bj + 8 * fq + 4 * n);
#pragma unroll
                        for (int j = 0; j < 4; ++j) v[bj][n][j] *= rn * wv[j];
                    }
                if (kind == 0) {
                    bf16_t* o = dst + (((size_t)b * nh + h) * S + s) * 64 + 8 * fq;
#pragma unroll
                    for (int bj = 0; bj < 2; ++bj) { u32x4 pw; pw.x = pk2(v[bj][0][0], v[bj][0][1]); pw.y = pk2(v[bj][0][2], v[bj][0][3]); pw.z = pk2(v[bj][1][0], v[bj][1][1]); pw.w = pk2(v[bj][1][2], v[bj][1][3]);
                        *(u32x4*)(o + 32 * bj) = pw; }
                } else if (kind == 1) {
                    bf16_t* o = dst + ((size_t)b * nh + h) * 64 * S + vt_pos(s);
#pragma unroll
                    for (int bj = 0; bj < 2; ++bj)
#pragma unroll
                        for (int n = 0; n < 2; ++n)
#pragma unroll
                            for (int j = 0; j < 4; ++j) o[(size_t)(32 * bj + 8 * fq + 4 * n + j) * S] = f2bf(v[bj][n][j]);
                } else if (kind == 2) {
                    bf16_t* o = dst + (size_t)row * D + 8 * fq;
#pragma unroll
                    for (int bj = 0; bj < 2; ++bj) { u32x4 pw; pw.x = pk2(fast_sigmoid(v[bj][0][0]), fast_sigmoid(v[bj][0][1])); pw.y = pk2(fast_sigmoid(v[bj][0][2]), fast_sigmoid(v[bj][0][3]));
                        pw.z = pk2(fast_sigmoid(v[bj][1][0]), fast_sigmoid(v[bj][1][1])); pw.w = pk2(fast_sigmoid(v[bj][1][2]), fast_sigmoid(v[bj][1][3])); *(u32x4*)(o + 32 * bj) = pw; }
                } else {
                    float* o = (float*)(ws + OFF_NGATE) + (size_t)row * 24;
#pragma unroll
                    for (int n = 0; n < 2; ++n)
#pragma unroll
                        for (int j = 0; j < 4; ++j) { const int d = 8 * fq + 4 * n + j; if (d < 24) o[d] = fast_sigmoid(v[0][n][j]); }
                }
                asm volatile("" ::: "memory");
            }
    }
};
struct EpiCmp1 {
    static constexpr bool PERM = true, KHOOK = false;
    float* HID; const float* bias;
    __device__ __forceinline__ void operator()(const f32x4 (&acc)[2][2][4][2], const Unit& u, int wr, int wc, int fr, int fq) const {
#pragma unroll
        for (int ai = 0; ai < 2; ++ai)
#pragma unroll
            for (int m = 0; m < 4; ++m) {
                const int row = u.pm * BM + ai * HALF + wr * 64 + m * 16 + fr;
#pragma unroll
                for (int bj = 0; bj < 2; ++bj)
#pragma unroll
                    for (int n = 0; n < 2; ++n) {
                        const int col = bj * HALF + wc * 32 + fq * 8 + 4 * n; const f32x4 bv = *(const f32x4*)(bias + u.pn * 256 + col);
                        f32x4 o;
#pragma unroll
                        for (int j = 0; j < 4; ++j) o[j] = silu_fast(acc[ai][bj][m][n][j] + bv[j]);
                        *(f32x4*)(HID + ((size_t)u.pn * 2048 + row) * 256 + col) = o;
                    }
                asm volatile("" ::: "memory");
            }
    }
};
struct EpiMerge {
    static constexpr bool PERM = true, KHOOK = true;
    const bf16_t* G0; const bf16_t* G1; const bf16_t* G2; bf16_t* OUT;
    __device__ __forceinline__ void khook(f32x4 (&acc)[2][2][4][2], const Unit& u, int t, int wr, int wc, int fr, int fq) const {
        if (t != 8 && t != 12) return;
        const bf16_t* NUM = t == 8 ? G0 : G1; const bf16_t* DEN = t == 8 ? G1 : G2;
#pragma unroll
        for (int ai = 0; ai < 2; ++ai)
#pragma unroll
            for (int m = 0; m < 4; ++m) {
                const int row = u.pm * BM + ai * HALF + wr * 64 + m * 16 + fr;
#pragma unroll
                for (int bj = 0; bj < 2; ++bj) {
                    const size_t o = (size_t)row * D + u.pn * BM + bj * HALF + wc * 32 + fq * 8;
                    const u32x4 nu = *(const u32x4*)(NUM + o), de = *(const u32x4*)(DEN + o);
#pragma unroll
                    for (int q = 0; q < 4; ++q) {
                        const float n0 = __uint_as_float(nu[q] << 16), n1 = __uint_as_float(nu[q] & 0xffff0000u), d0 = __uint_as_float(de[q] << 16), d1 = __uint_as_float(de[q] & 0xffff0000u);
                        acc[ai][bj][m][q >> 1][(q & 1) * 2] *= n0 * __builtin_amdgcn_rcpf(d0); acc[ai][bj][m][q >> 1][(q & 1) * 2 + 1] *= n1 * __builtin_amdgcn_rcpf(d1);
                    }
                }
                asm volatile("" : "+v"(acc[ai][0][m][0]), "+v"(acc[ai][0][m][1]), "+v"(acc[ai][1][m][0]), "+v"(acc[ai][1][m][1]) :: "memory");
            }
    }
    __device__ __forceinline__ void operator()(const f32x4 (&acc)[2][2][4][2], const Unit& u, int wr, int wc, int fr, int fq) const {
#pragma unroll
        for (int ai = 0; ai < 2; ++ai)
#pragma unroll
            for (int m = 0; m < 4; ++m) {
                const int row = u.pm * BM + ai * HALF + wr * 64 + m * 16 + fr;
#pragma unroll
                for (int bj = 0; bj < 2; ++bj) {
                    const size_t o = (size_t)row * D + u.pn * BM + bj * HALF + wc * 32 + fq * 8;
                    const u32x4 ge = *(const u32x4*)(G2 + o); u32x4 pw;
#pragma unroll
                    for (int q = 0; q < 4; ++q) {
                        const float g0 = __uint_as_float(ge[q] << 16), g1 = __uint_as_float(ge[q] & 0xffff0000u);
                        pw[q] = pk2(acc[ai][bj][m][q >> 1][(q & 1) * 2] * g0, acc[ai][bj][m][q >> 1][(q & 1) * 2 + 1] * g1);
                    }
                    *(u32x4*)(OUT + o) = pw;
                }
                asm volatile("" ::: "memory");
            }
    }
};
}

__device__ __forceinline__ void conv_item(const float* W, int ldw, int col0, int nvalid, int ksrc, const float* wn, bf16_t* Bt, size_t ldbt, int row0, int kofs, LAS float* scr, int lane) {
    const int n_ = lane & 31;
#pragma unroll 8
    for (int i = 0; i < 32; ++i) { const int kk = 2 * i + (lane >> 5); float v = 0.f; if (n_ < nvalid) { v = W[(size_t)(ksrc + kk) * ldw + col0 + n_]; if (wn) v *= wn[ksrc + kk]; } scr[kk * 33 + n_] = v; }
    asm volatile("s_waitcnt lgkmcnt(0)" ::: "memory");
    const int c = lane & 7;
#pragma unroll
    for (int j = 0; j < 4; ++j) { const int n = (lane >> 3) + 8 * j; const LAS float* s = scr + (8 * c) * 33 + n;
        u32x4 o; o.x = pk2(s[0 * 33], s[1 * 33]); o.y = pk2(s[2 * 33], s[3 * 33]); o.z = pk2(s[4 * 33], s[5 * 33]); o.w = pk2(s[6 * 33], s[7 * 33]);
        *(u32x4*)(Bt + (size_t)(row0 + n) * ldbt + kofs + 8 * c) = o; }
    asm volatile("s_waitcnt lgkmcnt(0)" ::: "memory");
}
struct ConvCtx { LAS unsigned char* ldsr; LAS float* scr; int gw, ngw, lane; };
#define CONV_LAUNDER ConvCtx c = c_; { int t_ = c_.lane; asm volatile("" : "+v"(t_)); c.lane = t_ & 63; const int wv_ = __builtin_amdgcn_readfirstlane(t_ >> 6); c.gw = blockIdx.x * 8 + wv_; c.scr = (LAS float*)(c.ldsr + wv_ * 8448); }
__device__ __forceinline__ void conv_ffn(const ConvCtx& c_, const float* nw, const float* wg, const float* wu, const float* wd, unsigned char* dstbase) {
    CONV_LAUNDER;
    bf16_t* GU = (bf16_t*)dstbase; bf16_t* DN = (bf16_t*)(dstbase + FFNW_D);
    constexpr int I_GU = 176 * 16, I_D = 32 * 44;
    for (int it = c.gw; it < I_GU + I_D; it += c.ngw) {
        if (it < I_GU) { const int rb = it / 16, kb = it % 16, tile = rb >> 3, r32 = rb & 7, bj = r32 >> 2, cc = (r32 & 3) * 32;
            conv_item(bj ? wu : wg, F, tile * 128 + cc, 32, kb * 64, nw, GU, D, rb * 32, kb * 64, c.scr, c.lane); }
        else { const int r = it - I_GU, rb = r / 44, kb = r % 44; conv_item(wd, D, rb * 32, 32, kb * 64, nullptr, DN, F, rb * 32, kb * 64, c.scr, c.lane); }
    }
}
struct MixW { const float *mixn, *win, *w1k, *w1v, *ua, *ub, *uc, *wo, *pos; };
__device__ __forceinline__ void conv_mix(const ConvCtx& c_, const MixW& w, unsigned char* ws) {
    CONV_LAUNDER;
    bf16_t* BIN = (bf16_t*)(ws + OFF_BT_IN); bf16_t* BC1 = (bf16_t*)(ws + OFF_BT_C1); bf16_t* BM_ = (bf16_t*)(ws + OFF_BT_M); bf16_t* BO = (bf16_t*)(ws + OFF_BT_O);
    constexpr int I_IN = 184 * 16, I_C1 = 16 * 32, I_M = 32 * 16, I_O = 32 * 16, I_B = 8;
    for (int it = c.gw; it < I_IN + I_C1 + I_M + I_O + I_B; it += c.ngw) {
        int r = it;
        if (r < I_IN) { const int rb = r / 16, kb = r % 16, tile = rb >> 3, r32 = rb & 7, bj = r32 >> 2, slot = tile * 4 + (r32 & 3);
            const int sc = pg8::win_slot_col(slot); int nvalid = sc < 0 ? 0 : 32; if (slot == 88) nvalid = bj == 0 ? 24 : 0;
            conv_item(w.win, DIN, sc + 32 * bj, nvalid, kb * 64, w.mixn, BIN, D, rb * 32, kb * 64, c.scr, c.lane); continue; }
        r -= I_IN;
        if (r < I_C1) { const int rb = r / 32, kb = r % 32; conv_item(rb >= 8 ? w.w1v : w.w1k, 256, (rb & 7) * 32, 32, kb * 64, nullptr, BC1, 2048, rb * 32, kb * 64, c.scr, c.lane); continue; }
        r -= I_C1;
        if (r < I_M) { const int rb = r / 16, kb = r % 16;
            if (kb < 8) conv_item(w.ua, D, rb * 32, 32, kb * 64, nullptr, BM_, D, rb * 32, kb * 64, c.scr, c.lane);
            else if (kb < 12) conv_item(w.ub, D, rb * 32, 32, (kb - 8) * 64, nullptr, BM_, D, rb * 32, kb * 64, c.scr, c.lane);
            else conv_item(w.uc, D, rb * 32, 32, (kb - 12) * 64, nullptr, BM_, D, rb * 32, kb * 64, c.scr, c.lane);
            continue; }
        r -= I_M;
        if (r < I_O) { const int rb = r / 16, kb = r % 16; conv_item(w.wo, D, rb * 32, 32, kb * 64, nullptr, BO, D, rb * 32, kb * 64, c.scr, c.lane); continue; }
        r -= I_O;
        { const int kv = r >> 2, j = (r & 3) * 64 + c.lane; const float* w1 = kv ? w.w1v : w.w1k; float s = 0.f;
          for (int k = 0; k < 2048; ++k) s += w.pos[k] * w1[(size_t)k * 256 + j];
          ((float*)(ws + OFF_BIASC))[kv * 256 + j] = s; }
    }
}

__device__ __forceinline__ void ph_cmp2(char* lds_base, int tid_in, const float* hid, const float* w2k, const float* w2v, const float* knorm, bf16_t* KCN, bf16_t* VCT) {
    VB_SETUP;
    for (int item = vb0; item < 1024; item += nvb) {
    const int gw = item * 4 + (tid >> 6), lane = tid & 63;
    const int kv = gw / 2048, R = gw % 2048, grp = R / 512, n = R % 512;
    const float* h = hid + ((size_t)kv * 2048 + R) * 256; const float* w2 = kv ? w2v : w2k;
    float s = 0.f; for (int k = 0; k < 256; ++k) s += h[k] * w2[k * 64 + lane];
    if (n >= NCMP) s = 0.f;
    if (kv == 0) { const float ss = wave_sum(s * s); KCN[((size_t)grp * 512 + n) * 64 + lane] = f2bf(s * rsqrtf(ss * (1.f / 64.f) + EPS) * knorm[lane]); }
    else VCT[((size_t)grp * 64 + lane) * 512 + vt_pos(n)] = f2bf(s);
    }
}

__device__ __forceinline__ void ph_nsa(char* lds_base, int tid_in, unsigned char* ws, const float* rel_bias) {
    VB_SETUP;
    typedef float row64[64]; typedef float row512[512]; typedef float row1024[1024];
    row64* q = (row64*)lds; row512* sc = (row512*)(lds + 1024); row1024* ss = (row1024*)(lds + 1024 + 8192);
    float* imp = (float*)(lds + 1024 + 8192 + 16384); float* scoreS = imp + 128; int* sel = (int*)(scoreS + 128);
    const int lane = tid & 63, w = tid >> 6;
    for (int item = vb0; item < NB * 2 * S; item += nvb) {
    const int t = item % S, g = (item / S) % 2, b = item / (2 * S);
    const int grp = b * 2 + g, h = g * 4 + w;
    bf16_t* Q16 = (bf16_t*)(ws + OFF_Q16);
    const bf16_t* KCN = (const bf16_t*)(ws + OFF_KCN); const bf16_t* VCT = (const bf16_t*)(ws + OFF_VCT);
    const bf16_t* KS = (const bf16_t*)(ws + OFF_KSLC) + (size_t)grp * S * 64; const bf16_t* VST = (const bf16_t*)(ws + OFF_VSLCT) + (size_t)grp * 64 * S;
    const bf16_t* KW = (const bf16_t*)(ws + OFF_KWIN) + (size_t)grp * S * 64; const bf16_t* VWT = (const bf16_t*)(ws + OFF_VWINT) + (size_t)grp * 64 * S;
    const float* NG = (const float*)(ws + OFF_NGATE) + (size_t)(b * S + t) * 24;
    const size_t qoff = (((size_t)b * 16 + h) * S + t) * 64 + lane;
    q[w][lane] = bf2f(Q16[qoff]);
    __syncthreads();
    const int nvalid = t >= 31 ? (t - 31) / 16 + 1 : 0;
    for (int n = tid; n < 512; n += 256) {
        if (n < nvalid) {
            float d0 = 0.f, d1 = 0.f, d2 = 0.f, d3 = 0.f;
            _Pragma("unroll 4") for (int d = 0; d < 64; ++d) { const float kv = bf2f(KCN[((size_t)grp * 512 + n) * 64 + d]); d0 += q[0][d] * kv; d1 += q[1][d] * kv; d2 += q[2][d] * kv; d3 += q[3][d] * kv; }
            const int bk = t5b(t - (16 * n + 31));
            sc[0][n] = d0 + rel_bias[bk * 12 + g * 4 + 0] * LOG2E; sc[1][n] = d1 + rel_bias[bk * 12 + g * 4 + 1] * LOG2E;
            sc[2][n] = d2 + rel_bias[bk * 12 + g * 4 + 2] * LOG2E; sc[3][n] = d3 + rel_bias[bk * 12 + g * 4 + 3] * LOG2E;
        } else { sc[0][n] = 0.f; sc[1][n] = 0.f; sc[2][n] = 0.f; sc[3][n] = 0.f; }
    }
    __syncthreads();
    {
        float mx = -INFINITY; for (int n = lane; n < nvalid; n += 64) mx = fmaxf(mx, sc[w][n]);
        mx = wave_max(mx);
        float sm = 0.f; for (int n = lane; n < nvalid; n += 64) { const float e = exp2f(sc[w][n] - mx); sc[w][n] = e; sm += e; }
        sm = wave_sum(sm);
        const float inv = nvalid > 0 ? 1.f / sm : 0.f;
        for (int n = lane; n < 512; n += 64) sc[w][n] = n < nvalid ? sc[w][n] * inv : 0.f;
    }
    __syncthreads();
    float o_c = 0.f;
    for (int n = 0; n < nvalid; ++n) o_c += sc[w][n] * bf2f(VCT[((size_t)grp * 64 + lane) * 512 + vt_pos(n)]);
    const int cur = t / 64;
    if (tid < 128) {
        const int j = tid; float s = 0.f;
        for (int n = 4 * j - 1; n <= 4 * j + 3; ++n) if (n >= 0 && n < NCMP) s += sc[0][n] + sc[1][n] + sc[2][n] + sc[3][n];
        imp[j] = s;
        const bool forced = (j == 0) || (j == cur) || (j == cur - 1);
        scoreS[j] = forced ? 1e4f : (j <= cur ? s : -1.0f);
    }
    __syncthreads();
    if (tid < 128) {
        const int j = tid; const float sj = scoreS[j]; int rank = 0;
        for (int k = 0; k < 128; ++k) { const float sk = scoreS[k]; rank += (sk > sj) || (sk == sj && k < j); }
        if (rank < 16) sel[rank] = j;
    }
    __syncthreads();
    float o_s = 0.f;
    {
        float mx = -INFINITY;
        for (int i = 0; i < 16; ++i) {
            const int j = sel[i]; const int pos = j * 64 + lane; float s = -INFINITY;
            if (j <= cur && pos <= t) {
                float d0 = 0.f; _Pragma("unroll 4") for (int d = 0; d < 64; ++d) d0 += q[w][d] * bf2f(KS[(size_t)pos * 64 + d]);
                s = d0 + rel_bias[t5b(t - pos) * 12 + h] * LOG2E;
            }
            ss[w][i * 64 + lane] = s; mx = fmaxf(mx, s);
        }
        mx = wave_max(mx);
        float sm = 0.f;
        for (int i = 0; i < 16; ++i) { const float s = ss[w][i * 64 + lane]; const float e = (s == -INFINITY) ? 0.f : exp2f(s - mx); ss[w][i * 64 + lane] = e; sm += e; }
        sm = wave_sum(sm);
        for (int i = 0; i < 16; ++i) { const int j = sel[i]; if (j > cur) continue;
            for (int k = 0; k < 64; ++k) { const float p = ss[w][i * 64 + k]; if (p != 0.f) o_s += p * bf2f(VST[(size_t)lane * S + vt_pos(j * 64 + k)]); } }
        o_s /= sm;
    }
    float o_w = 0.f;
    {
        const int lo = t - 511; float mx = -INFINITY;
        for (int c = 0; c < 8; ++c) {
            const int pos = lo + c * 64 + lane; float s = -INFINITY;
            if (pos >= 0) { float d0 = 0.f; _Pragma("unroll 4") for (int d = 0; d < 64; ++d) d0 += q[w][d] * bf2f(KW[(size_t)pos * 64 + d]); s = d0 + rel_bias[t5b(t - pos) * 12 + h] * LOG2E; }
            ss[w][c * 64 + lane] = s; mx = fmaxf(mx, s);
        }
        mx = wave_max(mx);
        float sm = 0.f;
        for (int c = 0; c < 8; ++c) { const float s = ss[w][c * 64 + lane]; const float e = (s == -INFINITY) ? 0.f : exp2f(s - mx); ss[w][c * 64 + lane] = e; sm += e; }
        sm = wave_sum(sm);
        for (int k = 0; k < 512; ++k) { const int pos = lo + k; if (pos < 0) continue; o_w += ss[w][k] * bf2f(VWT[(size_t)lane * S + vt_pos(pos)]); }
        o_w /= sm;
    }
    const float out = NG[h] * o_c + NG[8 + h] * o_s + NG[16 + h] * o_w;
    Q16[qoff] = f2bf(out);
    __syncthreads();
    }
}

__device__ __forceinline__ void ph_sb(char* lds_base, int tid_in, unsigned char* ws) {
    VB_SETUP;
    typedef float row64[64]; row64* qs = (row64*)lds;
    const int lane = tid & 63, w = tid >> 6;
    for (int item = vb0; item < NB * 4 * S / 4; item += nvb) {
    const int gw = item * 4 + w; const int t = gw % S, h = (gw / S) % 4, b = gw / (4 * S);
    bf16_t* Q16 = (bf16_t*)(ws + OFF_Q16);
    const bf16_t* K = (const bf16_t*)(ws + OFF_SBK) + ((size_t)b * 4 + h) * S * 64; const bf16_t* VT = (const bf16_t*)(ws + OFF_SBVT) + ((size_t)b * 4 + h) * 64 * S;
    const size_t qoff = (((size_t)b * 16 + 8 + h) * S + t) * 64 + lane;
    qs[w][lane] = bf2f(Q16[qoff]);
    __syncthreads();
    float carry = 0.f, o = 0.f;
    for (int hi = t; hi > 0; hi -= 64) {
        const int pos = hi - 64 + lane; const bool ok = pos >= 0;
        float z = 0.f;
        if (ok) _Pragma("unroll 4") for (int d = 0; d < 64; ++d) z += qs[w][d] * bf2f(K[(size_t)pos * 64 + d]);
        const float sp = fmaxf(z, 0.f) + log2f(1.f + exp2f(-fabsf(z)));
        const float lf = ok ? -sp : 0.f; const float ls = z + lf;
        float suf = lf;
#pragma unroll
        for (int o2 = 1; o2 < 64; o2 <<= 1) { const float tmp = __shfl_down(suf, o2); if (lane + o2 < 64) suf += tmp; }
        const float after = carry + suf - lf;
        const float wgt = ok ? exp2f(ls + after) : 0.f;
        for (int L = 0; L < 64; ++L) { const float wl = __shfl(wgt, L); const int p = hi - 64 + L; if (p >= 0) o += wl * bf2f(VT[(size_t)lane * S + p]); }
        carry += __shfl(suf, 0);
    }
    Q16[qoff] = f2bf(o);
    __syncthreads();
    }
}

__device__ __forceinline__ void ph_swa(char* lds_base, int tid_in, unsigned char* ws, const float* rel_bias, const float* sinks) {
    VB_SETUP;
    typedef float row64[64]; typedef float row128[128]; row64* qs = (row64*)lds; row128* es = (row128*)(lds + 1024);
    const int lane = tid & 63, w = tid >> 6;
    for (int item = vb0; item < NB * 4 * S / 4; item += nvb) {
    const int gw = item * 4 + w; const int t = gw % S, h = (gw / S) % 4, b = gw / (4 * S), g = h / 2;
    bf16_t* Q16 = (bf16_t*)(ws + OFF_Q16);
    const bf16_t* K = (const bf16_t*)(ws + OFF_WK) + ((size_t)b * 2 + g) * S * 64; const bf16_t* VT = (const bf16_t*)(ws + OFF_WVT) + ((size_t)b * 2 + g) * 64 * S;
    const size_t qoff = (((size_t)b * 16 + 12 + h) * S + t) * 64 + lane;
    qs[w][lane] = bf2f(Q16[qoff]);
    __syncthreads();
    const float sink = sinks[h] * LOG2E;
    float mx = sink; const int lo = t - 127;
    for (int c = 0; c < 2; ++c) {
        const int pos = lo + c * 64 + lane; float s = -INFINITY;
        if (pos >= 0) { float d0 = 0.f; _Pragma("unroll 4") for (int d = 0; d < 64; ++d) d0 += qs[w][d] * bf2f(K[(size_t)pos * 64 + d]); s = d0 + rel_bias[t5b(t - pos) * 12 + 8 + h] * LOG2E; }
        es[w][c * 64 + lane] = s; mx = fmaxf(mx, s);
    }
    mx = wave_max(mx);
    float sm = 0.f;
    for (int c = 0; c < 2; ++c) { const float s = es[w][c * 64 + lane]; const float e = (s == -INFINITY) ? 0.f : exp2f(s - mx); es[w][c * 64 + lane] = e; sm += e; }
    sm = wave_sum(sm) + exp2f(sink - mx);
    float o = 0.f;
    for (int k = 0; k < 128; ++k) { const int pos = lo + k; if (pos < 0) continue; o += es[w][k] * bf2f(VT[(size_t)lane * S + pos]); }
    Q16[qoff] = f2bf(o / sm);
    __syncthreads();
    }
}


typedef float f32x16 __attribute__((ext_vector_type(16)));
__host__ __device__ __forceinline__ int crow(int r, int hi) { return (r & 3) + 8 * (r >> 2) + 4 * hi; }
__device__ __forceinline__ float xhalf(float v) { return __shfl_xor(v, 32); }
__device__ __forceinline__ bf16x8 pack8(const f32x16& p, int s) {
    u32x4 w; w.x = pk2(p[8 * s + 0], p[8 * s + 1]); w.y = pk2(p[8 * s + 2], p[8 * s + 3]); w.z = pk2(p[8 * s + 4], p[8 * s + 5]); w.w = pk2(p[8 * s + 6], p[8 * s + 7]);
    return __builtin_bit_cast(bf16x8, w);
}
constexpr int TAB_N = 130;
__device__ __forceinline__ int tab_idx(int dist) { return min(max(dist, -1), 128) + 1; }
__device__ __forceinline__ void build_tabs(LAS float* tab, const float* rel_bias, int tid) {
    for (int i = tid; i < 12 * TAB_N; i += 512) {
        const int hh = i / TAB_N, e = i % TAB_N; float v;
        if (e == 0) v = -INFINITY;
        else if (hh < 8) v = e == 129 ? 0.f : (rel_bias[t5b(e - 1) * 12 + hh] - rel_bias[31 * 12 + hh]) * LOG2E;
        else v = e == 129 ? -INFINITY : rel_bias[t5b(e - 1) * 12 + hh] * LOG2E;
        tab[i] = v;
    }
}
__device__ __forceinline__ void qk_global(f32x16& p0, f32x16& p1, const bf16_t* K, const bf16x8 (&qf)[4], int lane) {
    const bf16_t* kp = K + (size_t)(lane & 31) * 64 + 8 * (lane >> 5);
    f32x16 z;
#pragma unroll
    for (int r = 0; r < 16; ++r) z[r] = 0.f;
    p0 = z; p1 = z;
#pragma unroll
    for (int c = 0; c < 4; ++c) {
        const bf16x8 k0 = *(const bf16x8*)(kp + 16 * c), k1 = *(const bf16x8*)(kp + 32 * 64 + 16 * c);
        p0 = __builtin_amdgcn_mfma_f32_32x32x16_bf16(k0, qf[c], p0, 0, 0, 0);
        p1 = __builtin_amdgcn_mfma_f32_32x32x16_bf16(k1, qf[c], p1, 0, 0, 0);
    }
}
__device__ __forceinline__ void pv_global(f32x16 (&o)[2], const bf16_t* VT, size_t pitch, const f32x16& p0, const f32x16& p1, int lane) {
    const bf16_t* vp = VT + (size_t)(lane & 31) * pitch + 8 * (lane >> 5);
#pragma unroll
    for (int kh = 0; kh < 2; ++kh)
#pragma unroll
        for (int s = 0; s < 2; ++s) {
            const bf16x8 pf = pack8(kh ? p1 : p0, s);
#pragma unroll
            for (int dh = 0; dh < 2; ++dh) {
                const bf16x8 vf = *(const bf16x8*)(vp + (size_t)(32 * dh) * pitch + 32 * kh + 16 * s);
                o[dh] = __builtin_amdgcn_mfma_f32_32x32x16_bf16(vf, pf, o[dh], 0, 0, 0);
            }
        }
}
__device__ __forceinline__ void softmax_step(f32x16& p0, f32x16& p1, float& m, float& l, f32x16 (&o)[2]) {
    float mx = fmaxf(p0[0], p1[0]);
#pragma unroll
    for (int r = 1; r < 16; ++r) mx = fmaxf(mx, fmaxf(p0[r], p1[r]));
    mx = fmaxf(mx, xhalf(mx));
    const float mn = fmaxf(m, mx);
    const float ms = (mn == -INFINITY) ? 0.f : mn;
    const float alpha = __builtin_amdgcn_exp2f(m - ms);
    float sum = 0.f;
#pragma unroll
    for (int r = 0; r < 16; ++r) { p0[r] = __builtin_amdgcn_exp2f(p0[r] - ms); p1[r] = __builtin_amdgcn_exp2f(p1[r] - ms); sum += p0[r] + p1[r]; }
    l = l * alpha + sum; m = mn;
    if (__any(alpha != 1.f)) {
#pragma unroll
        for (int r = 0; r < 16; ++r) { o[0][r] *= alpha; o[1][r] *= alpha; }
    }
}
__device__ __forceinline__ void store_ot(bf16_t* dst, const f32x16 (&o)[2], float scale, int hi) {
#pragma unroll
    for (int dh = 0; dh < 2; ++dh)
#pragma unroll
        for (int m4 = 0; m4 < 4; ++m4) {
            uint2 w; w.x = pk2(o[dh][4 * m4] * scale, o[dh][4 * m4 + 1] * scale); w.y = pk2(o[dh][4 * m4 + 2] * scale, o[dh][4 * m4 + 3] * scale);
            *(uint2*)(dst + 32 * dh + 8 * m4 + 4 * hi) = w;
        }
}

__device__ __forceinline__ void swa_unit(unsigned char* ws, const LAS float* tabW, const float* sinks, int unit, int lane) {
    const int t0 = (unit & 255) * 32, h = (unit >> 8) & 3, b = unit >> 10, g = h >> 1, hi = lane >> 5, t = t0 + (lane & 31);
    bf16_t* qrow = (bf16_t*)(ws + OFF_Q16) + (((size_t)b * 16 + 12 + h) * S + t) * 64;
    const bf16_t* K = (const bf16_t*)(ws + OFF_WK) + ((size_t)b * 2 + g) * S * 64; const bf16_t* VT = (const bf16_t*)(ws + OFF_WVT) + ((size_t)b * 2 + g) * 64 * S;
    bf16x8 qf[4];
#pragma unroll
    for (int c = 0; c < 4; ++c) qf[c] = *(const bf16x8*)(qrow + 16 * c + 8 * hi);
    const float sink = sinks[h] * LOG2E;
    float m = sink, l = hi == 0 ? 1.f : 0.f;
    f32x16 o[2];
#pragma unroll
    for (int r = 0; r < 16; ++r) { o[0][r] = 0.f; o[1][r] = 0.f; }
    const LAS float* tb = tabW + h * TAB_N;
    const int jlo = t0 >= 127 ? (t0 - 127) >> 6 : 0, jhi = (t0 + 31) >> 6;
    for (int j = jlo; j <= jhi; ++j) {
        f32x16 p0, p1;
        qk_global(p0, p1, K + (size_t)j * 64 * 64, qf, lane);
#pragma unroll
        for (int r = 0; r < 16; ++r) { const int d0 = t - (j * 64 + crow(r, hi)); p0[r] += tb[tab_idx(d0)]; p1[r] += tb[tab_idx(d0 - 32)]; }
        softmax_step(p0, p1, m, l, o);
        pv_global(o, VT + (size_t)j * 64, S, p0, p1, lane);
    }
    l += xhalf(l);
    store_ot(qrow, o, 1.f / l, hi);
}

constexpr float SB_CUT = 64.f;
__device__ __forceinline__ void sb_unit(unsigned char* ws, int unit, int lane) {
    const int t0 = (unit & 255) * 32, h = (unit >> 8) & 3, b = unit >> 10, hi = lane >> 5, t = t0 + (lane & 31);
    bf16_t* qrow = (bf16_t*)(ws + OFF_Q16) + (((size_t)b * 16 + 8 + h) * S + t) * 64;
    const bf16_t* K = (const bf16_t*)(ws + OFF_SBK) + ((size_t)b * 4 + h) * S * 64; const bf16_t* VT = (const bf16_t*)(ws + OFF_SBVT) + ((size_t)b * 4 + h) * 64 * S;
    bf16x8 qf[4];
#pragma unroll
    for (int c = 0; c < 4; ++c) qf[c] = *(const bf16x8*)(qrow + 16 * c + 8 * hi);
    f32x16 o[2];
#pragma unroll
    for (int r = 0; r < 16; ++r) { o[0][r] = 0.f; o[1][r] = 0.f; }
    float carry = 0.f;
    for (int j = (t0 + 31) >> 6; j >= 0; --j) {
        f32x16 z0, z1, f0, f1;
        qk_global(z0, z1, K + (size_t)j * 64 * 64, qf, lane);
        float gs[8];
#pragma unroll
        for (int u = 0; u < 8; ++u) gs[u] = 0.f;
        const int kb = j * 64;
#pragma unroll
        for (int r = 0; r < 16; ++r) {
            { const float z = z0[r]; const bool ok = kb + crow(r, hi) < t; const float sp = fmaxf(z, 0.f) + __builtin_amdgcn_logf(1.f + __builtin_amdgcn_exp2f(-fabsf(z))); f0[r] = ok ? -sp : 0.f; gs[r >> 2] += f0[r]; }
            { const float z = z1[r]; const bool ok = kb + 32 + crow(r, hi) < t; const float sp = fmaxf(z, 0.f) + __builtin_amdgcn_logf(1.f + __builtin_amdgcn_exp2f(-fabsf(z))); f1[r] = ok ? -sp : 0.f; gs[4 + (r >> 2)] += f1[r]; }
        }
        float T = 0.f, A[8];
#pragma unroll
        for (int u = 7; u >= 0; --u) { const float pg = xhalf(gs[u]); A[u] = T + (hi == 0 ? pg : 0.f); T += gs[u] + pg; }
#pragma unroll
        for (int u = 0; u < 8; ++u) {
            float run = carry + A[u];
#pragma unroll
            for (int i = 3; i >= 0; --i) {
                const int r = 4 * (u & 3) + i;
                if (u < 4) { const bool ok = kb + crow(r, hi) < t; const float lf = f0[r]; z0[r] = ok ? __builtin_amdgcn_exp2f(z0[r] + lf + run) : 0.f; run += lf; }
                else { const bool ok = kb + 32 + crow(r, hi) < t; const float lf = f1[r]; z1[r] = ok ? __builtin_amdgcn_exp2f(z1[r] + lf + run) : 0.f; run += lf; }
            }
        }
        carry += T;
        pv_global(o, VT + (size_t)j * 64, S, z0, z1, lane);
        if (__all(carry < -SB_CUT)) break;
    }
    store_ot(qrow, o, 1.f, hi);
}

struct Params { const float* in[26]; float* out; unsigned char* ws; };
constexpr int LDS_BYTES = 147456;
__device__ __forceinline__ const float* inptr(const Params& p, int i) { asm volatile("" : "+s"(i)); return p.in[i]; }
#define PH_BEGIN(lexpr) int lq = (lexpr); asm volatile("" : "+s"(lq)); unsigned char* ws = p.ws; asm volatile("" : "+s"(ws)); float* X = p.out; asm volatile("" : "+s"(X)); \
    bf16_t* XB = (bf16_t*)(ws + OFF_XB); float* SSQ = (float*)(ws + OFF_SSQ); (void)XB; (void)SSQ; (void)X; (void)lq
#define IN(i) inptr(p, i)
#define CCX() ConvCtx{ldsr, nullptr, 0, (int)gridDim.x * 8, MYTID()}
#define FFN_SRC(l, base) IN(base) + (size_t)(l) * D, IN((base) + 1) + (size_t)(l) * D * F, IN((base) + 2) + (size_t)(l) * D * F, IN((base) + 3) + (size_t)(l) * F * D
__device__ __forceinline__ MixW mixw_of(const Params& p, int l) { MixW w; w.mixn = IN(6) + (size_t)l * D; w.win = IN(7) + (size_t)l * D * DIN; w.w1k = IN(11) + (size_t)l * 2048 * 256; w.w1v = IN(13) + (size_t)l * 2048 * 256;
    w.ua = IN(18) + (size_t)l * 512 * D; w.ub = IN(19) + (size_t)l * 256 * D; w.uc = IN(20) + (size_t)l * 256 * D; w.wo = IN(21) + (size_t)l * D * D; w.pos = IN(10) + (size_t)l * 2048; return w; }

__global__ void __launch_bounds__(512) mega_fwd(Params p) {
    extern __shared__ __attribute__((aligned(16))) char lds_base[];
    cg::grid_group grid = cg::this_grid();
    LAS unsigned char* ldsr = (LAS unsigned char*)lds_base;
    const int wave_s = __builtin_amdgcn_readfirstlane(threadIdx.x >> 6);
    const int G_ = gridDim.x, bid = blockIdx.x;
#define GSYNC() grid.sync()
    {
        PH_BEGIN(0);
        conv_ffn(CCX(), FFN_SRC(lq, 2), ws + OFF_FFN1W);
        conv_mix(CCX(), mixw_of(p, lq), ws);
        __syncthreads();
        ph_prep(lds_base, MYTID(), IN(0), X, XB, SSQ);
    }
    GSYNC();
#pragma unroll 1
    for (int l = 0; l < 2; ++l) {
#pragma unroll 1
        for (int f = 0; f < 2; ++f) {
            if (f == 1) {
                {
                    PH_BEGIN(l);
                    pg8::Ops g; g.A = (const char*)XB; g.Bt = (const char*)(ws + OFF_BT_IN); g.lda_b = D * 2; g.ldb_b = D * 2; g.a_kstep = 128; g.nt = D / 64; g.a_mode = 0;
                    pg8::StaticOrder so; so.init(M, 5888, G_, bid);
                    pg8::EpiWin E{ws, SSQ, IN(8) + lq * 64, IN(9) + lq * 64, IN(15) + lq * 64, IN(16) + lq * 64};
                    pg8::gemm_phase(ldsr, MYTID(), g, so, E);
                }
                GSYNC();
                {
                    PH_BEGIN(l);
                    pg8::Ops g; g.A = (const char*)(ws + OFF_KCMP); g.Bt = (const char*)(ws + OFF_BT_C1); g.lda_b = 2048; g.ldb_b = 4096; g.a_kstep = 128; g.nt = 32; g.a_mode = 2;
                    pg8::StaticOrder so; so.init(2048, 512, G_, bid);
                    pg8::EpiCmp1 E{(float*)(ws + OFF_HID), (const float*)(ws + OFF_BIASC)};
                    pg8::gemm_phase(ldsr, MYTID(), g, so, E);
                }
                GSYNC();
                {
                    PH_BEGIN(l);
                    ph_cmp2(lds_base, MYTID(), (const float*)(ws + OFF_HID), IN(12) + (size_t)lq * 256 * 64, IN(14) + (size_t)lq * 256 * 64, IN(9) + lq * 64, (bf16_t*)(ws + OFF_KCN), (bf16_t*)(ws + OFF_VCT));
                }
                GSYNC();
                {
                    PH_BEGIN(l);
                    const float* rel_bias = IN(1);
                    LAS float* tabs = (LAS float*)(ldsr + 131072);
                    build_tabs(tabs, rel_bias, MYTID());
                    __syncthreads();
                    ph_nsa(lds_base, MYTID(), ws, rel_bias);
                    int t_ = MYTID(); asm volatile("" : "+v"(t_));
                    const int lane_ = t_ & 63, gw_ = blockIdx.x * 8 + __builtin_amdgcn_readfirstlane(t_ >> 6);
                    for (int u = gw_; u < 2048; u += G_ * 8) swa_unit(ws, tabs + 8 * TAB_N, IN(17) + lq * 4, u, lane_);
                    for (int u = gw_; u < 2048; u += G_ * 8) sb_unit(ws, u, lane_);
                }
                GSYNC();
                {
                    PH_BEGIN(l);
                    conv_ffn(CCX(), FFN_SRC(lq, 22), ws + OFF_FFN2W);
                    __syncthreads();
                    bf16_t* GATES = (bf16_t*)(ws + OFF_A);
                    pg8::Ops g; g.A = (const char*)(ws + OFF_Q16); g.Bt = (const char*)(ws + OFF_BT_M); g.lda_b = 128; g.ldb_b = D * 2; g.a_kstep = (size_t)S * 128; g.nt = 16; g.a_mode = 1;
                    pg8::StaticOrder so; so.init(M, D, G_, bid);
                    pg8::EpiMerge E{GATES, GATES + (size_t)M * D, GATES + (size_t)2 * M * D, (bf16_t*)(ws + OFF_MERGED)};
                    pg8::gemm_phase(ldsr, MYTID(), g, so, E);
                }
                GSYNC();
                {
                    PH_BEGIN(l);
                    if (lq == 0) { conv_ffn(CCX(), FFN_SRC(1, 2), ws + OFF_FFN1W); __syncthreads(); }
                    pg8::Ops g; g.A = (const char*)(ws + OFF_MERGED); g.Bt = (const char*)(ws + OFF_BT_O); g.lda_b = D * 2; g.ldb_b = D * 2; g.a_kstep = 128; g.nt = 16; g.a_mode = 0;
                    pg8::StaticOrder so; so.init(M, D, G_, bid);
                    pg8::EpiResid E{X, XB, SSQ, 1.0f};
                    pg8::gemm_phase(ldsr, MYTID(), g, so, E);
                }
                GSYNC();
            }
            {
                PH_BEGIN(l);
                int fq_ = f; asm volatile("" : "+s"(fq_));
                unsigned char* wbase = ws + (fq_ == 0 ? OFF_FFN1W : OFF_FFN2W);
                if (fq_ == 1 && lq == 0) { conv_mix(CCX(), mixw_of(p, 1), ws); __syncthreads(); }
                pg8::Ops g; g.A = (const char*)XB; g.Bt = (const char*)wbase; g.lda_b = D * 2; g.ldb_b = D * 2; g.a_kstep = 128; g.nt = 16; g.a_mode = 0;
                pg8::StaticOrder so; so.init(M, 2 * F, G_, bid);
                pg8::EpiFfnUp E{(bf16_t*)(ws + OFF_A), SSQ};
                pg8::gemm_phase(ldsr, MYTID(), g, so, E);
            }
            GSYNC();
            {
                PH_BEGIN(l);
                int fq_ = f; asm volatile("" : "+s"(fq_));
                unsigned char* wbase = ws + (fq_ == 0 ? OFF_FFN1W : OFF_FFN2W);
                pg8::Ops g; g.A = (const char*)(ws + OFF_A); g.Bt = (const char*)(wbase + FFNW_D); g.lda_b = F * 2; g.ldb_b = F * 2; g.a_kstep = 128; g.nt = F / 64; g.a_mode = 0;
                pg8::StaticOrder so; so.init(M, D, G_, bid);
                pg8::EpiResid E{X, XB, SSQ, 0.5f};
                pg8::gemm_phase(ldsr, MYTID(), g, so, E);
            }
            GSYNC();
        }
    }
}

extern "C" void kernel_launch(void* const* d_in, const int* in_sizes, int n_in, void* d_out, int out_size, void* d_ws, size_t ws_size, hipStream_t stream) {
    static int grid_blocks = 0;
    if (grid_blocks == 0) {
        if (ws_size < WS_END || n_in != 26) { fprintf(stderr, "kernel_launch: bad sizes (ws %zu)\n", ws_size); grid_blocks = -1; return; }
        int dev = 0, cus = 0, per_cu = 0;
        (void)hipGetDevice(&dev); (void)hipDeviceGetAttribute(&cus, hipDeviceAttributeMultiprocessorCount, dev);
        (void)hipFuncSetAttribute((const void*)mega_fwd, hipFuncAttributeMaxDynamicSharedMemorySize, LDS_BYTES);
        (void)hipOccupancyMaxActiveBlocksPerMultiprocessor(&per_cu, (const void*)mega_fwd, 512, LDS_BYTES);
        if (per_cu < 1) { fprintf(stderr, "kernel_launch: occupancy query says %d\n", per_cu); per_cu = 1; }
        grid_blocks = cus * (per_cu > 1 ? 1 : per_cu);
        (void)hipGetLastError();
    }
    if (grid_blocks < 0) return;
    Params p{}; for (int i = 0; i < 26; ++i) p.in[i] = (const float*)d_in[i]; p.out = (float*)d_out; p.ws = (unsigned char*)d_ws;
    void* args[] = {&p};
    hipError_t e = hipLaunchCooperativeKernel((void*)mega_fwd, dim3(grid_blocks), dim3(512), args, LDS_BYTES, stream);
    if (e != hipSuccess) fprintf(stderr, "cooperative launch failed: %s (grid %d)\n", hipGetErrorString(e), grid_blocks);
}
```

```cpp
#include <hip/hip_runtime.h>
#include <hip/hip_cooperative_groups.h>
#include <stdint.h>
#include <cstdio>
namespace cg = cooperative_groups;
__device__ __forceinline__ int lane_id() { return (int)__builtin_amdgcn_mbcnt_hi(~0u, __builtin_amdgcn_mbcnt_lo(~0u, 0u)); }
#define MYTID() (wave_s * 64 + lane_id())
#define VB_SETUP int tidx_ = tid_in; asm volatile("" : "+v"(tidx_)); const int tid = tidx_ & 255, vhalf = tidx_ >> 8; const int vb0 = blockIdx.x * 2 + vhalf, nvb = gridDim.x * 2; char* lds = lds_base + vhalf * 32768; (void)tid; (void)lds; (void)vb0; (void)nvb
#define LAS __attribute__((address_space(3)))

typedef unsigned short bf16_t;
typedef short bf16x8 __attribute__((ext_vector_type(8)));
typedef float f32x4 __attribute__((ext_vector_type(4)));
typedef unsigned u32x4 __attribute__((ext_vector_type(4)));
__device__ __forceinline__ float bf2f(bf16_t v) { return __uint_as_float(((unsigned)v) << 16); }
__device__ __forceinline__ bf16_t f2bf(float f) { unsigned u = __float_as_uint(f); return (bf16_t)((u + 0x7fffu + ((u >> 16) & 1u)) >> 16); }
__device__ __forceinline__ unsigned pk2(float lo, float hi) { return (unsigned)f2bf(lo) | ((unsigned)f2bf(hi) << 16); }

__host__ __device__ __forceinline__ int vperm16(int k) { return 8 * ((k >> 2) & 1) + 4 * (k >> 3) + (k & 3); }
__device__ __forceinline__ size_t vt_pos(int s) { return (size_t)((s & ~15) + vperm16(s & 15)); }
constexpr int NB = 2, S = 8192, M = NB * S, D = 1024, F = 2816, HD = 64, DIN = 5656;
constexpr int NCMP = 511, NSLC = 128;
constexpr float LOG2E = 1.4426950408889634f;
constexpr float C2 = 0.125f * LOG2E;
constexpr float EPS = 1e-6f;

constexpr size_t MiB = 1u << 20;
constexpr size_t OFF_CTL = 0;
constexpr size_t OFF_SSQ = 1 * MiB;
constexpr size_t OFF_XB = 2 * MiB;
constexpr size_t OFF_A = 34 * MiB;
constexpr size_t OFF_MIXW = 130 * MiB;
constexpr size_t OFF_BT_IN = OFF_MIXW, OFF_BT_C1 = OFF_MIXW + 12 * MiB, OFF_BT_M = OFF_MIXW + 14 * MiB, OFF_BT_O = OFF_MIXW + 16 * MiB;
constexpr size_t OFF_Q16 = 148 * MiB;
constexpr size_t OFF_KV = 180 * MiB;
constexpr size_t KV2 = 4 * MiB, KV4 = 8 * MiB;
constexpr size_t OFF_KCMP = OFF_KV, OFF_VCMP = OFF_KCMP + KV2, OFF_KSLC = OFF_VCMP + KV2, OFF_VSLCT = OFF_KSLC + KV2,
                 OFF_KWIN = OFF_VSLCT + KV2, OFF_VWINT = OFF_KWIN + KV2, OFF_WK = OFF_VWINT + KV2, OFF_WVT = OFF_WK + KV2,
                 OFF_SBK = OFF_WVT + KV2, OFF_SBVT = OFF_SBK + KV4;
constexpr size_t OFF_MERGED = OFF_KV;
constexpr size_t OFF_FFN1W = OFF_Q16, OFF_FFN2W = OFF_KV + 32 * MiB;
constexpr size_t FFNW_D = 11 * MiB;
constexpr size_t OFF_SMALL = 229 * MiB;
constexpr size_t OFF_NGATE = OFF_SMALL;
constexpr size_t OFF_KCN = OFF_NGATE + 2 * MiB;
constexpr size_t OFF_VCT = OFF_KCN + MiB / 4;
constexpr size_t OFF_HID = OFF_VCT + MiB / 4;
constexpr size_t OFF_BIASC = OFF_HID + 4 * MiB;
constexpr size_t WS_END = OFF_BIASC + MiB;
static_assert(OFF_SBVT + KV4 <= OFF_FFN2W + 17 * MiB && OFF_FFN2W + 17 * MiB <= OFF_SMALL, "ws map");

__device__ const unsigned char T5B[128] = {
    0, 1, 2, 3, 4, 5, 6, 7, 8, 9, 10, 11, 12, 13, 14, 15, 16, 16, 16, 17, 17, 18, 18, 18, 19, 19, 19, 20, 20, 20, 20, 21, 21, 21, 21, 22, 22, 22, 22, 22, 23, 23, 23, 23, 23, 23, 24, 24, 24, 24, 24, 24, 25, 25, 25, 25, 25, 25, 25, 26, 26, 26, 26, 26, 26, 26, 26, 27, 27, 27, 27, 27, 27, 27, 27, 27, 27, 28, 28, 28, 28, 28, 28, 28, 28, 28, 28, 29, 29, 29, 29, 29, 29, 29, 29, 29, 29, 29, 29, 30, 30, 30, 30, 30, 30, 30, 30, 30, 30, 30, 30, 30, 30, 31, 31, 31, 31, 31, 31, 31, 31, 31, 31, 31, 31, 31, 31, 31};
__device__ __forceinline__ int t5b(int dist) { return dist >= 128 ? 31 : (int)T5B[dist < 0 ? 0 : dist]; }

__device__ __forceinline__ float wave_sum(float v) {
#pragma unroll
    for (int o = 1; o < 64; o <<= 1) v += __shfl_xor(v, o);
    return v;
}
__device__ __forceinline__ float wave_max(float v) {
#pragma unroll
    for (int o = 1; o < 64; o <<= 1) v = fmaxf(v, __shfl_xor(v, o));
    return v;
}
__device__ __forceinline__ float sigmoidf_(float x) { return 1.f / (1.f + __expf(-x)); }
__device__ __forceinline__ float siluf_(float x) { return x / (1.f + __expf(-x)); }
__device__ __forceinline__ float fast_sigmoid(float x) { return __builtin_amdgcn_rcpf(1.f + __builtin_amdgcn_exp2f(-x * LOG2E)); }

__device__ __forceinline__ void ph_prep(char* lds_base, int tid_in, const float* xin, float* X, bf16_t* XB, float* SSQ) {
    VB_SETUP;
    for (int item = vb0; item < M / 4; item += nvb) {
    const int row = item * 4 + (tid >> 6), lane = tid & 63;
    float ss = 0.f;
    for (int j = 0; j < 16; ++j) {
        const int c = j * 64 + lane; const float v = xin[(size_t)row * D + c];
        if (X != xin) X[(size_t)row * D + c] = v;
        XB[(size_t)row * D + c] = f2bf(v); ss += v * v;
    }
    ss = wave_sum(ss);
    if (lane < 16) SSQ[(size_t)row * 16 + lane] = lane == 0 ? ss : 0.f;
    }
}

namespace pg8 {
constexpr int BM = 256, BK = 64, HALF = 128, HTB = HALF * BK * 2, STAGE_BYTES = 8 * HTB, NXCD = 8, WGM = 8;
__host__ __device__ __forceinline__ int lds_byte(int r, int c) { const int st = (r >> 4) * 2 + (c >> 5), rr = r & 15, cc = c & 31, ob = rr * 64 + cc * 2; return st * 1024 + (ob ^ (((ob >> 9) & 1) << 5)); }
__host__ __device__ __forceinline__ void stage_rc(int b, int& R, int& C) { const int st = b / 1024, sb = b % 1024, swz = sb ^ (((sb >> 9) & 1) << 5); R = (st >> 1) * 16 + swz / 64; C = (st & 1) * 32 + (swz % 64) / 2; }
__host__ __device__ __forceinline__ int perm32(int rho) { const int n = rho >> 4, i = rho & 15; return 8 * (i >> 2) + 4 * n + (i & 3); }
struct Unit { int pm, pn; };
struct StaticOrder {
    int nM, nN, nwg, G, c;
    __device__ void init(int M_, int N_, int G_, int c_) { nM = M_ / BM; nN = N_ / BM; nwg = nM * nN; G = G_; c = c_; }
    __device__ bool next(int i, Unit& u) const {
        const long L = (long)i * G + c; if (L >= nwg) return false;
        int wgid = (int)L; { const int q = nwg / NXCD, r = nwg % NXCD, xcd = wgid % NXCD, off = wgid / NXCD; wgid = (xcd < r ? xcd * (q + 1) : r * (q + 1) + (xcd - r) * q) + off; }
        const int nig = WGM * nN, gid = wgid / nig, fm = gid * WGM, gsz = (nM - fm) < WGM ? (nM - fm) : WGM;
        u.pm = fm + ((wgid % nig) % gsz); u.pn = (wgid % nig) / gsz; return true;
    }
};
struct Ops {
    const char* A; const char* Bt; unsigned lda_b, ldb_b; size_t a_kstep; int nt;
    int a_mode;
    __device__ __forceinline__ const char* a_base(const Unit& u) const {
        if (a_mode == 1) return A + (size_t)(u.pm >> 5) * (16ull * S * 128) + (size_t)(u.pm & 31) * (256 * 128);
        if (a_mode == 2) return A + (size_t)u.pn * KV2 + (size_t)u.pm * 256 * lda_b;
        return A + (size_t)u.pm * 256 * lda_b;
    }
    __device__ __forceinline__ const char* b_base(const Unit& u) const { return Bt + (size_t)u.pn * 256 * ldb_b; }
};

template <class Epi, class Sched>
__device__ __forceinline__ void gemm_phase(LAS unsigned char* lds, int tid_in, const Ops& G, const Sched& S_, const Epi& E) {
    int tid_ = tid_in; asm volatile("" : "+v"(tid_));
    const int tid = tid_, wid = __builtin_amdgcn_readfirstlane(tid >> 6), lane = tid & 63, wr = wid >> 2, wc = wid & 3, fr = lane & 15, fq = lane >> 4;
    const int nt = G.nt;
    unsigned voffA[2], voffB[2];
#pragma unroll
    for (int i = 0; i < 2; ++i) { int R, C; stage_rc(tid * 16 + i * 8192, R, C); const int Rb = Epi::PERM ? ((R & ~31) + perm32(R & 31)) : R;
        voffA[i] = (unsigned)R * G.lda_b + (unsigned)C * 2u; voffB[i] = (unsigned)Rb * G.ldb_b + (unsigned)C * 2u; }
    const size_t kstepA = G.a_kstep, kstepB = (size_t)(BK * 2);
    const size_t hstepA = (size_t)HALF * G.lda_b, hstepB = (size_t)HALF * G.ldb_b;
    const unsigned ldsw = (unsigned)wid * 1024u;
    const int aoff = lds_byte(wr * 64 + fr, fq * 8), boff = lds_byte(wc * 32 + fr, fq * 8);
#define PG8_SA(b, h) (((b) * 2 + (h)) * HTB)
#define PG8_SB(b, h) ((4 + (b) * 2 + (h)) * HTB)
#define PG8_STAGE(bufoff, gbase, voff) do { _Pragma("unroll") for (int _i = 0; _i < 2; ++_i) \
        __builtin_amdgcn_global_load_lds((const unsigned*)((const char*)(gbase) + (voff)[_i]), (LAS unsigned*)(lds + (bufoff) + ldsw + _i * 8192), 16, 0, 0); } while (0)
#define PG8_LDA(dst, b, h) do { _Pragma("unroll") for (int m = 0; m < 4; ++m) _Pragma("unroll") for (int k = 0; k < 2; ++k) dst[m][k] = *(const LAS bf16x8*)(lds + PG8_SA(b, h) + aoff + m * 2048 + k * 1024); } while (0)
#define PG8_LDB(dst, b, h) do { _Pragma("unroll") for (int n = 0; n < 2; ++n) _Pragma("unroll") for (int k = 0; k < 2; ++k) dst[n][k] = *(const LAS bf16x8*)(lds + PG8_SB(b, h) + boff + n * 2048 + k * 1024); } while (0)
#define PG8_MMA(ai, bj, At, Bt) do { __builtin_amdgcn_s_setprio(1); _Pragma("unroll") for (int m = 0; m < 4; ++m) _Pragma("unroll") for (int n = 0; n < 2; ++n) _Pragma("unroll") for (int k = 0; k < 2; ++k) \
        acc[ai][bj][m][n] = __builtin_amdgcn_mfma_f32_16x16x32_bf16(Bt[n][k], At[m][k], acc[ai][bj][m][n], 0, 0, 0); __builtin_amdgcn_s_setprio(0); } while (0)
#define PG8_WAIT_V(n) asm volatile("s_waitcnt vmcnt(" #n ")" ::: "memory")
#define PG8_WAIT_L(n) asm volatile("s_waitcnt lgkmcnt(" #n ")" ::: "memory")
#define PG8_BAR __builtin_amdgcn_s_barrier()
#define PG8_SCHED __builtin_amdgcn_sched_barrier(0)
    Unit cur, nxt; int ui = 0;
    if (!S_.next(0, cur)) return;
    f32x4 acc[2][2][4][2];
#pragma unroll
    for (int a = 0; a < 2; ++a)
#pragma unroll
        for (int b = 0; b < 2; ++b)
#pragma unroll
            for (int m = 0; m < 4; ++m)
#pragma unroll
                for (int n = 0; n < 2; ++n) acc[a][b][m][n] = (f32x4){0.f, 0.f, 0.f, 0.f};
    bf16x8 At[4][2], B0[2][2], B1[2][2];
    const char* cA = G.a_base(cur); const char* cB = G.b_base(cur);
    PG8_STAGE(PG8_SB(0, 0), cB, voffB); PG8_STAGE(PG8_SB(0, 1), cB + hstepB, voffB); PG8_STAGE(PG8_SA(0, 0), cA, voffA); PG8_STAGE(PG8_SA(0, 1), cA + hstepA, voffA);
    if (wr == 1) PG8_BAR;
    PG8_WAIT_V(2); PG8_BAR;
    PG8_STAGE(PG8_SB(1, 0), cB + kstepB, voffB); PG8_STAGE(PG8_SA(1, 0), cA + kstepA, voffA); PG8_STAGE(PG8_SB(1, 1), cB + hstepB + kstepB, voffB);
    PG8_WAIT_V(6); PG8_BAR;
    for (;;) {
        const bool has_next = S_.next(ui + 1, nxt);
        const char* nA = has_next ? G.a_base(nxt) : cA; const char* nB = has_next ? G.b_base(nxt) : cB;
        for (int t = 0; t < nt; t += 2) {
            const bool last = (t == nt - 2);
            const char* a1 = cA + (size_t)(t + 1) * kstepA;
            const char* a2 = last ? nA : cA + (size_t)(t + 2) * kstepA; const char* b2 = last ? nB : cB + (size_t)(t + 2) * kstepB;
            const char* a3 = a2 + kstepA; const char* b3 = b2 + kstepB;
            if constexpr (Epi::KHOOK) E.khook(acc, cur, t, wr, wc, fr, fq);
            PG8_LDB(B0, 0, 0); PG8_LDB(B1, 0, 1); PG8_SCHED; PG8_LDA(At, 0, 0); PG8_STAGE(PG8_SA(1, 1), a1 + hstepA, voffA);
            PG8_WAIT_V(8); PG8_WAIT_L(0); PG8_BAR; PG8_MMA(0, 0, At, B0); PG8_MMA(0, 1, At, B1); PG8_BAR; PG8_SCHED;
            PG8_LDA(At, 0, 1); PG8_STAGE(PG8_SB(0, 0), b2, voffB); PG8_STAGE(PG8_SB(0, 1), b2 + hstepB, voffB); PG8_STAGE(PG8_SA(0, 0), a2, voffA);
            PG8_WAIT_V(8); PG8_WAIT_L(0); PG8_BAR; PG8_MMA(1, 0, At, B0); PG8_MMA(1, 1, At, B1); PG8_BAR; PG8_SCHED;
            PG8_LDB(B0, 1, 0); PG8_LDB(B1, 1, 1); PG8_SCHED; PG8_LDA(At, 1, 0); PG8_STAGE(PG8_SA(0, 1), a2 + hstepA, voffA);
            PG8_WAIT_V(8); PG8_WAIT_L(0); PG8_BAR; PG8_MMA(0, 0, At, B0); PG8_MMA(0, 1, At, B1); PG8_BAR; PG8_SCHED;
            PG8_LDA(At, 1, 1); PG8_STAGE(PG8_SB(1, 0), b3, voffB); PG8_STAGE(PG8_SB(1, 1), b3 + hstepB, voffB); PG8_STAGE(PG8_SA(1, 0), a3, voffA);
            PG8_WAIT_V(8); PG8_WAIT_L(0); PG8_BAR; PG8_MMA(1, 0, At, B0); PG8_MMA(1, 1, At, B1); PG8_BAR; PG8_SCHED;
        }
        if (wr == 0) PG8_BAR;
        E(acc, cur, wr, wc, fr, fq);
        if (!has_next) break;
#pragma unroll
        for (int a = 0; a < 2; ++a)
#pragma unroll
            for (int b = 0; b < 2; ++b)
#pragma unroll
                for (int m = 0; m < 4; ++m)
#pragma unroll
                    for (int n = 0; n < 2; ++n) acc[a][b][m][n] = (f32x4){0.f, 0.f, 0.f, 0.f};
        cur = nxt; cA = nA; cB = nB; ++ui;
        if (wr == 1) PG8_BAR;
    }
    PG8_WAIT_V(0);
    PG8_BAR;
#undef PG8_SA
#undef PG8_SB
#undef PG8_STAGE
#undef PG8_LDA
#undef PG8_LDB
#undef PG8_MMA
#undef PG8_WAIT_V
#undef PG8_WAIT_L
#undef PG8_BAR
#undef PG8_SCHED
}

__device__ __forceinline__ float rstd_of(const float* ssq, int row) {
    const f32x4* p = (const f32x4*)(ssq + (size_t)row * 16); const f32x4 a = p[0], b = p[1], c = p[2], d = p[3];
    const float s = ((a[0] + a[1]) + (a[2] + a[3])) + ((b[0] + b[1]) + (b[2] + b[3])) + ((c[0] + c[1]) + (c[2] + c[3])) + ((d[0] + d[1]) + (d[2] + d[3]));
    return rsqrtf(s * (1.f / D) + EPS);
}
__device__ __forceinline__ float silu_fast(float x) { return x * __builtin_amdgcn_rcpf(1.f + __builtin_amdgcn_exp2f(-x * LOG2E)); }

struct EpiFfnUp {
    static constexpr bool PERM = true, KHOOK = false;
    bf16_t* H; const float* ssq;
    __device__ __forceinline__ void operator()(const f32x4 (&acc)[2][2][4][2], const Unit& u, int wr, int wc, int fr, int fq) const {
#pragma unroll
        for (int ai = 0; ai < 2; ++ai)
#pragma unroll
            for (int m = 0; m < 4; ++m) {
                const int row = u.pm * BM + ai * HALF + wr * 64 + m * 16 + fr; const float r = rstd_of(ssq, row);
                float h[8];
#pragma unroll
                for (int n = 0; n < 2; ++n)
#pragma unroll
                    for (int j = 0; j < 4; ++j) h[n * 4 + j] = silu_fast(r * acc[ai][0][m][n][j]) * (r * acc[ai][1][m][n][j]);
                u32x4 w; w.x = pk2(h[0], h[1]); w.y = pk2(h[2], h[3]); w.z = pk2(h[4], h[5]); w.w = pk2(h[6], h[7]);
                *(u32x4*)(H + (size_t)row * F + u.pn * 128 + wc * 32 + fq * 8) = w;
                asm volatile("" ::: "memory");
            }
    }
};
struct EpiResid {
    static constexpr bool PERM = true, KHOOK = false;
    float* X; bf16_t* XB; float* ssq; float alpha;
    __device__ __forceinline__ void operator()(const f32x4 (&acc)[2][2][4][2], const Unit& u, int wr, int wc, int fr, int fq) const {
#pragma unroll
        for (int ai = 0; ai < 2; ++ai)
#pragma unroll
            for (int m = 0; m < 4; ++m) {
                const int row = u.pm * BM + ai * HALF + wr * 64 + m * 16 + fr; float ss = 0.f;
#pragma unroll
                for (int bj = 0; bj < 2; ++bj) {
                    const size_t o = (size_t)row * D + u.pn * BM + bj * HALF + wc * 32 + fq * 8;
                    f32x4 x0 = *(const f32x4*)(X + o), x1 = *(const f32x4*)(X + o + 4);
                    x0 += acc[ai][bj][m][0] * alpha; x1 += acc[ai][bj][m][1] * alpha;
                    *(f32x4*)(X + o) = x0; *(f32x4*)(X + o + 4) = x1;
                    u32x4 w; w.x = pk2(x0[0], x0[1]); w.y = pk2(x0[2], x0[3]); w.z = pk2(x1[0], x1[1]); w.w = pk2(x1[2], x1[3]);
                    *(u32x4*)(XB + o) = w;
                    ss += (x0[0] * x0[0] + x0[1] * x0[1]) + (x0[2] * x0[2] + x0[3] * x0[3]) + (x1[0] * x1[0] + x1[1] * x1[1]) + (x1[2] * x1[2] + x1[3] * x1[3]);
                }
                ss += __shfl_xor(ss, 16); ss += __shfl_xor(ss, 32);
                if (fq == 0) ssq[(size_t)row * 16 + u.pn * 4 + wc] = ss;
                asm volatile("" ::: "memory");
            }
    }
};
__host__ __device__ __forceinline__ int win_slot_col(int slot) {
    if (slot < 8) return 64 * slot;
    if (slot < 20) return 512 + 64 * (slot - 8);
    if (slot < 40) return 1304 + 64 * (slot - 20);
    if (slot < 88) return 2584 + 64 * (slot - 40);
    if (slot == 88) return 1280;
    return -1;
}
struct EpiWin {
    static constexpr bool PERM = true, KHOOK = false;
    unsigned char* ws; const float* ssq; const float *nsa_qn, *nsa_kn, *swa_qn, *swa_kn;
    __device__ __forceinline__ void operator()(const f32x4 (&acc)[2][2][4][2], const Unit& u, int wr, int wc, int fr, int fq) const {
        const int slot = u.pn * 4 + wc;
        if (slot >= 89) return;
        int kind = 0; const float* nw = nullptr; float scale = 1.f; bf16_t* dst = nullptr; int nh = 2, h = 0;
        if (slot < 8) { nw = nsa_qn; scale = C2; dst = (bf16_t*)(ws + OFF_Q16); nh = 16; h = slot; }
        else if (slot < 10) { dst = (bf16_t*)(ws + OFF_KCMP); h = slot - 8; }
        else if (slot < 12) { dst = (bf16_t*)(ws + OFF_VCMP); h = slot - 10; }
        else if (slot < 14) { nw = nsa_kn; dst = (bf16_t*)(ws + OFF_KSLC); h = slot - 12; }
        else if (slot < 16) { kind = 1; dst = (bf16_t*)(ws + OFF_VSLCT); h = slot - 14; }
        else if (slot < 18) { nw = nsa_kn; dst = (bf16_t*)(ws + OFF_KWIN); h = slot - 16; }
        else if (slot < 20) { kind = 1; dst = (bf16_t*)(ws + OFF_VWINT); h = slot - 18; }
        else if (slot < 24) { scale = C2; dst = (bf16_t*)(ws + OFF_Q16); nh = 16; h = 8 + slot - 20; }
        else if (slot < 28) { dst = (bf16_t*)(ws + OFF_SBK); nh = 4; h = slot - 24; }
        else if (slot < 32) { kind = 1; dst = (bf16_t*)(ws + OFF_SBVT); nh = 4; h = slot - 28; }
        else if (slot < 36) { nw = swa_qn; scale = C2; dst = (bf16_t*)(ws + OFF_Q16); nh = 16; h = 12 + slot - 32; }
        else if (slot < 38) { nw = swa_kn; dst = (bf16_t*)(ws + OFF_WK); h = slot - 36; }
        else if (slot < 40) { kind = 1; dst = (bf16_t*)(ws + OFF_WVT); h = slot - 38; }
        else if (slot < 88) { kind = 2; dst = (bf16_t*)(ws + OFF_A) + (size_t)((slot - 40) >> 4) * M * D + ((slot - 40) & 15) * 64; }
        else { kind = 3; }
#pragma unroll
        for (int ai = 0; ai < 2; ++ai)
#pragma unroll
            for (int m = 0; m < 4; ++m) {
                const int row = u.pm * BM + ai * HALF + wr * 64 + m * 16 + fr; const float r = rstd_of(ssq, row);
                const int b = row / S, s = row % S;
                float v[2][2][4]; float ss = 0.f;
#pragma unroll
                for (int bj = 0; bj < 2; ++bj)
#pragma unroll
                    for (int n = 0; n < 2; ++n)
#pragma unroll
                        for (int j = 0; j < 4; ++j) { const float x = r * acc[ai][bj][m][n][j]; v[bj][n][j] = x; ss += x * x; }
                float rn = scale;
                if (nw) { ss += __shfl_xor(ss, 16); ss += __shfl_xor(ss, 32); rn = rsqrtf(ss * (1.f / 64.f) + EPS) * scale; }
#pragma unroll
                for (int bj = 0; bj < 2; ++bj)
#pragma unroll
                    for (int n = 0; n < 2; ++n) {
                        f32x4 wv = (f32x4){1.f, 1.f, 1.f, 1.f}; if (nw) wv = *(const f32x4*)(nw + 32 * bj + 8 * fq + 4 * n);
#pragma unroll
                        for (int j = 0; j < 4; ++j) v[bj][n][j] *= rn * wv[j];
                    }
                if (kind == 0) {
                    bf16_t* o = dst + (((size_t)b * nh + h) * S + s) * 64 + 8 * fq;
#pragma unroll
                    for (int bj = 0; bj < 2; ++bj) { u32x4 pw; pw.x = pk2(v[bj][0][0], v[bj][0][1]); pw.y = pk2(v[bj][0][2], v[bj][0][3]); pw.z = pk2(v[bj][1][0], v[bj][1][1]); pw.w = pk2(v[bj][1][2], v[bj][1][3]);
                        *(u32x4*)(o + 32 * bj) = pw; }
                } else if (kind == 1) {
                    bf16_t* o = dst + ((size_t)b * nh + h) * 64 * S + vt_pos(s);
#pragma unroll
                    for (int bj = 0; bj < 2; ++bj)
#pragma unroll
                        for (int n = 0; n < 2; ++n)
#pragma unroll
                            for (int j = 0; j < 4; ++j) o[(size_t)(32 * bj + 8 * fq + 4 * n + j) * S] = f2bf(v[bj][n][j]);
                } else if (kind == 2) {
                    bf16_t* o = dst + (size_t)row * D + 8 * fq;
#pragma unroll
                    for (int bj = 0; bj < 2; ++bj) { u32x4 pw; pw.x = pk2(fast_sigmoid(v[bj][0][0]), fast_sigmoid(v[bj][0][1])); pw.y = pk2(fast_sigmoid(v[bj][0][2]), fast_sigmoid(v[bj][0][3]));
                        pw.z = pk2(fast_sigmoid(v[bj][1][0]), fast_sigmoid(v[bj][1][1])); pw.w = pk2(fast_sigmoid(v[bj][1][2]), fast_sigmoid(v[bj][1][3])); *(u32x4*)(o + 32 * bj) = pw; }
                } else {
                    float* o = (float*)(ws + OFF_NGATE) + (size_t)row * 24;
#pragma unroll
                    for (int n = 0; n < 2; ++n)
#pragma unroll
                        for (int j = 0; j < 4; ++j) { const int d = 8 * fq + 4 * n + j; if (d < 24) o[d] = fast_sigmoid(v[0][n][j]); }
                }
                asm volatile("" ::: "memory");
            }
    }
};
struct EpiCmp1 {
    static constexpr bool PERM = true, KHOOK = false;
    float* HID; const float* bias;
    __device__ __forceinline__ void operator()(const f32x4 (&acc)[2][2][4][2], const Unit& u, int wr, int wc, int fr, int fq) const {
#pragma unroll
        for (int ai = 0; ai < 2; ++ai)
#pragma unroll
            for (int m = 0; m < 4; ++m) {
                const int row = u.pm * BM + ai * HALF + wr * 64 + m * 16 + fr;
#pragma unroll
                for (int bj = 0; bj < 2; ++bj)
#pragma unroll
                    for (int n = 0; n < 2; ++n) {
                        const int col = bj * HALF + wc * 32 + fq * 8 + 4 * n; const f32x4 bv = *(const f32x4*)(bias + u.pn * 256 + col);
                        f32x4 o;
#pragma unroll
                        for (int j = 0; j < 4; ++j) o[j] = silu_fast(acc[ai][bj][m][n][j] + bv[j]);
                        *(f32x4*)(HID + ((size_t)u.pn * 2048 + row) * 256 + col) = o;
                    }
                asm volatile("" ::: "memory");
            }
    }
};
struct EpiMerge {
    static constexpr bool PERM = true, KHOOK = true;
    const bf16_t* G0; const bf16_t* G1; const bf16_t* G2; bf16_t* OUT;
    __device__ __forceinline__ void khook(f32x4 (&acc)[2][2][4][2], const Unit& u, int t, int wr, int wc, int fr, int fq) const {
        if (t != 8 && t != 12) return;
        const bf16_t* NUM = t == 8 ? G0 : G1; const bf16_t* DEN = t == 8 ? G1 : G2;
#pragma unroll
        for (int ai = 0; ai < 2; ++ai)
#pragma unroll
            for (int m = 0; m < 4; ++m) {
                const int row = u.pm * BM + ai * HALF + wr * 64 + m * 16 + fr;
#pragma unroll
                for (int bj = 0; bj < 2; ++bj) {
                    const size_t o = (size_t)row * D + u.pn * BM + bj * HALF + wc * 32 + fq * 8;
                    const u32x4 nu = *(const u32x4*)(NUM + o), de = *(const u32x4*)(DEN + o);
#pragma unroll
                    for (int q = 0; q < 4; ++q) {
                        const float n0 = __uint_as_float(nu[q] << 16), n1 = __uint_as_float(nu[q] & 0xffff0000u), d0 = __uint_as_float(de[q] << 16), d1 = __uint_as_float(de[q] & 0xffff0000u);
                        acc[ai][bj][m][q >> 1][(q & 1) * 2] *= n0 * __builtin_amdgcn_rcpf(d0); acc[ai][bj][m][q >> 1][(q & 1) * 2 + 1] *= n1 * __builtin_amdgcn_rcpf(d1);
                    }
                }
                asm volatile("" : "+v"(acc[ai][0][m][0]), "+v"(acc[ai][0][m][1]), "+v"(acc[ai][1][m][0]), "+v"(acc[ai][1][m][1]) :: "memory");
            }
    }
    __device__ __forceinline__ void operator()(const f32x4 (&acc)[2][2][4][2], const Unit& u, int wr, int wc, int fr, int fq) const {
#pragma unroll
        for (int ai = 0; ai < 2; ++ai)
#pragma unroll
            for (int m = 0; m < 4; ++m) {
                const int row = u.pm * BM + ai * HALF + wr * 64 + m * 16 + fr;
#pragma unroll
                for (int bj = 0; bj < 2; ++bj) {
                    const size_t o = (size_t)row * D + u.pn * BM + bj * HALF + wc * 32 + fq * 8;
                    const u32x4 ge = *(const u32x4*)(G2 + o); u32x4 pw;
#pragma unroll
                    for (int q = 0; q < 4; ++q) {
                        const float g0 = __uint_as_float(ge[q] << 16), g1 = __uint_as_float(ge[q] & 0xffff0000u);
                        pw[q] = pk2(acc[ai][bj][m][q >> 1][(q & 1) * 2] * g0, acc[ai][bj][m][q >> 1][(q & 1) * 2 + 1] * g1);
                    }
                    *(u32x4*)(OUT + o) = pw;
                }
                asm volatile("" ::: "memory");
            }
    }
};
}

__device__ __forceinline__ void conv_item(const float* W, int ldw, int col0, int nvalid, int ksrc, const float* wn, bf16_t* Bt, size_t ldbt, int row0, int kofs, LAS float* scr, int lane) {
    const int n_ = lane & 31;
#pragma unroll 8
    for (int i = 0; i < 32; ++i) { const int kk = 2 * i + (lane >> 5); float v = 0.f; if (n_ < nvalid) { v = W[(size_t)(ksrc + kk) * ldw + col0 + n_]; if (wn) v *= wn[ksrc + kk]; } scr[kk * 33 + n_] = v; }
    asm volatile("s_waitcnt lgkmcnt(0)" ::: "memory");
    const int c = lane & 7;
#pragma unroll
    for (int j = 0; j < 4; ++j) { const int n = (lane >> 3) + 8 * j; const LAS float* s = scr + (8 * c) * 33 + n;
        u32x4 o; o.x = pk2(s[0 * 33], s[1 * 33]); o.y = pk2(s[2 * 33], s[3 * 33]); o.z = pk2(s[4 * 33], s[5 * 33]); o.w = pk2(s[6 * 33], s[7 * 33]);
        *(u32x4*)(Bt + (size_t)(row0 + n) * ldbt + kofs + 8 * c) = o; }
    asm volatile("s_waitcnt lgkmcnt(0)" ::: "memory");
}
struct ConvCtx { LAS unsigned char* ldsr; LAS float* scr; int gw, ngw, lane; };
#define CONV_LAUNDER ConvCtx c = c_; { int t_ = c_.lane; asm volatile("" : "+v"(t_)); c.lane = t_ & 63; const int wv_ = __builtin_amdgcn_readfirstlane(t_ >> 6); c.gw = blockIdx.x * 8 + wv_; c.scr = (LAS float*)(c.ldsr + wv_ * 8448); }
__device__ __forceinline__ void conv_ffn(const ConvCtx& c_, const float* nw, const float* wg, const float* wu, const float* wd, unsigned char* dstbase) {
    CONV_LAUNDER;
    bf16_t* GU = (bf16_t*)dstbase; bf16_t* DN = (bf16_t*)(dstbase + FFNW_D);
    constexpr int I_GU = 176 * 16, I_D = 32 * 44;
    for (int it = c.gw; it < I_GU + I_D; it += c.ngw) {
        if (it < I_GU) { const int rb = it / 16, kb = it % 16, tile = rb >> 3, r32 = rb & 7, bj = r32 >> 2, cc = (r32 & 3) * 32;
            conv_item(bj ? wu : wg, F, tile * 128 + cc, 32, kb * 64, nw, GU, D, rb * 32, kb * 64, c.scr, c.lane); }
        else { const int r = it - I_GU, rb = r / 44, kb = r % 44; conv_item(wd, D, rb * 32, 32, kb * 64, nullptr, DN, F, rb * 32, kb * 64, c.scr, c.lane); }
    }
}
struct MixW { const float *mixn, *win, *w1k, *w1v, *ua, *ub, *uc, *wo, *pos; };
__device__ __forceinline__ void conv_mix(const ConvCtx& c_, const MixW& w, unsigned char* ws) {
    CONV_LAUNDER;
    bf16_t* BIN = (bf16_t*)(ws + OFF_BT_IN); bf16_t* BC1 = (bf16_t*)(ws + OFF_BT_C1); bf16_t* BM_ = (bf16_t*)(ws + OFF_BT_M); bf16_t* BO = (bf16_t*)(ws + OFF_BT_O);
    constexpr int I_IN = 184 * 16, I_C1 = 16 * 32, I_M = 32 * 16, I_O = 32 * 16, I_B = 8;
    for (int it = c.gw; it < I_IN + I_C1 + I_M + I_O + I_B; it += c.ngw) {
        int r = it;
        if (r < I_IN) { const int rb = r / 16, kb = r % 16, tile = rb >> 3, r32 = rb & 7, bj = r32 >> 2, slot = tile * 4 + (r32 & 3);
            const int sc = pg8::win_slot_col(slot); int nvalid = sc < 0 ? 0 : 32; if (slot == 88) nvalid = bj == 0 ? 24 : 0;
            conv_item(w.win, DIN, sc + 32 * bj, nvalid, kb * 64, w.mixn, BIN, D, rb * 32, kb * 64, c.scr, c.lane); continue; }
        r -= I_IN;
        if (r < I_C1) { const int rb = r / 32, kb = r % 32; conv_item(rb >= 8 ? w.w1v : w.w1k, 256, (rb & 7) * 32, 32, kb * 64, nullptr, BC1, 2048, rb * 32, kb * 64, c.scr, c.lane); continue; }
        r -= I_C1;
        if (r < I_M) { const int rb = r / 16, kb = r % 16;
            if (kb < 8) conv_item(w.ua, D, rb * 32, 32, kb * 64, nullptr, BM_, D, rb * 32, kb * 64, c.scr, c.lane);
            else if (kb < 12) conv_item(w.ub, D, rb * 32, 32, (kb - 8) * 64, nullptr, BM_, D, rb * 32, kb * 64, c.scr, c.lane);
            else conv_item(w.uc, D, rb * 32, 32, (kb - 12) * 64, nullptr, BM_, D, rb * 32, kb * 64, c.scr, c.lane);
            continue; }
        r -= I_M;
        if (r < I_O) { const int rb = r / 16, kb = r % 16; conv_item(w.wo, D, rb * 32, 32, kb * 64, nullptr, BO, D, rb * 32, kb * 64, c.scr, c.lane); continue; }
        r -= I_O;
        { const int kv = r >> 2, j = (r & 3) * 64 + c.lane; const float* w1 = kv ? w.w1v : w.w1k; float s = 0.f;
          for (int k = 0; k < 2048; ++k) s += w.pos[k] * w1[(size_t)k * 256 + j];
          ((float*)(ws + OFF_BIASC))[kv * 256 + j] = s; }
    }
}

__device__ __forceinline__ void ph_cmp2(char* lds_base, int tid_in, const float* hid, const float* w2k, const float* w2v, const float* knorm, bf16_t* KCN, bf16_t* VCT) {
    VB_SETUP;
    for (int item = vb0; item < 1024; item += nvb) {
    const int gw = item * 4 + (tid >> 6), lane = tid & 63;
    const int kv = gw / 2048, R = gw % 2048, grp = R / 512, n = R % 512;
    const float* h = hid + ((size_t)kv * 2048 + R) * 256; const float* w2 = kv ? w2v : w2k;
    float s = 0.f; for (int k = 0; k < 256; ++k) s += h[k] * w2[k * 64 + lane];
    if (n >= NCMP) s = 0.f;
    if (kv == 0) { const float ss = wave_sum(s * s); KCN[((size_t)grp * 512 + n) * 64 + lane] = f2bf(s * rsqrtf(ss * (1.f / 64.f) + EPS) * knorm[lane]); }
    else VCT[((size_t)grp * 64 + lane) * 512 + vt_pos(n)] = f2bf(s);
    }
}

typedef float f32x16 __attribute__((ext_vector_type(16)));
__host__ __device__ __forceinline__ int crow(int r, int hi) { return (r & 3) + 8 * (r >> 2) + 4 * hi; }
__device__ __forceinline__ float xhalf(float v) { return __shfl_xor(v, 32); }
__device__ __forceinline__ bf16x8 pack8(const f32x16& p, int s) {
    u32x4 w; w.x = pk2(p[8 * s + 0], p[8 * s + 1]); w.y = pk2(p[8 * s + 2], p[8 * s + 3]); w.z = pk2(p[8 * s + 4], p[8 * s + 5]); w.w = pk2(p[8 * s + 6], p[8 * s + 7]);
    return __builtin_bit_cast(bf16x8, w);
}
constexpr int TAB_N = 130;
__device__ __forceinline__ int tab_idx(int dist) { return min(max(dist, -1), 128) + 1; }
__device__ __forceinline__ void build_tabs(LAS float* tab, const float* rel_bias, int tid) {
    for (int i = tid; i < 12 * TAB_N; i += 512) {
        const int hh = i / TAB_N, e = i % TAB_N; float v;
        if (e == 0) v = -INFINITY;
        else if (hh < 8) v = e == 129 ? 0.f : (rel_bias[t5b(e - 1) * 12 + hh] - rel_bias[31 * 12 + hh]) * LOG2E;
        else v = e == 129 ? -INFINITY : rel_bias[t5b(e - 1) * 12 + hh] * LOG2E;
        tab[i] = v;
    }
}
__device__ __forceinline__ void qk_global(f32x16& p0, f32x16& p1, const bf16_t* K, const bf16x8 (&qf)[4], int lane) {
    const bf16_t* kp = K + (size_t)(lane & 31) * 64 + 8 * (lane >> 5);
    f32x16 z;
#pragma unroll
    for (int r = 0; r < 16; ++r) z[r] = 0.f;
    p0 = z; p1 = z;
#pragma unroll
    for (int c = 0; c < 4; ++c) {
        const bf16x8 k0 = *(const bf16x8*)(kp + 16 * c), k1 = *(const bf16x8*)(kp + 32 * 64 + 16 * c);
        p0 = __builtin_amdgcn_mfma_f32_32x32x16_bf16(k0, qf[c], p0, 0, 0, 0);
        p1 = __builtin_amdgcn_mfma_f32_32x32x16_bf16(k1, qf[c], p1, 0, 0, 0);
    }
}
__device__ __forceinline__ void pv_global(f32x16 (&o)[2], const bf16_t* VT, size_t pitch, const f32x16& p0, const f32x16& p1, int lane) {
    const bf16_t* vp = VT + (size_t)(lane & 31) * pitch + 8 * (lane >> 5);
#pragma unroll
    for (int kh = 0; kh < 2; ++kh)
#pragma unroll
        for (int s = 0; s < 2; ++s) {
            const bf16x8 pf = pack8(kh ? p1 : p0, s);
#pragma unroll
            for (int dh = 0; dh < 2; ++dh) {
                const bf16x8 vf = *(const bf16x8*)(vp + (size_t)(32 * dh) * pitch + 32 * kh + 16 * s);
                o[dh] = __builtin_amdgcn_mfma_f32_32x32x16_bf16(vf, pf, o[dh], 0, 0, 0);
            }
        }
}
__device__ __forceinline__ void softmax_step(f32x16& p0, f32x16& p1, float& m, float& l, f32x16 (&o)[2]) {
    float mx = fmaxf(p0[0], p1[0]);
#pragma unroll
    for (int r = 1; r < 16; ++r) mx = fmaxf(mx, fmaxf(p0[r], p1[r]));
    mx = fmaxf(mx, xhalf(mx));
    const float mn = fmaxf(m, mx);
    const float ms = (mn == -INFINITY) ? 0.f : mn;
    const float alpha = __builtin_amdgcn_exp2f(m - ms);
    float sum = 0.f;
#pragma unroll
    for (int r = 0; r < 16; ++r) { p0[r] = __builtin_amdgcn_exp2f(p0[r] - ms); p1[r] = __builtin_amdgcn_exp2f(p1[r] - ms); sum += p0[r] + p1[r]; }
    l = l * alpha + sum; m = mn;
    if (__any(alpha != 1.f)) {
#pragma unroll
        for (int r = 0; r < 16; ++r) { o[0][r] *= alpha; o[1][r] *= alpha; }
    }
}
__device__ __forceinline__ void store_ot(bf16_t* dst, const f32x16 (&o)[2], float scale, int hi) {
#pragma unroll
    for (int dh = 0; dh < 2; ++dh)
#pragma unroll
        for (int m4 = 0; m4 < 4; ++m4) {
            uint2 w; w.x = pk2(o[dh][4 * m4] * scale, o[dh][4 * m4 + 1] * scale); w.y = pk2(o[dh][4 * m4 + 2] * scale, o[dh][4 * m4 + 3] * scale);
            *(uint2*)(dst + 32 * dh + 8 * m4 + 4 * hi) = w;
        }
}

__device__ __forceinline__ void swa_unit(unsigned char* ws, const LAS float* tabW, const float* sinks, int unit, int lane) {
    const int t0 = (unit & 255) * 32, h = (unit >> 8) & 3, b = unit >> 10, g = h >> 1, hi = lane >> 5, t = t0 + (lane & 31);
    bf16_t* qrow = (bf16_t*)(ws + OFF_Q16) + (((size_t)b * 16 + 12 + h) * S + t) * 64;
    const bf16_t* K = (const bf16_t*)(ws + OFF_WK) + ((size_t)b * 2 + g) * S * 64; const bf16_t* VT = (const bf16_t*)(ws + OFF_WVT) + ((size_t)b * 2 + g) * 64 * S;
    bf16x8 qf[4];
#pragma unroll
    for (int c = 0; c < 4; ++c) qf[c] = *(const bf16x8*)(qrow + 16 * c + 8 * hi);
    const float sink = sinks[h] * LOG2E;
    float m = sink, l = hi == 0 ? 1.f : 0.f;
    f32x16 o[2];
#pragma unroll
    for (int r = 0; r < 16; ++r) { o[0][r] = 0.f; o[1][r] = 0.f; }
    const LAS float* tb = tabW + h * TAB_N;
    const int jlo = t0 >= 127 ? (t0 - 127) >> 6 : 0, jhi = (t0 + 31) >> 6;
    for (int j = jlo; j <= jhi; ++j) {
        f32x16 p0, p1;
        qk_global(p0, p1, K + (size_t)j * 64 * 64, qf, lane);
#pragma unroll
        for (int r = 0; r < 16; ++r) { const int d0 = t - (j * 64 + crow(r, hi)); p0[r] += tb[tab_idx(d0)]; p1[r] += tb[tab_idx(d0 - 32)]; }
        softmax_step(p0, p1, m, l, o);
        pv_global(o, VT + (size_t)j * 64, S, p0, p1, lane);
    }
    l += xhalf(l);
    store_ot(qrow, o, 1.f / l, hi);
}

constexpr float SB_CUT = 64.f;
__device__ __forceinline__ void sb_unit(unsigned char* ws, int unit, int lane) {
    const int t0 = (unit & 255) * 32, h = (unit >> 8) & 3, b = unit >> 10, hi = lane >> 5, t = t0 + (lane & 31);
    bf16_t* qrow = (bf16_t*)(ws + OFF_Q16) + (((size_t)b * 16 + 8 + h) * S + t) * 64;
    const bf16_t* K = (const bf16_t*)(ws + OFF_SBK) + ((size_t)b * 4 + h) * S * 64; const bf16_t* VT = (const bf16_t*)(ws + OFF_SBVT) + ((size_t)b * 4 + h) * 64 * S;
    bf16x8 qf[4];
#pragma unroll
    for (int c = 0; c < 4; ++c) qf[c] = *(const bf16x8*)(qrow + 16 * c + 8 * hi);
    f32x16 o[2];
#pragma unroll
    for (int r = 0; r < 16; ++r) { o[0][r] = 0.f; o[1][r] = 0.f; }
    float carry = 0.f;
    for (int j = (t0 + 31) >> 6; j >= 0; --j) {
        f32x16 z0, z1, f0, f1;
        qk_global(z0, z1, K + (size_t)j * 64 * 64, qf, lane);
        float gs[8];
#pragma unroll
        for (int u = 0; u < 8; ++u) gs[u] = 0.f;
        const int kb = j * 64;
#pragma unroll
        for (int r = 0; r < 16; ++r) {
            { const float z = z0[r]; const bool ok = kb + crow(r, hi) < t; const float sp = fmaxf(z, 0.f) + __builtin_amdgcn_logf(1.f + __builtin_amdgcn_exp2f(-fabsf(z))); f0[r] = ok ? -sp : 0.f; gs[r >> 2] += f0[r]; }
            { const float z = z1[r]; const bool ok = kb + 32 + crow(r, hi) < t; const float sp = fmaxf(z, 0.f) + __builtin_amdgcn_logf(1.f + __builtin_amdgcn_exp2f(-fabsf(z))); f1[r] = ok ? -sp : 0.f; gs[4 + (r >> 2)] += f1[r]; }
        }
        float T = 0.f, A[8];
#pragma unroll
        for (int u = 7; u >= 0; --u) { const float pg = xhalf(gs[u]); A[u] = T + (hi == 0 ? pg : 0.f); T += gs[u] + pg; }
#pragma unroll
        for (int u = 0; u < 8; ++u) {
            float run = carry + A[u];
#pragma unroll
            for (int i = 3; i >= 0; --i) {
                const int r = 4 * (u & 3) + i;
                if (u < 4) { const bool ok = kb + crow(r, hi) < t; const float lf = f0[r]; z0[r] = ok ? __builtin_amdgcn_exp2f(z0[r] + lf + run) : 0.f; run += lf; }
                else { const bool ok = kb + 32 + crow(r, hi) < t; const float lf = f1[r]; z1[r] = ok ? __builtin_amdgcn_exp2f(z1[r] + lf + run) : 0.f; run += lf; }
            }
        }
        carry += T;
        pv_global(o, VT + (size_t)j * 64, S, z0, z1, lane);
        if (__all(carry < -SB_CUT)) break;
    }
    store_ot(qrow, o, 1.f, hi);
}


constexpr int NSA_STAGE = 16384, NSA_IMPG = 32768, NSA_IMPL = 65536, NSA_SEL = 98304;
struct TileSrc { const bf16_t* K; const bf16_t* VT; size_t vpitch; };
__device__ __forceinline__ void nsa_issue(LAS unsigned char* stage, const TileSrc& ts, int j, int tid, int wave) {
    const int row = tid >> 3, chunk = (tid & 7) ^ ((row >> 1) & 7);
    __builtin_amdgcn_global_load_lds((const unsigned*)(ts.K + ((size_t)j * 64 + row) * 64 + chunk * 8), (LAS unsigned*)(stage + wave * 1024), 16, 0, 0);
    __builtin_amdgcn_global_load_lds((const unsigned*)(ts.VT + (size_t)row * ts.vpitch + (size_t)j * 64 + chunk * 8), (LAS unsigned*)(stage + 8192 + wave * 1024), 16, 0, 0);
}
__device__ __forceinline__ void qk_lds(f32x16& p0, f32x16& p1, const LAS unsigned char* Kst, const bf16x8 (&qf)[4], float cinit, int lrow, int swz, int hi) {
    f32x16 z;
#pragma unroll
    for (int r = 0; r < 16; ++r) z[r] = cinit;
    p0 = z; p1 = z;
#pragma unroll
    for (int c = 0; c < 4; ++c) {
        const int off = lrow + (((2 * c + hi) ^ swz) << 4);
        const bf16x8 k0 = *(const LAS bf16x8*)(Kst + off), k1 = *(const LAS bf16x8*)(Kst + 4096 + off);
        p0 = __builtin_amdgcn_mfma_f32_32x32x16_bf16(k0, qf[c], p0, 0, 0, 0);
        p1 = __builtin_amdgcn_mfma_f32_32x32x16_bf16(k1, qf[c], p1, 0, 0, 0);
    }
}
__device__ __forceinline__ void pv_lds(f32x16 (&o)[2], const LAS unsigned char* Vst, const f32x16& p0, const f32x16& p1, int lrow, int swz, int hi) {
#pragma unroll
    for (int kh = 0; kh < 2; ++kh)
#pragma unroll
        for (int s = 0; s < 2; ++s) {
            const bf16x8 pf = pack8(kh ? p1 : p0, s);
            const int off = lrow + (((4 * kh + 2 * s + hi) ^ swz) << 4);
#pragma unroll
            for (int dh = 0; dh < 2; ++dh) {
                const bf16x8 vf = *(const LAS bf16x8*)(Vst + dh * 4096 + off);
                o[dh] = __builtin_amdgcn_mfma_f32_32x32x16_bf16(vf, pf, o[dh], 0, 0, 0);
            }
        }
}
__device__ __forceinline__ float quad_sum(float v) {
    v += __int_as_float(__builtin_amdgcn_mov_dpp(__float_as_int(v), 0xB1, 0xf, 0xf, true));
    v += __int_as_float(__builtin_amdgcn_mov_dpp(__float_as_int(v), 0x4E, 0xf, 0xf, true));
    return v;
}
#define NSA_WAITBAR() do { asm volatile("s_waitcnt vmcnt(0) lgkmcnt(0)" ::: "memory"); __builtin_amdgcn_s_barrier(); asm volatile("" ::: "memory"); } while (0)

__device__ __forceinline__ void nsa_unit(LAS unsigned char* lds, const LAS float* tabN, unsigned char* ws, int b, int g, int qt, int tid_in) {
    int tid = tid_in; asm volatile("" : "+v"(tid));
    const int lane = tid & 63, wave = __builtin_amdgcn_readfirstlane(tid >> 6), hi = lane >> 5, col = lane & 31, qi = col >> 2, r = col & 3;
    const int t0 = qt * 64, qloc = 8 * wave + qi, t = t0 + qloc, h = 4 * g + r, grp = b * 2 + g;
    const int lrow = col * 128, swz = (col >> 1) & 7;
    bf16_t* qrow = (bf16_t*)(ws + OFF_Q16) + (((size_t)b * 16 + h) * S + t) * 64;
    bf16x8 qf[4];
#pragma unroll
    for (int c = 0; c < 4; ++c) qf[c] = *(const bf16x8*)(qrow + 16 * c + 8 * hi);
    const LAS float* tb = tabN + h * TAB_N;
    LAS float* impG = (LAS float*)(lds + NSA_IMPG); LAS float* impL = (LAS float*)(lds + NSA_IMPL); LAS unsigned* selm = (LAS unsigned*)(lds + NSA_SEL);
    const float* NG = (const float*)(ws + OFF_NGATE) + (size_t)(b * S + t) * 24;
    f32x16 out[2];
#pragma unroll
    for (int rr = 0; rr < 16; ++rr) { out[0][rr] = 0.f; out[1][rr] = 0.f; }

    {
        TileSrc ts; ts.K = (const bf16_t*)(ws + OFF_KCN) + (size_t)grp * 512 * 64; ts.VT = (const bf16_t*)(ws + OFF_VCT) + (size_t)grp * 64 * 512; ts.vpitch = 512;
        const int nmax = min((t0 + 32) >> 4, 510), nct = (nmax >> 6) + 1;
        float m = -INFINITY, l = 0.f;
        if (tid < 64) impL[tid * 128] = 0.f;
        NSA_WAITBAR();
        nsa_issue(lds, ts, 0, tid, wave);
        for (int i = 0; i < nct; ++i) {
            NSA_WAITBAR();
            if (i + 1 < nct) nsa_issue(lds + ((i + 1) & 1) * NSA_STAGE, ts, i + 1, tid, wave);
            const LAS unsigned char* st = lds + (i & 1) * NSA_STAGE;
            f32x16 p0, p1;
            qk_lds(p0, p1, st, qf, 0.f, lrow, swz, hi);
            float mx = -INFINITY;
#pragma unroll
            for (int rr = 0; rr < 16; ++rr) { const int dc = t - 16 * (i * 64 + crow(rr, hi)) - 31; p0[rr] += tb[tab_idx(dc)]; p1[rr] += tb[tab_idx(dc - 512)]; mx = fmaxf(mx, fmaxf(p0[rr], p1[rr])); }
            mx = fmaxf(mx, xhalf(mx));
            const float mn = fmaxf(m, mx), ms = (mn == -INFINITY) ? 0.f : mn;
            float sum = 0.f;
#pragma unroll
            for (int rr = 0; rr < 16; ++rr) sum += __builtin_amdgcn_exp2f(p0[rr] - ms) + __builtin_amdgcn_exp2f(p1[rr] - ms);
            l = l * __builtin_amdgcn_exp2f(m - ms) + sum; m = mn;
        }
        l += xhalf(l);
        const float ms = (m == -INFINITY) ? 0.f : m, il = l > 0.f ? 1.f / l : 0.f;
        f32x16 o[2];
#pragma unroll
        for (int rr = 0; rr < 16; ++rr) { o[0][rr] = 0.f; o[1][rr] = 0.f; }
        NSA_WAITBAR();
        nsa_issue(lds, ts, 0, tid, wave);
        for (int i = 0; i < nct; ++i) {
            NSA_WAITBAR();
            if (i + 1 < nct) nsa_issue(lds + ((i + 1) & 1) * NSA_STAGE, ts, i + 1, tid, wave);
            const LAS unsigned char* st = lds + (i & 1) * NSA_STAGE;
            f32x16 p0, p1;
            qk_lds(p0, p1, st, qf, 0.f, lrow, swz, hi);
#pragma unroll
            for (int rr = 0; rr < 16; ++rr) { const int dc = t - 16 * (i * 64 + crow(rr, hi)) - 31;
                p0[rr] = __builtin_amdgcn_exp2f(p0[rr] + tb[tab_idx(dc)] - ms) * il; p1[rr] = __builtin_amdgcn_exp2f(p1[rr] + tb[tab_idx(dc - 512)] - ms) * il; }
#pragma unroll
            for (int u = 0; u < 8; ++u) {
                const f32x16& pp = u < 4 ? p0 : p1; const int r0 = 4 * (u & 3);
                const float G = quad_sum((pp[r0] + pp[r0 + 1]) + (pp[r0 + 2] + pp[r0 + 3])), L = quad_sum(pp[r0 + 3]);
                const int j = 16 * i + 8 * (u >> 2) + 2 * (u & 3) + hi;
                if (r == 0) { impG[qloc * 128 + j] = G; if (j + 1 < 128) impL[qloc * 128 + j + 1] = L; }
            }
            pv_lds(o, st + 8192, p0, p1, lrow, swz, hi);
        }
        const float gc = NG[h];
#pragma unroll
        for (int rr = 0; rr < 16; ++rr) { out[0][rr] += gc * o[0][rr]; out[1][rr] += gc * o[1][rr]; }
    }
    NSA_WAITBAR();
    {
        int tid2 = tid_in; asm volatile("" : "+v"(tid2));
        const int q = tid2 >> 3, sub = tid2 & 7;
        unsigned mw[4] = {0u, 0u, 0u, 0u};
        if (qt <= 15) { if (sub == 0) mw[0] = (qt == 31) ? 0xffffffffu : ((2u << qt) - 1u); }
        else {
            float vj[16]; int rk[16];
#pragma unroll
            for (int i = 0; i < 16; ++i) { const int j = sub + 8 * i; vj[i] = impG[q * 128 + j] + impL[q * 128 + j]; rk[i] = 0; }
            for (int k = 1; k <= qt - 2; ++k) {
                const float vk = impG[q * 128 + k] + impL[q * 128 + k];
#pragma unroll
                for (int i = 0; i < 16; ++i) { const int j = sub + 8 * i; rk[i] += (vk > vj[i]) || (vk == vj[i] && k < j); }
            }
#pragma unroll
            for (int i = 0; i < 16; ++i) { const int j = sub + 8 * i; const bool forced = (j == 0) || (j == qt) || (j == qt - 1); const bool cand = j >= 1 && j <= qt - 2;
                if (forced || (cand && rk[i] < 13)) mw[j >> 5] |= 1u << (j & 31); }
        }
#pragma unroll
        for (int wd = 0; wd < 4; ++wd) { unsigned x = mw[wd]; x |= __shfl_xor((int)x, 1); x |= __shfl_xor((int)x, 2); x |= __shfl_xor((int)x, 4); if (sub == 0) selm[q * 4 + wd] = x; }
    }
    NSA_WAITBAR();
    unsigned sm0 = selm[qloc * 4 + 0], sm1 = selm[qloc * 4 + 1], sm2 = selm[qloc * 4 + 2], sm3 = selm[qloc * 4 + 3];
    {
        TileSrc ts; ts.K = (const bf16_t*)(ws + OFF_KSLC) + (size_t)grp * S * 64; ts.VT = (const bf16_t*)(ws + OFF_VSLCT) + (size_t)grp * 64 * S; ts.vpitch = S;
        float m = -INFINITY, l = 0.f;
        f32x16 o[2];
#pragma unroll
        for (int rr = 0; rr < 16; ++rr) { o[0][rr] = 0.f; o[1][rr] = 0.f; }
        nsa_issue(lds, ts, 0, tid, wave);
        for (int j = 0; j <= qt; ++j) {
            NSA_WAITBAR();
            if (j + 1 <= qt) nsa_issue(lds + ((j + 1) & 1) * NSA_STAGE, ts, j + 1, tid, wave);
            const LAS unsigned char* st = lds + (j & 1) * NSA_STAGE;
            const unsigned mword = j < 32 ? sm0 : j < 64 ? sm1 : j < 96 ? sm2 : sm3;
            const float cinit = ((mword >> (j & 31)) & 1u) ? 0.f : -INFINITY;
            f32x16 p0, p1;
            qk_lds(p0, p1, st, qf, cinit, lrow, swz, hi);
            if (j >= qt - 2) {
#pragma unroll
                for (int rr = 0; rr < 16; ++rr) { const int d0 = t - (j * 64 + crow(rr, hi)); p0[rr] += tb[tab_idx(d0)]; p1[rr] += tb[tab_idx(d0 - 32)]; }
            }
            softmax_step(p0, p1, m, l, o);
            pv_lds(o, st + 8192, p0, p1, lrow, swz, hi);
        }
        l += xhalf(l);
        const float gs = NG[8 + h] / l;
#pragma unroll
        for (int rr = 0; rr < 16; ++rr) { out[0][rr] += gs * o[0][rr]; out[1][rr] += gs * o[1][rr]; }
    }
    {
        TileSrc ts; ts.K = (const bf16_t*)(ws + OFF_KWIN) + (size_t)grp * S * 64; ts.VT = (const bf16_t*)(ws + OFF_VWINT) + (size_t)grp * 64 * S; ts.vpitch = S;
        float m = -INFINITY, l = 0.f;
        f32x16 o[2];
#pragma unroll
        for (int rr = 0; rr < 16; ++rr) { o[0][rr] = 0.f; o[1][rr] = 0.f; }
        const int j0 = qt >= 8 ? qt - 8 : 0, nt = qt - j0 + 1;
        NSA_WAITBAR();
        nsa_issue(lds, ts, j0, tid, wave);
        for (int i = 0; i < nt; ++i) {
            const int j = j0 + i;
            NSA_WAITBAR();
            if (i + 1 < nt) nsa_issue(lds + ((i + 1) & 1) * NSA_STAGE, ts, j + 1, tid, wave);
            const LAS unsigned char* st = lds + (i & 1) * NSA_STAGE;
            f32x16 p0, p1;
            qk_lds(p0, p1, st, qf, 0.f, lrow, swz, hi);
            if (j >= qt - 2) {
#pragma unroll
                for (int rr = 0; rr < 16; ++rr) { const int d0 = t - (j * 64 + crow(rr, hi)); p0[rr] += tb[tab_idx(d0)]; p1[rr] += tb[tab_idx(d0 - 32)]; }
            } else if (j == qt - 8) {
#pragma unroll
                for (int rr = 0; rr < 16; ++rr) { const int d0 = t - (j * 64 + crow(rr, hi)); if (d0 >= 512) p0[rr] = -INFINITY; if (d0 - 32 >= 512) p1[rr] = -INFINITY; }
            }
            softmax_step(p0, p1, m, l, o);
            pv_lds(o, st + 8192, p0, p1, lrow, swz, hi);
        }
        l += xhalf(l);
        const float gw = NG[16 + h] / l;
#pragma unroll
        for (int rr = 0; rr < 16; ++rr) { out[0][rr] += gw * o[0][rr]; out[1][rr] += gw * o[1][rr]; }
    }
    store_ot(qrow, out, 1.f, hi);
    NSA_WAITBAR();
}

struct Params { const float* in[26]; float* out; unsigned char* ws; };
constexpr int LDS_BYTES = 147456;
__device__ __forceinline__ const float* inptr(const Params& p, int i) { asm volatile("" : "+s"(i)); return p.in[i]; }
#define PH_BEGIN(lexpr) int lq = (lexpr); asm volatile("" : "+s"(lq)); unsigned char* ws = p.ws; asm volatile("" : "+s"(ws)); float* X = p.out; asm volatile("" : "+s"(X)); \
    bf16_t* XB = (bf16_t*)(ws + OFF_XB); float* SSQ = (float*)(ws + OFF_SSQ); (void)XB; (void)SSQ; (void)X; (void)lq
#define IN(i) inptr(p, i)
#define CCX() ConvCtx{ldsr, nullptr, 0, (int)gridDim.x * 8, MYTID()}
#define FFN_SRC(l, base) IN(base) + (size_t)(l) * D, IN((base) + 1) + (size_t)(l) * D * F, IN((base) + 2) + (size_t)(l) * D * F, IN((base) + 3) + (size_t)(l) * F * D
__device__ __forceinline__ MixW mixw_of(const Params& p, int l) { MixW w; w.mixn = IN(6) + (size_t)l * D; w.win = IN(7) + (size_t)l * D * DIN; w.w1k = IN(11) + (size_t)l * 2048 * 256; w.w1v = IN(13) + (size_t)l * 2048 * 256;
    w.ua = IN(18) + (size_t)l * 512 * D; w.ub = IN(19) + (size_t)l * 256 * D; w.uc = IN(20) + (size_t)l * 256 * D; w.wo = IN(21) + (size_t)l * D * D; w.pos = IN(10) + (size_t)l * 2048; return w; }

__global__ void __launch_bounds__(512) mega_fwd(Params p) {
    extern __shared__ __attribute__((aligned(16))) char lds_base[];
    cg::grid_group grid = cg::this_grid();
    LAS unsigned char* ldsr = (LAS unsigned char*)lds_base;
    const int wave_s = __builtin_amdgcn_readfirstlane(threadIdx.x >> 6);
    const int G_ = gridDim.x, bid = blockIdx.x;
#define GSYNC() grid.sync()
    {
        PH_BEGIN(0);
        conv_ffn(CCX(), FFN_SRC(lq, 2), ws + OFF_FFN1W);
        conv_mix(CCX(), mixw_of(p, lq), ws);
        __syncthreads();
        ph_prep(lds_base, MYTID(), IN(0), X, XB, SSQ);
    }
    GSYNC();
#pragma unroll 1
    for (int l = 0; l < 2; ++l) {
#pragma unroll 1
        for (int f = 0; f < 2; ++f) {
            if (f == 1) {
                {
                    PH_BEGIN(l);
                    pg8::Ops g; g.A = (const char*)XB; g.Bt = (const char*)(ws + OFF_BT_IN); g.lda_b = D * 2; g.ldb_b = D * 2; g.a_kstep = 128; g.nt = D / 64; g.a_mode = 0;
                    pg8::StaticOrder so; so.init(M, 5888, G_, bid);
                    pg8::EpiWin E{ws, SSQ, IN(8) + lq * 64, IN(9) + lq * 64, IN(15) + lq * 64, IN(16) + lq * 64};
                    pg8::gemm_phase(ldsr, MYTID(), g, so, E);
                }
                GSYNC();
                {
                    PH_BEGIN(l);
                    pg8::Ops g; g.A = (const char*)(ws + OFF_KCMP); g.Bt = (const char*)(ws + OFF_BT_C1); g.lda_b = 2048; g.ldb_b = 4096; g.a_kstep = 128; g.nt = 32; g.a_mode = 2;
                    pg8::StaticOrder so; so.init(2048, 512, G_, bid);
                    pg8::EpiCmp1 E{(float*)(ws + OFF_HID), (const float*)(ws + OFF_BIASC)};
                    pg8::gemm_phase(ldsr, MYTID(), g, so, E);
                }
                GSYNC();
                {
                    PH_BEGIN(l);
                    ph_cmp2(lds_base, MYTID(), (const float*)(ws + OFF_HID), IN(12) + (size_t)lq * 256 * 64, IN(14) + (size_t)lq * 256 * 64, IN(9) + lq * 64, (bf16_t*)(ws + OFF_KCN), (bf16_t*)(ws + OFF_VCT));
                }
                GSYNC();
                {
                    PH_BEGIN(l);
                    const float* rel_bias = IN(1);
                    LAS float* tabs = (LAS float*)(ldsr + 131072);
                    build_tabs(tabs, rel_bias, MYTID());
                    __syncthreads();
                    int t_ = MYTID(); asm volatile("" : "+v"(t_));
                    for (int ps = bid; ps < 256; ps += G_) {
                        const int bg = ps >> 6, i = ps & 63;
#pragma unroll 1
                        for (int k2 = 0; k2 < 2; ++k2) nsa_unit(ldsr, tabs, ws, bg >> 1, bg & 1, k2 ? 127 - i : i, t_);
                    }
                    const int lane_ = t_ & 63, gw_ = blockIdx.x * 8 + __builtin_amdgcn_readfirstlane(t_ >> 6);
                    for (int u = gw_; u < 2048; u += G_ * 8) swa_unit(ws, tabs + 8 * TAB_N, IN(17) + lq * 4, u, lane_);
                    for (int u = gw_; u < 2048; u += G_ * 8) sb_unit(ws, u, lane_);
                }
                GSYNC();
                {
                    PH_BEGIN(l);
                    conv_ffn(CCX(), FFN_SRC(lq, 22), ws + OFF_FFN2W);
                    __syncthreads();
                    bf16_t* GATES = (bf16_t*)(ws + OFF_A);
                    pg8::Ops g; g.A = (const char*)(ws + OFF_Q16); g.Bt = (const char*)(ws + OFF_BT_M); g.lda_b = 128; g.ldb_b = D * 2; g.a_kstep = (size_t)S * 128; g.nt = 16; g.a_mode = 1;
                    pg8::StaticOrder so; so.init(M, D, G_, bid);
                    pg8::EpiMerge E{GATES, GATES + (size_t)M * D, GATES + (size_t)2 * M * D, (bf16_t*)(ws + OFF_MERGED)};
                    pg8::gemm_phase(ldsr, MYTID(), g, so, E);
                }
                GSYNC();
                {
                    PH_BEGIN(l);
                    if (lq == 0) { conv_ffn(CCX(), FFN_SRC(1, 2), ws + OFF_FFN1W); __syncthreads(); }
                    pg8::Ops g; g.A = (const char*)(ws + OFF_MERGED); g.Bt = (const char*)(ws + OFF_BT_O); g.lda_b = D * 2; g.ldb_b = D * 2; g.a_kstep = 128; g.nt = 16; g.a_mode = 0;
                    pg8::StaticOrder so; so.init(M, D, G_, bid);
                    pg8::EpiResid E{X, XB, SSQ, 1.0f};
                    pg8::gemm_phase(ldsr, MYTID(), g, so, E);
                }
                GSYNC();
            }
            {
                PH_BEGIN(l);
                int fq_ = f; asm volatile("" : "+s"(fq_));
                unsigned char* wbase = ws + (fq_ == 0 ? OFF_FFN1W : OFF_FFN2W);
                if (fq_ == 1 && lq == 0) { conv_mix(CCX(), mixw_of(p, 1), ws); __syncthreads(); }
                pg8::Ops g; g.A = (const char*)XB; g.Bt = (const char*)wbase; g.lda_b = D * 2; g.ldb_b = D * 2; g.a_kstep = 128; g.nt = 16; g.a_mode = 0;
                pg8::StaticOrder so; so.init(M, 2 * F, G_, bid);
                pg8::EpiFfnUp E{(bf16_t*)(ws + OFF_A), SSQ};
                pg8::gemm_phase(ldsr, MYTID(), g, so, E);
            }
            GSYNC();
            {
                PH_BEGIN(l);
                int fq_ = f; asm volatile("" : "+s"(fq_));
                unsigned char* wbase = ws + (fq_ == 0 ? OFF_FFN1W : OFF_FFN2W);
                pg8::Ops g; g.A = (const char*)(ws + OFF_A); g.Bt = (const char*)(wbase + FFNW_D); g.lda_b = F * 2; g.ldb_b = F * 2; g.a_kstep = 128; g.nt = F / 64; g.a_mode = 0;
                pg8::StaticOrder so; so.init(M, D, G_, bid);
                pg8::EpiResid E{X, XB, SSQ, 0.5f};
                pg8::gemm_phase(ldsr, MYTID(), g, so, E);
            }
            GSYNC();
        }
    }
}

extern "C" void kernel_launch(void* const* d_in, const int* in_sizes, int n_in, void* d_out, int out_size, void* d_ws, size_t ws_size, hipStream_t stream) {
    static int grid_blocks = 0;
    if (grid_blocks == 0) {
        if (ws_size < WS_END || n_in != 26) { fprintf(stderr, "kernel_launch: bad sizes (ws %zu)\n", ws_size); grid_blocks = -1; return; }
        int dev = 0, cus = 0, per_cu = 0;
        (void)hipGetDevice(&dev); (void)hipDeviceGetAttribute(&cus, hipDeviceAttributeMultiprocessorCount, dev);
        (void)hipFuncSetAttribute((const void*)mega_fwd, hipFuncAttributeMaxDynamicSharedMemorySize, LDS_BYTES);
        (void)hipOccupancyMaxActiveBlocksPerMultiprocessor(&per_cu, (const void*)mega_fwd, 512, LDS_BYTES);
        if (per_cu < 1) { fprintf(stderr, "kernel_launch: occupancy query says %d\n", per_cu); per_cu = 1; }
        grid_blocks = cus * (per_cu > 1 ? 1 : per_cu);
        (void)hipGetLastError();
    }
    if (grid_blocks < 0) return;
    Params p{}; for (int i = 0; i < 26; ++i) p.in[i] = (const float*)d_in[i]; p.out = (float*)d_out; p.ws = (unsigned char*)d_ws;
    void* args[] = {&p};
    hipError_t e = hipLaunchCooperativeKernel((void*)mega_fwd, dim3(grid_blocks), dim3(512), args, LDS_BYTES, stream);
    if (e != hipSuccess) fprintf(stderr, "cooperative launch failed: %s (grid %d)\n", hipGetErrorString(e), grid_blocks);
}
```

```cpp
#include <hip/hip_runtime.h>
#include <hip/hip_cooperative_groups.h>
#include <stdint.h>
#include <cstdio>
namespace cg = cooperative_groups;
#ifndef PROBE
#define PROBE 0
#endif
#ifndef TSP
#define TSP 0
#endif
#ifndef TSF
#define TSF -1
#endif
#define TS_B(k) if (TSP == (k) && (TSF < 0 || TSF == ts_inst)) { ts_t0 = __builtin_amdgcn_s_memrealtime(); }
#define TS_E(k) if (TSP == (k) && (TSF < 0 || TSF == ts_inst)) { ts_acc += __builtin_amdgcn_s_memrealtime() - ts_t0; }
#define REP(k) for (int rep_ = 0; rep_ < (PROBE == (k) ? 2 : 1); ++rep_)
#define LASTREP(k) (rep_ == (PROBE == (k) ? 1 : 0))
__device__ __forceinline__ int lane_id() { int r; asm volatile("v_mbcnt_lo_u32_b32 %0, -1, 0\n\tv_mbcnt_hi_u32_b32 %0, -1, %0" : "=v"(r)); return r; }
#define MYTID() (wave_s * 64 + lane_id())
#define VB_SETUP int tidx_ = tid_in; asm volatile("" : "+v"(tidx_)); const int tid = tidx_ & 255, vhalf = tidx_ >> 8; const int vb0 = blockIdx.x * 2 + vhalf, nvb = gridDim.x * 2; char* lds = lds_base + vhalf * 32768; (void)tid; (void)lds; (void)vb0; (void)nvb
#define LAS __attribute__((address_space(3)))

typedef unsigned short bf16_t;
typedef short bf16x8 __attribute__((ext_vector_type(8)));
typedef float f32x4 __attribute__((ext_vector_type(4)));
typedef unsigned u32x4 __attribute__((ext_vector_type(4)));
__device__ __forceinline__ float bf2f(bf16_t v) { return __uint_as_float(((unsigned)v) << 16); }
__device__ __forceinline__ bf16_t f2bf(float f) { unsigned u = __float_as_uint(f); return (bf16_t)((u + 0x7fffu + ((u >> 16) & 1u)) >> 16); }
typedef float f32x2_t __attribute__((ext_vector_type(2))); typedef __bf16 bf16x2_t __attribute__((ext_vector_type(2)));
__device__ __forceinline__ unsigned pk2(float lo, float hi) { f32x2_t v = {lo, hi}; bf16x2_t b = __builtin_convertvector(v, bf16x2_t); return __builtin_bit_cast(unsigned, b); }

__host__ __device__ __forceinline__ int vperm16(int k) { return 8 * ((k >> 2) & 1) + 4 * (k >> 3) + (k & 3); }
__device__ __forceinline__ size_t vt_pos(int s) { return (size_t)((s & ~15) + vperm16(s & 15)); }
constexpr int NB = 2, S = 8192, M = NB * S, D = 1024, F = 2816, HD = 64, DIN = 5656;
constexpr int NCMP = 511, NSLC = 128;
constexpr float LOG2E = 1.4426950408889634f;
constexpr float C2 = 0.125f * LOG2E;
constexpr float EPS = 1e-6f;

constexpr size_t MiB = 1u << 20;
constexpr size_t OFF_CTL = 0;
constexpr size_t OFF_SSQ = 1 * MiB;
constexpr size_t OFF_XB = 2 * MiB;
constexpr size_t OFF_A = 34 * MiB;
constexpr size_t OFF_MIXW = 130 * MiB;
constexpr size_t OFF_BT_IN = OFF_MIXW, OFF_BT_C1 = OFF_MIXW + 12 * MiB, OFF_BT_M = OFF_MIXW + 14 * MiB, OFF_BT_O = OFF_MIXW + 16 * MiB;
constexpr size_t OFF_W2T = OFF_MIXW + 11 * MiB + 768 * 1024;
constexpr size_t OFF_Q16 = 148 * MiB;
constexpr size_t OFF_KV = 180 * MiB;
constexpr size_t KV2 = 4 * MiB, KV4 = 8 * MiB;
constexpr size_t OFF_KCMP = OFF_KV, OFF_VCMP = OFF_KCMP + KV2, OFF_KSLC = OFF_VCMP + KV2, OFF_VSLCT = OFF_KSLC + KV2,
                 OFF_KWIN = OFF_VSLCT + KV2, OFF_VWINT = OFF_KWIN + KV2, OFF_WK = OFF_VWINT + KV2, OFF_WVT = OFF_WK + KV2,
                 OFF_SBK = OFF_WVT + KV2, OFF_SBVT = OFF_SBK + KV4;
constexpr size_t OFF_MERGED = OFF_KV;
constexpr size_t OFF_FFN1W = OFF_Q16, OFF_FFN2W = 237 * MiB;
constexpr size_t FFNW_D = 11 * MiB;
constexpr size_t OFF_SMALL = 229 * MiB;
constexpr size_t OFF_NGATE = OFF_SMALL;
constexpr size_t OFF_KCN = OFF_NGATE + 2 * MiB;
constexpr size_t OFF_VCT = OFF_KCN + MiB / 4;
constexpr size_t OFF_HID = OFF_VCT + MiB / 4;
constexpr size_t OFF_BIASC = OFF_HID + 4 * MiB;
constexpr size_t WS_END = OFF_FFN2W + 17 * MiB;
static_assert(OFF_SBVT + KV4 <= OFF_SMALL && OFF_BIASC + MiB <= OFF_FFN2W, "ws map");

__device__ const unsigned char T5B[128] = {
    0, 1, 2, 3, 4, 5, 6, 7, 8, 9, 10, 11, 12, 13, 14, 15, 16, 16, 16, 17, 17, 18, 18, 18, 19, 19, 19, 20, 20, 20, 20, 21, 21, 21, 21, 22, 22, 22, 22, 22, 23, 23, 23, 23, 23, 23, 24, 24, 24, 24, 24, 24, 25, 25, 25, 25, 25, 25, 25, 26, 26, 26, 26, 26, 26, 26, 26, 27, 27, 27, 27, 27, 27, 27, 27, 27, 27, 28, 28, 28, 28, 28, 28, 28, 28, 28, 28, 29, 29, 29, 29, 29, 29, 29, 29, 29, 29, 29, 29, 30, 30, 30, 30, 30, 30, 30, 30, 30, 30, 30, 30, 30, 30, 31, 31, 31, 31, 31, 31, 31, 31, 31, 31, 31, 31, 31, 31, 31};
__device__ __forceinline__ int t5b(int dist) { return dist >= 128 ? 31 : (int)T5B[dist < 0 ? 0 : dist]; }

template <int K> __device__ __forceinline__ float swz_xor(float v) { return __int_as_float(__builtin_amdgcn_ds_swizzle(__float_as_int(v), (K << 10) | 0x1f)); }
template <int K> __device__ __forceinline__ unsigned swz_xor_u(unsigned v) { return (unsigned)__builtin_amdgcn_ds_swizzle((int)v, (K << 10) | 0x1f); }
__device__ __forceinline__ float xhalf_sum(float v) { auto rr = __builtin_amdgcn_permlane32_swap(__float_as_uint(v), __float_as_uint(v), false, false); return __uint_as_float(rr[0]) + __uint_as_float(rr[1]); }
__device__ __forceinline__ float xhalf_max(float v) { auto rr = __builtin_amdgcn_permlane32_swap(__float_as_uint(v), __float_as_uint(v), false, false); return fmaxf(__uint_as_float(rr[0]), __uint_as_float(rr[1])); }
__device__ __forceinline__ float xhalf_other(float v, int hi) { auto rr = __builtin_amdgcn_permlane32_swap(__float_as_uint(v), __float_as_uint(v), false, false); return __uint_as_float(hi ? rr[0] : rr[1]); }
__device__ __forceinline__ float wave_sum(float v) {
    v += swz_xor<1>(v); v += swz_xor<2>(v); v += swz_xor<4>(v); v += swz_xor<8>(v); v += swz_xor<16>(v);
    return xhalf_sum(v);
}
__device__ __forceinline__ float sigmoidf_(float x) { return 1.f / (1.f + __expf(-x)); }
__device__ __forceinline__ float siluf_(float x) { return x / (1.f + __expf(-x)); }
__device__ __forceinline__ float fast_sigmoid(float x) { return __builtin_amdgcn_rcpf(1.f + __builtin_amdgcn_exp2f(-x * LOG2E)); }

__device__ __forceinline__ void ph_prep(int tid_in, const float* xin, bf16_t* XB, float* SSQ) {
    int t_ = tid_in; asm volatile("" : "+v"(t_));
    const int lane = t_ & 63, gw = blockIdx.x * 8 + __builtin_amdgcn_readfirstlane(t_ >> 6);
    for (int row = gw; row < M; row += gridDim.x * 8) {
        const f32x4* xr = (const f32x4*)(xin + (size_t)row * D) + lane; float ss = 0.f;
        f32x4 v[4];
#pragma unroll
        for (int j = 0; j < 4; ++j) v[j] = xr[64 * j];
#pragma unroll
        for (int j = 0; j < 4; ++j) { ss += (v[j][0] * v[j][0] + v[j][1] * v[j][1]) + (v[j][2] * v[j][2] + v[j][3] * v[j][3]);
            uint2 w; w.x = pk2(v[j][0], v[j][1]); w.y = pk2(v[j][2], v[j][3]); *((uint2*)(XB + (size_t)row * D) + lane + 64 * j) = w; }
        ss = wave_sum(ss);
        if (lane < 16) SSQ[(size_t)row * 16 + lane] = lane == 0 ? ss : 0.f;
    }
}

namespace pg8 {
constexpr int BM = 256, BK = 64, HALF = 128, HTB = HALF * BK * 2, STAGE_BYTES = 8 * HTB, NXCD = 8, WGM = 8;
__host__ __device__ __forceinline__ int lds_byte(int r, int c) { const int st = (r >> 4) * 2 + (c >> 5), rr = r & 15, cc = c & 31, ob = rr * 64 + cc * 2; return st * 1024 + (ob ^ (((ob >> 9) & 1) << 5)); }
__host__ __device__ __forceinline__ void stage_rc(int b, int& R, int& C) { const int st = b / 1024, sb = b % 1024, swz = sb ^ (((sb >> 9) & 1) << 5); R = (st >> 1) * 16 + swz / 64; C = (st & 1) * 32 + (swz % 64) / 2; }
__host__ __device__ __forceinline__ int perm32(int rho) { const int n = rho >> 4, i = rho & 15; return 8 * (i >> 2) + 4 * n + (i & 3); }
struct Unit { int pm, pn; };
struct StaticOrder {
    int nM, nN, nwg, G, c;
    __device__ __forceinline__ void init(int M_, int N_, int G_, int c_) { nM = M_ / BM; nN = N_ / BM; nwg = nM * nN; G = G_; c = c_; }
    __device__ __forceinline__ bool next(int i, Unit& u) const {
        const long L = (long)i * G + c; if (L >= nwg) return false;
        int wgid = (int)L; { const int q = nwg / NXCD, r = nwg % NXCD, xcd = wgid % NXCD, off = wgid / NXCD; wgid = (xcd < r ? xcd * (q + 1) : r * (q + 1) + (xcd - r) * q) + off; }
        const int nig = WGM * nN, gid = wgid / nig, fm = gid * WGM, gsz = (nM - fm) < WGM ? (nM - fm) : WGM;
        u.pm = fm + ((wgid % nig) % gsz); u.pn = (wgid % nig) / gsz; return true;
    }
};
struct Ops {
    const char* A; const char* Bt; unsigned lda_b, ldb_b; size_t a_kstep; int nt;
    int a_mode;
    __device__ __forceinline__ const char* a_base(const Unit& u) const {
        if (a_mode == 1) return A + (size_t)(u.pm >> 5) * (16ull * S * 128) + (size_t)(u.pm & 31) * (256 * 128);
        if (a_mode == 2) return A + (size_t)u.pn * KV2 + (size_t)u.pm * 256 * lda_b;
        return A + (size_t)u.pm * 256 * lda_b;
    }
    __device__ __forceinline__ const char* b_base(const Unit& u) const { return Bt + (size_t)u.pn * 256 * ldb_b; }
};

template <class Epi, class Sched>
__device__ __forceinline__ void gemm_phase(LAS unsigned char* lds, int tid_in, const Ops& G, const Sched& S_, const Epi& E) {
    int tid_ = tid_in; asm volatile("" : "+v"(tid_));
    const int tid = tid_, wid = __builtin_amdgcn_readfirstlane(tid >> 6), lane = tid & 63, wr = wid >> 2, wc = wid & 3, fr = lane & 15, fq = lane >> 4;
    const int nt = G.nt;
    unsigned voffA[2], voffB[2];
#pragma unroll
    for (int i = 0; i < 2; ++i) { int R, C; stage_rc(tid * 16 + i * 8192, R, C); const int Rb = Epi::PERM ? ((R & ~31) + perm32(R & 31)) : R;
        voffA[i] = (unsigned)R * G.lda_b + (unsigned)C * 2u; voffB[i] = (unsigned)Rb * G.ldb_b + (unsigned)C * 2u; }
    const size_t kstepA = G.a_kstep, kstepB = (size_t)(BK * 2);
    const size_t hstepA = (size_t)HALF * G.lda_b, hstepB = (size_t)HALF * G.ldb_b;
    const unsigned ldsw = (unsigned)wid * 1024u;
    const int aoff = lds_byte(wr * 64 + fr, fq * 8), boff = lds_byte(wc * 32 + fr, fq * 8);
#define PG8_SA(b, h) (((b) * 2 + (h)) * HTB)
#define PG8_SB(b, h) ((4 + (b) * 2 + (h)) * HTB)
#define PG8_STAGE(bufoff, gbase, voff) do { _Pragma("unroll") for (int _i = 0; _i < 2; ++_i) \
        __builtin_amdgcn_global_load_lds((const unsigned*)((const char*)(gbase) + (voff)[_i]), (LAS unsigned*)(lds + (bufoff) + ldsw + _i * 8192), 16, 0, 0); } while (0)
#define PG8_LDA(dst, b, h) do { _Pragma("unroll") for (int m = 0; m < 4; ++m) _Pragma("unroll") for (int k = 0; k < 2; ++k) dst[m][k] = *(const LAS bf16x8*)(lds + PG8_SA(b, h) + aoff + m * 2048 + k * 1024); } while (0)
#define PG8_LDB(dst, b, h) do { _Pragma("unroll") for (int n = 0; n < 2; ++n) _Pragma("unroll") for (int k = 0; k < 2; ++k) dst[n][k] = *(const LAS bf16x8*)(lds + PG8_SB(b, h) + boff + n * 2048 + k * 1024); } while (0)
#define PG8_MMA(ai, bj, At, Bt) do { __builtin_amdgcn_s_setprio(1); _Pragma("unroll") for (int m = 0; m < 4; ++m) _Pragma("unroll") for (int n = 0; n < 2; ++n) _Pragma("unroll") for (int k = 0; k < 2; ++k) \
        acc[ai][bj][m][n] = __builtin_amdgcn_mfma_f32_16x16x32_bf16(Bt[n][k], At[m][k], acc[ai][bj][m][n], 0, 0, 0); __builtin_amdgcn_s_setprio(0); } while (0)
#define PG8_WAIT_V(n) asm volatile("s_waitcnt vmcnt(" #n ")" ::: "memory")
#define PG8_WAIT_L(n) asm volatile("s_waitcnt lgkmcnt(" #n ")" ::: "memory")
#define PG8_BAR __builtin_amdgcn_s_barrier()
#define PG8_SCHED __builtin_amdgcn_sched_barrier(0)
    Unit cur, nxt; int ui = 0;
    if (!S_.next(0, cur)) return;
    f32x4 acc[2][2][4][2];
#pragma unroll
    for (int a = 0; a < 2; ++a)
#pragma unroll
        for (int b = 0; b < 2; ++b)
#pragma unroll
            for (int m = 0; m < 4; ++m)
#pragma unroll
                for (int n = 0; n < 2; ++n) acc[a][b][m][n] = (f32x4){0.f, 0.f, 0.f, 0.f};
    bf16x8 At[4][2], B0[2][2], B1[2][2];
    const char* cA = G.a_base(cur); const char* cB = G.b_base(cur);
    PG8_STAGE(PG8_SB(0, 0), cB, voffB); PG8_STAGE(PG8_SB(0, 1), cB + hstepB, voffB); PG8_STAGE(PG8_SA(0, 0), cA, voffA); PG8_STAGE(PG8_SA(0, 1), cA + hstepA, voffA);
    if (wr == 1) PG8_BAR;
    PG8_WAIT_V(2); PG8_BAR;
    PG8_STAGE(PG8_SB(1, 0), cB + kstepB, voffB); PG8_STAGE(PG8_SA(1, 0), cA + kstepA, voffA); PG8_STAGE(PG8_SB(1, 1), cB + hstepB + kstepB, voffB);
    PG8_WAIT_V(6); PG8_BAR;
    for (;;) {
        const bool has_next = S_.next(ui + 1, nxt);
        const char* nA = has_next ? G.a_base(nxt) : cA; const char* nB = has_next ? G.b_base(nxt) : cB;
        for (int t = 0; t < nt; t += 2) {
            const bool last = (t == nt - 2);
            const char* a1 = cA + (size_t)(t + 1) * kstepA;
            const char* a2 = last ? nA : cA + (size_t)(t + 2) * kstepA; const char* b2 = last ? nB : cB + (size_t)(t + 2) * kstepB;
            const char* a3 = a2 + kstepA; const char* b3 = b2 + kstepB;
            if constexpr (Epi::KHOOK) E.khook(acc, cur, t, wr, wc, fr, fq);
            PG8_LDB(B0, 0, 0); PG8_LDB(B1, 0, 1); PG8_SCHED; PG8_LDA(At, 0, 0); PG8_STAGE(PG8_SA(1, 1), a1 + hstepA, voffA);
            PG8_WAIT_V(8); PG8_WAIT_L(0); PG8_BAR; PG8_MMA(0, 0, At, B0); PG8_MMA(0, 1, At, B1); PG8_BAR; PG8_SCHED;
            PG8_LDA(At, 0, 1); PG8_STAGE(PG8_SB(0, 0), b2, voffB); PG8_STAGE(PG8_SB(0, 1), b2 + hstepB, voffB); PG8_STAGE(PG8_SA(0, 0), a2, voffA);
            PG8_WAIT_V(8); PG8_WAIT_L(0); PG8_BAR; PG8_MMA(1, 0, At, B0); PG8_MMA(1, 1, At, B1); PG8_BAR; PG8_SCHED;
            PG8_LDB(B0, 1, 0); PG8_LDB(B1, 1, 1); PG8_SCHED; PG8_LDA(At, 1, 0); PG8_STAGE(PG8_SA(0, 1), a2 + hstepA, voffA);
            PG8_WAIT_V(8); PG8_WAIT_L(0); PG8_BAR; PG8_MMA(0, 0, At, B0); PG8_MMA(0, 1, At, B1); PG8_BAR; PG8_SCHED;
            PG8_LDA(At, 1, 1); PG8_STAGE(PG8_SB(1, 0), b3, voffB); PG8_STAGE(PG8_SB(1, 1), b3 + hstepB, voffB); PG8_STAGE(PG8_SA(1, 0), a3, voffA);
            PG8_WAIT_V(8); PG8_WAIT_L(0); PG8_BAR; PG8_MMA(1, 0, At, B0); PG8_MMA(1, 1, At, B1); PG8_BAR; PG8_SCHED;
        }
        if (wr == 0) PG8_BAR;
        E(acc, cur, wr, wc, fr, fq);
        if (!has_next) break;
#pragma unroll
        for (int a = 0; a < 2; ++a)
#pragma unroll
            for (int b = 0; b < 2; ++b)
#pragma unroll
                for (int m = 0; m < 4; ++m)
#pragma unroll
                    for (int n = 0; n < 2; ++n) acc[a][b][m][n] = (f32x4){0.f, 0.f, 0.f, 0.f};
        cur = nxt; cA = nA; cB = nB; ++ui;
        if (wr == 1) PG8_BAR;
    }
    PG8_WAIT_V(0);
    PG8_BAR;
#undef PG8_SA
#undef PG8_SB
#undef PG8_STAGE
#undef PG8_LDA
#undef PG8_LDB
#undef PG8_MMA
#undef PG8_WAIT_V
#undef PG8_WAIT_L
#undef PG8_BAR
#undef PG8_SCHED
}

__device__ __forceinline__ float rstd_of(const float* ssq, int row) {
    const f32x4* p = (const f32x4*)(ssq + (size_t)row * 16); const f32x4 a = p[0], b = p[1], c = p[2], d = p[3];
    const float s = ((a[0] + a[1]) + (a[2] + a[3])) + ((b[0] + b[1]) + (b[2] + b[3])) + ((c[0] + c[1]) + (c[2] + c[3])) + ((d[0] + d[1]) + (d[2] + d[3]));
    return rsqrtf(s * (1.f / D) + EPS);
}
__device__ __forceinline__ float silu_fast(float x) { return x * __builtin_amdgcn_rcpf(1.f + __builtin_amdgcn_exp2f(-x * LOG2E)); }

struct EpiFfnUp {
    static constexpr bool PERM = true, KHOOK = false;
    bf16_t* H; const float* ssq;
    __device__ __forceinline__ void operator()(const f32x4 (&acc)[2][2][4][2], const Unit& u, int wr, int wc, int fr, int fq) const {
#pragma unroll
        for (int ai = 0; ai < 2; ++ai)
#pragma unroll
            for (int m = 0; m < 4; ++m) {
                const int row = u.pm * BM + ai * HALF + wr * 64 + m * 16 + fr; const float r = rstd_of(ssq, row);
                float h[8];
#pragma unroll
                for (int n = 0; n < 2; ++n)
#pragma unroll
                    for (int j = 0; j < 4; ++j) h[n * 4 + j] = silu_fast(r * acc[ai][0][m][n][j]) * (r * acc[ai][1][m][n][j]);
                u32x4 w; w.x = pk2(h[0], h[1]); w.y = pk2(h[2], h[3]); w.z = pk2(h[4], h[5]); w.w = pk2(h[6], h[7]);
                *(u32x4*)(H + (size_t)row * F + u.pn * 128 + wc * 32 + fq * 8) = w;
                asm volatile("" ::: "memory");
            }
    }
};
struct EpiResid {
    static constexpr bool PERM = true, KHOOK = false;
    const float* XI; float* X; bf16_t* XB; float* ssq; float alpha;
    __device__ __forceinline__ void operator()(const f32x4 (&acc)[2][2][4][2], const Unit& u, int wr, int wc, int fr, int fq) const {
#pragma unroll
        for (int ai = 0; ai < 2; ++ai)
#pragma unroll
            for (int m = 0; m < 4; ++m) {
                const int row = u.pm * BM + ai * HALF + wr * 64 + m * 16 + fr; float ss = 0.f;
#pragma unroll
                for (int bj = 0; bj < 2; ++bj) {
                    const size_t o = (size_t)row * D + u.pn * BM + bj * HALF + wc * 32 + fq * 8;
                    f32x4 x0 = *(const f32x4*)(XI + o), x1 = *(const f32x4*)(XI + o + 4);
                    x0 += acc[ai][bj][m][0] * alpha; x1 += acc[ai][bj][m][1] * alpha;
                    *(f32x4*)(X + o) = x0; *(f32x4*)(X + o + 4) = x1;
                    u32x4 w; w.x = pk2(x0[0], x0[1]); w.y = pk2(x0[2], x0[3]); w.z = pk2(x1[0], x1[1]); w.w = pk2(x1[2], x1[3]);
                    *(u32x4*)(XB + o) = w;
                    ss += (x0[0] * x0[0] + x0[1] * x0[1]) + (x0[2] * x0[2] + x0[3] * x0[3]) + (x1[0] * x1[0] + x1[1] * x1[1]) + (x1[2] * x1[2] + x1[3] * x1[3]);
                }
                ss += swz_xor<16>(ss); ss = xhalf_sum(ss);
                if (fq == 0) ssq[(size_t)row * 16 + u.pn * 4 + wc] = ss;
                asm volatile("" ::: "memory");
            }
    }
};
__host__ __device__ __forceinline__ int win_slot_col(int slot) {
    if (slot < 8) return 64 * slot;
    if (slot < 20) return 512 + 64 * (slot - 8);
    if (slot < 40) return 1304 + 64 * (slot - 20);
    if (slot < 88) return 2584 + 64 * (slot - 40);
    if (slot == 88) return 1280;
    return -1;
}
struct EpiWin {
    static constexpr bool PERM = true, KHOOK = false;
    unsigned char* ws; const float* ssq; const float *nsa_qn, *nsa_kn, *swa_qn, *swa_kn;
    __device__ __forceinline__ void operator()(const f32x4 (&acc)[2][2][4][2], const Unit& u, int wr, int wc, int fr, int fq) const {
        const int slot = u.pn * 4 + wc;
        if (slot >= 89) return;
        int kind = 0; const float* nw = nullptr; float scale = 1.f; bf16_t* dst = nullptr; int nh = 2, h = 0;
        if (slot < 8) { nw = nsa_qn; scale = C2; dst = (bf16_t*)(ws + OFF_Q16); nh = 16; h = slot; }
        else if (slot < 10) { dst = (bf16_t*)(ws + OFF_KCMP); h = slot - 8; }
        else if (slot < 12) { dst = (bf16_t*)(ws + OFF_VCMP); h = slot - 10; }
        else if (slot < 14) { nw = nsa_kn; dst = (bf16_t*)(ws + OFF_KSLC); h = slot - 12; }
        else if (slot < 16) { kind = 1; dst = (bf16_t*)(ws + OFF_VSLCT); h = slot - 14; }
        else if (slot < 18) { nw = nsa_kn; dst = (bf16_t*)(ws + OFF_KWIN); h = slot - 16; }
        else if (slot < 20) { kind = 1; dst = (bf16_t*)(ws + OFF_VWINT); h = slot - 18; }
        else if (slot < 24) { scale = C2; dst = (bf16_t*)(ws + OFF_Q16); nh = 16; h = 8 + slot - 20; }
        else if (slot < 28) { dst = (bf16_t*)(ws + OFF_SBK); nh = 4; h = slot - 24; }
        else if (slot < 32) { kind = 1; dst = (bf16_t*)(ws + OFF_SBVT); nh = 4; h = slot - 28; }
        else if (slot < 36) { nw = swa_qn; scale = C2; dst = (bf16_t*)(ws + OFF_Q16); nh = 16; h = 12 + slot - 32; }
        else if (slot < 38) { nw = swa_kn; dst = (bf16_t*)(ws + OFF_WK); h = slot - 36; }
        else if (slot < 40) { kind = 1; dst = (bf16_t*)(ws + OFF_WVT); h = slot - 38; }
        else if (slot < 88) { kind = 2; dst = (bf16_t*)(ws + OFF_A) + (size_t)((slot - 40) >> 4) * M * D + ((slot - 40) & 15) * 64; }
        else { kind = 3; }
#pragma unroll
        for (int ai = 0; ai < 2; ++ai)
#pragma unroll
            for (int m = 0; m < 4; ++m) {
                const int row = u.pm * BM + ai * HALF + wr * 64 + m * 16 + fr; const float r = rstd_of(ssq, row);
                const int b = row / S, s = row % S;
                float v[2][2][4]; float ss = 0.f;
#pragma unroll
                for (int bj = 0; bj < 2; ++bj)
#pragma unroll
                    for (int n = 0; n < 2; ++n)
#pragma unroll
                        for (int j = 0; j < 4; ++j) { const float x = r * acc[ai][bj][m][n][j]; v[bj][n][j] = x; ss += x * x; }
                float rn = scale;
                if (nw) { ss += swz_xor<16>(ss); ss = xhalf_sum(ss); rn = rsqrtf(ss * (1.f / 64.f) + EPS) * scale; }
#pragma unroll
                for (int bj = 0; bj < 2; ++bj)
#pragma unroll
                    for (int n = 0; n < 2; ++n) {
                        f32x4 wv = (f32x4){1.f, 1.f, 1.f, 1.f}; if (nw) wv = *(const f32x4*)(nw + 32 * bj + 8 * fq + 4 * n);
#pragma unroll
                        for (int j = 0; j < 4; ++j) v[bj][n][j] *= rn * wv[j];
                    }
                if (kind == 0) {
                    bf16_t* o = dst + (((size_t)b * nh + h) * S + s) * 64 + 8 * fq;
#pragma unroll
                    for (int bj = 0; bj < 2; ++bj) { u32x4 pw; pw.x = pk2(v[bj][0][0], v[bj][0][1]); pw.y = pk2(v[bj][0][2], v[bj][0][3]); pw.z = pk2(v[bj][1][0], v[bj][1][1]); pw.w = pk2(v[bj][1][2], v[bj][1][3]);
                        *(u32x4*)(o + 32 * bj) = pw; }
                } else if (kind == 1) {
                    bf16_t* o = dst + ((size_t)b * nh + h) * 64 * S + vt_pos(s);
#pragma unroll
                    for (int bj = 0; bj < 2; ++bj)
#pragma unroll
                        for (int n = 0; n < 2; ++n)
#pragma unroll
                            for (int j = 0; j < 4; ++j) o[(size_t)(32 * bj + 8 * fq + 4 * n + j) * S] = f2bf(v[bj][n][j]);
                } else if (kind == 2) {
                    bf16_t* o = dst + (size_t)row * D + 8 * fq;
#pragma unroll
                    for (int bj = 0; bj < 2; ++bj) { u32x4 pw; pw.x = pk2(fast_sigmoid(v[bj][0][0]), fast_sigmoid(v[bj][0][1])); pw.y = pk2(fast_sigmoid(v[bj][0][2]), fast_sigmoid(v[bj][0][3]));
                        pw.z = pk2(fast_sigmoid(v[bj][1][0]), fast_sigmoid(v[bj][1][1])); pw.w = pk2(fast_sigmoid(v[bj][1][2]), fast_sigmoid(v[bj][1][3])); *(u32x4*)(o + 32 * bj) = pw; }
                } else {
                    float* o = (float*)(ws + OFF_NGATE) + (size_t)row * 24;
#pragma unroll
                    for (int n = 0; n < 2; ++n)
#pragma unroll
                        for (int j = 0; j < 4; ++j) { const int d = 8 * fq + 4 * n + j; if (d < 24) o[d] = fast_sigmoid(v[0][n][j]); }
                }
                asm volatile("" ::: "memory");
            }
    }
};
struct EpiCmp1 {
    static constexpr bool PERM = true, KHOOK = false;
    float* HID; const float* bias;
    __device__ __forceinline__ void operator()(const f32x4 (&acc)[2][2][4][2], const Unit& u, int wr, int wc, int fr, int fq) const {
#pragma unroll
        for (int ai = 0; ai < 2; ++ai)
#pragma unroll
            for (int m = 0; m < 4; ++m) {
                const int row = u.pm * BM + ai * HALF + wr * 64 + m * 16 + fr;
#pragma unroll
                for (int bj = 0; bj < 2; ++bj)
#pragma unroll
                    for (int n = 0; n < 2; ++n) {
                        const int col = bj * HALF + wc * 32 + fq * 8 + 4 * n; const f32x4 bv = *(const f32x4*)(bias + u.pn * 256 + col);
                        f32x4 o;
#pragma unroll
                        for (int j = 0; j < 4; ++j) o[j] = silu_fast(acc[ai][bj][m][n][j] + bv[j]);
                        *(f32x4*)(HID + ((size_t)u.pn * 2048 + row) * 256 + col) = o;
                    }
                asm volatile("" ::: "memory");
            }
    }
};
struct EpiMerge {
    static constexpr bool PERM = true, KHOOK = true;
    const bf16_t* G0; const bf16_t* G1; const bf16_t* G2; bf16_t* OUT;
    __device__ __forceinline__ void khook(f32x4 (&acc)[2][2][4][2], const Unit& u, int t, int wr, int wc, int fr, int fq) const {
        if (t != 8 && t != 12) return;
        const bf16_t* NUM = t == 8 ? G0 : G1; const bf16_t* DEN = t == 8 ? G1 : G2;
#pragma unroll
        for (int ai = 0; ai < 2; ++ai)
#pragma unroll
            for (int m = 0; m < 4; ++m) {
                const int row = u.pm * BM + ai * HALF + wr * 64 + m * 16 + fr;
#pragma unroll
                for (int bj = 0; bj < 2; ++bj) {
                    const size_t o = (size_t)row * D + u.pn * BM + bj * HALF + wc * 32 + fq * 8;
                    const u32x4 nu = *(const u32x4*)(NUM + o), de = *(const u32x4*)(DEN + o);
#pragma unroll
                    for (int q = 0; q < 4; ++q) {
                        const float n0 = __uint_as_float(nu[q] << 16), n1 = __uint_as_float(nu[q] & 0xffff0000u), d0 = __uint_as_float(de[q] << 16), d1 = __uint_as_float(de[q] & 0xffff0000u);
                        acc[ai][bj][m][q >> 1][(q & 1) * 2] *= n0 * __builtin_amdgcn_rcpf(d0); acc[ai][bj][m][q >> 1][(q & 1) * 2 + 1] *= n1 * __builtin_amdgcn_rcpf(d1);
                    }
                }
                asm volatile("" : "+v"(acc[ai][0][m][0]), "+v"(acc[ai][0][m][1]), "+v"(acc[ai][1][m][0]), "+v"(acc[ai][1][m][1]) :: "memory");
            }
    }
    __device__ __forceinline__ void operator()(const f32x4 (&acc)[2][2][4][2], const Unit& u, int wr, int wc, int fr, int fq) const {
#pragma unroll
        for (int ai = 0; ai < 2; ++ai)
#pragma unroll
            for (int m = 0; m < 4; ++m) {
                const int row = u.pm * BM + ai * HALF + wr * 64 + m * 16 + fr;
#pragma unroll
                for (int bj = 0; bj < 2; ++bj) {
                    const size_t o = (size_t)row * D + u.pn * BM + bj * HALF + wc * 32 + fq * 8;
                    const u32x4 ge = *(const u32x4*)(G2 + o); u32x4 pw;
#pragma unroll
                    for (int q = 0; q < 4; ++q) {
                        const float g0 = __uint_as_float(ge[q] << 16), g1 = __uint_as_float(ge[q] & 0xffff0000u);
                        pw[q] = pk2(acc[ai][bj][m][q >> 1][(q & 1) * 2] * g0, acc[ai][bj][m][q >> 1][(q & 1) * 2 + 1] * g1);
                    }
                    *(u32x4*)(OUT + o) = pw;
                }
                asm volatile("" ::: "memory");
            }
    }
};
}

__device__ __forceinline__ void conv_item4(const float* W, int ldw, int col0, int nvalid, int ksrc, const float* wn, bf16_t* Bt, size_t ldbt, int row0, int kofs, LAS float* scr, int lane) {
    const int n4 = (lane & 7) * 4, kr = lane >> 3, c = lane & 7;
    f32x4 v[4][8];
#pragma unroll
    for (int q = 0; q < 4; ++q)
#pragma unroll
        for (int i = 0; i < 8; ++i) { const int kk = ksrc + 64 * q + 8 * i + kr; v[q][i] = (f32x4){0.f, 0.f, 0.f, 0.f};
            if (n4 < nvalid) { v[q][i] = *(const f32x4*)(W + (size_t)kk * ldw + col0 + n4); if (wn) v[q][i] *= wn[kk]; } }
#pragma unroll
    for (int q = 0; q < 4; ++q) {
#pragma unroll
        for (int i = 0; i < 8; ++i) { const int kk = 8 * i + kr; scr[kk * 33 + n4] = v[q][i][0]; scr[kk * 33 + n4 + 1] = v[q][i][1]; scr[kk * 33 + n4 + 2] = v[q][i][2]; scr[kk * 33 + n4 + 3] = v[q][i][3]; }
        asm volatile("s_waitcnt lgkmcnt(0)" ::: "memory");
#pragma unroll
        for (int j = 0; j < 4; ++j) { const int n = (lane >> 3) + 8 * j; const LAS float* s = scr + (8 * c) * 33 + n;
            u32x4 o; o.x = pk2(s[0 * 33], s[1 * 33]); o.y = pk2(s[2 * 33], s[3 * 33]); o.z = pk2(s[4 * 33], s[5 * 33]); o.w = pk2(s[6 * 33], s[7 * 33]);
            *(u32x4*)(Bt + (size_t)(row0 + n) * ldbt + kofs + 64 * q + 8 * c) = o; }
        asm volatile("s_waitcnt lgkmcnt(0)" ::: "memory");
    }
}
__device__ __forceinline__ void conv_wide(const float* W, int ldw, int col0, int ksrc, const float* wn, bf16_t* Bt, size_t ldbt, int r0, int r1, int r2, int r3, int kofs, LAS float* scr, int lane) {
    const int cg = lane & 31, rh = lane >> 5;
    f32x4 v[16];
#pragma unroll
    for (int i = 0; i < 16; ++i) { const int kk = ksrc + 2 * i + rh; v[i] = *(const f32x4*)(W + (size_t)kk * ldw + col0 + 4 * cg); if (wn) v[i] *= wn[kk]; }
#pragma unroll
    for (int c = 0; c < 2; ++c) {
#pragma unroll
        for (int i = 0; i < 8; ++i) { LAS float* d = scr + (2 * i + rh) * 129 + 4 * cg; d[0] = v[8 * c + i][0]; d[1] = v[8 * c + i][1]; d[2] = v[8 * c + i][2]; d[3] = v[8 * c + i][3]; }
        asm volatile("s_waitcnt lgkmcnt(0)" ::: "memory");
#pragma unroll
        for (int j = 0; j < 4; ++j) { const int t = lane + 64 * j, n = t >> 1, half = t & 1, sub = n >> 5; const LAS float* s = scr + (8 * half) * 129 + n;
            const int row = (sub == 0 ? r0 : sub == 1 ? r1 : sub == 2 ? r2 : r3) + (n & 31);
            u32x4 o; o.x = pk2(s[0 * 129], s[1 * 129]); o.y = pk2(s[2 * 129], s[3 * 129]); o.z = pk2(s[4 * 129], s[5 * 129]); o.w = pk2(s[6 * 129], s[7 * 129]);
            *(u32x4*)(Bt + (size_t)row * ldbt + kofs + 16 * c + 8 * half) = o; }
        asm volatile("s_waitcnt lgkmcnt(0)" ::: "memory");
    }
}
struct ConvCtx { LAS unsigned char* ldsr; LAS float* scr; int gw, ngw, lane; };
#define CONV_LAUNDER ConvCtx c = c_; { int t_ = c_.lane; asm volatile("" : "+v"(t_)); c.lane = t_ & 63; const int wv_ = __builtin_amdgcn_readfirstlane(t_ >> 6); c.gw = ((int)blockIdx.x - c_.gw) * 8 + wv_; c.scr = (LAS float*)(c.ldsr + wv_ * 8448); }
__device__ __forceinline__ void conv_ffn(const ConvCtx& c_, const float* nw, const float* wg, const float* wu, const float* wd, unsigned char* dstbase) {
    CONV_LAUNDER;
    bf16_t* GU = (bf16_t*)dstbase; bf16_t* DN = (bf16_t*)(dstbase + FFNW_D);
    constexpr int I_GU = 2 * 22 * 32, I_D = 8 * 88;
    for (int it = c.gw; it < I_GU + I_D; it += c.ngw) {
        if (it < I_GU) { const int kb = it / 44, cb = it % 44, isup = cb / 22, tile = cb % 22, rb = tile * 256 + isup * 128;
            conv_wide(isup ? wu : wg, F, tile * 128, kb * 32, nw, GU, D, rb, rb + 32, rb + 64, rb + 96, kb * 32, c.scr, c.lane); }
        else { const int r = it - I_GU, kb = r / 8, cb = r % 8, rb = cb * 128; conv_wide(wd, D, rb, kb * 32, nullptr, DN, F, rb, rb + 32, rb + 64, rb + 96, kb * 32, c.scr, c.lane); }
    }
}
struct MixW { const float *mixn, *win, *w1k, *w1v, *ua, *ub, *uc, *wo, *pos, *w2k, *w2v; };
__device__ __forceinline__ void conv_mix(const ConvCtx& c_, const MixW& w, unsigned char* ws) {
    CONV_LAUNDER;
    bf16_t* BIN = (bf16_t*)(ws + OFF_BT_IN); bf16_t* BC1 = (bf16_t*)(ws + OFF_BT_C1); bf16_t* BM_ = (bf16_t*)(ws + OFF_BT_M); bf16_t* BO = (bf16_t*)(ws + OFF_BT_O);
    constexpr int I_IN = 184 * 4, I_C1 = 16 * 8, I_M = 32 * 4, I_O = 32 * 4, I_B = 512, I_W2 = 4;
    bf16_t* W2T = (bf16_t*)(ws + OFF_W2T);
    for (int it = c.gw; it < I_IN + I_C1 + I_M + I_O + I_B + I_W2; it += c.ngw) {
        int r = it;
        if (r < I_IN) { const int rb = r / 4, kb = r % 4, tile = rb >> 3, r32 = rb & 7, bj = r32 >> 2, slot = tile * 4 + (r32 & 3);
            const int sc = pg8::win_slot_col(slot); int nvalid = sc < 0 ? 0 : 32; if (slot == 88) nvalid = bj == 0 ? 24 : 0;
            conv_item4(w.win, DIN, sc + 32 * bj, nvalid, kb * 256, w.mixn, BIN, D, rb * 32, kb * 256, c.scr, c.lane); continue; }
        r -= I_IN;
        if (r < I_C1) { const int rb = r / 8, kb = r % 8; conv_item4(rb >= 8 ? w.w1v : w.w1k, 256, (rb & 7) * 32, 32, kb * 256, nullptr, BC1, 2048, rb * 32, kb * 256, c.scr, c.lane); continue; }
        r -= I_C1;
        if (r < I_M) { const int rb = r / 4, kb = r % 4;
            if (kb < 2) conv_item4(w.ua, D, rb * 32, 32, kb * 256, nullptr, BM_, D, rb * 32, kb * 256, c.scr, c.lane);
            else if (kb == 2) conv_item4(w.ub, D, rb * 32, 32, 0, nullptr, BM_, D, rb * 32, 512, c.scr, c.lane);
            else conv_item4(w.uc, D, rb * 32, 32, 0, nullptr, BM_, D, rb * 32, 768, c.scr, c.lane);
            continue; }
        r -= I_M;
        if (r < I_O) { const int rb = r / 4, kb = r % 4; conv_item4(w.wo, D, rb * 32, 32, kb * 256, nullptr, BO, D, rb * 32, kb * 256, c.scr, c.lane); continue; }
        r -= I_O;
        if (r >= I_B) { r -= I_B; const int kv = r >> 1, rb = r & 1;
            conv_item4(kv ? w.w2v : w.w2k, 64, rb * 32, 32, 0, nullptr, W2T + (size_t)kv * 64 * 256, 256, rb * 32, 0, c.scr, c.lane); continue; }
        { const int kv = r >> 8, j = r & 255; const float* w1 = kv ? w.w1v : w.w1k; float s = 0.f;
#pragma unroll 8
          for (int i = 0; i < 32; ++i) { const int kk = c.lane + 64 * i; s += w.pos[kk] * w1[(size_t)kk * 256 + j]; }
          s = wave_sum(s);
          if (c.lane == 0) ((float*)(ws + OFF_BIASC))[kv * 256 + j] = s; }
    }
}

typedef float f32x16 __attribute__((ext_vector_type(16)));
__host__ __device__ __forceinline__ int crow(int r, int hi) { return (r & 3) + 8 * (r >> 2) + 4 * hi; }
__device__ __forceinline__ bf16x8 pack8(const f32x16& p, int s) {
    u32x4 w; w.x = pk2(p[8 * s + 0], p[8 * s + 1]); w.y = pk2(p[8 * s + 2], p[8 * s + 3]); w.z = pk2(p[8 * s + 4], p[8 * s + 5]); w.w = pk2(p[8 * s + 6], p[8 * s + 7]);
    return __builtin_bit_cast(bf16x8, w);
}
constexpr int TAB_N = 130;
__device__ __forceinline__ int tab_idx(int dist) { return min(max(dist, -1), 128) + 1; }
__device__ __forceinline__ void build_tabs(LAS float* tab, const float* rel_bias, int tid) {
    for (int i = tid; i < 12 * TAB_N; i += 512) {
        const int hh = i / TAB_N, e = i % TAB_N; float v;
        if (e == 0) v = -INFINITY;
        else if (hh < 8) v = e == 129 ? 0.f : (rel_bias[t5b(e - 1) * 12 + hh] - rel_bias[31 * 12 + hh]) * LOG2E;
        else v = e == 129 ? -INFINITY : rel_bias[t5b(e - 1) * 12 + hh] * LOG2E;
        tab[i] = v;
    }
}
__device__ __forceinline__ void qk_global(f32x16& p0, f32x16& p1, const bf16_t* K, const bf16x8 (&qf)[4], int lane) {
    const bf16_t* kp = K + (size_t)(lane & 31) * 64 + 8 * (lane >> 5);
    bf16x8 kf[8];
#pragma unroll
    for (int c = 0; c < 4; ++c) { kf[2 * c] = *(const bf16x8*)(kp + 16 * c); kf[2 * c + 1] = *(const bf16x8*)(kp + 32 * 64 + 16 * c); }
    f32x16 z;
#pragma unroll
    for (int r = 0; r < 16; ++r) z[r] = 0.f;
    p0 = z; p1 = z;
#pragma unroll
    for (int c = 0; c < 4; ++c) {
        p0 = __builtin_amdgcn_mfma_f32_32x32x16_bf16(kf[2 * c], qf[c], p0, 0, 0, 0);
        p1 = __builtin_amdgcn_mfma_f32_32x32x16_bf16(kf[2 * c + 1], qf[c], p1, 0, 0, 0);
    }
}
__device__ __forceinline__ void pv_global(f32x16 (&o)[2], const bf16_t* VT, size_t pitch, const f32x16& p0, const f32x16& p1, int lane) {
    const bf16_t* vp = VT + (size_t)(lane & 31) * pitch + 8 * (lane >> 5);
    bf16x8 vf[8];
#pragma unroll
    for (int q = 0; q < 4; ++q)
#pragma unroll
        for (int dh = 0; dh < 2; ++dh) vf[2 * q + dh] = *(const bf16x8*)(vp + (size_t)(32 * dh) * pitch + 16 * q);
#pragma unroll
    for (int q = 0; q < 4; ++q) {
        const bf16x8 pf = pack8((q >> 1) ? p1 : p0, q & 1);
#pragma unroll
        for (int dh = 0; dh < 2; ++dh) o[dh] = __builtin_amdgcn_mfma_f32_32x32x16_bf16(vf[2 * q + dh], pf, o[dh], 0, 0, 0);
    }
}
__device__ __forceinline__ void softmax_step(f32x16& p0, f32x16& p1, float& m, float& l, f32x16 (&o)[2]) {
    float mx = fmaxf(p0[0], p1[0]);
#pragma unroll
    for (int r = 1; r < 16; ++r) mx = fmaxf(mx, fmaxf(p0[r], p1[r]));
    mx = xhalf_max(mx);
    const float mn = fmaxf(m, mx);
    const float ms = (mn == -INFINITY) ? 0.f : mn;
    const float alpha = __builtin_amdgcn_exp2f(m - ms);
    float sum = 0.f;
#pragma unroll
    for (int r = 0; r < 16; ++r) { p0[r] = __builtin_amdgcn_exp2f(p0[r] - ms); p1[r] = __builtin_amdgcn_exp2f(p1[r] - ms); sum += p0[r] + p1[r]; }
    l = l * alpha + sum; m = mn;
    if (__any(alpha != 1.f)) {
#pragma unroll
        for (int r = 0; r < 16; ++r) { o[0][r] *= alpha; o[1][r] *= alpha; }
    }
}
constexpr float SM_THR = 6.f;
__device__ __forceinline__ float max3f(float a, float b, float c) { return fmaxf(fmaxf(a, b), c); }
__device__ __forceinline__ void softmax_rel(f32x16& p0, f32x16& p1, float& mref, float& l, f32x16 (&o)[2], bool first) {
    float a = max3f(p0[0], p0[1], p1[0]), b = max3f(p0[2], p0[3], p1[1]);
    a = max3f(a, p1[2], p1[3]);
#pragma unroll
    for (int r = 4; r < 16; r += 4) { a = max3f(a, p0[r], p0[r + 1]); b = max3f(b, p0[r + 2], p0[r + 3]); a = max3f(a, p1[r], p1[r + 1]); b = max3f(b, p1[r + 2], p1[r + 3]); }
    const float mx = xhalf_max(fmaxf(a, b));
    if (first || __any(mx > SM_THR)) {
        const float d = first ? (mx == -INFINITY ? 0.f : mx) : fmaxf(mx, 0.f); const f32x2_t d2 = {d, d};
        mref += d;
        const float f = first ? 1.f : __builtin_amdgcn_exp2f(-d); const f32x2_t f2 = {f, f};
        l *= f;
#pragma unroll
        for (int r = 0; r < 16; r += 2) {
            f32x2_t x = {p0[r], p0[r + 1]}; x = x - d2; p0[r] = x[0]; p0[r + 1] = x[1];
            f32x2_t y = {p1[r], p1[r + 1]}; y = y - d2; p1[r] = y[0]; p1[r + 1] = y[1];
            f32x2_t u = {o[0][r], o[0][r + 1]}; u = u * f2; o[0][r] = u[0]; o[0][r + 1] = u[1];
            f32x2_t v = {o[1][r], o[1][r + 1]}; v = v * f2; o[1][r] = v[0]; o[1][r + 1] = v[1];
        }
    }
    f32x2_t s2 = {0.f, 0.f};
#pragma unroll
    for (int r = 0; r < 16; r += 2) {
        p0[r] = __builtin_amdgcn_exp2f(p0[r]); p0[r + 1] = __builtin_amdgcn_exp2f(p0[r + 1]); p1[r] = __builtin_amdgcn_exp2f(p1[r]); p1[r + 1] = __builtin_amdgcn_exp2f(p1[r + 1]);
        const f32x2_t x = {p0[r], p0[r + 1]}, y = {p1[r], p1[r + 1]}; s2 = s2 + x; s2 = s2 + y;
    }
    l += s2[0] + s2[1];
}
__device__ __forceinline__ void store_ot(bf16_t* dst, const f32x16 (&o)[2], float scale, int hi) {
#pragma unroll
    for (int dh = 0; dh < 2; ++dh)
#pragma unroll
        for (int m4 = 0; m4 < 4; ++m4) {
            uint2 w; w.x = pk2(o[dh][4 * m4] * scale, o[dh][4 * m4 + 1] * scale); w.y = pk2(o[dh][4 * m4 + 2] * scale, o[dh][4 * m4 + 3] * scale);
            *(uint2*)(dst + 32 * dh + 8 * m4 + 4 * hi) = w;
        }
}

__device__ __forceinline__ void cmp2_unit(unsigned char* ws, const float* knorm, int unit, int lane) {
    const int kv = unit >> 6, hi = lane >> 5, row = (unit & 63) * 32 + (lane & 31), n = row & 511, grp = row >> 9;
    const float* hrow = (const float*)(ws + OFF_HID) + ((size_t)kv * 2048 + row) * 256 + 8 * hi;
    const bf16_t* w2t = (const bf16_t*)(ws + OFF_W2T) + (size_t)kv * 64 * 256 + (size_t)(lane & 31) * 256 + 8 * hi;
    f32x16 o[2];
#pragma unroll
    for (int r = 0; r < 16; ++r) { o[0][r] = 0.f; o[1][r] = 0.f; }
#pragma unroll 4
    for (int c = 0; c < 16; ++c) {
        const f32x4 a = *(const f32x4*)(hrow + 16 * c), b = *(const f32x4*)(hrow + 16 * c + 4);
        u32x4 w; w.x = pk2(a[0], a[1]); w.y = pk2(a[2], a[3]); w.z = pk2(b[0], b[1]); w.w = pk2(b[2], b[3]);
        const bf16x8 hb = __builtin_bit_cast(bf16x8, w);
#pragma unroll
        for (int dh = 0; dh < 2; ++dh) { const bf16x8 wf = *(const bf16x8*)(w2t + (size_t)dh * 32 * 256 + 16 * c); o[dh] = __builtin_amdgcn_mfma_f32_32x32x16_bf16(wf, hb, o[dh], 0, 0, 0); }
    }
    const bool valid = n < NCMP;
    if (kv == 0) {
        float ss = 0.f;
#pragma unroll
        for (int r = 0; r < 16; ++r) ss += o[0][r] * o[0][r] + o[1][r] * o[1][r];
        ss = xhalf_sum(ss);
        const float rn = valid ? rsqrtf(ss * (1.f / 64.f) + EPS) : 0.f;
        bf16_t* dst = (bf16_t*)(ws + OFF_KCN) + ((size_t)grp * 512 + n) * 64;
#pragma unroll
        for (int dh = 0; dh < 2; ++dh)
#pragma unroll
            for (int m4 = 0; m4 < 4; ++m4) { const int d = 32 * dh + 8 * m4 + 4 * hi; const f32x4 kn = *(const f32x4*)(knorm + d);
                uint2 w; w.x = pk2(o[dh][4 * m4] * rn * kn[0], o[dh][4 * m4 + 1] * rn * kn[1]); w.y = pk2(o[dh][4 * m4 + 2] * rn * kn[2], o[dh][4 * m4 + 3] * rn * kn[3]);
                *(uint2*)(dst + d) = w; }
    } else {
        bf16_t* dst = (bf16_t*)(ws + OFF_VCT) + (size_t)grp * 64 * 512 + vt_pos(n);
#pragma unroll
        for (int dh = 0; dh < 2; ++dh)
#pragma unroll
            for (int r = 0; r < 16; ++r) dst[(size_t)(32 * dh + crow(r, hi)) * 512] = f2bf(valid ? o[dh][r] : 0.f);
    }
}

__device__ __forceinline__ void ldk_global(bf16x8 (&kf)[8], const bf16_t* K, int lane) {
    const bf16_t* kp = K + (size_t)(lane & 31) * 64 + 8 * (lane >> 5);
#pragma unroll
    for (int c = 0; c < 4; ++c) { kf[2 * c] = *(const bf16x8*)(kp + 16 * c); kf[2 * c + 1] = *(const bf16x8*)(kp + 32 * 64 + 16 * c); }
}
__device__ __forceinline__ void ldv_global(bf16x8 (&vf)[8], const bf16_t* VT, size_t pitch, int lane) {
    const bf16_t* vp = VT + (size_t)(lane & 31) * pitch + 8 * (lane >> 5);
#pragma unroll
    for (int q = 0; q < 4; ++q)
#pragma unroll
        for (int dh = 0; dh < 2; ++dh) vf[2 * q + dh] = *(const bf16x8*)(vp + (size_t)(32 * dh) * pitch + 16 * q);
}
__device__ __forceinline__ void mm_qk(f32x16& p0, f32x16& p1, const bf16x8 (&kf)[8], const bf16x8 (&qf)[4]) {
    f32x16 z;
#pragma unroll
    for (int r = 0; r < 16; ++r) z[r] = 0.f;
    p0 = z; p1 = z;
#pragma unroll
    for (int c = 0; c < 4; ++c) { p0 = __builtin_amdgcn_mfma_f32_32x32x16_bf16(kf[2 * c], qf[c], p0, 0, 0, 0); p1 = __builtin_amdgcn_mfma_f32_32x32x16_bf16(kf[2 * c + 1], qf[c], p1, 0, 0, 0); }
}
__device__ __forceinline__ void mm_pv(f32x16 (&o)[2], const bf16x8 (&vf)[8], const f32x16& p0, const f32x16& p1) {
#pragma unroll
    for (int q = 0; q < 4; ++q) { const bf16x8 pf = pack8((q >> 1) ? p1 : p0, q & 1);
#pragma unroll
        for (int dh = 0; dh < 2; ++dh) o[dh] = __builtin_amdgcn_mfma_f32_32x32x16_bf16(vf[2 * q + dh], pf, o[dh], 0, 0, 0); }
}
__device__ __forceinline__ void swa_unit(unsigned char* ws, const LAS float* tabW, const float* sinks, int unit, int lane, bool do_store) {
    const int t0 = (unit & 255) * 32, h = (unit >> 8) & 3, b = unit >> 10, g = h >> 1, hi = lane >> 5, t = t0 + (lane & 31);
    bf16_t* qrow = (bf16_t*)(ws + OFF_Q16) + (((size_t)b * 16 + 12 + h) * S + t) * 64;
    const bf16_t* K = (const bf16_t*)(ws + OFF_WK) + ((size_t)b * 2 + g) * S * 64; const bf16_t* VT = (const bf16_t*)(ws + OFF_WVT) + ((size_t)b * 2 + g) * 64 * S;
    bf16x8 qf[4];
#pragma unroll
    for (int c = 0; c < 4; ++c) qf[c] = *(const bf16x8*)(qrow + 16 * c + 8 * hi);
    const float sink = sinks[h] * LOG2E;
    float m = sink, l = hi == 0 ? 1.f : 0.f;
    f32x16 o[2];
#pragma unroll
    for (int r = 0; r < 16; ++r) { o[0][r] = 0.f; o[1][r] = 0.f; }
    const LAS float* tb = tabW + h * TAB_N;
    const int jlo = t0 >= 127 ? (t0 - 127) >> 6 : 0, jhi = (t0 + 31) >> 6;
    bf16x8 kf[8], vf[8];
    ldk_global(kf, K + (size_t)jlo * 4096, lane);
    for (int j = jlo; j <= jhi; ++j) {
        ldv_global(vf, VT + (size_t)j * 64, S, lane);
        f32x16 p0, p1;
        mm_qk(p0, p1, kf, qf);
        if (j < jhi) ldk_global(kf, K + (size_t)(j + 1) * 4096, lane);
#pragma unroll
        for (int r = 0; r < 16; ++r) { const int d0 = t - (j * 64 + crow(r, hi)); p0[r] += tb[tab_idx(d0)]; p1[r] += tb[tab_idx(d0 - 32)]; }
        softmax_step(p0, p1, m, l, o);
        mm_pv(o, vf, p0, p1);
    }
    l = xhalf_sum(l);
    if (do_store) store_ot(qrow, o, 1.f / l, hi);
}

constexpr float SB_CUT = 64.f;
__device__ __forceinline__ void sb_unit(unsigned char* ws, int unit, int lane, bool do_store) {
    const int t0 = (unit & 255) * 32, h = (unit >> 8) & 3, b = unit >> 10, hi = lane >> 5, t = t0 + (lane & 31);
    bf16_t* qrow = (bf16_t*)(ws + OFF_Q16) + (((size_t)b * 16 + 8 + h) * S + t) * 64;
    const bf16_t* K = (const bf16_t*)(ws + OFF_SBK) + ((size_t)b * 4 + h) * S * 64; const bf16_t* VT = (const bf16_t*)(ws + OFF_SBVT) + ((size_t)b * 4 + h) * 64 * S;
    bf16x8 qf[4];
#pragma unroll
    for (int c = 0; c < 4; ++c) qf[c] = *(const bf16x8*)(qrow + 16 * c + 8 * hi);
    f32x16 o[2];
#pragma unroll
    for (int r = 0; r < 16; ++r) { o[0][r] = 0.f; o[1][r] = 0.f; }
    float carry = 0.f;
    bf16x8 kf[8], vf[8];
    const int jd = (t0 + 31) >> 6;
    ldk_global(kf, K + (size_t)jd * 4096, lane);
    for (int j = jd; j >= 0; --j) {
        f32x16 z0, z1, f0, f1;
        mm_qk(z0, z1, kf, qf);
        if (j > 0) ldk_global(kf, K + (size_t)(j - 1) * 4096, lane);
        float gs[8];
#pragma unroll
        for (int u = 0; u < 8; ++u) gs[u] = 0.f;
        const int kb = j * 64;
#pragma unroll
        for (int r = 0; r < 16; ++r) {
            { const float z = z0[r]; const bool ok = kb + crow(r, hi) < t; const float sp = fmaxf(z, 0.f) + __builtin_amdgcn_logf(1.f + __builtin_amdgcn_exp2f(-fabsf(z))); f0[r] = ok ? -sp : 0.f; gs[r >> 2] += f0[r]; }
            { const float z = z1[r]; const bool ok = kb + 32 + crow(r, hi) < t; const float sp = fmaxf(z, 0.f) + __builtin_amdgcn_logf(1.f + __builtin_amdgcn_exp2f(-fabsf(z))); f1[r] = ok ? -sp : 0.f; gs[4 + (r >> 2)] += f1[r]; }
        }
        ldv_global(vf, VT + (size_t)j * 64, S, lane);
        float T = 0.f, A[8];
#pragma unroll
        for (int u = 7; u >= 0; --u) { const float pg = xhalf_other(gs[u], hi); A[u] = T + (hi == 0 ? pg : 0.f); T += gs[u] + pg; }
#pragma unroll
        for (int u = 0; u < 8; ++u) {
            float run = carry + A[u];
#pragma unroll
            for (int i = 3; i >= 0; --i) {
                const int r = 4 * (u & 3) + i;
                if (u < 4) { const bool ok = kb + crow(r, hi) < t; const float lf = f0[r]; z0[r] = ok ? __builtin_amdgcn_exp2f(z0[r] + lf + run) : 0.f; run += lf; }
                else { const bool ok = kb + 32 + crow(r, hi) < t; const float lf = f1[r]; z1[r] = ok ? __builtin_amdgcn_exp2f(z1[r] + lf + run) : 0.f; run += lf; }
            }
        }
        carry += T;
        mm_pv(o, vf, z0, z1);
        if (__all(carry < -SB_CUT)) break;
    }
    if (do_store) store_ot(qrow, o, 1.f, hi);
}


constexpr int NSA_STAGE = 16384, NSA_IMPG = 32768, NSA_IMPL = 65536, NSA_SEL = 98304;
struct TileSrc { const bf16_t* K; const bf16_t* VT; size_t vpitch; };
__device__ __forceinline__ void nsa_issue(LAS unsigned char* stage, const TileSrc& ts, int j, int tid, int wave) {
    const int row = tid >> 3, chunk = (tid & 7) ^ ((row >> 1) & 7);
    __builtin_amdgcn_global_load_lds((const unsigned*)(ts.K + ((size_t)j * 64 + row) * 64 + chunk * 8), (LAS unsigned*)(stage + wave * 1024), 16, 0, 0);
    __builtin_amdgcn_global_load_lds((const unsigned*)(ts.VT + (size_t)row * ts.vpitch + (size_t)j * 64 + chunk * 8), (LAS unsigned*)(stage + 8192 + wave * 1024), 16, 0, 0);
}
__device__ __forceinline__ void qk_lds(f32x16& p0, f32x16& p1, const LAS unsigned char* Kst, const bf16x8 (&qf)[4], float cinit, int lrow, int swz, int hi) {
    bf16x8 kf[8];
#pragma unroll
    for (int c = 0; c < 4; ++c) { const int off = lrow + (((2 * c + hi) ^ swz) << 4); kf[2 * c] = *(const LAS bf16x8*)(Kst + off); kf[2 * c + 1] = *(const LAS bf16x8*)(Kst + 4096 + off); }
    f32x16 z;
#pragma unroll
    for (int r = 0; r < 16; ++r) z[r] = cinit;
    p0 = z; p1 = z;
    __builtin_amdgcn_sched_barrier(0);
#pragma unroll
    for (int c = 0; c < 4; ++c) {
        p0 = __builtin_amdgcn_mfma_f32_32x32x16_bf16(kf[2 * c], qf[c], p0, 0, 0, 0);
        p1 = __builtin_amdgcn_mfma_f32_32x32x16_bf16(kf[2 * c + 1], qf[c], p1, 0, 0, 0);
    }
}
__device__ __forceinline__ void pv_lds(f32x16 (&o)[2], const LAS unsigned char* Vst, const f32x16& p0, const f32x16& p1, int lrow, int swz, int hi) {
    bf16x8 vf[8];
#pragma unroll
    for (int kh = 0; kh < 2; ++kh)
#pragma unroll
        for (int s = 0; s < 2; ++s) { const int off = lrow + (((4 * kh + 2 * s + hi) ^ swz) << 4);
#pragma unroll
            for (int dh = 0; dh < 2; ++dh) vf[4 * kh + 2 * s + dh] = *(const LAS bf16x8*)(Vst + dh * 4096 + off); }
    bf16x8 pf[4];
#pragma unroll
    for (int kh = 0; kh < 2; ++kh)
#pragma unroll
        for (int s = 0; s < 2; ++s) pf[2 * kh + s] = pack8(kh ? p1 : p0, s);
    __builtin_amdgcn_sched_barrier(0);
#pragma unroll
    for (int q = 0; q < 4; ++q)
#pragma unroll
        for (int dh = 0; dh < 2; ++dh) o[dh] = __builtin_amdgcn_mfma_f32_32x32x16_bf16(vf[2 * q + dh], pf[q], o[dh], 0, 0, 0);
}
__device__ __forceinline__ float quad_sum(float v) {
    v += __int_as_float(__builtin_amdgcn_mov_dpp(__float_as_int(v), 0xB1, 0xf, 0xf, true));
    v += __int_as_float(__builtin_amdgcn_mov_dpp(__float_as_int(v), 0x4E, 0xf, 0xf, true));
    return v;
}
#define NSA_WAITBAR() do { asm volatile("s_waitcnt vmcnt(0) lgkmcnt(0)" ::: "memory"); __builtin_amdgcn_s_barrier(); asm volatile("" ::: "memory"); } while (0)

__device__ __forceinline__ void nsa_unit(LAS unsigned char* lds, const LAS float* tabN, unsigned char* ws, int b, int g, int qt, int tid_in, bool do_store) {
    int tid = tid_in; asm volatile("" : "+v"(tid));
    const int lane = tid & 63, wave = __builtin_amdgcn_readfirstlane(tid >> 6), hi = lane >> 5, col = lane & 31, qi = col >> 2, r = col & 3;
    const int t0 = qt * 64, qloc = 8 * wave + qi, t = t0 + qloc, h = 4 * g + r, grp = b * 2 + g;
    const int lrow = col * 128, swz = (col >> 1) & 7;
    bf16_t* qrow = (bf16_t*)(ws + OFF_Q16) + (((size_t)b * 16 + h) * S + t) * 64;
    bf16x8 qf[4];
#pragma unroll
    for (int c = 0; c < 4; ++c) qf[c] = *(const bf16x8*)(qrow + 16 * c + 8 * hi);
    const LAS float* tb = tabN + h * TAB_N;
    LAS float* impG = (LAS float*)(lds + NSA_IMPG); LAS float* impL = (LAS float*)(lds + NSA_IMPL); LAS unsigned* selm = (LAS unsigned*)(lds + NSA_SEL);
    const float* NG = (const float*)(ws + OFF_NGATE) + (size_t)(b * S + t) * 24;
    f32x16 out[2];
#pragma unroll
    for (int rr = 0; rr < 16; ++rr) { out[0][rr] = 0.f; out[1][rr] = 0.f; }

    {
        TileSrc ts; ts.K = (const bf16_t*)(ws + OFF_KCN) + (size_t)grp * 512 * 64; ts.VT = (const bf16_t*)(ws + OFF_VCT) + (size_t)grp * 64 * 512; ts.vpitch = 512;
        const int nmax = min((t0 + 32) >> 4, 510), nct = (nmax >> 6) + 1;
        float m = -INFINITY, l = 0.f;
        if (tid < 64) impL[tid * 128] = 0.f;
        NSA_WAITBAR();
        nsa_issue(lds, ts, 0, tid, wave);
        for (int i = 0; i < nct; ++i) {
            NSA_WAITBAR();
            if (i + 1 < nct) nsa_issue(lds + ((i + 1) & 1) * NSA_STAGE, ts, i + 1, tid, wave);
            const LAS unsigned char* st = lds + (i & 1) * NSA_STAGE;
            f32x16 p0, p1;
            qk_lds(p0, p1, st, qf, 0.f, lrow, swz, hi);
            float mx = -INFINITY;
#pragma unroll
            for (int rr = 0; rr < 16; ++rr) { const int dc = t - 16 * (i * 64 + crow(rr, hi)) - 31; p0[rr] += tb[tab_idx(dc)]; p1[rr] += tb[tab_idx(dc - 512)]; mx = fmaxf(mx, fmaxf(p0[rr], p1[rr])); }
            mx = xhalf_max(mx);
            const float mn = fmaxf(m, mx), ms = (mn == -INFINITY) ? 0.f : mn;
            float sum = 0.f;
#pragma unroll
            for (int rr = 0; rr < 16; ++rr) sum += __builtin_amdgcn_exp2f(p0[rr] - ms) + __builtin_amdgcn_exp2f(p1[rr] - ms);
            l = l * __builtin_amdgcn_exp2f(m - ms) + sum; m = mn;
        }
        l = xhalf_sum(l);
        const float ms = (m == -INFINITY) ? 0.f : m, il = l > 0.f ? 1.f / l : 0.f;
        f32x16 o[2];
#pragma unroll
        for (int rr = 0; rr < 16; ++rr) { o[0][rr] = 0.f; o[1][rr] = 0.f; }
        NSA_WAITBAR();
        nsa_issue(lds, ts, 0, tid, wave);
        for (int i = 0; i < nct; ++i) {
            NSA_WAITBAR();
            if (i + 1 < nct) nsa_issue(lds + ((i + 1) & 1) * NSA_STAGE, ts, i + 1, tid, wave);
            const LAS unsigned char* st = lds + (i & 1) * NSA_STAGE;
            f32x16 p0, p1;
            qk_lds(p0, p1, st, qf, 0.f, lrow, swz, hi);
#pragma unroll
            for (int rr = 0; rr < 16; ++rr) { const int dc = t - 16 * (i * 64 + crow(rr, hi)) - 31;
                p0[rr] = __builtin_amdgcn_exp2f(p0[rr] + tb[tab_idx(dc)] - ms) * il; p1[rr] = __builtin_amdgcn_exp2f(p1[rr] + tb[tab_idx(dc - 512)] - ms) * il; }
#pragma unroll
            for (int u = 0; u < 8; ++u) {
                const f32x16& pp = u < 4 ? p0 : p1; const int r0 = 4 * (u & 3);
                const float G = quad_sum((pp[r0] + pp[r0 + 1]) + (pp[r0 + 2] + pp[r0 + 3])), L = quad_sum(pp[r0 + 3]);
                const int j = 16 * i + 8 * (u >> 2) + 2 * (u & 3) + hi;
                if (r == 0) { impG[qloc * 128 + j] = G; if (j + 1 < 128) impL[qloc * 128 + j + 1] = L; }
            }
            pv_lds(o, st + 8192, p0, p1, lrow, swz, hi);
        }
        const float gc = NG[h];
#pragma unroll
        for (int rr = 0; rr < 16; ++rr) { out[0][rr] += gc * o[0][rr]; out[1][rr] += gc * o[1][rr]; }
    }
    NSA_WAITBAR();
    {
        int tid2 = tid_in; asm volatile("" : "+v"(tid2));
        const int q = tid2 >> 3, sub = tid2 & 7;
        unsigned mw[4] = {0u, 0u, 0u, 0u};
        if (qt <= 15) { if (sub == 0) mw[0] = (qt == 31) ? 0xffffffffu : ((2u << qt) - 1u); }
        else {
            unsigned vb[16];
#pragma unroll
            for (int i = 0; i < 16; ++i) { const int j = sub + 8 * i; const bool cand = j >= 1 && j <= qt - 2; vb[i] = cand ? __float_as_uint(impG[q * 128 + j] + impL[q * 128 + j]) + 1u : 0u; }
            unsigned T = 0u;
#pragma unroll 1
            for (int bit = 30; bit >= 0; --bit) {
                const unsigned trial = T | (1u << bit); unsigned c = 0u;
#pragma unroll
                for (int i = 0; i < 16; ++i) c += vb[i] >= trial ? 1u : 0u;
                c += swz_xor_u<1>(c); c += swz_xor_u<2>(c); c += swz_xor_u<4>(c);
                if (c >= 13u) T = trial;
            }
            unsigned cge = 0u;
#pragma unroll
            for (int i = 0; i < 16; ++i) cge += vb[i] >= T ? 1u : 0u;
            cge += swz_xor_u<1>(cge); cge += swz_xor_u<2>(cge); cge += swz_xor_u<4>(cge);
            if (cge == 13u) {
#pragma unroll
                for (int i = 0; i < 16; ++i) { const int j = sub + 8 * i; if (vb[i] >= T && vb[i] != 0u) mw[j >> 5] |= 1u << (j & 31); }
            } else {
                for (int i = 0; i < 16; ++i) { const int j = sub + 8 * i; if (vb[i] == 0u) continue; int rk = 0;
                    for (int kk = 1; kk <= qt - 2; ++kk) { const unsigned vk = __float_as_uint(impG[q * 128 + kk] + impL[q * 128 + kk]) + 1u; rk += (vk > vb[i]) || (vk == vb[i] && kk < j); }
                    if (rk < 13) mw[j >> 5] |= 1u << (j & 31); }
            }
            if (sub == 0) mw[0] |= 1u;
#pragma unroll
            for (int i = 0; i < 16; ++i) { const int j = sub + 8 * i; if (j == qt || j == qt - 1) mw[j >> 5] |= 1u << (j & 31); }
        }
#pragma unroll
        for (int wd = 0; wd < 4; ++wd) { unsigned x = mw[wd]; x |= swz_xor_u<1>(x); x |= swz_xor_u<2>(x); x |= swz_xor_u<4>(x); if (sub == 0) selm[q * 4 + wd] = x; }
    }
    NSA_WAITBAR();
    unsigned sm0 = selm[qloc * 4 + 0], sm1 = selm[qloc * 4 + 1], sm2 = selm[qloc * 4 + 2], sm3 = selm[qloc * 4 + 3];
    {
        TileSrc ts; ts.K = (const bf16_t*)(ws + OFF_KSLC) + (size_t)grp * S * 64; ts.VT = (const bf16_t*)(ws + OFF_VSLCT) + (size_t)grp * 64 * S; ts.vpitch = S;
        float m = 0.f, l = 0.f;
        f32x16 o[2];
#pragma unroll
        for (int rr = 0; rr < 16; ++rr) { o[0][rr] = 0.f; o[1][rr] = 0.f; }
        nsa_issue(lds, ts, 0, tid, wave);
        for (int j = 0; j <= qt; ++j) {
            NSA_WAITBAR();
            if (j + 1 <= qt) nsa_issue(lds + ((j + 1) & 1) * NSA_STAGE, ts, j + 1, tid, wave);
            const LAS unsigned char* st = lds + (j & 1) * NSA_STAGE;
            const unsigned mword = j < 32 ? sm0 : j < 64 ? sm1 : j < 96 ? sm2 : sm3;
            const bool selb = (mword >> (j & 31)) & 1u;
            if (!__any(selb)) continue;
            const float cinit = selb ? -m : -INFINITY;
            f32x16 p0, p1;
            qk_lds(p0, p1, st, qf, cinit, lrow, swz, hi);
            if (j >= qt - 2) {
#pragma unroll
                for (int rr = 0; rr < 16; ++rr) { const int d0 = t - (j * 64 + crow(rr, hi)); p0[rr] += tb[tab_idx(d0)]; p1[rr] += tb[tab_idx(d0 - 32)]; }
            }
            softmax_rel(p0, p1, m, l, o, j == 0);
            pv_lds(o, st + 8192, p0, p1, lrow, swz, hi);
        }
        l = xhalf_sum(l);
        const float gs = NG[8 + h] / l;
#pragma unroll
        for (int rr = 0; rr < 16; ++rr) { out[0][rr] += gs * o[0][rr]; out[1][rr] += gs * o[1][rr]; }
    }
    {
        TileSrc ts; ts.K = (const bf16_t*)(ws + OFF_KWIN) + (size_t)grp * S * 64; ts.VT = (const bf16_t*)(ws + OFF_VWINT) + (size_t)grp * 64 * S; ts.vpitch = S;
        float m = 0.f, l = 0.f;
        f32x16 o[2];
#pragma unroll
        for (int rr = 0; rr < 16; ++rr) { o[0][rr] = 0.f; o[1][rr] = 0.f; }
        const int j0 = qt >= 8 ? qt - 8 : 0, nt = qt - j0 + 1;
        NSA_WAITBAR();
        nsa_issue(lds, ts, j0, tid, wave);
        for (int i = 0; i < nt; ++i) {
            const int j = j0 + i;
            NSA_WAITBAR();
            if (i + 1 < nt) nsa_issue(lds + ((i + 1) & 1) * NSA_STAGE, ts, j + 1, tid, wave);
            const LAS unsigned char* st = lds + (i & 1) * NSA_STAGE;
            f32x16 p0, p1;
            qk_lds(p0, p1, st, qf, -m, lrow, swz, hi);
            if (j >= qt - 2) {
#pragma unroll
                for (int rr = 0; rr < 16; ++rr) { const int d0 = t - (j * 64 + crow(rr, hi)); p0[rr] += tb[tab_idx(d0)]; p1[rr] += tb[tab_idx(d0 - 32)]; }
            } else if (j == qt - 8) {
#pragma unroll
                for (int rr = 0; rr < 16; ++rr) { const int d0 = t - (j * 64 + crow(rr, hi)); if (d0 >= 512) p0[rr] = -INFINITY; if (d0 - 32 >= 512) p1[rr] = -INFINITY; }
            }
            softmax_rel(p0, p1, m, l, o, i == 0);
            pv_lds(o, st + 8192, p0, p1, lrow, swz, hi);
        }
        l = xhalf_sum(l);
        const float gw = NG[16 + h] / l;
#pragma unroll
        for (int rr = 0; rr < 16; ++rr) { out[0][rr] += gw * o[0][rr]; out[1][rr] += gw * o[1][rr]; }
    }
    if (do_store) store_ot(qrow, out, 1.f, hi);
    NSA_WAITBAR();
}


#define XB_TMO      128
#define XB_XCNT(j)  (256  + 64 * (j))
#define XB_XSUB(j)  (1280 + 64 * (j))
#define XB_XGEN(j)  (2304 + 64 * (j))
#define XB_TOP      3328
#define XB_TOPGEN   3392
#define XCD_BAR_WORDS 3456
#define XB_SPIN_CAP (1u << 18)
constexpr size_t CTL_ZERO_BYTES = 65536, CTL_BAR_OFF = 16384;
constexpr int LDS_XB_OFF = 131072 + 8192;
__device__ __forceinline__ unsigned xb_ld(unsigned* p)              { return __hip_atomic_load(p, __ATOMIC_RELAXED, __HIP_MEMORY_SCOPE_AGENT); }
__device__ __forceinline__ unsigned xb_add(unsigned* p, unsigned v) { return __hip_atomic_fetch_add(p, v, __ATOMIC_RELAXED, __HIP_MEMORY_SCOPE_AGENT); }
__device__ __forceinline__ unsigned xb_xcc_id() { return (unsigned)__builtin_amdgcn_s_getreg((3 << 11) | 20) & 0xFu; }
#define XB_SPIN(cond, bar) do { unsigned _sp = 0; while (cond) { __builtin_amdgcn_s_sleep(1); \
    if ((++_sp & 255u) == 0u) { if (xb_ld(&(bar)[XB_TMO])) break; if (_sp > XB_SPIN_CAP) { atomicAdd(&(bar)[XB_TMO], 1u); break; } } } } while (0)
__device__ __forceinline__ void xcd_barrier_complete(unsigned* bar, unsigned x, unsigned G, unsigned& nloc, unsigned& nx) {
    unsigned sum, cnt, mine, sp = 0u;
    for (;;) {
        sum = 0u; cnt = 0u; mine = 0u;
#pragma unroll
        for (unsigned j = 0; j < 16; ++j) { const unsigned c = xb_ld(&bar[XB_XCNT(j)]); sum += c; cnt += (c > 0u) ? 1u : 0u; mine = (j == x) ? c : mine; }
        if (sum == G) break;
        __builtin_amdgcn_s_sleep(1);
        if ((++sp & 255u) == 0u) { if (xb_ld(&bar[XB_TMO])) break; if (sp > XB_SPIN_CAP) { atomicAdd(&bar[XB_TMO], 1u); break; } }
    }
    nloc = mine > 0u ? mine : 1u; nx = cnt > 0u ? cnt : 1u;
}
__device__ __forceinline__ void xcd_barrier(unsigned* bar, volatile LAS unsigned* st, unsigned G, bool leader) {
    asm volatile("s_waitcnt vmcnt(0)" ::: "memory");
    __syncthreads();
    if (leader) {
        const unsigned x = xb_xcc_id();
        __builtin_amdgcn_s_waitcnt(0);
        unsigned nloc = st[0], nx = st[1];
        if (nloc == 0u) { xcd_barrier_complete(bar, x, G, nloc, nx); st[0] = nloc; st[1] = nx; }
        const unsigned old = xb_add(&bar[XB_XSUB(x)], 1u);
        const unsigned gen = old / nloc;
        if (old + 1u == (gen + 1u) * nloc) {
            __builtin_amdgcn_fence(__ATOMIC_RELEASE, "agent");
            asm volatile("s_waitcnt vmcnt(0)" ::: "memory");
            const unsigned og = xb_add(&bar[XB_TOP], 1u);
            const unsigned tg = og / nx;
            if (og + 1u == (tg + 1u) * nx) xb_add(&bar[XB_TOPGEN], 1u);
            else XB_SPIN(xb_ld(&bar[XB_TOPGEN]) == tg, bar);
            __builtin_amdgcn_fence(__ATOMIC_ACQUIRE, "agent");
            xb_add(&bar[XB_XGEN(x)], 1u);
            asm volatile("s_waitcnt vmcnt(0)" ::: "memory");
        } else {
            XB_SPIN(xb_ld(&bar[XB_XGEN(x)]) == gen, bar);
            __builtin_amdgcn_fence(__ATOMIC_ACQUIRE, "agent");
            asm volatile("s_waitcnt vmcnt(0)" ::: "memory");
        }
    }
    __syncthreads();
}

struct Params { const float* in[26]; float* out; unsigned char* ws; };
constexpr int LDS_BYTES = 147456;
__device__ __forceinline__ const float* inptr(const Params& p, int i) { asm volatile("" : "+s"(i)); return p.in[i]; }
#define PH_BEGIN(lexpr) int lq = (lexpr); asm volatile("" : "+s"(lq)); unsigned char* ws = p.ws; asm volatile("" : "+s"(ws)); float* X = p.out; asm volatile("" : "+s"(X)); \
    bf16_t* XB = (bf16_t*)(ws + OFF_XB); float* SSQ = (float*)(ws + OFF_SSQ); (void)XB; (void)SSQ; (void)X; (void)lq
#define IN(i) inptr(p, i)
#define CCX() ConvCtx{ldsr, nullptr, 0, (int)gridDim.x * 8, MYTID()}
#define CCS(b0) ConvCtx{ldsr, nullptr, (b0), ((int)gridDim.x - (b0)) * 8, MYTID()}
#define FFN_SRC(l, base) IN(base) + (size_t)(l) * D, IN((base) + 1) + (size_t)(l) * D * F, IN((base) + 2) + (size_t)(l) * D * F, IN((base) + 3) + (size_t)(l) * F * D
__device__ __forceinline__ MixW mixw_of(const Params& p, int l) { MixW w; w.mixn = IN(6) + (size_t)l * D; w.win = IN(7) + (size_t)l * D * DIN; w.w1k = IN(11) + (size_t)l * 2048 * 256; w.w1v = IN(13) + (size_t)l * 2048 * 256;
    w.ua = IN(18) + (size_t)l * 512 * D; w.ub = IN(19) + (size_t)l * 256 * D; w.uc = IN(20) + (size_t)l * 256 * D; w.wo = IN(21) + (size_t)l * D * D; w.pos = IN(10) + (size_t)l * 2048; w.w2k = IN(12) + (size_t)l * 256 * 64; w.w2v = IN(14) + (size_t)l * 256 * 64; return w; }

__global__ void __launch_bounds__(512) mega_fwd(Params p) {
    extern __shared__ __attribute__((aligned(16))) char lds_base[];
    cg::grid_group grid = cg::this_grid();
    LAS unsigned char* ldsr = (LAS unsigned char*)lds_base;
    const int wave_s = __builtin_amdgcn_readfirstlane(threadIdx.x >> 6);
    const int G_ = gridDim.x, bid = blockIdx.x;
    unsigned long long ts_t0 = 0, ts_acc = 0; (void)ts_t0; int ts_inst = 0; (void)ts_inst;
    if (threadIdx.x == 0) { volatile LAS unsigned* st_ = (volatile LAS unsigned*)(ldsr + LDS_XB_OFF); st_[0] = 0u; st_[1] = 0u;
        (void)xb_add((unsigned*)(p.ws + OFF_CTL + CTL_BAR_OFF) + XB_XCNT(xb_xcc_id()), 1u); }
    __syncthreads();
#define GSYNC_CG() do { TS_B(27); grid.sync(); TS_E(27); } while (0)
#define GSYNC(id) do { if (PROBE == 40) { unsigned char* wsb2_ = p.ws; asm volatile("" : "+s"(wsb2_)); xcd_barrier((unsigned*)(wsb2_ + OFF_CTL + CTL_BAR_OFF), (volatile LAS unsigned*)(ldsr + LDS_XB_OFF), (unsigned)G_, MYTID() == 0); } TS_B(27); TS_B(100 + (id)); { unsigned char* wsb_ = p.ws; asm volatile("" : "+s"(wsb_)); xcd_barrier((unsigned*)(wsb_ + OFF_CTL + CTL_BAR_OFF), (volatile LAS unsigned*)(ldsr + LDS_XB_OFF), (unsigned)G_, MYTID() == 0); } TS_E(27); TS_E(100 + (id)); } while (0)
    REP(9) {
        PH_BEGIN(0);
        TS_B(21); conv_ffn(CCX(), FFN_SRC(lq, 2), ws + OFF_FFN1W); __syncthreads(); TS_E(21);
        TS_B(22); conv_mix(CCX(), mixw_of(p, lq), ws); __syncthreads(); TS_E(22);
        TS_B(23); ph_prep(MYTID(), IN(0), XB, SSQ); __syncthreads(); TS_E(23);
        GSYNC_CG();
    }
#pragma unroll 1
    for (int l = 0; l < 2; ++l) {
#pragma unroll 1
        for (int f = 0; f < 2; ++f) {
            ts_inst = l * 2 + f;
            if (f == 1) {
                REP(3) {
                    PH_BEGIN(l);
                    pg8::Ops g; g.A = (const char*)XB; g.Bt = (const char*)(ws + OFF_BT_IN); g.lda_b = D * 2; g.ldb_b = D * 2; g.a_kstep = 128; g.nt = D / 64; g.a_mode = 0;
                    pg8::StaticOrder so; so.init(M, 5888, G_, bid);
                    pg8::EpiWin E{ws, SSQ, IN(8) + lq * 64, IN(9) + lq * 64, IN(15) + lq * 64, IN(16) + lq * 64};
                    TS_B(25); pg8::gemm_phase(ldsr, MYTID(), g, so, E); TS_E(25);
                    GSYNC(2);
                }
                {
                    PH_BEGIN(l);
                    if (bid < 16) {
                        pg8::Ops g; g.A = (const char*)(ws + OFF_KCMP); g.Bt = (const char*)(ws + OFF_BT_C1); g.lda_b = 2048; g.ldb_b = 4096; g.a_kstep = 128; g.nt = 32; g.a_mode = 2;
                        pg8::StaticOrder so; so.init(2048, 512, G_, bid);
                        pg8::EpiCmp1 E{(float*)(ws + OFF_HID), (const float*)(ws + OFF_BIASC)};
                        TS_B(29); pg8::gemm_phase(ldsr, MYTID(), g, so, E); TS_E(29);
                    } else {
                        LAS float* tabs = (LAS float*)(ldsr + 131072);
                        build_tabs(tabs, IN(1), MYTID());
                        __syncthreads();
                        int t_ = MYTID(); asm volatile("" : "+v"(t_));
                        const int lane_ = t_ & 63, gw_ = (bid - 16) * 8 + __builtin_amdgcn_readfirstlane(t_ >> 6), ngw_ = (G_ - 16) * 8;
                        REP(6) {
                            for (int u = gw_; u < 2048; u += ngw_) sb_unit(ws, u, lane_, LASTREP(6));
                            for (int u = gw_; u < 2048; u += ngw_) swa_unit(ws, tabs + 8 * TAB_N, IN(17) + lq * 4, u, lane_, LASTREP(6));
                        }
                    }
                }
                GSYNC(3);
                {
                    PH_BEGIN(l);
                    int t_ = MYTID(); asm volatile("" : "+v"(t_));
                    const int lane_ = t_ & 63, gw_ = bid * 8 + __builtin_amdgcn_readfirstlane(t_ >> 6);
                    TS_B(30);
                    for (int u = gw_; u < 128; u += G_ * 8) cmp2_unit(ws, IN(9) + lq * 64, u, lane_);
                    TS_E(30);
                }
                GSYNC(4);
                {
                    PH_BEGIN(l);
                    LAS float* tabs = (LAS float*)(ldsr + 131072);
                    build_tabs(tabs, IN(1), MYTID());
                    __syncthreads();
                    int t_ = MYTID(); asm volatile("" : "+v"(t_));
                    TS_B(32);
                    REP(5) {
                        for (int ps = bid; ps < 256; ps += G_) {
                            const int bg = (ps & 7) >> 1, i = (ps & 1) * 32 + (ps >> 3);
#pragma unroll 1
                            for (int k2 = 0; k2 < 2; ++k2) nsa_unit(ldsr, tabs, ws, bg >> 1, bg & 1, k2 ? 127 - i : i, t_, LASTREP(5));
                        }
                    }
                    TS_E(32);
                }
                GSYNC(5);
                REP(7) {
                    PH_BEGIN(l);
                    TS_B(21); conv_ffn(CCX(), FFN_SRC(lq, 22), ws + OFF_FFN2W);
                    __syncthreads(); TS_E(21);
                    bf16_t* GATES = (bf16_t*)(ws + OFF_A);
                    pg8::Ops g; g.A = (const char*)(ws + OFF_Q16); g.Bt = (const char*)(ws + OFF_BT_M); g.lda_b = 128; g.ldb_b = D * 2; g.a_kstep = (size_t)S * 128; g.nt = 16; g.a_mode = 1;
                    pg8::StaticOrder so; so.init(M, D, G_, bid);
                    pg8::EpiMerge E{GATES, GATES + (size_t)M * D, GATES + (size_t)2 * M * D, (bf16_t*)(ws + OFF_MERGED)};
                    TS_B(28); pg8::gemm_phase(ldsr, MYTID(), g, so, E); TS_E(28);
                    GSYNC(6);
                }
                REP(8) {
                    PH_BEGIN(l);
                    if (lq == 0) { TS_B(21); conv_ffn(CCX(), FFN_SRC(1, 2), ws + OFF_FFN1W); __syncthreads(); TS_E(21); }
                    pg8::Ops g; g.A = (const char*)(ws + OFF_MERGED); g.Bt = (const char*)(ws + OFF_BT_O); g.lda_b = D * 2; g.ldb_b = D * 2; g.a_kstep = 128; g.nt = 16; g.a_mode = 0;
                    pg8::StaticOrder so; so.init(M, D, G_, bid);
                    pg8::EpiResid E{X, X, XB, SSQ, LASTREP(8) ? 1.0f : 0.f};
                    TS_B(26); pg8::gemm_phase(ldsr, MYTID(), g, so, E); TS_E(26);
                    GSYNC(7);
                }
            }
            REP(1) {
                PH_BEGIN(l);
                int fq_ = f; asm volatile("" : "+s"(fq_));
                unsigned char* wbase = ws + (fq_ == 0 ? OFF_FFN1W : OFF_FFN2W);
                if (fq_ == 1 && lq == 0) { TS_B(22); conv_mix(CCX(), mixw_of(p, 1), ws); __syncthreads(); TS_E(22); }
                pg8::Ops g; g.A = (const char*)XB; g.Bt = (const char*)wbase; g.lda_b = D * 2; g.ldb_b = D * 2; g.a_kstep = 128; g.nt = 16; g.a_mode = 0;
                pg8::StaticOrder so; so.init(M, 2 * F, G_, bid);
                pg8::EpiFfnUp E{(bf16_t*)(ws + OFF_A), SSQ};
                TS_B(24); pg8::gemm_phase(ldsr, MYTID(), g, so, E); TS_E(24);
                GSYNC(8);
            }
            REP(2) {
                PH_BEGIN(l);
                int fq_ = f; asm volatile("" : "+s"(fq_));
                unsigned char* wbase = ws + (fq_ == 0 ? OFF_FFN1W : OFF_FFN2W);
                pg8::Ops g; g.A = (const char*)(ws + OFF_A); g.Bt = (const char*)(wbase + FFNW_D); g.lda_b = F * 2; g.ldb_b = F * 2; g.a_kstep = 128; g.nt = F / 64; g.a_mode = 0;
                pg8::StaticOrder so; so.init(M, D, G_, bid);
                pg8::EpiResid E{(lq == 0 && fq_ == 0) ? IN(0) : (const float*)X, X, XB, SSQ, LASTREP(2) ? 0.5f : 0.f};
                TS_B(31); pg8::gemm_phase(ldsr, MYTID(), g, so, E); TS_E(31);
                if (!(l == 1 && f == 1)) GSYNC(9);
            }
        }
    }
#ifdef TSPMAX
    if (TSP != 0) {
        unsigned* mx_ = (unsigned*)(p.ws + OFF_CTL) + 8192;
        if (MYTID() == 0) atomicMax(mx_, (unsigned)ts_acc);
        xcd_barrier((unsigned*)(p.ws + OFF_CTL + CTL_BAR_OFF), (volatile LAS unsigned*)(ldsr + LDS_XB_OFF), (unsigned)G_, MYTID() == 0);
        if (bid == 0) { const unsigned long long mxv = __hip_atomic_load(mx_, __ATOMIC_RELAXED, __HIP_MEMORY_SCOPE_AGENT); const unsigned long long te = __builtin_amdgcn_s_memrealtime(); while (__builtin_amdgcn_s_memrealtime() - te < 10ull * mxv) __builtin_amdgcn_s_sleep(8); }
    }
#else
    if (TSP != 0 && bid == 0) { const unsigned long long te = __builtin_amdgcn_s_memrealtime(); while (__builtin_amdgcn_s_memrealtime() - te < 10ull * ts_acc) __builtin_amdgcn_s_sleep(8); }
#endif
}

extern "C" void kernel_launch(void* const* d_in, const int* in_sizes, int n_in, void* d_out, int out_size, void* d_ws, size_t ws_size, hipStream_t stream) {
    static int grid_blocks = 0;
    if (grid_blocks == 0) {
        if (ws_size < WS_END || n_in != 26) { fprintf(stderr, "kernel_launch: bad sizes (ws %zu)\n", ws_size); grid_blocks = -1; return; }
        int dev = 0, cus = 0, per_cu = 0;
        (void)hipGetDevice(&dev); (void)hipDeviceGetAttribute(&cus, hipDeviceAttributeMultiprocessorCount, dev);
        (void)hipFuncSetAttribute((const void*)mega_fwd, hipFuncAttributeMaxDynamicSharedMemorySize, LDS_BYTES);
        (void)hipOccupancyMaxActiveBlocksPerMultiprocessor(&per_cu, (const void*)mega_fwd, 512, LDS_BYTES);
        if (per_cu < 1) { fprintf(stderr, "kernel_launch: occupancy query says %d\n", per_cu); per_cu = 1; }
        grid_blocks = cus * (per_cu > 1 ? 1 : per_cu);
        (void)hipGetLastError();
    }
    if (grid_blocks < 0) return;
    if (hipMemsetAsync((char*)d_ws + OFF_CTL, 0, CTL_ZERO_BYTES, stream) != hipSuccess) { fprintf(stderr, "kernel_launch: memset failed\n"); return; }
    Params p{}; for (int i = 0; i < 26; ++i) p.in[i] = (const float*)d_in[i]; p.out = (float*)d_out; p.ws = (unsigned char*)d_ws;
    void* args[] = {&p};
    hipError_t e = hipLaunchCooperativeKernel((void*)mega_fwd, dim3(grid_blocks), dim3(512), args, LDS_BYTES, stream);
    if (e != hipSuccess) fprintf(stderr, "cooperative launch failed: %s (grid %d)\n", hipGetErrorString(e), grid_blocks);
}
```

```cpp
#include <hip/hip_runtime.h>
#include <hip/hip_cooperative_groups.h>
#include <stdint.h>
#include <cstdio>
namespace cg = cooperative_groups;
#ifndef PROBE
#define PROBE 0
#endif
#ifndef TSP
#define TSP 0
#endif
#ifndef TSF
#define TSF -1
#endif
#define TS_B(k) if (TSP == (k) && (TSF < 0 || TSF == ts_inst)) { ts_t0 = __builtin_amdgcn_s_memrealtime(); }
#define TS_E(k) if (TSP == (k) && (TSF < 0 || TSF == ts_inst)) { ts_acc += __builtin_amdgcn_s_memrealtime() - ts_t0; }
#define REP(k) for (int rep_ = 0; rep_ < (PROBE == (k) ? 2 : 1); ++rep_)
#define LASTREP(k) (rep_ == (PROBE == (k) ? 1 : 0))
__device__ __forceinline__ int lane_id() { int r; asm volatile("v_mbcnt_lo_u32_b32 %0, -1, 0\n\tv_mbcnt_hi_u32_b32 %0, -1, %0" : "=v"(r)); return r; }
#define MYTID() (wave_s * 64 + lane_id())
#define VB_SETUP int tidx_ = tid_in; asm volatile("" : "+v"(tidx_)); const int tid = tidx_ & 255, vhalf = tidx_ >> 8; const int vb0 = blockIdx.x * 2 + vhalf, nvb = gridDim.x * 2; char* lds = lds_base + vhalf * 32768; (void)tid; (void)lds; (void)vb0; (void)nvb
#define LAS __attribute__((address_space(3)))

typedef unsigned short bf16_t;
typedef short bf16x8 __attribute__((ext_vector_type(8)));
typedef float f32x4 __attribute__((ext_vector_type(4)));
typedef unsigned u32x4 __attribute__((ext_vector_type(4)));
__device__ __forceinline__ float bf2f(bf16_t v) { return __uint_as_float(((unsigned)v) << 16); }
__device__ __forceinline__ bf16_t f2bf(float f) { unsigned u = __float_as_uint(f); return (bf16_t)((u + 0x7fffu + ((u >> 16) & 1u)) >> 16); }
typedef float f32x2_t __attribute__((ext_vector_type(2))); typedef __bf16 bf16x2_t __attribute__((ext_vector_type(2)));
__device__ __forceinline__ unsigned pk2(float lo, float hi) { f32x2_t v = {lo, hi}; bf16x2_t b = __builtin_convertvector(v, bf16x2_t); return __builtin_bit_cast(unsigned, b); }

__host__ __device__ __forceinline__ int vperm16(int k) { return 8 * ((k >> 2) & 1) + 4 * (k >> 3) + (k & 3); }
__device__ __forceinline__ size_t vt_pos(int s) { return (size_t)((s & ~15) + vperm16(s & 15)); }
constexpr int NB = 2, S = 8192, M = NB * S, D = 1024, F = 2816, HD = 64, DIN = 5656;
constexpr int NCMP = 511, NSLC = 128;
constexpr float LOG2E = 1.4426950408889634f;
constexpr float C2 = 0.125f * LOG2E;
constexpr float EPS = 1e-6f;

constexpr size_t MiB = 1u << 20;
constexpr size_t OFF_CTL = 0;
constexpr size_t OFF_SSQ = 1 * MiB;
constexpr size_t OFF_XB = 2 * MiB;
constexpr size_t OFF_A = 34 * MiB;
constexpr size_t OFF_MIXW = 130 * MiB;
constexpr size_t OFF_BT_IN = OFF_MIXW, OFF_BT_C1 = OFF_MIXW + 12 * MiB, OFF_BT_M = OFF_MIXW + 14 * MiB, OFF_BT_O = OFF_MIXW + 16 * MiB;
constexpr size_t OFF_W2T = OFF_MIXW + 11 * MiB + 768 * 1024;
constexpr size_t OFF_Q16 = 148 * MiB;
constexpr size_t OFF_KV = 180 * MiB;
constexpr size_t KV2 = 4 * MiB, KV4 = 8 * MiB;
constexpr size_t OFF_KCMP = OFF_KV, OFF_VCMP = OFF_KCMP + KV2, OFF_KSLC = OFF_VCMP + KV2, OFF_VSLCT = OFF_KSLC + KV2,
                 OFF_KWIN = OFF_VSLCT + KV2, OFF_VWINT = OFF_KWIN + KV2, OFF_WK = OFF_VWINT + KV2, OFF_WVT = OFF_WK + KV2,
                 OFF_SBK = OFF_WVT + KV2, OFF_SBVT = OFF_SBK + KV4;
constexpr size_t OFF_MERGED = OFF_KV;
constexpr size_t OFF_FFN1W = OFF_Q16, OFF_FFN2W = 237 * MiB;
constexpr size_t FFNW_D = 11 * MiB;
constexpr size_t OFF_SMALL = 229 * MiB;
constexpr size_t OFF_NGATE = OFF_SMALL;
constexpr size_t OFF_KCN = OFF_NGATE + 2 * MiB;
constexpr size_t OFF_VCT = OFF_KCN + MiB / 4;
constexpr size_t OFF_HID = OFF_VCT + MiB / 4;
constexpr size_t OFF_BIASC = OFF_HID + 4 * MiB;
constexpr size_t WS_END = OFF_FFN2W + 17 * MiB;
static_assert(OFF_SBVT + KV4 <= OFF_SMALL && OFF_BIASC + MiB <= OFF_FFN2W, "ws map");

__device__ const unsigned char T5B[128] = {
    0, 1, 2, 3, 4, 5, 6, 7, 8, 9, 10, 11, 12, 13, 14, 15, 16, 16, 16, 17, 17, 18, 18, 18, 19, 19, 19, 20, 20, 20, 20, 21, 21, 21, 21, 22, 22, 22, 22, 22, 23, 23, 23, 23, 23, 23, 24, 24, 24, 24, 24, 24, 25, 25, 25, 25, 25, 25, 25, 26, 26, 26, 26, 26, 26, 26, 26, 27, 27, 27, 27, 27, 27, 27, 27, 27, 27, 28, 28, 28, 28, 28, 28, 28, 28, 28, 28, 29, 29, 29, 29, 29, 29, 29, 29, 29, 29, 29, 29, 30, 30, 30, 30, 30, 30, 30, 30, 30, 30, 30, 30, 30, 30, 31, 31, 31, 31, 31, 31, 31, 31, 31, 31, 31, 31, 31, 31, 31};
__device__ __forceinline__ int t5b(int dist) { return dist >= 128 ? 31 : (int)T5B[dist < 0 ? 0 : dist]; }

template <int K> __device__ __forceinline__ float swz_xor(float v) { return __int_as_float(__builtin_amdgcn_ds_swizzle(__float_as_int(v), (K << 10) | 0x1f)); }
template <int K> __device__ __forceinline__ unsigned swz_xor_u(unsigned v) { return (unsigned)__builtin_amdgcn_ds_swizzle((int)v, (K << 10) | 0x1f); }
__device__ __forceinline__ float xhalf_sum(float v) { auto rr = __builtin_amdgcn_permlane32_swap(__float_as_uint(v), __float_as_uint(v), false, false); return __uint_as_float(rr[0]) + __uint_as_float(rr[1]); }
__device__ __forceinline__ float xhalf_max(float v) { auto rr = __builtin_amdgcn_permlane32_swap(__float_as_uint(v), __float_as_uint(v), false, false); return fmaxf(__uint_as_float(rr[0]), __uint_as_float(rr[1])); }
__device__ __forceinline__ float xhalf_other(float v, int hi) { auto rr = __builtin_amdgcn_permlane32_swap(__float_as_uint(v), __float_as_uint(v), false, false); return __uint_as_float(hi ? rr[0] : rr[1]); }
__device__ __forceinline__ float wave_sum(float v) {
    v += swz_xor<1>(v); v += swz_xor<2>(v); v += swz_xor<4>(v); v += swz_xor<8>(v); v += swz_xor<16>(v);
    return xhalf_sum(v);
}
__device__ __forceinline__ float sigmoidf_(float x) { return 1.f / (1.f + __expf(-x)); }
__device__ __forceinline__ float siluf_(float x) { return x / (1.f + __expf(-x)); }
__device__ __forceinline__ float fast_sigmoid(float x) { return __builtin_amdgcn_rcpf(1.f + __builtin_amdgcn_exp2f(-x * LOG2E)); }

__device__ __forceinline__ void ph_prep(int tid_in, const float* xin, bf16_t* XB, float* SSQ) {
    int t_ = tid_in; asm volatile("" : "+v"(t_));
    const int lane = t_ & 63, gw = blockIdx.x * 8 + __builtin_amdgcn_readfirstlane(t_ >> 6);
    for (int row = gw; row < M; row += gridDim.x * 8) {
        const f32x4* xr = (const f32x4*)(xin + (size_t)row * D) + lane; float ss = 0.f;
        f32x4 v[4];
#pragma unroll
        for (int j = 0; j < 4; ++j) v[j] = xr[64 * j];
#pragma unroll
        for (int j = 0; j < 4; ++j) { ss += (v[j][0] * v[j][0] + v[j][1] * v[j][1]) + (v[j][2] * v[j][2] + v[j][3] * v[j][3]);
            uint2 w; w.x = pk2(v[j][0], v[j][1]); w.y = pk2(v[j][2], v[j][3]); *((uint2*)(XB + (size_t)row * D) + lane + 64 * j) = w; }
        ss = wave_sum(ss);
        if (lane < 16) SSQ[(size_t)row * 16 + lane] = lane == 0 ? ss : 0.f;
    }
}

namespace pg8 {
constexpr int BM = 256, BK = 64, HALF = 128, HTB = HALF * BK * 2, STAGE_BYTES = 8 * HTB, NXCD = 8, WGM = 8;
__host__ __device__ __forceinline__ int lds_byte(int r, int c) { const int st = (r >> 4) * 2 + (c >> 5), rr = r & 15, cc = c & 31, ob = rr * 64 + cc * 2; return st * 1024 + (ob ^ (((ob >> 9) & 1) << 5)); }
__host__ __device__ __forceinline__ void stage_rc(int b, int& R, int& C) { const int st = b / 1024, sb = b % 1024, swz = sb ^ (((sb >> 9) & 1) << 5); R = (st >> 1) * 16 + swz / 64; C = (st & 1) * 32 + (swz % 64) / 2; }
__host__ __device__ __forceinline__ int perm32(int rho) { const int n = rho >> 4, i = rho & 15; return 8 * (i >> 2) + 4 * n + (i & 3); }
struct Unit { int pm, pn; };
struct StaticOrder {
    int nM, nN, nwg, G, c;
    __device__ __forceinline__ void init(int M_, int N_, int G_, int c_) { nM = M_ / BM; nN = N_ / BM; nwg = nM * nN; G = G_; c = c_; }
    __device__ __forceinline__ bool next(int i, Unit& u) const {
        const long L = (long)i * G + c; if (L >= nwg) return false;
        int wgid = (int)L; { const int q = nwg / NXCD, r = nwg % NXCD, xcd = wgid % NXCD, off = wgid / NXCD; wgid = (xcd < r ? xcd * (q + 1) : r * (q + 1) + (xcd - r) * q) + off; }
        const int nig = WGM * nN, gid = wgid / nig, fm = gid * WGM, gsz = (nM - fm) < WGM ? (nM - fm) : WGM;
        u.pm = fm + ((wgid % nig) % gsz); u.pn = (wgid % nig) / gsz; return true;
    }
};
struct Ops {
    const char* A; const char* Bt; unsigned lda_b, ldb_b; size_t a_kstep; int nt;
    int a_mode;
    __device__ __forceinline__ const char* a_base(const Unit& u) const {
        if (a_mode == 1) return A + (size_t)(u.pm >> 5) * (16ull * S * 128) + (size_t)(u.pm & 31) * (256 * 128);
        if (a_mode == 2) return A + (size_t)u.pn * KV2 + (size_t)u.pm * 256 * lda_b;
        return A + (size_t)u.pm * 256 * lda_b;
    }
    __device__ __forceinline__ const char* b_base(const Unit& u) const { return Bt + (size_t)u.pn * 256 * ldb_b; }
};

template <class Epi, class Sched>
__device__ __forceinline__ void gemm_phase(LAS unsigned char* lds, int tid_in, const Ops& G, const Sched& S_, const Epi& E) {
    int tid_ = tid_in; asm volatile("" : "+v"(tid_));
    const int tid = tid_, wid = __builtin_amdgcn_readfirstlane(tid >> 6), lane = tid & 63, wr = wid >> 2, wc = wid & 3, fr = lane & 15, fq = lane >> 4;
    const int nt = G.nt;
    unsigned voffA[2], voffB[2];
#pragma unroll
    for (int i = 0; i < 2; ++i) { int R, C; stage_rc(tid * 16 + i * 8192, R, C); const int Rb = Epi::PERM ? ((R & ~31) + perm32(R & 31)) : R;
        voffA[i] = (unsigned)R * G.lda_b + (unsigned)C * 2u; voffB[i] = (unsigned)Rb * G.ldb_b + (unsigned)C * 2u; }
    const size_t kstepA = G.a_kstep, kstepB = (size_t)(BK * 2);
    const size_t hstepA = (size_t)HALF * G.lda_b, hstepB = (size_t)HALF * G.ldb_b;
    const unsigned ldsw = (unsigned)wid * 1024u;
    const int aoff = lds_byte(wr * 64 + fr, fq * 8), boff = lds_byte(wc * 32 + fr, fq * 8);
#define PG8_SA(b, h) (((b) * 2 + (h)) * HTB)
#define PG8_SB(b, h) ((4 + (b) * 2 + (h)) * HTB)
#define PG8_STAGE(bufoff, gbase, voff) do { _Pragma("unroll") for (int _i = 0; _i < 2; ++_i) \
        __builtin_amdgcn_global_load_lds((const unsigned*)((const char*)(gbase) + (voff)[_i]), (LAS unsigned*)(lds + (bufoff) + ldsw + _i * 8192), 16, 0, 0); } while (0)
#define PG8_LDA(dst, b, h) do { _Pragma("unroll") for (int m = 0; m < 4; ++m) _Pragma("unroll") for (int k = 0; k < 2; ++k) dst[m][k] = *(const LAS bf16x8*)(lds + PG8_SA(b, h) + aoff + m * 2048 + k * 1024); } while (0)
#define PG8_LDB(dst, b, h) do { _Pragma("unroll") for (int n = 0; n < 2; ++n) _Pragma("unroll") for (int k = 0; k < 2; ++k) dst[n][k] = *(const LAS bf16x8*)(lds + PG8_SB(b, h) + boff + n * 2048 + k * 1024); } while (0)
#define PG8_MMA(ai, bj, At, Bt) do { __builtin_amdgcn_s_setprio(1); _Pragma("unroll") for (int m = 0; m < 4; ++m) _Pragma("unroll") for (int n = 0; n < 2; ++n) _Pragma("unroll") for (int k = 0; k < 2; ++k) \
        acc[ai][bj][m][n] = __builtin_amdgcn_mfma_f32_16x16x32_bf16(Bt[n][k], At[m][k], acc[ai][bj][m][n], 0, 0, 0); __builtin_amdgcn_s_setprio(0); } while (0)
#define PG8_WAIT_V(n) asm volatile("s_waitcnt vmcnt(" #n ")" ::: "memory")
#define PG8_WAIT_L(n) asm volatile("s_waitcnt lgkmcnt(" #n ")" ::: "memory")
#define PG8_BAR __builtin_amdgcn_s_barrier()
#define PG8_SCHED __builtin_amdgcn_sched_barrier(0)
    Unit cur, nxt; int ui = 0;
    if (!S_.next(0, cur)) return;
    f32x4 acc[2][2][4][2];
#pragma unroll
    for (int a = 0; a < 2; ++a)
#pragma unroll
        for (int b = 0; b < 2; ++b)
#pragma unroll
            for (int m = 0; m < 4; ++m)
#pragma unroll
                for (int n = 0; n < 2; ++n) acc[a][b][m][n] = (f32x4){0.f, 0.f, 0.f, 0.f};
    bf16x8 At[4][2], B0[2][2], B1[2][2];
    const char* cA = G.a_base(cur); const char* cB = G.b_base(cur);
    PG8_STAGE(PG8_SB(0, 0), cB, voffB); PG8_STAGE(PG8_SB(0, 1), cB + hstepB, voffB); PG8_STAGE(PG8_SA(0, 0), cA, voffA); PG8_STAGE(PG8_SA(0, 1), cA + hstepA, voffA);
    if (wr == 1) PG8_BAR;
    PG8_WAIT_V(2); PG8_BAR;
    PG8_STAGE(PG8_SB(1, 0), cB + kstepB, voffB); PG8_STAGE(PG8_SA(1, 0), cA + kstepA, voffA); PG8_STAGE(PG8_SB(1, 1), cB + hstepB + kstepB, voffB);
    PG8_WAIT_V(6); PG8_BAR;
    for (;;) {
        const bool has_next = S_.next(ui + 1, nxt);
        const char* nA = has_next ? G.a_base(nxt) : cA; const char* nB = has_next ? G.b_base(nxt) : cB;
        for (int t = 0; t < nt; t += 2) {
            const bool last = (t == nt - 2);
            const char* a1 = cA + (size_t)(t + 1) * kstepA;
            const char* a2 = last ? nA : cA + (size_t)(t + 2) * kstepA; const char* b2 = last ? nB : cB + (size_t)(t + 2) * kstepB;
            const char* a3 = a2 + kstepA; const char* b3 = b2 + kstepB;
            if constexpr (Epi::KHOOK) E.khook(acc, cur, t, wr, wc, fr, fq);
            PG8_LDB(B0, 0, 0); PG8_LDB(B1, 0, 1); PG8_SCHED; PG8_LDA(At, 0, 0); PG8_STAGE(PG8_SA(1, 1), a1 + hstepA, voffA);
            PG8_WAIT_V(8); PG8_WAIT_L(0); PG8_BAR; PG8_MMA(0, 0, At, B0); PG8_MMA(0, 1, At, B1); PG8_BAR; PG8_SCHED;
            PG8_LDA(At, 0, 1); PG8_STAGE(PG8_SB(0, 0), b2, voffB); PG8_STAGE(PG8_SB(0, 1), b2 + hstepB, voffB); PG8_STAGE(PG8_SA(0, 0), a2, voffA);
            PG8_WAIT_V(8); PG8_WAIT_L(0); PG8_BAR; PG8_MMA(1, 0, At, B0); PG8_MMA(1, 1, At, B1); PG8_BAR; PG8_SCHED;
            PG8_LDB(B0, 1, 0); PG8_LDB(B1, 1, 1); PG8_SCHED; PG8_LDA(At, 1, 0); PG8_STAGE(PG8_SA(0, 1), a2 + hstepA, voffA);
            PG8_WAIT_V(8); PG8_WAIT_L(0); PG8_BAR; PG8_MMA(0, 0, At, B0); PG8_MMA(0, 1, At, B1); PG8_BAR; PG8_SCHED;
            PG8_LDA(At, 1, 1); PG8_STAGE(PG8_SB(1, 0), b3, voffB); PG8_STAGE(PG8_SB(1, 1), b3 + hstepB, voffB); PG8_STAGE(PG8_SA(1, 0), a3, voffA);
            PG8_WAIT_V(8); PG8_WAIT_L(0); PG8_BAR; PG8_MMA(1, 0, At, B0); PG8_MMA(1, 1, At, B1); PG8_BAR; PG8_SCHED;
        }
        if (wr == 0) PG8_BAR;
        E(acc, cur, wr, wc, fr, fq);
        if (!has_next) break;
#pragma unroll
        for (int a = 0; a < 2; ++a)
#pragma unroll
            for (int b = 0; b < 2; ++b)
#pragma unroll
                for (int m = 0; m < 4; ++m)
#pragma unroll
                    for (int n = 0; n < 2; ++n) acc[a][b][m][n] = (f32x4){0.f, 0.f, 0.f, 0.f};
        cur = nxt; cA = nA; cB = nB; ++ui;
        if (wr == 1) PG8_BAR;
    }
    PG8_WAIT_V(0);
    PG8_BAR;
#undef PG8_SA
#undef PG8_SB
#undef PG8_STAGE
#undef PG8_LDA
#undef PG8_LDB
#undef PG8_MMA
#undef PG8_WAIT_V
#undef PG8_WAIT_L
#undef PG8_BAR
#undef PG8_SCHED
}

__device__ __forceinline__ float rstd_of(const float* ssq, int row) {
    const f32x4* p = (const f32x4*)(ssq + (size_t)row * 16); const f32x4 a = p[0], b = p[1], c = p[2], d = p[3];
    const float s = ((a[0] + a[1]) + (a[2] + a[3])) + ((b[0] + b[1]) + (b[2] + b[3])) + ((c[0] + c[1]) + (c[2] + c[3])) + ((d[0] + d[1]) + (d[2] + d[3]));
    return rsqrtf(s * (1.f / D) + EPS);
}
__device__ __forceinline__ float silu_fast(float x) { return x * __builtin_amdgcn_rcpf(1.f + __builtin_amdgcn_exp2f(-x * LOG2E)); }

struct EpiFfnUp {
    static constexpr bool PERM = true, KHOOK = false;
    bf16_t* H; const float* ssq;
    __device__ __forceinline__ void operator()(const f32x4 (&acc)[2][2][4][2], const Unit& u, int wr, int wc, int fr, int fq) const {
#pragma unroll
        for (int ai = 0; ai < 2; ++ai)
#pragma unroll
            for (int m = 0; m < 4; ++m) {
                const int row = u.pm * BM + ai * HALF + wr * 64 + m * 16 + fr; const float r = rstd_of(ssq, row);
                float h[8];
#pragma unroll
                for (int n = 0; n < 2; ++n)
#pragma unroll
                    for (int j = 0; j < 4; ++j) h[n * 4 + j] = silu_fast(r * acc[ai][0][m][n][j]) * (r * acc[ai][1][m][n][j]);
                u32x4 w; w.x = pk2(h[0], h[1]); w.y = pk2(h[2], h[3]); w.z = pk2(h[4], h[5]); w.w = pk2(h[6], h[7]);
                *(u32x4*)(H + (size_t)row * F + u.pn * 128 + wc * 32 + fq * 8) = w;
                asm volatile("" ::: "memory");
            }
    }
};
struct EpiResid {
    static constexpr bool PERM = true, KHOOK = false;
    const float* XI; float* X; bf16_t* XB; float* ssq; float alpha;
    __device__ __forceinline__ void operator()(const f32x4 (&acc)[2][2][4][2], const Unit& u, int wr, int wc, int fr, int fq) const {
#pragma unroll
        for (int ai = 0; ai < 2; ++ai)
#pragma unroll
            for (int m = 0; m < 4; ++m) {
                const int row = u.pm * BM + ai * HALF + wr * 64 + m * 16 + fr; float ss = 0.f;
#pragma unroll
                for (int bj = 0; bj < 2; ++bj) {
                    const size_t o = (size_t)row * D + u.pn * BM + bj * HALF + wc * 32 + fq * 8;
                    f32x4 x0 = *(const f32x4*)(XI + o), x1 = *(const f32x4*)(XI + o + 4);
                    x0 += acc[ai][bj][m][0] * alpha; x1 += acc[ai][bj][m][1] * alpha;
                    *(f32x4*)(X + o) = x0; *(f32x4*)(X + o + 4) = x1;
                    u32x4 w; w.x = pk2(x0[0], x0[1]); w.y = pk2(x0[2], x0[3]); w.z = pk2(x1[0], x1[1]); w.w = pk2(x1[2], x1[3]);
                    *(u32x4*)(XB + o) = w;
                    ss += (x0[0] * x0[0] + x0[1] * x0[1]) + (x0[2] * x0[2] + x0[3] * x0[3]) + (x1[0] * x1[0] + x1[1] * x1[1]) + (x1[2] * x1[2] + x1[3] * x1[3]);
                }
                ss += swz_xor<16>(ss); ss = xhalf_sum(ss);
                if (fq == 0) ssq[(size_t)row * 16 + u.pn * 4 + wc] = ss;
                asm volatile("" ::: "memory");
            }
    }
};
__host__ __device__ __forceinline__ int win_slot_col(int slot) {
    if (slot < 8) return 64 * slot;
    if (slot < 20) return 512 + 64 * (slot - 8);
    if (slot < 40) return 1304 + 64 * (slot - 20);
    if (slot < 88) return 2584 + 64 * (slot - 40);
    if (slot == 88) return 1280;
    return -1;
}
struct EpiWin {
    static constexpr bool PERM = true, KHOOK = false;
    unsigned char* ws; const float* ssq; const float *nsa_qn, *nsa_kn, *swa_qn, *swa_kn;
    __device__ __forceinline__ void operator()(const f32x4 (&acc)[2][2][4][2], const Unit& u, int wr, int wc, int fr, int fq) const {
        const int slot = u.pn * 4 + wc;
        if (slot >= 89) return;
        int kind = 0; const float* nw = nullptr; float scale = 1.f; bf16_t* dst = nullptr; int nh = 2, h = 0;
        if (slot < 8) { nw = nsa_qn; scale = C2; dst = (bf16_t*)(ws + OFF_Q16); nh = 16; h = slot; }
        else if (slot < 10) { dst = (bf16_t*)(ws + OFF_KCMP); h = slot - 8; }
        else if (slot < 12) { dst = (bf16_t*)(ws + OFF_VCMP); h = slot - 10; }
        else if (slot < 14) { nw = nsa_kn; dst = (bf16_t*)(ws + OFF_KSLC); h = slot - 12; }
        else if (slot < 16) { kind = 1; dst = (bf16_t*)(ws + OFF_VSLCT); h = slot - 14; }
        else if (slot < 18) { nw = nsa_kn; dst = (bf16_t*)(ws + OFF_KWIN); h = slot - 16; }
        else if (slot < 20) { kind = 1; dst = (bf16_t*)(ws + OFF_VWINT); h = slot - 18; }
        else if (slot < 24) { scale = C2; dst = (bf16_t*)(ws + OFF_Q16); nh = 16; h = 8 + slot - 20; }
        else if (slot < 28) { dst = (bf16_t*)(ws + OFF_SBK); nh = 4; h = slot - 24; }
        else if (slot < 32) { kind = 1; dst = (bf16_t*)(ws + OFF_SBVT); nh = 4; h = slot - 28; }
        else if (slot < 36) { nw = swa_qn; scale = C2; dst = (bf16_t*)(ws + OFF_Q16); nh = 16; h = 12 + slot - 32; }
        else if (slot < 38) { nw = swa_kn; dst = (bf16_t*)(ws + OFF_WK); h = slot - 36; }
        else if (slot < 40) { kind = 1; dst = (bf16_t*)(ws + OFF_WVT); h = slot - 38; }
        else if (slot < 88) { kind = 2; dst = (bf16_t*)(ws + OFF_A) + (size_t)((slot - 40) >> 4) * M * D + ((slot - 40) & 15) * 64; }
        else { kind = 3; }
#pragma unroll
        for (int ai = 0; ai < 2; ++ai)
#pragma unroll
            for (int m = 0; m < 4; ++m) {
                const int row = u.pm * BM + ai * HALF + wr * 64 + m * 16 + fr; const float r = rstd_of(ssq, row);
                const int b = row / S, s = row % S;
                float v[2][2][4]; float ss = 0.f;
#pragma unroll
                for (int bj = 0; bj < 2; ++bj)
#pragma unroll
                    for (int n = 0; n < 2; ++n)
#pragma unroll
                        for (int j = 0; j < 4; ++j) { const float x = r * acc[ai][bj][m][n][j]; v[bj][n][j] = x; ss += x * x; }
                float rn = scale;
                if (nw) { ss += swz_xor<16>(ss); ss = xhalf_sum(ss); rn = rsqrtf(ss * (1.f / 64.f) + EPS) * scale; }
#pragma unroll
                for (int bj = 0; bj < 2; ++bj)
#pragma unroll
                    for (int n = 0; n < 2; ++n) {
                        f32x4 wv = (f32x4){1.f, 1.f, 1.f, 1.f}; if (nw) wv = *(const f32x4*)(nw + 32 * bj + 8 * fq + 4 * n);
#pragma unroll
                        for (int j = 0; j < 4; ++j) v[bj][n][j] *= rn * wv[j];
                    }
                if (kind == 0) {
                    bf16_t* o = dst + (((size_t)b * nh + h) * S + s) * 64 + 8 * fq;
#pragma unroll
                    for (int bj = 0; bj < 2; ++bj) { u32x4 pw; pw.x = pk2(v[bj][0][0], v[bj][0][1]); pw.y = pk2(v[bj][0][2], v[bj][0][3]); pw.z = pk2(v[bj][1][0], v[bj][1][1]); pw.w = pk2(v[bj][1][2], v[bj][1][3]);
                        *(u32x4*)(o + 32 * bj) = pw; }
                } else if (kind == 1) {
                    bf16_t* o = dst + ((size_t)b * nh + h) * 64 * S + vt_pos(s);
#pragma unroll
                    for (int bj = 0; bj < 2; ++bj)
#pragma unroll
                        for (int n = 0; n < 2; ++n)
#pragma unroll
                            for (int j = 0; j < 4; ++j) o[(size_t)(32 * bj + 8 * fq + 4 * n + j) * S] = f2bf(v[bj][n][j]);
                } else if (kind == 2) {
                    bf16_t* o = dst + (size_t)row * D + 8 * fq;
#pragma unroll
                    for (int bj = 0; bj < 2; ++bj) { u32x4 pw; pw.x = pk2(fast_sigmoid(v[bj][0][0]), fast_sigmoid(v[bj][0][1])); pw.y = pk2(fast_sigmoid(v[bj][0][2]), fast_sigmoid(v[bj][0][3]));
                        pw.z = pk2(fast_sigmoid(v[bj][1][0]), fast_sigmoid(v[bj][1][1])); pw.w = pk2(fast_sigmoid(v[bj][1][2]), fast_sigmoid(v[bj][1][3])); *(u32x4*)(o + 32 * bj) = pw; }
                } else {
                    float* o = (float*)(ws + OFF_NGATE) + (size_t)row * 24;
#pragma unroll
                    for (int n = 0; n < 2; ++n)
#pragma unroll
                        for (int j = 0; j < 4; ++j) { const int d = 8 * fq + 4 * n + j; if (d < 24) o[d] = fast_sigmoid(v[0][n][j]); }
                }
                asm volatile("" ::: "memory");
            }
    }
};
struct EpiCmp1 {
    static constexpr bool PERM = true, KHOOK = false;
    float* HID; const float* bias;
    __device__ __forceinline__ void operator()(const f32x4 (&acc)[2][2][4][2], const Unit& u, int wr, int wc, int fr, int fq) const {
#pragma unroll
        for (int ai = 0; ai < 2; ++ai)
#pragma unroll
            for (int m = 0; m < 4; ++m) {
                const int row = u.pm * BM + ai * HALF + wr * 64 + m * 16 + fr;
#pragma unroll
                for (int bj = 0; bj < 2; ++bj)
#pragma unroll
                    for (int n = 0; n < 2; ++n) {
                        const int col = bj * HALF + wc * 32 + fq * 8 + 4 * n; const f32x4 bv = *(const f32x4*)(bias + u.pn * 256 + col);
                        f32x4 o;
#pragma unroll
                        for (int j = 0; j < 4; ++j) o[j] = silu_fast(acc[ai][bj][m][n][j] + bv[j]);
                        *(f32x4*)(HID + ((size_t)u.pn * 2048 + row) * 256 + col) = o;
                    }
                asm volatile("" ::: "memory");
            }
    }
};
struct EpiMerge {
    static constexpr bool PERM = true, KHOOK = true;
    const bf16_t* G0; const bf16_t* G1; const bf16_t* G2; bf16_t* OUT;
    __device__ __forceinline__ void khook(f32x4 (&acc)[2][2][4][2], const Unit& u, int t, int wr, int wc, int fr, int fq) const {
        if (t != 8 && t != 12) return;
        const bf16_t* NUM = t == 8 ? G0 : G1; const bf16_t* DEN = t == 8 ? G1 : G2;
#pragma unroll
        for (int ai = 0; ai < 2; ++ai)
#pragma unroll
            for (int m = 0; m < 4; ++m) {
                const int row = u.pm * BM + ai * HALF + wr * 64 + m * 16 + fr;
#pragma unroll
                for (int bj = 0; bj < 2; ++bj) {
                    const size_t o = (size_t)row * D + u.pn * BM + bj * HALF + wc * 32 + fq * 8;
                    const u32x4 nu = *(const u32x4*)(NUM + o), de = *(const u32x4*)(DEN + o);
#pragma unroll
                    for (int q = 0; q < 4; ++q) {
                        const float n0 = __uint_as_float(nu[q] << 16), n1 = __uint_as_float(nu[q] & 0xffff0000u), d0 = __uint_as_float(de[q] << 16), d1 = __uint_as_float(de[q] & 0xffff0000u);
                        acc[ai][bj][m][q >> 1][(q & 1) * 2] *= n0 * __builtin_amdgcn_rcpf(d0); acc[ai][bj][m][q >> 1][(q & 1) * 2 + 1] *= n1 * __builtin_amdgcn_rcpf(d1);
                    }
                }
                asm volatile("" : "+v"(acc[ai][0][m][0]), "+v"(acc[ai][0][m][1]), "+v"(acc[ai][1][m][0]), "+v"(acc[ai][1][m][1]) :: "memory");
            }
    }
    __device__ __forceinline__ void operator()(const f32x4 (&acc)[2][2][4][2], const Unit& u, int wr, int wc, int fr, int fq) const {
#pragma unroll
        for (int ai = 0; ai < 2; ++ai)
#pragma unroll
            for (int m = 0; m < 4; ++m) {
                const int row = u.pm * BM + ai * HALF + wr * 64 + m * 16 + fr;
#pragma unroll
                for (int bj = 0; bj < 2; ++bj) {
                    const size_t o = (size_t)row * D + u.pn * BM + bj * HALF + wc * 32 + fq * 8;
                    const u32x4 ge = *(const u32x4*)(G2 + o); u32x4 pw;
#pragma unroll
                    for (int q = 0; q < 4; ++q) {
                        const float g0 = __uint_as_float(ge[q] << 16), g1 = __uint_as_float(ge[q] & 0xffff0000u);
                        pw[q] = pk2(acc[ai][bj][m][q >> 1][(q & 1) * 2] * g0, acc[ai][bj][m][q >> 1][(q & 1) * 2 + 1] * g1);
                    }
                    *(u32x4*)(OUT + o) = pw;
                }
                asm volatile("" ::: "memory");
            }
    }
};
}

__device__ __forceinline__ void conv_item4(const float* W, int ldw, int col0, int nvalid, int ksrc, const float* wn, bf16_t* Bt, size_t ldbt, int row0, int kofs, LAS float* scr, int lane) {
    const int n4 = (lane & 7) * 4, kr = lane >> 3, c = lane & 7;
    f32x4 v[4][8];
#pragma unroll
    for (int q = 0; q < 4; ++q)
#pragma unroll
        for (int i = 0; i < 8; ++i) { const int kk = ksrc + 64 * q + 8 * i + kr; v[q][i] = (f32x4){0.f, 0.f, 0.f, 0.f};
            if (n4 < nvalid) { v[q][i] = *(const f32x4*)(W + (size_t)kk * ldw + col0 + n4); if (wn) v[q][i] *= wn[kk]; } }
#pragma unroll
    for (int q = 0; q < 4; ++q) {
#pragma unroll
        for (int i = 0; i < 8; ++i) { const int kk = 8 * i + kr; scr[kk * 33 + n4] = v[q][i][0]; scr[kk * 33 + n4 + 1] = v[q][i][1]; scr[kk * 33 + n4 + 2] = v[q][i][2]; scr[kk * 33 + n4 + 3] = v[q][i][3]; }
        asm volatile("s_waitcnt lgkmcnt(0)" ::: "memory");
#pragma unroll
        for (int j = 0; j < 4; ++j) { const int n = (lane >> 3) + 8 * j; const LAS float* s = scr + (8 * c) * 33 + n;
            u32x4 o; o.x = pk2(s[0 * 33], s[1 * 33]); o.y = pk2(s[2 * 33], s[3 * 33]); o.z = pk2(s[4 * 33], s[5 * 33]); o.w = pk2(s[6 * 33], s[7 * 33]);
            *(u32x4*)(Bt + (size_t)(row0 + n) * ldbt + kofs + 64 * q + 8 * c) = o; }
        asm volatile("s_waitcnt lgkmcnt(0)" ::: "memory");
    }
}
__device__ __forceinline__ void conv_wide(const float* W, int ldw, int col0, int ksrc, const float* wn, bf16_t* Bt, size_t ldbt, int r0, int r1, int r2, int r3, int kofs, LAS float* scr, int lane) {
    const int cg = lane & 31, rh = lane >> 5;
    f32x4 v[16];
#pragma unroll
    for (int i = 0; i < 16; ++i) { const int kk = ksrc + 2 * i + rh; v[i] = *(const f32x4*)(W + (size_t)kk * ldw + col0 + 4 * cg); if (wn) v[i] *= wn[kk]; }
#pragma unroll
    for (int c = 0; c < 2; ++c) {
#pragma unroll
        for (int i = 0; i < 8; ++i) { LAS float* d = scr + (2 * i + rh) * 129 + 4 * cg; d[0] = v[8 * c + i][0]; d[1] = v[8 * c + i][1]; d[2] = v[8 * c + i][2]; d[3] = v[8 * c + i][3]; }
        asm volatile("s_waitcnt lgkmcnt(0)" ::: "memory");
#pragma unroll
        for (int j = 0; j < 4; ++j) { const int t = lane + 64 * j, n = t >> 1, half = t & 1, sub = n >> 5; const LAS float* s = scr + (8 * half) * 129 + n;
            const int row = (sub == 0 ? r0 : sub == 1 ? r1 : sub == 2 ? r2 : r3) + (n & 31);
            u32x4 o; o.x = pk2(s[0 * 129], s[1 * 129]); o.y = pk2(s[2 * 129], s[3 * 129]); o.z = pk2(s[4 * 129], s[5 * 129]); o.w = pk2(s[6 * 129], s[7 * 129]);
            *(u32x4*)(Bt + (size_t)row * ldbt + kofs + 16 * c + 8 * half) = o; }
        asm volatile("s_waitcnt lgkmcnt(0)" ::: "memory");
    }
}
struct ConvCtx { LAS unsigned char* ldsr; LAS float* scr; int gw, ngw, lane; };
#define CONV_LAUNDER ConvCtx c = c_; { int t_ = c_.lane; asm volatile("" : "+v"(t_)); c.lane = t_ & 63; const int wv_ = __builtin_amdgcn_readfirstlane(t_ >> 6); c.gw = ((int)blockIdx.x - c_.gw) * 8 + wv_; c.scr = (LAS float*)(c.ldsr + wv_ * 8448); }
__device__ __forceinline__ void conv_ffn(const ConvCtx& c_, const float* nw, const float* wg, const float* wu, const float* wd, unsigned char* dstbase) {
    CONV_LAUNDER;
    bf16_t* GU = (bf16_t*)dstbase; bf16_t* DN = (bf16_t*)(dstbase + FFNW_D);
    constexpr int I_GU = 2 * 22 * 32, I_D = 8 * 88;
    for (int it = c.gw; it < I_GU + I_D; it += c.ngw) {
        if (it < I_GU) { const int kb = it / 44, cb = it % 44, isup = cb / 22, tile = cb % 22, rb = tile * 256 + isup * 128;
            conv_wide(isup ? wu : wg, F, tile * 128, kb * 32, nw, GU, D, rb, rb + 32, rb + 64, rb + 96, kb * 32, c.scr, c.lane); }
        else { const int r = it - I_GU, kb = r / 8, cb = r % 8, rb = cb * 128; conv_wide(wd, D, rb, kb * 32, nullptr, DN, F, rb, rb + 32, rb + 64, rb + 96, kb * 32, c.scr, c.lane); }
    }
}
struct MixW { const float *mixn, *win, *w1k, *w1v, *ua, *ub, *uc, *wo, *pos, *w2k, *w2v; };
__device__ __forceinline__ void conv_mix(const ConvCtx& c_, const MixW& w, unsigned char* ws) {
    CONV_LAUNDER;
    bf16_t* BIN = (bf16_t*)(ws + OFF_BT_IN); bf16_t* BC1 = (bf16_t*)(ws + OFF_BT_C1); bf16_t* BM_ = (bf16_t*)(ws + OFF_BT_M); bf16_t* BO = (bf16_t*)(ws + OFF_BT_O);
    constexpr int I_IN = 184 * 4, I_C1 = 16 * 8, I_M = 32 * 4, I_O = 32 * 4, I_B = 512, I_W2 = 4;
    bf16_t* W2T = (bf16_t*)(ws + OFF_W2T);
    for (int it = c.gw; it < I_IN + I_C1 + I_M + I_O + I_B + I_W2; it += c.ngw) {
        int r = it;
        if (r < I_IN) { const int rb = r / 4, kb = r % 4, tile = rb >> 3, r32 = rb & 7, bj = r32 >> 2, slot = tile * 4 + (r32 & 3);
            const int sc = pg8::win_slot_col(slot); int nvalid = sc < 0 ? 0 : 32; if (slot == 88) nvalid = bj == 0 ? 24 : 0;
            conv_item4(w.win, DIN, sc + 32 * bj, nvalid, kb * 256, w.mixn, BIN, D, rb * 32, kb * 256, c.scr, c.lane); continue; }
        r -= I_IN;
        if (r < I_C1) { const int rb = r / 8, kb = r % 8; conv_item4(rb >= 8 ? w.w1v : w.w1k, 256, (rb & 7) * 32, 32, kb * 256, nullptr, BC1, 2048, rb * 32, kb * 256, c.scr, c.lane); continue; }
        r -= I_C1;
        if (r < I_M) { const int rb = r / 4, kb = r % 4;
            if (kb < 2) conv_item4(w.ua, D, rb * 32, 32, kb * 256, nullptr, BM_, D, rb * 32, kb * 256, c.scr, c.lane);
            else if (kb == 2) conv_item4(w.ub, D, rb * 32, 32, 0, nullptr, BM_, D, rb * 32, 512, c.scr, c.lane);
            else conv_item4(w.uc, D, rb * 32, 32, 0, nullptr, BM_, D, rb * 32, 768, c.scr, c.lane);
            continue; }
        r -= I_M;
        if (r < I_O) { const int rb = r / 4, kb = r % 4; conv_item4(w.wo, D, rb * 32, 32, kb * 256, nullptr, BO, D, rb * 32, kb * 256, c.scr, c.lane); continue; }
        r -= I_O;
        if (r >= I_B) { r -= I_B; const int kv = r >> 1, rb = r & 1;
            conv_item4(kv ? w.w2v : w.w2k, 64, rb * 32, 32, 0, nullptr, W2T + (size_t)kv * 64 * 256, 256, rb * 32, 0, c.scr, c.lane); continue; }
        { const int kv = r >> 8, j = r & 255; const float* w1 = kv ? w.w1v : w.w1k; float s = 0.f;
#pragma unroll 8
          for (int i = 0; i < 32; ++i) { const int kk = c.lane + 64 * i; s += w.pos[kk] * w1[(size_t)kk * 256 + j]; }
          s = wave_sum(s);
          if (c.lane == 0) ((float*)(ws + OFF_BIASC))[kv * 256 + j] = s; }
    }
}

typedef float f32x16 __attribute__((ext_vector_type(16)));
__host__ __device__ __forceinline__ int crow(int r, int hi) { return (r & 3) + 8 * (r >> 2) + 4 * hi; }
__device__ __forceinline__ bf16x8 pack8(const f32x16& p, int s) {
    u32x4 w; w.x = pk2(p[8 * s + 0], p[8 * s + 1]); w.y = pk2(p[8 * s + 2], p[8 * s + 3]); w.z = pk2(p[8 * s + 4], p[8 * s + 5]); w.w = pk2(p[8 * s + 6], p[8 * s + 7]);
    return __builtin_bit_cast(bf16x8, w);
}
constexpr int TAB_N = 130;
__device__ __forceinline__ int tab_idx(int dist) { return min(max(dist, -1), 128) + 1; }
__device__ __forceinline__ void build_tabs(LAS float* tab, const float* rel_bias, int tid) {
    for (int i = tid; i < 12 * TAB_N; i += 512) {
        const int hh = i / TAB_N, e = i % TAB_N; float v;
        if (e == 0) v = -INFINITY;
        else if (hh < 8) v = e == 129 ? 0.f : (rel_bias[t5b(e - 1) * 12 + hh] - rel_bias[31 * 12 + hh]) * LOG2E;
        else v = e == 129 ? -INFINITY : rel_bias[t5b(e - 1) * 12 + hh] * LOG2E;
        tab[i] = v;
    }
}
__device__ __forceinline__ void qk_global(f32x16& p0, f32x16& p1, const bf16_t* K, const bf16x8 (&qf)[4], int lane) {
    const bf16_t* kp = K + (size_t)(lane & 31) * 64 + 8 * (lane >> 5);
    bf16x8 kf[8];
#pragma unroll
    for (int c = 0; c < 4; ++c) { kf[2 * c] = *(const bf16x8*)(kp + 16 * c); kf[2 * c + 1] = *(const bf16x8*)(kp + 32 * 64 + 16 * c); }
    f32x16 z;
#pragma unroll
    for (int r = 0; r < 16; ++r) z[r] = 0.f;
    p0 = z; p1 = z;
#pragma unroll
    for (int c = 0; c < 4; ++c) {
        p0 = __builtin_amdgcn_mfma_f32_32x32x16_bf16(kf[2 * c], qf[c], p0, 0, 0, 0);
        p1 = __builtin_amdgcn_mfma_f32_32x32x16_bf16(kf[2 * c + 1], qf[c], p1, 0, 0, 0);
    }
}
__device__ __forceinline__ void pv_global(f32x16 (&o)[2], const bf16_t* VT, size_t pitch, const f32x16& p0, const f32x16& p1, int lane) {
    const bf16_t* vp = VT + (size_t)(lane & 31) * pitch + 8 * (lane >> 5);
    bf16x8 vf[8];
#pragma unroll
    for (int q = 0; q < 4; ++q)
#pragma unroll
        for (int dh = 0; dh < 2; ++dh) vf[2 * q + dh] = *(const bf16x8*)(vp + (size_t)(32 * dh) * pitch + 16 * q);
#pragma unroll
    for (int q = 0; q < 4; ++q) {
        const bf16x8 pf = pack8((q >> 1) ? p1 : p0, q & 1);
#pragma unroll
        for (int dh = 0; dh < 2; ++dh) o[dh] = __builtin_amdgcn_mfma_f32_32x32x16_bf16(vf[2 * q + dh], pf, o[dh], 0, 0, 0);
    }
}
__device__ __forceinline__ void softmax_step(f32x16& p0, f32x16& p1, float& m, float& l, f32x16 (&o)[2]) {
    float mx = fmaxf(p0[0], p1[0]);
#pragma unroll
    for (int r = 1; r < 16; ++r) mx = fmaxf(mx, fmaxf(p0[r], p1[r]));
    mx = xhalf_max(mx);
    const float mn = fmaxf(m, mx);
    const float ms = (mn == -INFINITY) ? 0.f : mn;
    const float alpha = __builtin_amdgcn_exp2f(m - ms);
    float sum = 0.f;
#pragma unroll
    for (int r = 0; r < 16; ++r) { p0[r] = __builtin_amdgcn_exp2f(p0[r] - ms); p1[r] = __builtin_amdgcn_exp2f(p1[r] - ms); sum += p0[r] + p1[r]; }
    l = l * alpha + sum; m = mn;
    if (__any(alpha != 1.f)) {
#pragma unroll
        for (int r = 0; r < 16; ++r) { o[0][r] *= alpha; o[1][r] *= alpha; }
    }
}
constexpr float SM_THR = 6.f;
__device__ __forceinline__ float max3f(float a, float b, float c) { return fmaxf(fmaxf(a, b), c); }
__device__ __forceinline__ void softmax_rel(f32x16& p0, f32x16& p1, float& mref, float& l, f32x16 (&o)[2], bool first) {
    float a = max3f(p0[0], p0[1], p1[0]), b = max3f(p0[2], p0[3], p1[1]);
    a = max3f(a, p1[2], p1[3]);
#pragma unroll
    for (int r = 4; r < 16; r += 4) { a = max3f(a, p0[r], p0[r + 1]); b = max3f(b, p0[r + 2], p0[r + 3]); a = max3f(a, p1[r], p1[r + 1]); b = max3f(b, p1[r + 2], p1[r + 3]); }
    const float mx = xhalf_max(fmaxf(a, b));
    if (first || __any(mx > SM_THR)) {
        const float d = first ? (mx == -INFINITY ? 0.f : mx) : fmaxf(mx, 0.f); const f32x2_t d2 = {d, d};
        mref += d;
        const float f = first ? 1.f : __builtin_amdgcn_exp2f(-d); const f32x2_t f2 = {f, f};
        l *= f;
#pragma unroll
        for (int r = 0; r < 16; r += 2) {
            f32x2_t x = {p0[r], p0[r + 1]}; x = x - d2; p0[r] = x[0]; p0[r + 1] = x[1];
            f32x2_t y = {p1[r], p1[r + 1]}; y = y - d2; p1[r] = y[0]; p1[r + 1] = y[1];
            f32x2_t u = {o[0][r], o[0][r + 1]}; u = u * f2; o[0][r] = u[0]; o[0][r + 1] = u[1];
            f32x2_t v = {o[1][r], o[1][r + 1]}; v = v * f2; o[1][r] = v[0]; o[1][r + 1] = v[1];
        }
    }
    f32x2_t s2 = {0.f, 0.f};
#pragma unroll
    for (int r = 0; r < 16; r += 2) {
        p0[r] = __builtin_amdgcn_exp2f(p0[r]); p0[r + 1] = __builtin_amdgcn_exp2f(p0[r + 1]); p1[r] = __builtin_amdgcn_exp2f(p1[r]); p1[r + 1] = __builtin_amdgcn_exp2f(p1[r + 1]);
        const f32x2_t x = {p0[r], p0[r + 1]}, y = {p1[r], p1[r + 1]}; s2 = s2 + x; s2 = s2 + y;
    }
    l += s2[0] + s2[1];
}
__device__ __forceinline__ void store_ot(bf16_t* dst, const f32x16 (&o)[2], float scale, int hi) {
#pragma unroll
    for (int dh = 0; dh < 2; ++dh)
#pragma unroll
        for (int m4 = 0; m4 < 4; ++m4) {
            uint2 w; w.x = pk2(o[dh][4 * m4] * scale, o[dh][4 * m4 + 1] * scale); w.y = pk2(o[dh][4 * m4 + 2] * scale, o[dh][4 * m4 + 3] * scale);
            *(uint2*)(dst + 32 * dh + 8 * m4 + 4 * hi) = w;
        }
}

__device__ __forceinline__ void cmp2_unit(unsigned char* ws, const float* knorm, int unit, int lane) {
    const int kv = unit >> 6, hi = lane >> 5, row = (unit & 63) * 32 + (lane & 31), n = row & 511, grp = row >> 9;
    const float* hrow = (const float*)(ws + OFF_HID) + ((size_t)kv * 2048 + row) * 256 + 8 * hi;
    const bf16_t* w2t = (const bf16_t*)(ws + OFF_W2T) + (size_t)kv * 64 * 256 + (size_t)(lane & 31) * 256 + 8 * hi;
    f32x16 o[2];
#pragma unroll
    for (int r = 0; r < 16; ++r) { o[0][r] = 0.f; o[1][r] = 0.f; }
#pragma unroll 4
    for (int c = 0; c < 16; ++c) {
        const f32x4 a = *(const f32x4*)(hrow + 16 * c), b = *(const f32x4*)(hrow + 16 * c + 4);
        u32x4 w; w.x = pk2(a[0], a[1]); w.y = pk2(a[2], a[3]); w.z = pk2(b[0], b[1]); w.w = pk2(b[2], b[3]);
        const bf16x8 hb = __builtin_bit_cast(bf16x8, w);
#pragma unroll
        for (int dh = 0; dh < 2; ++dh) { const bf16x8 wf = *(const bf16x8*)(w2t + (size_t)dh * 32 * 256 + 16 * c); o[dh] = __builtin_amdgcn_mfma_f32_32x32x16_bf16(wf, hb, o[dh], 0, 0, 0); }
    }
    const bool valid = n < NCMP;
    if (kv == 0) {
        float ss = 0.f;
#pragma unroll
        for (int r = 0; r < 16; ++r) ss += o[0][r] * o[0][r] + o[1][r] * o[1][r];
        ss = xhalf_sum(ss);
        const float rn = valid ? rsqrtf(ss * (1.f / 64.f) + EPS) : 0.f;
        bf16_t* dst = (bf16_t*)(ws + OFF_KCN) + ((size_t)grp * 512 + n) * 64;
#pragma unroll
        for (int dh = 0; dh < 2; ++dh)
#pragma unroll
            for (int m4 = 0; m4 < 4; ++m4) { const int d = 32 * dh + 8 * m4 + 4 * hi; const f32x4 kn = *(const f32x4*)(knorm + d);
                uint2 w; w.x = pk2(o[dh][4 * m4] * rn * kn[0], o[dh][4 * m4 + 1] * rn * kn[1]); w.y = pk2(o[dh][4 * m4 + 2] * rn * kn[2], o[dh][4 * m4 + 3] * rn * kn[3]);
                *(uint2*)(dst + d) = w; }
    } else {
        bf16_t* dst = (bf16_t*)(ws + OFF_VCT) + (size_t)grp * 64 * 512 + vt_pos(n);
#pragma unroll
        for (int dh = 0; dh < 2; ++dh)
#pragma unroll
            for (int r = 0; r < 16; ++r) dst[(size_t)(32 * dh + crow(r, hi)) * 512] = f2bf(valid ? o[dh][r] : 0.f);
    }
}

__device__ __forceinline__ void ldk_global(bf16x8 (&kf)[8], const bf16_t* K, int lane) {
    const bf16_t* kp = K + (size_t)(lane & 31) * 64 + 8 * (lane >> 5);
#pragma unroll
    for (int c = 0; c < 4; ++c) { kf[2 * c] = *(const bf16x8*)(kp + 16 * c); kf[2 * c + 1] = *(const bf16x8*)(kp + 32 * 64 + 16 * c); }
}
__device__ __forceinline__ void ldv_global(bf16x8 (&vf)[8], const bf16_t* VT, size_t pitch, int lane) {
    const bf16_t* vp = VT + (size_t)(lane & 31) * pitch + 8 * (lane >> 5);
#pragma unroll
    for (int q = 0; q < 4; ++q)
#pragma unroll
        for (int dh = 0; dh < 2; ++dh) vf[2 * q + dh] = *(const bf16x8*)(vp + (size_t)(32 * dh) * pitch + 16 * q);
}
__device__ __forceinline__ void mm_qk(f32x16& p0, f32x16& p1, const bf16x8 (&kf)[8], const bf16x8 (&qf)[4]) {
    f32x16 z;
#pragma unroll
    for (int r = 0; r < 16; ++r) z[r] = 0.f;
    p0 = z; p1 = z;
#pragma unroll
    for (int c = 0; c < 4; ++c) { p0 = __builtin_amdgcn_mfma_f32_32x32x16_bf16(kf[2 * c], qf[c], p0, 0, 0, 0); p1 = __builtin_amdgcn_mfma_f32_32x32x16_bf16(kf[2 * c + 1], qf[c], p1, 0, 0, 0); }
}
__device__ __forceinline__ void mm_pv(f32x16 (&o)[2], const bf16x8 (&vf)[8], const f32x16& p0, const f32x16& p1) {
#pragma unroll
    for (int q = 0; q < 4; ++q) { const bf16x8 pf = pack8((q >> 1) ? p1 : p0, q & 1);
#pragma unroll
        for (int dh = 0; dh < 2; ++dh) o[dh] = __builtin_amdgcn_mfma_f32_32x32x16_bf16(vf[2 * q + dh], pf, o[dh], 0, 0, 0); }
}
__device__ __forceinline__ void swa_unit(unsigned char* ws, const LAS float* tabW, const float* sinks, int unit, int lane, bool do_store) {
    const int t0 = (unit & 255) * 32, h = (unit >> 8) & 3, b = unit >> 10, g = h >> 1, hi = lane >> 5, t = t0 + (lane & 31);
    bf16_t* qrow = (bf16_t*)(ws + OFF_Q16) + (((size_t)b * 16 + 12 + h) * S + t) * 64;
    const bf16_t* K = (const bf16_t*)(ws + OFF_WK) + ((size_t)b * 2 + g) * S * 64; const bf16_t* VT = (const bf16_t*)(ws + OFF_WVT) + ((size_t)b * 2 + g) * 64 * S;
    bf16x8 qf[4];
#pragma unroll
    for (int c = 0; c < 4; ++c) qf[c] = *(const bf16x8*)(qrow + 16 * c + 8 * hi);
    const float sink = sinks[h] * LOG2E;
    float m = sink, l = hi == 0 ? 1.f : 0.f;
    f32x16 o[2];
#pragma unroll
    for (int r = 0; r < 16; ++r) { o[0][r] = 0.f; o[1][r] = 0.f; }
    const LAS float* tb = tabW + h * TAB_N;
    const int jlo = t0 >= 127 ? (t0 - 127) >> 6 : 0, jhi = (t0 + 31) >> 6;
    bf16x8 kf[8], vf[8];
    ldk_global(kf, K + (size_t)jlo * 4096, lane);
    for (int j = jlo; j <= jhi; ++j) {
        ldv_global(vf, VT + (size_t)j * 64, S, lane);
        f32x16 p0, p1;
        mm_qk(p0, p1, kf, qf);
        if (j < jhi) ldk_global(kf, K + (size_t)(j + 1) * 4096, lane);
#pragma unroll
        for (int r = 0; r < 16; ++r) { const int d0 = t - (j * 64 + crow(r, hi)); p0[r] += tb[tab_idx(d0)]; p1[r] += tb[tab_idx(d0 - 32)]; }
        softmax_step(p0, p1, m, l, o);
        mm_pv(o, vf, p0, p1);
    }
    l = xhalf_sum(l);
    if (do_store) store_ot(qrow, o, 1.f / l, hi);
}

constexpr float SB_CUT = 64.f;
__device__ __forceinline__ void sb_unit(unsigned char* ws, int unit, int lane, bool do_store) {
    const int t0 = (unit & 255) * 32, h = (unit >> 8) & 3, b = unit >> 10, hi = lane >> 5, t = t0 + (lane & 31);
    bf16_t* qrow = (bf16_t*)(ws + OFF_Q16) + (((size_t)b * 16 + 8 + h) * S + t) * 64;
    const bf16_t* K = (const bf16_t*)(ws + OFF_SBK) + ((size_t)b * 4 + h) * S * 64; const bf16_t* VT = (const bf16_t*)(ws + OFF_SBVT) + ((size_t)b * 4 + h) * 64 * S;
    bf16x8 qf[4];
#pragma unroll
    for (int c = 0; c < 4; ++c) qf[c] = *(const bf16x8*)(qrow + 16 * c + 8 * hi);
    f32x16 o[2];
#pragma unroll
    for (int r = 0; r < 16; ++r) { o[0][r] = 0.f; o[1][r] = 0.f; }
    float carry = 0.f;
    bf16x8 kf[8], vf[8];
    const int jd = (t0 + 31) >> 6;
    ldk_global(kf, K + (size_t)jd * 4096, lane);
    for (int j = jd; j >= 0; --j) {
        f32x16 z0, z1, f0, f1;
        mm_qk(z0, z1, kf, qf);
        if (j > 0) ldk_global(kf, K + (size_t)(j - 1) * 4096, lane);
        float gs[8];
#pragma unroll
        for (int u = 0; u < 8; ++u) gs[u] = 0.f;
        const int kb = j * 64;
#pragma unroll
        for (int r = 0; r < 16; ++r) {
            { const float z = z0[r]; const bool ok = kb + crow(r, hi) < t; const float sp = fmaxf(z, 0.f) + __builtin_amdgcn_logf(1.f + __builtin_amdgcn_exp2f(-fabsf(z))); f0[r] = ok ? -sp : 0.f; gs[r >> 2] += f0[r]; }
            { const float z = z1[r]; const bool ok = kb + 32 + crow(r, hi) < t; const float sp = fmaxf(z, 0.f) + __builtin_amdgcn_logf(1.f + __builtin_amdgcn_exp2f(-fabsf(z))); f1[r] = ok ? -sp : 0.f; gs[4 + (r >> 2)] += f1[r]; }
        }
        ldv_global(vf, VT + (size_t)j * 64, S, lane);
        float T = 0.f, A[8];
#pragma unroll
        for (int u = 7; u >= 0; --u) { const float pg = xhalf_other(gs[u], hi); A[u] = T + (hi == 0 ? pg : 0.f); T += gs[u] + pg; }
#pragma unroll
        for (int u = 0; u < 8; ++u) {
            float run = carry + A[u];
#pragma unroll
            for (int i = 3; i >= 0; --i) {
                const int r = 4 * (u & 3) + i;
                if (u < 4) { const bool ok = kb + crow(r, hi) < t; const float lf = f0[r]; z0[r] = ok ? __builtin_amdgcn_exp2f(z0[r] + lf + run) : 0.f; run += lf; }
                else { const bool ok = kb + 32 + crow(r, hi) < t; const float lf = f1[r]; z1[r] = ok ? __builtin_amdgcn_exp2f(z1[r] + lf + run) : 0.f; run += lf; }
            }
        }
        carry += T;
        mm_pv(o, vf, z0, z1);
        if (__all(carry < -SB_CUT)) break;
    }
    if (do_store) store_ot(qrow, o, 1.f, hi);
}


constexpr int NSA_STAGE = 16384, NSA_IMPG = 32768, NSA_IMPL = 65536, NSA_SEL = 98304;
struct TileSrc { const bf16_t* K; const bf16_t* VT; size_t vpitch; };
__device__ __forceinline__ void nsa_issue(LAS unsigned char* stage, const TileSrc& ts, int j, int tid, int wave) {
    const int row = tid >> 3, chunk = (tid & 7) ^ ((row >> 1) & 7);
    __builtin_amdgcn_global_load_lds((const unsigned*)(ts.K + ((size_t)j * 64 + row) * 64 + chunk * 8), (LAS unsigned*)(stage + wave * 1024), 16, 0, 0);
    __builtin_amdgcn_global_load_lds((const unsigned*)(ts.VT + (size_t)row * ts.vpitch + (size_t)j * 64 + chunk * 8), (LAS unsigned*)(stage + 8192 + wave * 1024), 16, 0, 0);
}
__device__ __forceinline__ void qk_lds(f32x16& p0, f32x16& p1, const LAS unsigned char* Kst, const bf16x8 (&qf)[4], float cinit, int lrow, int swz, int hi) {
    bf16x8 kf[8];
#pragma unroll
    for (int c = 0; c < 4; ++c) { const int off = lrow + (((2 * c + hi) ^ swz) << 4); kf[2 * c] = *(const LAS bf16x8*)(Kst + off); kf[2 * c + 1] = *(const LAS bf16x8*)(Kst + 4096 + off); }
    f32x16 z;
#pragma unroll
    for (int r = 0; r < 16; ++r) z[r] = cinit;
    p0 = z; p1 = z;
    __builtin_amdgcn_sched_barrier(0);
#pragma unroll
    for (int c = 0; c < 4; ++c) {
        p0 = __builtin_amdgcn_mfma_f32_32x32x16_bf16(kf[2 * c], qf[c], p0, 0, 0, 0);
        p1 = __builtin_amdgcn_mfma_f32_32x32x16_bf16(kf[2 * c + 1], qf[c], p1, 0, 0, 0);
    }
}
__device__ __forceinline__ void pv_lds(f32x16 (&o)[2], const LAS unsigned char* Vst, const f32x16& p0, const f32x16& p1, int lrow, int swz, int hi) {
    bf16x8 vf[8];
#pragma unroll
    for (int kh = 0; kh < 2; ++kh)
#pragma unroll
        for (int s = 0; s < 2; ++s) { const int off = lrow + (((4 * kh + 2 * s + hi) ^ swz) << 4);
#pragma unroll
            for (int dh = 0; dh < 2; ++dh) vf[4 * kh + 2 * s + dh] = *(const LAS bf16x8*)(Vst + dh * 4096 + off); }
    bf16x8 pf[4];
#pragma unroll
    for (int kh = 0; kh < 2; ++kh)
#pragma unroll
        for (int s = 0; s < 2; ++s) pf[2 * kh + s] = pack8(kh ? p1 : p0, s);
    __builtin_amdgcn_sched_barrier(0);
#pragma unroll
    for (int q = 0; q < 4; ++q)
#pragma unroll
        for (int dh = 0; dh < 2; ++dh) o[dh] = __builtin_amdgcn_mfma_f32_32x32x16_bf16(vf[2 * q + dh], pf[q], o[dh], 0, 0, 0);
}
__device__ __forceinline__ float quad_sum(float v) {
    v += __int_as_float(__builtin_amdgcn_mov_dpp(__float_as_int(v), 0xB1, 0xf, 0xf, true));
    v += __int_as_float(__builtin_amdgcn_mov_dpp(__float_as_int(v), 0x4E, 0xf, 0xf, true));
    return v;
}
#define NSA_WAITBAR() do { asm volatile("s_waitcnt vmcnt(0) lgkmcnt(0)" ::: "memory"); __builtin_amdgcn_s_barrier(); asm volatile("" ::: "memory"); } while (0)

__device__ __forceinline__ void nsa_unit(LAS unsigned char* lds, const LAS float* tabN, unsigned char* ws, int b, int g, int qt, int tid_in, bool do_store) {
    int tid = tid_in; asm volatile("" : "+v"(tid));
    const int lane = tid & 63, wave = __builtin_amdgcn_readfirstlane(tid >> 6), hi = lane >> 5, col = lane & 31, qi = col >> 2, r = col & 3;
    const int t0 = qt * 64, qloc = 8 * wave + qi, t = t0 + qloc, h = 4 * g + r, grp = b * 2 + g;
    const int lrow = col * 128, swz = (col >> 1) & 7;
    bf16_t* qrow = (bf16_t*)(ws + OFF_Q16) + (((size_t)b * 16 + h) * S + t) * 64;
    bf16x8 qf[4];
#pragma unroll
    for (int c = 0; c < 4; ++c) qf[c] = *(const bf16x8*)(qrow + 16 * c + 8 * hi);
    const LAS float* tb = tabN + h * TAB_N;
    LAS float* impG = (LAS float*)(lds + NSA_IMPG); LAS float* impL = (LAS float*)(lds + NSA_IMPL); LAS unsigned* selm = (LAS unsigned*)(lds + NSA_SEL);
    const float* NG = (const float*)(ws + OFF_NGATE) + (size_t)(b * S + t) * 24;
    f32x16 out[2];
#pragma unroll
    for (int rr = 0; rr < 16; ++rr) { out[0][rr] = 0.f; out[1][rr] = 0.f; }

    {
        TileSrc ts; ts.K = (const bf16_t*)(ws + OFF_KCN) + (size_t)grp * 512 * 64; ts.VT = (const bf16_t*)(ws + OFF_VCT) + (size_t)grp * 64 * 512; ts.vpitch = 512;
        const int nmax = min((t0 + 32) >> 4, 510), nct = (nmax >> 6) + 1;
        float m = -INFINITY, l = 0.f;
        if (tid < 64) impL[tid * 128] = 0.f;
        NSA_WAITBAR();
        nsa_issue(lds, ts, 0, tid, wave);
        for (int i = 0; i < nct; ++i) {
            NSA_WAITBAR();
            if (i + 1 < nct) nsa_issue(lds + ((i + 1) & 1) * NSA_STAGE, ts, i + 1, tid, wave);
            const LAS unsigned char* st = lds + (i & 1) * NSA_STAGE;
            f32x16 p0, p1;
            qk_lds(p0, p1, st, qf, 0.f, lrow, swz, hi);
            float mx = -INFINITY;
#pragma unroll
            for (int rr = 0; rr < 16; ++rr) { const int dc = t - 16 * (i * 64 + crow(rr, hi)) - 31; p0[rr] += tb[tab_idx(dc)]; p1[rr] += tb[tab_idx(dc - 512)]; mx = fmaxf(mx, fmaxf(p0[rr], p1[rr])); }
            mx = xhalf_max(mx);
            const float mn = fmaxf(m, mx), ms = (mn == -INFINITY) ? 0.f : mn;
            float sum = 0.f;
#pragma unroll
            for (int rr = 0; rr < 16; ++rr) sum += __builtin_amdgcn_exp2f(p0[rr] - ms) + __builtin_amdgcn_exp2f(p1[rr] - ms);
            l = l * __builtin_amdgcn_exp2f(m - ms) + sum; m = mn;
        }
        l = xhalf_sum(l);
        const float ms = (m == -INFINITY) ? 0.f : m, il = l > 0.f ? 1.f / l : 0.f;
        f32x16 o[2];
#pragma unroll
        for (int rr = 0; rr < 16; ++rr) { o[0][rr] = 0.f; o[1][rr] = 0.f; }
        NSA_WAITBAR();
        nsa_issue(lds, ts, 0, tid, wave);
        for (int i = 0; i < nct; ++i) {
            NSA_WAITBAR();
            if (i + 1 < nct) nsa_issue(lds + ((i + 1) & 1) * NSA_STAGE, ts, i + 1, tid, wave);
            const LAS unsigned char* st = lds + (i & 1) * NSA_STAGE;
            f32x16 p0, p1;
            qk_lds(p0, p1, st, qf, 0.f, lrow, swz, hi);
#pragma unroll
            for (int rr = 0; rr < 16; ++rr) { const int dc = t - 16 * (i * 64 + crow(rr, hi)) - 31;
                p0[rr] = __builtin_amdgcn_exp2f(p0[rr] + tb[tab_idx(dc)] - ms) * il; p1[rr] = __builtin_amdgcn_exp2f(p1[rr] + tb[tab_idx(dc - 512)] - ms) * il; }
#pragma unroll
            for (int u = 0; u < 8; ++u) {
                const f32x16& pp = u < 4 ? p0 : p1; const int r0 = 4 * (u & 3);
                const float G = quad_sum((pp[r0] + pp[r0 + 1]) + (pp[r0 + 2] + pp[r0 + 3])), L = quad_sum(pp[r0 + 3]);
                const int j = 16 * i + 8 * (u >> 2) + 2 * (u & 3) + hi;
                if (r == 0) { impG[qloc * 128 + j] = G; if (j + 1 < 128) impL[qloc * 128 + j + 1] = L; }
            }
            pv_lds(o, st + 8192, p0, p1, lrow, swz, hi);
        }
        const float gc = NG[h];
#pragma unroll
        for (int rr = 0; rr < 16; ++rr) { out[0][rr] += gc * o[0][rr]; out[1][rr] += gc * o[1][rr]; }
    }
    NSA_WAITBAR();
    {
        int tid2 = tid_in; asm volatile("" : "+v"(tid2));
        const int q = tid2 >> 3, sub = tid2 & 7;
        unsigned mw[4] = {0u, 0u, 0u, 0u};
        if (qt <= 15) { if (sub == 0) mw[0] = (qt == 31) ? 0xffffffffu : ((2u << qt) - 1u); }
        else {
            unsigned vb[16];
#pragma unroll
            for (int i = 0; i < 16; ++i) { const int j = sub + 8 * i; const bool cand = j >= 1 && j <= qt - 2; vb[i] = cand ? __float_as_uint(impG[q * 128 + j] + impL[q * 128 + j]) + 1u : 0u; }
            unsigned T = 0u;
#pragma unroll 1
            for (int bit = 30; bit >= 0; --bit) {
                const unsigned trial = T | (1u << bit); unsigned c = 0u;
#pragma unroll
                for (int i = 0; i < 16; ++i) c += vb[i] >= trial ? 1u : 0u;
                c += swz_xor_u<1>(c); c += swz_xor_u<2>(c); c += swz_xor_u<4>(c);
                if (c >= 13u) T = trial;
            }
            unsigned cge = 0u;
#pragma unroll
            for (int i = 0; i < 16; ++i) cge += vb[i] >= T ? 1u : 0u;
            cge += swz_xor_u<1>(cge); cge += swz_xor_u<2>(cge); cge += swz_xor_u<4>(cge);
            if (cge == 13u) {
#pragma unroll
                for (int i = 0; i < 16; ++i) { const int j = sub + 8 * i; if (vb[i] >= T && vb[i] != 0u) mw[j >> 5] |= 1u << (j & 31); }
            } else {
                for (int i = 0; i < 16; ++i) { const int j = sub + 8 * i; if (vb[i] == 0u) continue; int rk = 0;
                    for (int kk = 1; kk <= qt - 2; ++kk) { const unsigned vk = __float_as_uint(impG[q * 128 + kk] + impL[q * 128 + kk]) + 1u; rk += (vk > vb[i]) || (vk == vb[i] && kk < j); }
                    if (rk < 13) mw[j >> 5] |= 1u << (j & 31); }
            }
            if (sub == 0) mw[0] |= 1u;
#pragma unroll
            for (int i = 0; i < 16; ++i) { const int j = sub + 8 * i; if (j == qt || j == qt - 1) mw[j >> 5] |= 1u << (j & 31); }
        }
#pragma unroll
        for (int wd = 0; wd < 4; ++wd) { unsigned x = mw[wd]; x |= swz_xor_u<1>(x); x |= swz_xor_u<2>(x); x |= swz_xor_u<4>(x); if (sub == 0) selm[q * 4 + wd] = x; }
    }
    NSA_WAITBAR();
    unsigned sm0 = selm[qloc * 4 + 0], sm1 = selm[qloc * 4 + 1], sm2 = selm[qloc * 4 + 2], sm3 = selm[qloc * 4 + 3];
    {
        TileSrc ts; ts.K = (const bf16_t*)(ws + OFF_KSLC) + (size_t)grp * S * 64; ts.VT = (const bf16_t*)(ws + OFF_VSLCT) + (size_t)grp * 64 * S; ts.vpitch = S;
        float m = 0.f, l = 0.f;
        f32x16 o[2];
#pragma unroll
        for (int rr = 0; rr < 16; ++rr) { o[0][rr] = 0.f; o[1][rr] = 0.f; }
        nsa_issue(lds, ts, 0, tid, wave);
        for (int j = 0; j <= qt; ++j) {
            NSA_WAITBAR();
            if (j + 1 <= qt) nsa_issue(lds + ((j + 1) & 1) * NSA_STAGE, ts, j + 1, tid, wave);
            const LAS unsigned char* st = lds + (j & 1) * NSA_STAGE;
            const unsigned mword = j < 32 ? sm0 : j < 64 ? sm1 : j < 96 ? sm2 : sm3;
            const bool selb = (mword >> (j & 31)) & 1u;
            if (!__any(selb)) continue;
            const float cinit = selb ? -m : -INFINITY;
            f32x16 p0, p1;
            qk_lds(p0, p1, st, qf, cinit, lrow, swz, hi);
            if (j >= qt - 2) {
#pragma unroll
                for (int rr = 0; rr < 16; ++rr) { const int d0 = t - (j * 64 + crow(rr, hi)); p0[rr] += tb[tab_idx(d0)]; p1[rr] += tb[tab_idx(d0 - 32)]; }
            }
            softmax_rel(p0, p1, m, l, o, j == 0);
            pv_lds(o, st + 8192, p0, p1, lrow, swz, hi);
        }
        l = xhalf_sum(l);
        const float gs = NG[8 + h] / l;
#pragma unroll
        for (int rr = 0; rr < 16; ++rr) { out[0][rr] += gs * o[0][rr]; out[1][rr] += gs * o[1][rr]; }
    }
    {
        TileSrc ts; ts.K = (const bf16_t*)(ws + OFF_KWIN) + (size_t)grp * S * 64; ts.VT = (const bf16_t*)(ws + OFF_VWINT) + (size_t)grp * 64 * S; ts.vpitch = S;
        float m = 0.f, l = 0.f;
        f32x16 o[2];
#pragma unroll
        for (int rr = 0; rr < 16; ++rr) { o[0][rr] = 0.f; o[1][rr] = 0.f; }
        const int j0 = qt >= 8 ? qt - 8 : 0, nt = qt - j0 + 1;
        NSA_WAITBAR();
        nsa_issue(lds, ts, j0, tid, wave);
        for (int i = 0; i < nt; ++i) {
            const int j = j0 + i;
            NSA_WAITBAR();
            if (i + 1 < nt) nsa_issue(lds + ((i + 1) & 1) * NSA_STAGE, ts, j + 1, tid, wave);
            const LAS unsigned char* st = lds + (i & 1) * NSA_STAGE;
            f32x16 p0, p1;
            qk_lds(p0, p1, st, qf, -m, lrow, swz, hi);
            if (j >= qt - 2) {
#pragma unroll
                for (int rr = 0; rr < 16; ++rr) { const int d0 = t - (j * 64 + crow(rr, hi)); p0[rr] += tb[tab_idx(d0)]; p1[rr] += tb[tab_idx(d0 - 32)]; }
            } else if (j == qt - 8) {
#pragma unroll
                for (int rr = 0; rr < 16; ++rr) { const int d0 = t - (j * 64 + crow(rr, hi)); if (d0 >= 512) p0[rr] = -INFINITY; if (d0 - 32 >= 512) p1[rr] = -INFINITY; }
            }
            softmax_rel(p0, p1, m, l, o, i == 0);
            pv_lds(o, st + 8192, p0, p1, lrow, swz, hi);
        }
        l = xhalf_sum(l);
        const float gw = NG[16 + h] / l;
#pragma unroll
        for (int rr = 0; rr < 16; ++rr) { out[0][rr] += gw * o[0][rr]; out[1][rr] += gw * o[1][rr]; }
    }
    if (do_store) store_ot(qrow, out, 1.f, hi);
    NSA_WAITBAR();
}


#define XB_TMO      128
#define XB_XCNT(j)  (256  + 64 * (j))
#define XB_XSUB(j)  (1280 + 64 * (j))
#define XB_XGEN(j)  (2304 + 64 * (j))
#define XB_TOP      3328
#define XB_TOPGEN   3392
#define XCD_BAR_WORDS 3456
#define XB_SPIN_CAP (1u << 18)
constexpr size_t CTL_ZERO_BYTES = 65536, CTL_BAR_OFF = 16384;
constexpr int LDS_XB_OFF = 131072 + 8192;
__device__ __forceinline__ unsigned xb_ld(unsigned* p)              { return __hip_atomic_load(p, __ATOMIC_RELAXED, __HIP_MEMORY_SCOPE_AGENT); }
__device__ __forceinline__ unsigned xb_add(unsigned* p, unsigned v) { return __hip_atomic_fetch_add(p, v, __ATOMIC_RELAXED, __HIP_MEMORY_SCOPE_AGENT); }
__device__ __forceinline__ unsigned xb_xcc_id() { return (unsigned)__builtin_amdgcn_s_getreg((3 << 11) | 20) & 0xFu; }
#define XB_SPIN(cond, bar) do { unsigned _sp = 0; while (cond) { __builtin_amdgcn_s_sleep(1); \
    if ((++_sp & 255u) == 0u) { if (xb_ld(&(bar)[XB_TMO])) break; if (_sp > XB_SPIN_CAP) { atomicAdd(&(bar)[XB_TMO], 1u); break; } } } } while (0)
__device__ __forceinline__ void xcd_barrier_complete(unsigned* bar, unsigned x, unsigned G, unsigned& nloc, unsigned& nx) {
    unsigned sum, cnt, mine, sp = 0u;
    for (;;) {
        sum = 0u; cnt = 0u; mine = 0u;
#pragma unroll
        for (unsigned j = 0; j < 16; ++j) { const unsigned c = xb_ld(&bar[XB_XCNT(j)]); sum += c; cnt += (c > 0u) ? 1u : 0u; mine = (j == x) ? c : mine; }
        if (sum == G) break;
        __builtin_amdgcn_s_sleep(1);
        if ((++sp & 255u) == 0u) { if (xb_ld(&bar[XB_TMO])) break; if (sp > XB_SPIN_CAP) { atomicAdd(&bar[XB_TMO], 1u); break; } }
    }
    nloc = mine > 0u ? mine : 1u; nx = cnt > 0u ? cnt : 1u;
}
__device__ __forceinline__ void xcd_barrier(unsigned* bar, volatile LAS unsigned* st, unsigned G, bool leader) {
    asm volatile("s_waitcnt vmcnt(0)" ::: "memory");
    __syncthreads();
    if (leader) {
        const unsigned x = xb_xcc_id();
        __builtin_amdgcn_s_waitcnt(0);
        unsigned nloc = st[0], nx = st[1];
        if (nloc == 0u) { xcd_barrier_complete(bar, x, G, nloc, nx); st[0] = nloc; st[1] = nx; }
        const unsigned old = xb_add(&bar[XB_XSUB(x)], 1u);
        const unsigned gen = old / nloc;
        if (old + 1u == (gen + 1u) * nloc) {
            __builtin_amdgcn_fence(__ATOMIC_RELEASE, "agent");
            asm volatile("s_waitcnt vmcnt(0)" ::: "memory");
            const unsigned og = xb_add(&bar[XB_TOP], 1u);
            const unsigned tg = og / nx;
            if (og + 1u == (tg + 1u) * nx) xb_add(&bar[XB_TOPGEN], 1u);
            else XB_SPIN(xb_ld(&bar[XB_TOPGEN]) == tg, bar);
            __builtin_amdgcn_fence(__ATOMIC_ACQUIRE, "agent");
            xb_add(&bar[XB_XGEN(x)], 1u);
            asm volatile("s_waitcnt vmcnt(0)" ::: "memory");
        } else {
            XB_SPIN(xb_ld(&bar[XB_XGEN(x)]) == gen, bar);
            __builtin_amdgcn_fence(__ATOMIC_ACQUIRE, "agent");
            asm volatile("s_waitcnt vmcnt(0)" ::: "memory");
        }
    }
    __syncthreads();
}

struct Params { const float* in[26]; float* out; unsigned char* ws; };
constexpr int LDS_BYTES = 147456;
__device__ __forceinline__ const float* inptr(const Params& p, int i) { asm volatile("" : "+s"(i)); return p.in[i]; }
#define PH_BEGIN(lexpr) int lq = (lexpr); asm volatile("" : "+s"(lq)); unsigned char* ws = p.ws; asm volatile("" : "+s"(ws)); float* X = p.out; asm volatile("" : "+s"(X)); \
    bf16_t* XB = (bf16_t*)(ws + OFF_XB); float* SSQ = (float*)(ws + OFF_SSQ); (void)XB; (void)SSQ; (void)X; (void)lq
#define IN(i) inptr(p, i)
#define CCX() ConvCtx{ldsr, nullptr, 0, (int)gridDim.x * 8, MYTID()}
#define CCS(b0) ConvCtx{ldsr, nullptr, (b0), ((int)gridDim.x - (b0)) * 8, MYTID()}
#define CCS(b0) ConvCtx{ldsr, nullptr, (b0), ((int)gridDim.x - (b0)) * 8, MYTID()}
#define FFN_SRC(l, base) IN(base) + (size_t)(l) * D, IN((base) + 1) + (size_t)(l) * D * F, IN((base) + 2) + (size_t)(l) * D * F, IN((base) + 3) + (size_t)(l) * F * D
__device__ __forceinline__ MixW mixw_of(const Params& p, int l) { MixW w; w.mixn = IN(6) + (size_t)l * D; w.win = IN(7) + (size_t)l * D * DIN; w.w1k = IN(11) + (size_t)l * 2048 * 256; w.w1v = IN(13) + (size_t)l * 2048 * 256;
    w.ua = IN(18) + (size_t)l * 512 * D; w.ub = IN(19) + (size_t)l * 256 * D; w.uc = IN(20) + (size_t)l * 256 * D; w.wo = IN(21) + (size_t)l * D * D; w.pos = IN(10) + (size_t)l * 2048; w.w2k = IN(12) + (size_t)l * 256 * 64; w.w2v = IN(14) + (size_t)l * 256 * 64; return w; }

__global__ void __launch_bounds__(512) mega_fwd(Params p) {
    extern __shared__ __attribute__((aligned(16))) char lds_base[];
    cg::grid_group grid = cg::this_grid();
    LAS unsigned char* ldsr = (LAS unsigned char*)lds_base;
    const int wave_s = __builtin_amdgcn_readfirstlane(threadIdx.x >> 6);
    const int G_ = gridDim.x, bid = blockIdx.x;
    unsigned long long ts_t0 = 0, ts_acc = 0; (void)ts_t0; int ts_inst = 0; (void)ts_inst;
    if (threadIdx.x == 0) { volatile LAS unsigned* st_ = (volatile LAS unsigned*)(ldsr + LDS_XB_OFF); st_[0] = 0u; st_[1] = 0u;
        (void)xb_add((unsigned*)(p.ws + OFF_CTL + CTL_BAR_OFF) + XB_XCNT(xb_xcc_id()), 1u); }
    __syncthreads();
#define GSYNC_CG() do { TS_B(27); grid.sync(); TS_E(27); } while (0)
#define GSYNC(id) do { if (PROBE == 40) { unsigned char* wsb2_ = p.ws; asm volatile("" : "+s"(wsb2_)); xcd_barrier((unsigned*)(wsb2_ + OFF_CTL + CTL_BAR_OFF), (volatile LAS unsigned*)(ldsr + LDS_XB_OFF), (unsigned)G_, MYTID() == 0); } TS_B(27); TS_B(100 + (id)); { unsigned char* wsb_ = p.ws; asm volatile("" : "+s"(wsb_)); xcd_barrier((unsigned*)(wsb_ + OFF_CTL + CTL_BAR_OFF), (volatile LAS unsigned*)(ldsr + LDS_XB_OFF), (unsigned)G_, MYTID() == 0); } TS_E(27); TS_E(100 + (id)); } while (0)
    REP(9) {
        PH_BEGIN(0);
        TS_B(21); conv_ffn(CCX(), FFN_SRC(lq, 2), ws + OFF_FFN1W); __syncthreads(); TS_E(21);
        TS_B(23); ph_prep(MYTID(), IN(0), XB, SSQ); __syncthreads(); TS_E(23);
        GSYNC_CG();
    }
#pragma unroll 1
    for (int l = 0; l < 2; ++l) {
#pragma unroll 1
        for (int f = 0; f < 2; ++f) {
            ts_inst = l * 2 + f;
            if (f == 1) {
                REP(3) {
                    PH_BEGIN(l);
                    pg8::Ops g; g.A = (const char*)XB; g.Bt = (const char*)(ws + OFF_BT_IN); g.lda_b = D * 2; g.ldb_b = D * 2; g.a_kstep = 128; g.nt = D / 64; g.a_mode = 0;
                    pg8::StaticOrder so; so.init(M, 5888, G_, bid);
                    pg8::EpiWin E{ws, SSQ, IN(8) + lq * 64, IN(9) + lq * 64, IN(15) + lq * 64, IN(16) + lq * 64};
                    TS_B(25); pg8::gemm_phase(ldsr, MYTID(), g, so, E); TS_E(25);
                    GSYNC(2);
                }
                {
                    PH_BEGIN(l);
                    if (bid < 16) {
                        pg8::Ops g; g.A = (const char*)(ws + OFF_KCMP); g.Bt = (const char*)(ws + OFF_BT_C1); g.lda_b = 2048; g.ldb_b = 4096; g.a_kstep = 128; g.nt = 32; g.a_mode = 2;
                        pg8::StaticOrder so; so.init(2048, 512, G_, bid);
                        pg8::EpiCmp1 E{(float*)(ws + OFF_HID), (const float*)(ws + OFF_BIASC)};
                        TS_B(29); pg8::gemm_phase(ldsr, MYTID(), g, so, E); TS_E(29);
                    } else {
                        LAS float* tabs = (LAS float*)(ldsr + 131072);
                        build_tabs(tabs, IN(1), MYTID());
                        __syncthreads();
                        int t_ = MYTID(); asm volatile("" : "+v"(t_));
                        const int lane_ = t_ & 63, gw_ = (bid - 16) * 8 + __builtin_amdgcn_readfirstlane(t_ >> 6), ngw_ = (G_ - 16) * 8;
                        REP(6) {
                            for (int u = gw_; u < 2048; u += ngw_) sb_unit(ws, u, lane_, LASTREP(6));
                            for (int u = gw_; u < 2048; u += ngw_) swa_unit(ws, tabs + 8 * TAB_N, IN(17) + lq * 4, u, lane_, LASTREP(6));
                        }
                    }
                }
                GSYNC(3);
                {
                    PH_BEGIN(l);
                    int t_ = MYTID(); asm volatile("" : "+v"(t_));
                    const int lane_ = t_ & 63, gw_ = bid * 8 + __builtin_amdgcn_readfirstlane(t_ >> 6);
                    TS_B(30);
                    for (int u = gw_; u < 128; u += G_ * 8) cmp2_unit(ws, IN(9) + lq * 64, u, lane_);
                    TS_E(30);
                }
                GSYNC(4);
                {
                    PH_BEGIN(l);
                    LAS float* tabs = (LAS float*)(ldsr + 131072);
                    build_tabs(tabs, IN(1), MYTID());
                    __syncthreads();
                    int t_ = MYTID(); asm volatile("" : "+v"(t_));
                    TS_B(32);
                    REP(5) {
                        for (int ps = bid; ps < 256; ps += G_) {
                            const int bg = (ps & 7) >> 1, i = (ps & 1) * 32 + (ps >> 3);
#pragma unroll 1
                            for (int k2 = 0; k2 < 2; ++k2) nsa_unit(ldsr, tabs, ws, bg >> 1, bg & 1, k2 ? 127 - i : i, t_, LASTREP(5));
                        }
                    }
                    TS_E(32);
                }
                GSYNC(5);
                REP(7) {
                    PH_BEGIN(l);
                    if (lq == 0) { TS_B(21); conv_ffn(CCX(), FFN_SRC(0, 22), ws + OFF_FFN2W); __syncthreads(); TS_E(21); }
                    bf16_t* GATES = (bf16_t*)(ws + OFF_A);
                    pg8::Ops g; g.A = (const char*)(ws + OFF_Q16); g.Bt = (const char*)(ws + OFF_BT_M); g.lda_b = 128; g.ldb_b = D * 2; g.a_kstep = (size_t)S * 128; g.nt = 16; g.a_mode = 1;
                    pg8::StaticOrder so; so.init(M, D, G_, bid);
                    pg8::EpiMerge E{GATES, GATES + (size_t)M * D, GATES + (size_t)2 * M * D, (bf16_t*)(ws + OFF_MERGED)};
                    TS_B(28); pg8::gemm_phase(ldsr, MYTID(), g, so, E); TS_E(28);
                    GSYNC(6);
                }
                REP(8) {
                    PH_BEGIN(l);
                    if (lq == 0) { TS_B(21); conv_ffn(CCX(), FFN_SRC(1, 2), ws + OFF_FFN1W); __syncthreads(); TS_E(21); }
                    pg8::Ops g; g.A = (const char*)(ws + OFF_MERGED); g.Bt = (const char*)(ws + OFF_BT_O); g.lda_b = D * 2; g.ldb_b = D * 2; g.a_kstep = 128; g.nt = 16; g.a_mode = 0;
                    pg8::StaticOrder so; so.init(M, D, G_, bid);
                    pg8::EpiResid E{X, X, XB, SSQ, LASTREP(8) ? 1.0f : 0.f};
                    TS_B(26); pg8::gemm_phase(ldsr, MYTID(), g, so, E); TS_E(26);
                    GSYNC(7);
                }
            }
            REP(1) {
                PH_BEGIN(l);
                int fq_ = f; asm volatile("" : "+s"(fq_));
                unsigned char* wbase = ws + (fq_ == 0 ? OFF_FFN1W : OFF_FFN2W);
                {
                    const int b0 = (1408 - 5 * G_ > 0 && 1408 - 5 * G_ < G_) ? 1408 - 5 * G_ : 0;
                    if (bid >= b0) {
                        const int inst = lq * 2 + fq_;
                        TS_B(22);
                        if (inst == 0) conv_mix(CCS(b0), mixw_of(p, 0), ws);
                        else if (inst == 1) conv_mix(CCS(b0), mixw_of(p, 1), ws);
                        else if (inst == 2) conv_ffn(CCS(b0), FFN_SRC(1, 22), ws + OFF_FFN2W);
                        __syncthreads(); TS_E(22);
                    }
                }
                pg8::Ops g; g.A = (const char*)XB; g.Bt = (const char*)wbase; g.lda_b = D * 2; g.ldb_b = D * 2; g.a_kstep = 128; g.nt = 16; g.a_mode = 0;
                pg8::StaticOrder so; so.init(M, 2 * F, G_, bid);
                pg8::EpiFfnUp E{(bf16_t*)(ws + OFF_A), SSQ};
                TS_B(24); pg8::gemm_phase(ldsr, MYTID(), g, so, E); TS_E(24);
                GSYNC(8);
            }
            REP(2) {
                PH_BEGIN(l);
                int fq_ = f; asm volatile("" : "+s"(fq_));
                unsigned char* wbase = ws + (fq_ == 0 ? OFF_FFN1W : OFF_FFN2W);
                pg8::Ops g; g.A = (const char*)(ws + OFF_A); g.Bt = (const char*)(wbase + FFNW_D); g.lda_b = F * 2; g.ldb_b = F * 2; g.a_kstep = 128; g.nt = F / 64; g.a_mode = 0;
                pg8::StaticOrder so; so.init(M, D, G_, bid);
                pg8::EpiResid E{(lq == 0 && fq_ == 0) ? IN(0) : (const float*)X, X, XB, SSQ, LASTREP(2) ? 0.5f : 0.f};
                TS_B(31); pg8::gemm_phase(ldsr, MYTID(), g, so, E); TS_E(31);
                if (!(l == 1 && f == 1)) GSYNC(9);
            }
        }
    }
#ifdef TSPMAX
    if (TSP != 0) {
        unsigned* mx_ = (unsigned*)(p.ws + OFF_CTL) + 8192;
        if (MYTID() == 0) atomicMax(mx_, (unsigned)ts_acc);
        xcd_barrier((unsigned*)(p.ws + OFF_CTL + CTL_BAR_OFF), (volatile LAS unsigned*)(ldsr + LDS_XB_OFF), (unsigned)G_, MYTID() == 0);
        if (bid == 0) { const unsigned long long mxv = __hip_atomic_load(mx_, __ATOMIC_RELAXED, __HIP_MEMORY_SCOPE_AGENT); const unsigned long long te = __builtin_amdgcn_s_memrealtime(); while (__builtin_amdgcn_s_memrealtime() - te < 10ull * mxv) __builtin_amdgcn_s_sleep(8); }
    }
#else
    if (TSP != 0 && bid == 0) { const unsigned long long te = __builtin_amdgcn_s_memrealtime(); while (__builtin_amdgcn_s_memrealtime() - te < 10ull * ts_acc) __builtin_amdgcn_s_sleep(8); }
#endif
}

extern "C" void kernel_launch(void* const* d_in, const int* in_sizes, int n_in, void* d_out, int out_size, void* d_ws, size_t ws_size, hipStream_t stream) {
    static int grid_blocks = 0;
    if (grid_blocks == 0) {
        if (ws_size < WS_END || n_in != 26) { fprintf(stderr, "kernel_launch: bad sizes (ws %zu)\n", ws_size); grid_blocks = -1; return; }
        int dev = 0, cus = 0, per_cu = 0;
        (void)hipGetDevice(&dev); (void)hipDeviceGetAttribute(&cus, hipDeviceAttributeMultiprocessorCount, dev);
        (void)hipFuncSetAttribute((const void*)mega_fwd, hipFuncAttributeMaxDynamicSharedMemorySize, LDS_BYTES);
        (void)hipOccupancyMaxActiveBlocksPerMultiprocessor(&per_cu, (const void*)mega_fwd, 512, LDS_BYTES);
        if (per_cu < 1) { fprintf(stderr, "kernel_launch: occupancy query says %d\n", per_cu); per_cu = 1; }
        grid_blocks = cus * (per_cu > 1 ? 1 : per_cu);
        (void)hipGetLastError();
    }
    if (grid_blocks < 0) return;
    if (hipMemsetAsync((char*)d_ws + OFF_CTL, 0, CTL_ZERO_BYTES, stream) != hipSuccess) { fprintf(stderr, "kernel_launch: memset failed\n"); return; }
    Params p{}; for (int i = 0; i < 26; ++i) p.in[i] = (const float*)d_in[i]; p.out = (float*)d_out; p.ws = (unsigned char*)d_ws;
    void* args[] = {&p};
    hipError_t e = hipLaunchCooperativeKernel((void*)mega_fwd, dim3(grid_blocks), dim3(512), args, LDS_BYTES, stream);
    if (e != hipSuccess) fprintf(stderr, "cooperative launch failed: %s (grid %d)\n", hipGetErrorString(e), grid_blocks);
}
```

```cpp
#include <hip/hip_runtime.h>
#include <hip/hip_cooperative_groups.h>
#include <stdint.h>
#include <cstdio>
namespace cg = cooperative_groups;
#ifndef PROBE
#define PROBE 0
#endif
#ifndef TSP
#define TSP 0
#endif
#ifndef TSF
#define TSF -1
#endif
#define TS_B(k) if (TSP == (k) && (TSF < 0 || TSF == ts_inst)) { ts_t0 = __builtin_amdgcn_s_memrealtime(); }
#define TS_E(k) if (TSP == (k) && (TSF < 0 || TSF == ts_inst)) { ts_acc += __builtin_amdgcn_s_memrealtime() - ts_t0; }
#define REP(k) for (int rep_ = 0; rep_ < (PROBE == (k) ? 2 : 1); ++rep_)
#define LASTREP(k) (rep_ == (PROBE == (k) ? 1 : 0))
__device__ __forceinline__ int lane_id() { int r; asm volatile("v_mbcnt_lo_u32_b32 %0, -1, 0\n\tv_mbcnt_hi_u32_b32 %0, -1, %0" : "=v"(r)); return r; }
#define MYTID() (wave_s * 64 + lane_id())
#define VB_SETUP int tidx_ = tid_in; asm volatile("" : "+v"(tidx_)); const int tid = tidx_ & 255, vhalf = tidx_ >> 8; const int vb0 = blockIdx.x * 2 + vhalf, nvb = gridDim.x * 2; char* lds = lds_base + vhalf * 32768; (void)tid; (void)lds; (void)vb0; (void)nvb
#define LAS __attribute__((address_space(3)))

typedef unsigned short bf16_t;
typedef short bf16x8 __attribute__((ext_vector_type(8)));
typedef float f32x4 __attribute__((ext_vector_type(4)));
typedef unsigned u32x4 __attribute__((ext_vector_type(4)));
__device__ __forceinline__ float bf2f(bf16_t v) { return __uint_as_float(((unsigned)v) << 16); }
__device__ __forceinline__ bf16_t f2bf(float f) { unsigned u = __float_as_uint(f); return (bf16_t)((u + 0x7fffu + ((u >> 16) & 1u)) >> 16); }
typedef float f32x2_t __attribute__((ext_vector_type(2))); typedef __bf16 bf16x2_t __attribute__((ext_vector_type(2)));
__device__ __forceinline__ unsigned pk2(float lo, float hi) { f32x2_t v = {lo, hi}; bf16x2_t b = __builtin_convertvector(v, bf16x2_t); return __builtin_bit_cast(unsigned, b); }

__host__ __device__ __forceinline__ int vperm16(int k) { return 8 * ((k >> 2) & 1) + 4 * (k >> 3) + (k & 3); }
__device__ __forceinline__ size_t vt_pos(int s) { return (size_t)((s & ~15) + vperm16(s & 15)); }
constexpr int NB = 2, S = 8192, M = NB * S, D = 1024, F = 2816, HD = 64, DIN = 5656;
constexpr int NCMP = 511, NSLC = 128;
constexpr float LOG2E = 1.4426950408889634f;
constexpr float C2 = 0.125f * LOG2E;
constexpr float EPS = 1e-6f;

constexpr size_t MiB = 1u << 20;
constexpr size_t OFF_CTL = 0;
constexpr size_t OFF_SSQ = 1 * MiB;
constexpr size_t OFF_XB = 2 * MiB;
constexpr size_t OFF_A = 34 * MiB;
constexpr size_t OFF_MIXW = 130 * MiB;
constexpr size_t OFF_BT_IN = OFF_MIXW, OFF_BT_C1 = OFF_MIXW + 12 * MiB, OFF_BT_M = OFF_MIXW + 14 * MiB, OFF_BT_O = OFF_MIXW + 16 * MiB;
constexpr size_t OFF_W2T = OFF_MIXW + 11 * MiB + 768 * 1024;
constexpr size_t OFF_Q16 = 148 * MiB;
constexpr size_t OFF_KV = 180 * MiB;
constexpr size_t KV2 = 4 * MiB, KV4 = 8 * MiB;
constexpr size_t OFF_KCMP = OFF_KV, OFF_VCMP = OFF_KCMP + KV2, OFF_KSLC = OFF_VCMP + KV2, OFF_VSLCT = OFF_KSLC + KV2,
                 OFF_KWIN = OFF_VSLCT + KV2, OFF_VWINT = OFF_KWIN + KV2, OFF_WK = OFF_VWINT + KV2, OFF_WVT = OFF_WK + KV2,
                 OFF_SBK = OFF_WVT + KV2, OFF_SBVT = OFF_SBK + KV4;
constexpr size_t OFF_MERGED = OFF_KV;
constexpr size_t OFF_FFN1W = OFF_Q16, OFF_FFN2W = 237 * MiB;
constexpr size_t FFNW_D = 11 * MiB;
constexpr size_t OFF_SMALL = 229 * MiB;
constexpr size_t OFF_NGATE = OFF_SMALL;
constexpr size_t OFF_KCN = OFF_NGATE + 2 * MiB;
constexpr size_t OFF_VCT = OFF_KCN + MiB / 4;
constexpr size_t OFF_HID = OFF_VCT + MiB / 4;
constexpr size_t OFF_BIASC = OFF_HID + 4 * MiB;
constexpr size_t WS_END = OFF_FFN2W + 17 * MiB;
static_assert(OFF_SBVT + KV4 <= OFF_SMALL && OFF_BIASC + MiB <= OFF_FFN2W, "ws map");

__device__ const unsigned char T5B[128] = {
    0, 1, 2, 3, 4, 5, 6, 7, 8, 9, 10, 11, 12, 13, 14, 15, 16, 16, 16, 17, 17, 18, 18, 18, 19, 19, 19, 20, 20, 20, 20, 21, 21, 21, 21, 22, 22, 22, 22, 22, 23, 23, 23, 23, 23, 23, 24, 24, 24, 24, 24, 24, 25, 25, 25, 25, 25, 25, 25, 26, 26, 26, 26, 26, 26, 26, 26, 27, 27, 27, 27, 27, 27, 27, 27, 27, 27, 28, 28, 28, 28, 28, 28, 28, 28, 28, 28, 29, 29, 29, 29, 29, 29, 29, 29, 29, 29, 29, 29, 30, 30, 30, 30, 30, 30, 30, 30, 30, 30, 30, 30, 30, 30, 31, 31, 31, 31, 31, 31, 31, 31, 31, 31, 31, 31, 31, 31, 31};
__device__ __forceinline__ int t5b(int dist) { return dist >= 128 ? 31 : (int)T5B[dist < 0 ? 0 : dist]; }

template <int K> __device__ __forceinline__ float swz_xor(float v) { return __int_as_float(__builtin_amdgcn_ds_swizzle(__float_as_int(v), (K << 10) | 0x1f)); }
template <int K> __device__ __forceinline__ unsigned swz_xor_u(unsigned v) { return (unsigned)__builtin_amdgcn_ds_swizzle((int)v, (K << 10) | 0x1f); }
__device__ __forceinline__ float xhalf_sum(float v) { auto rr = __builtin_amdgcn_permlane32_swap(__float_as_uint(v), __float_as_uint(v), false, false); return __uint_as_float(rr[0]) + __uint_as_float(rr[1]); }
__device__ __forceinline__ float xhalf_max(float v) { auto rr = __builtin_amdgcn_permlane32_swap(__float_as_uint(v), __float_as_uint(v), false, false); return fmaxf(__uint_as_float(rr[0]), __uint_as_float(rr[1])); }
__device__ __forceinline__ float xhalf_other(float v, int hi) { auto rr = __builtin_amdgcn_permlane32_swap(__float_as_uint(v), __float_as_uint(v), false, false); return __uint_as_float(hi ? rr[0] : rr[1]); }
__device__ __forceinline__ float wave_sum(float v) {
    v += swz_xor<1>(v); v += swz_xor<2>(v); v += swz_xor<4>(v); v += swz_xor<8>(v); v += swz_xor<16>(v);
    return xhalf_sum(v);
}
__device__ __forceinline__ float sigmoidf_(float x) { return 1.f / (1.f + __expf(-x)); }
__device__ __forceinline__ float siluf_(float x) { return x / (1.f + __expf(-x)); }
__device__ __forceinline__ float fast_sigmoid(float x) { return __builtin_amdgcn_rcpf(1.f + __builtin_amdgcn_exp2f(-x * LOG2E)); }

__device__ __forceinline__ void ph_prep(int tid_in, const float* xin, bf16_t* XB, float* SSQ) {
    int t_ = tid_in; asm volatile("" : "+v"(t_));
    const int lane = t_ & 63, gw = blockIdx.x * 8 + __builtin_amdgcn_readfirstlane(t_ >> 6);
    for (int row = gw; row < M; row += gridDim.x * 8) {
        const f32x4* xr = (const f32x4*)(xin + (size_t)row * D) + lane; float ss = 0.f;
        f32x4 v[4];
#pragma unroll
        for (int j = 0; j < 4; ++j) v[j] = xr[64 * j];
#pragma unroll
        for (int j = 0; j < 4; ++j) { ss += (v[j][0] * v[j][0] + v[j][1] * v[j][1]) + (v[j][2] * v[j][2] + v[j][3] * v[j][3]);
            uint2 w; w.x = pk2(v[j][0], v[j][1]); w.y = pk2(v[j][2], v[j][3]); *((uint2*)(XB + (size_t)row * D) + lane + 64 * j) = w; }
        ss = wave_sum(ss);
        if (lane < 16) SSQ[(size_t)row * 16 + lane] = lane == 0 ? ss : 0.f;
    }
}

namespace pg8 {
constexpr int BM = 256, BK = 64, HALF = 128, HTB = HALF * BK * 2, STAGE_BYTES = 8 * HTB, NXCD = 8, WGM = 8;
__host__ __device__ __forceinline__ int lds_byte(int r, int c) { const int st = (r >> 4) * 2 + (c >> 5), rr = r & 15, cc = c & 31, ob = rr * 64 + cc * 2; return st * 1024 + (ob ^ (((ob >> 9) & 1) << 5)); }
__host__ __device__ __forceinline__ void stage_rc(int b, int& R, int& C) { const int st = b / 1024, sb = b % 1024, swz = sb ^ (((sb >> 9) & 1) << 5); R = (st >> 1) * 16 + swz / 64; C = (st & 1) * 32 + (swz % 64) / 2; }
__host__ __device__ __forceinline__ int perm32(int rho) { const int n = rho >> 4, i = rho & 15; return 8 * (i >> 2) + 4 * n + (i & 3); }
struct Unit { int pm, pn; };
struct StaticOrder {
    int nM, nN, nwg, G, c;
    __device__ __forceinline__ void init(int M_, int N_, int G_, int c_) { nM = M_ / BM; nN = N_ / BM; nwg = nM * nN; G = G_; c = c_; }
    __device__ __forceinline__ bool next(int i, Unit& u) const {
        const long L = (long)i * G + c; if (L >= nwg) return false;
        int wgid = (int)L; { const int q = nwg / NXCD, r = nwg % NXCD, xcd = wgid % NXCD, off = wgid / NXCD; wgid = (xcd < r ? xcd * (q + 1) : r * (q + 1) + (xcd - r) * q) + off; }
        const int nig = WGM * nN, gid = wgid / nig, fm = gid * WGM, gsz = (nM - fm) < WGM ? (nM - fm) : WGM;
        u.pm = fm + ((wgid % nig) % gsz); u.pn = (wgid % nig) / gsz; return true;
    }
};
struct Ops {
    const char* A; const char* Bt; unsigned lda_b, ldb_b; size_t a_kstep; int nt;
    int a_mode;
    __device__ __forceinline__ const char* a_base(const Unit& u) const {
        if (a_mode == 1) return A + (size_t)(u.pm >> 5) * (16ull * S * 128) + (size_t)(u.pm & 31) * (256 * 128);
        if (a_mode == 2) return A + (size_t)u.pn * KV2 + (size_t)u.pm * 256 * lda_b;
        return A + (size_t)u.pm * 256 * lda_b;
    }
    __device__ __forceinline__ const char* b_base(const Unit& u) const { return Bt + (size_t)u.pn * 256 * ldb_b; }
};

template <class Epi, class Sched>
__device__ __forceinline__ void gemm_phase(LAS unsigned char* lds, int tid_in, const Ops& G, const Sched& S_, const Epi& E) {
    int tid_ = tid_in; asm volatile("" : "+v"(tid_));
    const int tid = tid_, wid = __builtin_amdgcn_readfirstlane(tid >> 6), lane = tid & 63, wr = wid >> 2, wc = wid & 3, fr = lane & 15, fq = lane >> 4;
    const int nt = G.nt;
    unsigned voffA[2], voffB[2];
#pragma unroll
    for (int i = 0; i < 2; ++i) { int R, C; stage_rc(tid * 16 + i * 8192, R, C); const int Rb = Epi::PERM ? ((R & ~31) + perm32(R & 31)) : R;
        voffA[i] = (unsigned)R * G.lda_b + (unsigned)C * 2u; voffB[i] = (unsigned)Rb * G.ldb_b + (unsigned)C * 2u; }
    const size_t kstepA = G.a_kstep, kstepB = (size_t)(BK * 2);
    const size_t hstepA = (size_t)HALF * G.lda_b, hstepB = (size_t)HALF * G.ldb_b;
    const unsigned ldsw = (unsigned)wid * 1024u;
    const int aoff = lds_byte(wr * 64 + fr, fq * 8), boff = lds_byte(wc * 32 + fr, fq * 8);
#define PG8_SA(b, h) (((b) * 2 + (h)) * HTB)
#define PG8_SB(b, h) ((4 + (b) * 2 + (h)) * HTB)
#define PG8_STAGE(bufoff, gbase, voff) do { _Pragma("unroll") for (int _i = 0; _i < 2; ++_i) \
        __builtin_amdgcn_global_load_lds((const unsigned*)((const char*)(gbase) + (voff)[_i]), (LAS unsigned*)(lds + (bufoff) + ldsw + _i * 8192), 16, 0, 0); } while (0)
#define PG8_LDA(dst, b, h) do { _Pragma("unroll") for (int m = 0; m < 4; ++m) _Pragma("unroll") for (int k = 0; k < 2; ++k) dst[m][k] = *(const LAS bf16x8*)(lds + PG8_SA(b, h) + aoff + m * 2048 + k * 1024); } while (0)
#define PG8_LDB(dst, b, h) do { _Pragma("unroll") for (int n = 0; n < 2; ++n) _Pragma("unroll") for (int k = 0; k < 2; ++k) dst[n][k] = *(const LAS bf16x8*)(lds + PG8_SB(b, h) + boff + n * 2048 + k * 1024); } while (0)
#define PG8_MMA(ai, bj, At, Bt) do { __builtin_amdgcn_s_setprio(1); _Pragma("unroll") for (int m = 0; m < 4; ++m) _Pragma("unroll") for (int n = 0; n < 2; ++n) _Pragma("unroll") for (int k = 0; k < 2; ++k) \
        acc[ai][bj][m][n] = __builtin_amdgcn_mfma_f32_16x16x32_bf16(Bt[n][k], At[m][k], acc[ai][bj][m][n], 0, 0, 0); __builtin_amdgcn_s_setprio(0); } while (0)
#define PG8_WAIT_V(n) asm volatile("s_waitcnt vmcnt(" #n ")" ::: "memory")
#define PG8_WAIT_L(n) asm volatile("s_waitcnt lgkmcnt(" #n ")" ::: "memory")
#define PG8_BAR __builtin_amdgcn_s_barrier()
#define PG8_SCHED __builtin_amdgcn_sched_barrier(0)
    Unit cur, nxt; int ui = 0;
    if (!S_.next(0, cur)) return;
    f32x4 acc[2][2][4][2];
#pragma unroll
    for (int a = 0; a < 2; ++a)
#pragma unroll
        for (int b = 0; b < 2; ++b)
#pragma unroll
            for (int m = 0; m < 4; ++m)
#pragma unroll
                for (int n = 0; n < 2; ++n) acc[a][b][m][n] = (f32x4){0.f, 0.f, 0.f, 0.f};
    bf16x8 At[4][2], B0[2][2], B1[2][2];
    const char* cA = G.a_base(cur); const char* cB = G.b_base(cur);
    PG8_STAGE(PG8_SB(0, 0), cB, voffB); PG8_STAGE(PG8_SB(0, 1), cB + hstepB, voffB); PG8_STAGE(PG8_SA(0, 0), cA, voffA); PG8_STAGE(PG8_SA(0, 1), cA + hstepA, voffA);
    if (wr == 1) PG8_BAR;
    PG8_WAIT_V(2); PG8_BAR;
    PG8_STAGE(PG8_SB(1, 0), cB + kstepB, voffB); PG8_STAGE(PG8_SA(1, 0), cA + kstepA, voffA); PG8_STAGE(PG8_SB(1, 1), cB + hstepB + kstepB, voffB);
    PG8_WAIT_V(6); PG8_BAR;
    for (;;) {
        const bool has_next = S_.next(ui + 1, nxt);
        const char* nA = has_next ? G.a_base(nxt) : cA; const char* nB = has_next ? G.b_base(nxt) : cB;
        for (int t = 0; t < nt; t += 2) {
            const bool last = (t == nt - 2);
            const char* a1 = cA + (size_t)(t + 1) * kstepA;
            const char* a2 = last ? nA : cA + (size_t)(t + 2) * kstepA; const char* b2 = last ? nB : cB + (size_t)(t + 2) * kstepB;
            const char* a3 = a2 + kstepA; const char* b3 = b2 + kstepB;
            if constexpr (Epi::KHOOK) E.khook(acc, cur, t, wr, wc, fr, fq);
            PG8_LDB(B0, 0, 0); PG8_LDB(B1, 0, 1); PG8_SCHED; PG8_LDA(At, 0, 0); PG8_STAGE(PG8_SA(1, 1), a1 + hstepA, voffA);
            PG8_WAIT_V(8); PG8_WAIT_L(0); PG8_BAR; PG8_MMA(0, 0, At, B0); PG8_MMA(0, 1, At, B1); PG8_BAR; PG8_SCHED;
            PG8_LDA(At, 0, 1); PG8_STAGE(PG8_SB(0, 0), b2, voffB); PG8_STAGE(PG8_SB(0, 1), b2 + hstepB, voffB); PG8_STAGE(PG8_SA(0, 0), a2, voffA);
            PG8_WAIT_V(8); PG8_WAIT_L(0); PG8_BAR; PG8_MMA(1, 0, At, B0); PG8_MMA(1, 1, At, B1); PG8_BAR; PG8_SCHED;
            PG8_LDB(B0, 1, 0); PG8_LDB(B1, 1, 1); PG8_SCHED; PG8_LDA(At, 1, 0); PG8_STAGE(PG8_SA(0, 1), a2 + hstepA, voffA);
            PG8_WAIT_V(8); PG8_WAIT_L(0); PG8_BAR; PG8_MMA(0, 0, At, B0); PG8_MMA(0, 1, At, B1); PG8_BAR; PG8_SCHED;
            PG8_LDA(At, 1, 1); PG8_STAGE(PG8_SB(1, 0), b3, voffB); PG8_STAGE(PG8_SB(1, 1), b3 + hstepB, voffB); PG8_STAGE(PG8_SA(1, 0), a3, voffA);
            PG8_WAIT_V(8); PG8_WAIT_L(0); PG8_BAR; PG8_MMA(1, 0, At, B0); PG8_MMA(1, 1, At, B1); PG8_BAR; PG8_SCHED;
        }
        if (wr == 0) PG8_BAR;
        E(acc, cur, wr, wc, fr, fq);
        if (!has_next) break;
#pragma unroll
        for (int a = 0; a < 2; ++a)
#pragma unroll
            for (int b = 0; b < 2; ++b)
#pragma unroll
                for (int m = 0; m < 4; ++m)
#pragma unroll
                    for (int n = 0; n < 2; ++n) acc[a][b][m][n] = (f32x4){0.f, 0.f, 0.f, 0.f};
        cur = nxt; cA = nA; cB = nB; ++ui;
        if (wr == 1) PG8_BAR;
    }
    PG8_WAIT_V(0);
    PG8_BAR;
#undef PG8_SA
#undef PG8_SB
#undef PG8_STAGE
#undef PG8_LDA
#undef PG8_LDB
#undef PG8_MMA
#undef PG8_WAIT_V
#undef PG8_WAIT_L
#undef PG8_BAR
#undef PG8_SCHED
}

__device__ __forceinline__ float rstd_of(const float* ssq, int row) {
    const f32x4* p = (const f32x4*)(ssq + (size_t)row * 16); const f32x4 a = p[0], b = p[1], c = p[2], d = p[3];
    const float s = ((a[0] + a[1]) + (a[2] + a[3])) + ((b[0] + b[1]) + (b[2] + b[3])) + ((c[0] + c[1]) + (c[2] + c[3])) + ((d[0] + d[1]) + (d[2] + d[3]));
    return rsqrtf(s * (1.f / D) + EPS);
}
__device__ __forceinline__ float silu_fast(float x) { return x * __builtin_amdgcn_rcpf(1.f + __builtin_amdgcn_exp2f(-x * LOG2E)); }

struct EpiFfnUp {
    static constexpr bool PERM = true, KHOOK = false;
    bf16_t* H; const float* ssq;
    __device__ __forceinline__ void operator()(const f32x4 (&acc)[2][2][4][2], const Unit& u, int wr, int wc, int fr, int fq) const {
#pragma unroll
        for (int ai = 0; ai < 2; ++ai)
#pragma unroll
            for (int m = 0; m < 4; ++m) {
                const int row = u.pm * BM + ai * HALF + wr * 64 + m * 16 + fr; const float r = rstd_of(ssq, row);
                float h[8];
#pragma unroll
                for (int n = 0; n < 2; ++n)
#pragma unroll
                    for (int j = 0; j < 4; ++j) h[n * 4 + j] = silu_fast(r * acc[ai][0][m][n][j]) * (r * acc[ai][1][m][n][j]);
                u32x4 w; w.x = pk2(h[0], h[1]); w.y = pk2(h[2], h[3]); w.z = pk2(h[4], h[5]); w.w = pk2(h[6], h[7]);
                *(u32x4*)(H + (size_t)row * F + u.pn * 128 + wc * 32 + fq * 8) = w;
                asm volatile("" ::: "memory");
            }
    }
};
struct EpiResid {
    static constexpr bool PERM = true, KHOOK = false;
    const float* XI; float* X; bf16_t* XB; float* ssq; float alpha;
    __device__ __forceinline__ void operator()(const f32x4 (&acc)[2][2][4][2], const Unit& u, int wr, int wc, int fr, int fq) const {
#pragma unroll
        for (int ai = 0; ai < 2; ++ai)
#pragma unroll
            for (int m = 0; m < 4; ++m) {
                const int row = u.pm * BM + ai * HALF + wr * 64 + m * 16 + fr; float ss = 0.f;
#pragma unroll
                for (int bj = 0; bj < 2; ++bj) {
                    const size_t o = (size_t)row * D + u.pn * BM + bj * HALF + wc * 32 + fq * 8;
                    f32x4 x0 = *(const f32x4*)(XI + o), x1 = *(const f32x4*)(XI + o + 4);
                    x0 += acc[ai][bj][m][0] * alpha; x1 += acc[ai][bj][m][1] * alpha;
                    *(f32x4*)(X + o) = x0; *(f32x4*)(X + o + 4) = x1;
                    u32x4 w; w.x = pk2(x0[0], x0[1]); w.y = pk2(x0[2], x0[3]); w.z = pk2(x1[0], x1[1]); w.w = pk2(x1[2], x1[3]);
                    *(u32x4*)(XB + o) = w;
                    ss += (x0[0] * x0[0] + x0[1] * x0[1]) + (x0[2] * x0[2] + x0[3] * x0[3]) + (x1[0] * x1[0] + x1[1] * x1[1]) + (x1[2] * x1[2] + x1[3] * x1[3]);
                }
                ss += swz_xor<16>(ss); ss = xhalf_sum(ss);
                if (fq == 0) ssq[(size_t)row * 16 + u.pn * 4 + wc] = ss;
                asm volatile("" ::: "memory");
            }
    }
};
__host__ __device__ __forceinline__ int win_slot_col(int slot) {
    if (slot < 8) return 64 * slot;
    if (slot < 20) return 512 + 64 * (slot - 8);
    if (slot < 40) return 1304 + 64 * (slot - 20);
    if (slot < 88) return 2584 + 64 * (slot - 40);
    if (slot == 88) return 1280;
    return -1;
}
struct EpiWin {
    static constexpr bool PERM = true, KHOOK = false;
    unsigned char* ws; const float* ssq; const float *nsa_qn, *nsa_kn, *swa_qn, *swa_kn;
    __device__ __forceinline__ void operator()(const f32x4 (&acc)[2][2][4][2], const Unit& u, int wr, int wc, int fr, int fq) const {
        const int slot = u.pn * 4 + wc;
        if (slot >= 89) return;
        int kind = 0; const float* nw = nullptr; float scale = 1.f; bf16_t* dst = nullptr; int nh = 2, h = 0;
        if (slot < 8) { nw = nsa_qn; scale = C2; dst = (bf16_t*)(ws + OFF_Q16); nh = 16; h = slot; }
        else if (slot < 10) { dst = (bf16_t*)(ws + OFF_KCMP); h = slot - 8; }
        else if (slot < 12) { dst = (bf16_t*)(ws + OFF_VCMP); h = slot - 10; }
        else if (slot < 14) { nw = nsa_kn; dst = (bf16_t*)(ws + OFF_KSLC); h = slot - 12; }
        else if (slot < 16) { kind = 1; dst = (bf16_t*)(ws + OFF_VSLCT); h = slot - 14; }
        else if (slot < 18) { nw = nsa_kn; dst = (bf16_t*)(ws + OFF_KWIN); h = slot - 16; }
        else if (slot < 20) { kind = 1; dst = (bf16_t*)(ws + OFF_VWINT); h = slot - 18; }
        else if (slot < 24) { scale = C2; dst = (bf16_t*)(ws + OFF_Q16); nh = 16; h = 8 + slot - 20; }
        else if (slot < 28) { dst = (bf16_t*)(ws + OFF_SBK); nh = 4; h = slot - 24; }
        else if (slot < 32) { kind = 1; dst = (bf16_t*)(ws + OFF_SBVT); nh = 4; h = slot - 28; }
        else if (slot < 36) { nw = swa_qn; scale = C2; dst = (bf16_t*)(ws + OFF_Q16); nh = 16; h = 12 + slot - 32; }
        else if (slot < 38) { nw = swa_kn; dst = (bf16_t*)(ws + OFF_WK); h = slot - 36; }
        else if (slot < 40) { kind = 1; dst = (bf16_t*)(ws + OFF_WVT); h = slot - 38; }
        else if (slot < 88) { kind = 2; dst = (bf16_t*)(ws + OFF_A) + (size_t)((slot - 40) >> 4) * M * D + ((slot - 40) & 15) * 64; }
        else { kind = 3; }
#pragma unroll
        for (int ai = 0; ai < 2; ++ai)
#pragma unroll
            for (int m = 0; m < 4; ++m) {
                const int row = u.pm * BM + ai * HALF + wr * 64 + m * 16 + fr; const float r = rstd_of(ssq, row);
                const int b = row / S, s = row % S;
                float v[2][2][4]; float ss = 0.f;
#pragma unroll
                for (int bj = 0; bj < 2; ++bj)
#pragma unroll
                    for (int n = 0; n < 2; ++n)
#pragma unroll
                        for (int j = 0; j < 4; ++j) { const float x = r * acc[ai][bj][m][n][j]; v[bj][n][j] = x; ss += x * x; }
                float rn = scale;
                if (nw) { ss += swz_xor<16>(ss); ss = xhalf_sum(ss); rn = rsqrtf(ss * (1.f / 64.f) + EPS) * scale; }
#pragma unroll
                for (int bj = 0; bj < 2; ++bj)
#pragma unroll
                    for (int n = 0; n < 2; ++n) {
                        f32x4 wv = (f32x4){1.f, 1.f, 1.f, 1.f}; if (nw) wv = *(const f32x4*)(nw + 32 * bj + 8 * fq + 4 * n);
#pragma unroll
                        for (int j = 0; j < 4; ++j) v[bj][n][j] *= rn * wv[j];
                    }
                if (kind == 0) {
                    bf16_t* o = dst + (((size_t)b * nh + h) * S + s) * 64 + 8 * fq;
#pragma unroll
                    for (int bj = 0; bj < 2; ++bj) { u32x4 pw; pw.x = pk2(v[bj][0][0], v[bj][0][1]); pw.y = pk2(v[bj][0][2], v[bj][0][3]); pw.z = pk2(v[bj][1][0], v[bj][1][1]); pw.w = pk2(v[bj][1][2], v[bj][1][3]);
                        *(u32x4*)(o + 32 * bj) = pw; }
                } else if (kind == 1) {
                    bf16_t* o = dst + ((size_t)b * nh + h) * 64 * S + vt_pos(s);
#pragma unroll
                    for (int bj = 0; bj < 2; ++bj)
#pragma unroll
                        for (int n = 0; n < 2; ++n)
#pragma unroll
                            for (int j = 0; j < 4; ++j) o[(size_t)(32 * bj + 8 * fq + 4 * n + j) * S] = f2bf(v[bj][n][j]);
                } else if (kind == 2) {
                    bf16_t* o = dst + (size_t)row * D + 8 * fq;
#pragma unroll
                    for (int bj = 0; bj < 2; ++bj) { u32x4 pw; pw.x = pk2(fast_sigmoid(v[bj][0][0]), fast_sigmoid(v[bj][0][1])); pw.y = pk2(fast_sigmoid(v[bj][0][2]), fast_sigmoid(v[bj][0][3]));
                        pw.z = pk2(fast_sigmoid(v[bj][1][0]), fast_sigmoid(v[bj][1][1])); pw.w = pk2(fast_sigmoid(v[bj][1][2]), fast_sigmoid(v[bj][1][3])); *(u32x4*)(o + 32 * bj) = pw; }
                } else {
                    float* o = (float*)(ws + OFF_NGATE) + (size_t)row * 24;
#pragma unroll
                    for (int n = 0; n < 2; ++n)
#pragma unroll
                        for (int j = 0; j < 4; ++j) { const int d = 8 * fq + 4 * n + j; if (d < 24) o[d] = fast_sigmoid(v[0][n][j]); }
                }
                asm volatile("" ::: "memory");
            }
    }
};
struct EpiCmp1 {
    static constexpr bool PERM = true, KHOOK = false;
    float* HID; const float* bias;
    __device__ __forceinline__ void operator()(const f32x4 (&acc)[2][2][4][2], const Unit& u, int wr, int wc, int fr, int fq) const {
#pragma unroll
        for (int ai = 0; ai < 2; ++ai)
#pragma unroll
            for (int m = 0; m < 4; ++m) {
                const int row = u.pm * BM + ai * HALF + wr * 64 + m * 16 + fr;
#pragma unroll
                for (int bj = 0; bj < 2; ++bj)
#pragma unroll
                    for (int n = 0; n < 2; ++n) {
                        const int col = bj * HALF + wc * 32 + fq * 8 + 4 * n; const f32x4 bv = *(const f32x4*)(bias + u.pn * 256 + col);
                        f32x4 o;
#pragma unroll
                        for (int j = 0; j < 4; ++j) o[j] = silu_fast(acc[ai][bj][m][n][j] + bv[j]);
                        *(f32x4*)(HID + ((size_t)u.pn * 2048 + row) * 256 + col) = o;
                    }
                asm volatile("" ::: "memory");
            }
    }
};
struct EpiMerge {
    static constexpr bool PERM = true, KHOOK = true;
    const bf16_t* G0; const bf16_t* G1; const bf16_t* G2; bf16_t* OUT;
    __device__ __forceinline__ void khook(f32x4 (&acc)[2][2][4][2], const Unit& u, int t, int wr, int wc, int fr, int fq) const {
        if (t != 8 && t != 12) return;
        const bf16_t* NUM = t == 8 ? G0 : G1; const bf16_t* DEN = t == 8 ? G1 : G2;
#pragma unroll
        for (int ai = 0; ai < 2; ++ai)
#pragma unroll
            for (int m = 0; m < 4; ++m) {
                const int row = u.pm * BM + ai * HALF + wr * 64 + m * 16 + fr;
#pragma unroll
                for (int bj = 0; bj < 2; ++bj) {
                    const size_t o = (size_t)row * D + u.pn * BM + bj * HALF + wc * 32 + fq * 8;
                    const u32x4 nu = *(const u32x4*)(NUM + o), de = *(const u32x4*)(DEN + o);
#pragma unroll
                    for (int q = 0; q < 4; ++q) {
                        const float n0 = __uint_as_float(nu[q] << 16), n1 = __uint_as_float(nu[q] & 0xffff0000u), d0 = __uint_as_float(de[q] << 16), d1 = __uint_as_float(de[q] & 0xffff0000u);
                        acc[ai][bj][m][q >> 1][(q & 1) * 2] *= n0 * __builtin_amdgcn_rcpf(d0); acc[ai][bj][m][q >> 1][(q & 1) * 2 + 1] *= n1 * __builtin_amdgcn_rcpf(d1);
                    }
                }
                asm volatile("" : "+v"(acc[ai][0][m][0]), "+v"(acc[ai][0][m][1]), "+v"(acc[ai][1][m][0]), "+v"(acc[ai][1][m][1]) :: "memory");
            }
    }
    __device__ __forceinline__ void operator()(const f32x4 (&acc)[2][2][4][2], const Unit& u, int wr, int wc, int fr, int fq) const {
#pragma unroll
        for (int ai = 0; ai < 2; ++ai)
#pragma unroll
            for (int m = 0; m < 4; ++m) {
                const int row = u.pm * BM + ai * HALF + wr * 64 + m * 16 + fr;
#pragma unroll
                for (int bj = 0; bj < 2; ++bj) {
                    const size_t o = (size_t)row * D + u.pn * BM + bj * HALF + wc * 32 + fq * 8;
                    const u32x4 ge = *(const u32x4*)(G2 + o); u32x4 pw;
#pragma unroll
                    for (int q = 0; q < 4; ++q) {
                        const float g0 = __uint_as_float(ge[q] << 16), g1 = __uint_as_float(ge[q] & 0xffff0000u);
                        pw[q] = pk2(acc[ai][bj][m][q >> 1][(q & 1) * 2] * g0, acc[ai][bj][m][q >> 1][(q & 1) * 2 + 1] * g1);
                    }
                    *(u32x4*)(OUT + o) = pw;
                }
                asm volatile("" ::: "memory");
            }
    }
};
}

__device__ __forceinline__ void conv_item4(const float* W, int ldw, int col0, int nvalid, int ksrc, const float* wn, bf16_t* Bt, size_t ldbt, int row0, int kofs, LAS float* scr, int lane) {
    const int n4 = (lane & 7) * 4, kr = lane >> 3, c = lane & 7;
    f32x4 v[4][8];
#pragma unroll
    for (int q = 0; q < 4; ++q)
#pragma unroll
        for (int i = 0; i < 8; ++i) { const int kk = ksrc + 64 * q + 8 * i + kr; v[q][i] = (f32x4){0.f, 0.f, 0.f, 0.f};
            if (n4 < nvalid) { v[q][i] = *(const f32x4*)(W + (size_t)kk * ldw + col0 + n4); if (wn) v[q][i] *= wn[kk]; } }
#pragma unroll
    for (int q = 0; q < 4; ++q) {
#pragma unroll
        for (int i = 0; i < 8; ++i) { const int kk = 8 * i + kr; scr[kk * 33 + n4] = v[q][i][0]; scr[kk * 33 + n4 + 1] = v[q][i][1]; scr[kk * 33 + n4 + 2] = v[q][i][2]; scr[kk * 33 + n4 + 3] = v[q][i][3]; }
        asm volatile("s_waitcnt lgkmcnt(0)" ::: "memory");
#pragma unroll
        for (int j = 0; j < 4; ++j) { const int n = (lane >> 3) + 8 * j; const LAS float* s = scr + (8 * c) * 33 + n;
            u32x4 o; o.x = pk2(s[0 * 33], s[1 * 33]); o.y = pk2(s[2 * 33], s[3 * 33]); o.z = pk2(s[4 * 33], s[5 * 33]); o.w = pk2(s[6 * 33], s[7 * 33]);
            *(u32x4*)(Bt + (size_t)(row0 + n) * ldbt + kofs + 64 * q + 8 * c) = o; }
        asm volatile("s_waitcnt lgkmcnt(0)" ::: "memory");
    }
}
__device__ __forceinline__ void conv_wide(const float* W, int ldw, int col0, int ksrc, const float* wn, bf16_t* Bt, size_t ldbt, int r0, int r1, int r2, int r3, int kofs, LAS float* scr, int lane) {
    const int cg = lane & 31, rh = lane >> 5;
    f32x4 v[16];
#pragma unroll
    for (int i = 0; i < 16; ++i) { const int kk = ksrc + 2 * i + rh; v[i] = *(const f32x4*)(W + (size_t)kk * ldw + col0 + 4 * cg); if (wn) v[i] *= wn[kk]; }
#pragma unroll
    for (int c = 0; c < 2; ++c) {
#pragma unroll
        for (int i = 0; i < 8; ++i) { LAS float* d = scr + (2 * i + rh) * 129 + 4 * cg; d[0] = v[8 * c + i][0]; d[1] = v[8 * c + i][1]; d[2] = v[8 * c + i][2]; d[3] = v[8 * c + i][3]; }
        asm volatile("s_waitcnt lgkmcnt(0)" ::: "memory");
#pragma unroll
        for (int j = 0; j < 4; ++j) { const int t = lane + 64 * j, n = t >> 1, half = t & 1, sub = n >> 5; const LAS float* s = scr + (8 * half) * 129 + n;
            const int row = (sub == 0 ? r0 : sub == 1 ? r1 : sub == 2 ? r2 : r3) + (n & 31);
            u32x4 o; o.x = pk2(s[0 * 129], s[1 * 129]); o.y = pk2(s[2 * 129], s[3 * 129]); o.z = pk2(s[4 * 129], s[5 * 129]); o.w = pk2(s[6 * 129], s[7 * 129]);
            *(u32x4*)(Bt + (size_t)row * ldbt + kofs + 16 * c + 8 * half) = o; }
        asm volatile("s_waitcnt lgkmcnt(0)" ::: "memory");
    }
}
struct ConvCtx { LAS unsigned char* ldsr; LAS float* scr; int gw, ngw, lane; };
#define CONV_LAUNDER ConvCtx c = c_; { int t_ = c_.lane; asm volatile("" : "+v"(t_)); c.lane = t_ & 63; const int wv_ = __builtin_amdgcn_readfirstlane(t_ >> 6); c.gw = ((int)blockIdx.x - c_.gw) * 8 + wv_; c.scr = (LAS float*)(c.ldsr + wv_ * 8448); }
__device__ __forceinline__ void conv_ffn(const ConvCtx& c_, const float* nw, const float* wg, const float* wu, const float* wd, unsigned char* dstbase) {
    CONV_LAUNDER;
    bf16_t* GU = (bf16_t*)dstbase; bf16_t* DN = (bf16_t*)(dstbase + FFNW_D);
    constexpr int I_GU = 2 * 22 * 32, I_D = 8 * 88;
    for (int it = c.gw; it < I_GU + I_D; it += c.ngw) {
        if (it < I_GU) { const int kb = it / 44, cb = it % 44, isup = cb / 22, tile = cb % 22, rb = tile * 256 + isup * 128;
            conv_wide(isup ? wu : wg, F, tile * 128, kb * 32, nw, GU, D, rb, rb + 32, rb + 64, rb + 96, kb * 32, c.scr, c.lane); }
        else { const int r = it - I_GU, kb = r / 8, cb = r % 8, rb = cb * 128; conv_wide(wd, D, rb, kb * 32, nullptr, DN, F, rb, rb + 32, rb + 64, rb + 96, kb * 32, c.scr, c.lane); }
    }
}
struct MixW { const float *mixn, *win, *w1k, *w1v, *ua, *ub, *uc, *wo, *pos, *w2k, *w2v; };
__device__ __forceinline__ void conv_mix(const ConvCtx& c_, const MixW& w, unsigned char* ws) {
    CONV_LAUNDER;
    bf16_t* BIN = (bf16_t*)(ws + OFF_BT_IN); bf16_t* BC1 = (bf16_t*)(ws + OFF_BT_C1); bf16_t* BM_ = (bf16_t*)(ws + OFF_BT_M); bf16_t* BO = (bf16_t*)(ws + OFF_BT_O);
    constexpr int I_IN = 184 * 4, I_C1 = 16 * 8, I_M = 32 * 4, I_O = 32 * 4, I_B = 512, I_W2 = 4;
    bf16_t* W2T = (bf16_t*)(ws + OFF_W2T);
    for (int it = c.gw; it < I_IN + I_C1 + I_M + I_O + I_B + I_W2; it += c.ngw) {
        int r = it;
        if (r < I_IN) { const int rb = r / 4, kb = r % 4, tile = rb >> 3, r32 = rb & 7, bj = r32 >> 2, slot = tile * 4 + (r32 & 3);
            const int sc = pg8::win_slot_col(slot); int nvalid = sc < 0 ? 0 : 32; if (slot == 88) nvalid = bj == 0 ? 24 : 0;
            conv_item4(w.win, DIN, sc + 32 * bj, nvalid, kb * 256, w.mixn, BIN, D, rb * 32, kb * 256, c.scr, c.lane); continue; }
        r -= I_IN;
        if (r < I_C1) { const int rb = r / 8, kb = r % 8; conv_item4(rb >= 8 ? w.w1v : w.w1k, 256, (rb & 7) * 32, 32, kb * 256, nullptr, BC1, 2048, rb * 32, kb * 256, c.scr, c.lane); continue; }
        r -= I_C1;
        if (r < I_M) { const int rb = r / 4, kb = r % 4;
            if (kb < 2) conv_item4(w.ua, D, rb * 32, 32, kb * 256, nullptr, BM_, D, rb * 32, kb * 256, c.scr, c.lane);
            else if (kb == 2) conv_item4(w.ub, D, rb * 32, 32, 0, nullptr, BM_, D, rb * 32, 512, c.scr, c.lane);
            else conv_item4(w.uc, D, rb * 32, 32, 0, nullptr, BM_, D, rb * 32, 768, c.scr, c.lane);
            continue; }
        r -= I_M;
        if (r < I_O) { const int rb = r / 4, kb = r % 4; conv_item4(w.wo, D, rb * 32, 32, kb * 256, nullptr, BO, D, rb * 32, kb * 256, c.scr, c.lane); continue; }
        r -= I_O;
        if (r >= I_B) { r -= I_B; const int kv = r >> 1, rb = r & 1;
            conv_item4(kv ? w.w2v : w.w2k, 64, rb * 32, 32, 0, nullptr, W2T + (size_t)kv * 64 * 256, 256, rb * 32, 0, c.scr, c.lane); continue; }
        { const int kv = r >> 8, j = r & 255; const float* w1 = kv ? w.w1v : w.w1k; float s = 0.f;
#pragma unroll 8
          for (int i = 0; i < 32; ++i) { const int kk = c.lane + 64 * i; s += w.pos[kk] * w1[(size_t)kk * 256 + j]; }
          s = wave_sum(s);
          if (c.lane == 0) ((float*)(ws + OFF_BIASC))[kv * 256 + j] = s; }
    }
}

typedef float f32x16 __attribute__((ext_vector_type(16)));
__host__ __device__ __forceinline__ int crow(int r, int hi) { return (r & 3) + 8 * (r >> 2) + 4 * hi; }
__device__ __forceinline__ bf16x8 pack8(const f32x16& p, int s) {
    u32x4 w; w.x = pk2(p[8 * s + 0], p[8 * s + 1]); w.y = pk2(p[8 * s + 2], p[8 * s + 3]); w.z = pk2(p[8 * s + 4], p[8 * s + 5]); w.w = pk2(p[8 * s + 6], p[8 * s + 7]);
    return __builtin_bit_cast(bf16x8, w);
}
constexpr int TAB_N = 130;
__device__ __forceinline__ int tab_idx(int dist) { return min(max(dist, -1), 128) + 1; }
__device__ __forceinline__ void build_tabs(LAS float* tab, const float* rel_bias, int tid) {
    for (int i = tid; i < 12 * TAB_N; i += 512) {
        const int hh = i / TAB_N, e = i % TAB_N; float v;
        if (e == 0) v = -INFINITY;
        else if (hh < 8) v = e == 129 ? 0.f : (rel_bias[t5b(e - 1) * 12 + hh] - rel_bias[31 * 12 + hh]) * LOG2E;
        else v = e == 129 ? -INFINITY : rel_bias[t5b(e - 1) * 12 + hh] * LOG2E;
        tab[i] = v;
    }
}
__device__ __forceinline__ void qk_global(f32x16& p0, f32x16& p1, const bf16_t* K, const bf16x8 (&qf)[4], int lane) {
    const bf16_t* kp = K + (size_t)(lane & 31) * 64 + 8 * (lane >> 5);
    bf16x8 kf[8];
#pragma unroll
    for (int c = 0; c < 4; ++c) { kf[2 * c] = *(const bf16x8*)(kp + 16 * c); kf[2 * c + 1] = *(const bf16x8*)(kp + 32 * 64 + 16 * c); }
    f32x16 z;
#pragma unroll
    for (int r = 0; r < 16; ++r) z[r] = 0.f;
    p0 = z; p1 = z;
#pragma unroll
    for (int c = 0; c < 4; ++c) {
        p0 = __builtin_amdgcn_mfma_f32_32x32x16_bf16(kf[2 * c], qf[c], p0, 0, 0, 0);
        p1 = __builtin_amdgcn_mfma_f32_32x32x16_bf16(kf[2 * c + 1], qf[c], p1, 0, 0, 0);
    }
}
__device__ __forceinline__ void pv_global(f32x16 (&o)[2], const bf16_t* VT, size_t pitch, const f32x16& p0, const f32x16& p1, int lane) {
    const bf16_t* vp = VT + (size_t)(lane & 31) * pitch + 8 * (lane >> 5);
    bf16x8 vf[8];
#pragma unroll
    for (int q = 0; q < 4; ++q)
#pragma unroll
        for (int dh = 0; dh < 2; ++dh) vf[2 * q + dh] = *(const bf16x8*)(vp + (size_t)(32 * dh) * pitch + 16 * q);
#pragma unroll
    for (int q = 0; q < 4; ++q) {
        const bf16x8 pf = pack8((q >> 1) ? p1 : p0, q & 1);
#pragma unroll
        for (int dh = 0; dh < 2; ++dh) o[dh] = __builtin_amdgcn_mfma_f32_32x32x16_bf16(vf[2 * q + dh], pf, o[dh], 0, 0, 0);
    }
}
__device__ __forceinline__ void softmax_step(f32x16& p0, f32x16& p1, float& m, float& l, f32x16 (&o)[2]) {
    float mx = fmaxf(p0[0], p1[0]);
#pragma unroll
    for (int r = 1; r < 16; ++r) mx = fmaxf(mx, fmaxf(p0[r], p1[r]));
    mx = xhalf_max(mx);
    const float mn = fmaxf(m, mx);
    const float ms = (mn == -INFINITY) ? 0.f : mn;
    const float alpha = __builtin_amdgcn_exp2f(m - ms);
    float sum = 0.f;
#pragma unroll
    for (int r = 0; r < 16; ++r) { p0[r] = __builtin_amdgcn_exp2f(p0[r] - ms); p1[r] = __builtin_amdgcn_exp2f(p1[r] - ms); sum += p0[r] + p1[r]; }
    l = l * alpha + sum; m = mn;
    if (__any(alpha != 1.f)) {
#pragma unroll
        for (int r = 0; r < 16; ++r) { o[0][r] *= alpha; o[1][r] *= alpha; }
    }
}
constexpr float SM_THR = 6.f;
__device__ __forceinline__ float max3f(float a, float b, float c) { return fmaxf(fmaxf(a, b), c); }
__device__ __forceinline__ void softmax_rel(f32x16& p0, f32x16& p1, float& mref, float& l, f32x16 (&o)[2], bool first) {
    float a = max3f(p0[0], p0[1], p1[0]), b = max3f(p0[2], p0[3], p1[1]);
    a = max3f(a, p1[2], p1[3]);
#pragma unroll
    for (int r = 4; r < 16; r += 4) { a = max3f(a, p0[r], p0[r + 1]); b = max3f(b, p0[r + 2], p0[r + 3]); a = max3f(a, p1[r], p1[r + 1]); b = max3f(b, p1[r + 2], p1[r + 3]); }
    const float mx = xhalf_max(fmaxf(a, b));
    if (first || __any(mx > SM_THR)) {
        const float d = first ? (mx == -INFINITY ? 0.f : mx) : fmaxf(mx, 0.f); const f32x2_t d2 = {d, d};
        mref += d;
        const float f = first ? 1.f : __builtin_amdgcn_exp2f(-d); const f32x2_t f2 = {f, f};
        l *= f;
#pragma unroll
        for (int r = 0; r < 16; r += 2) {
            f32x2_t x = {p0[r], p0[r + 1]}; x = x - d2; p0[r] = x[0]; p0[r + 1] = x[1];
            f32x2_t y = {p1[r], p1[r + 1]}; y = y - d2; p1[r] = y[0]; p1[r + 1] = y[1];
            f32x2_t u = {o[0][r], o[0][r + 1]}; u = u * f2; o[0][r] = u[0]; o[0][r + 1] = u[1];
            f32x2_t v = {o[1][r], o[1][r + 1]}; v = v * f2; o[1][r] = v[0]; o[1][r + 1] = v[1];
        }
    }
    f32x2_t s2 = {0.f, 0.f};
#pragma unroll
    for (int r = 0; r < 16; r += 2) {
        p0[r] = __builtin_amdgcn_exp2f(p0[r]); p0[r + 1] = __builtin_amdgcn_exp2f(p0[r + 1]); p1[r] = __builtin_amdgcn_exp2f(p1[r]); p1[r + 1] = __builtin_amdgcn_exp2f(p1[r + 1]);
        const f32x2_t x = {p0[r], p0[r + 1]}, y = {p1[r], p1[r + 1]}; s2 = s2 + x; s2 = s2 + y;
    }
    l += s2[0] + s2[1];
}
__device__ __forceinline__ void store_ot(bf16_t* dst, const f32x16 (&o)[2], float scale, int hi) {
#pragma unroll
    for (int dh = 0; dh < 2; ++dh)
#pragma unroll
        for (int m4 = 0; m4 < 4; ++m4) {
            uint2 w; w.x = pk2(o[dh][4 * m4] * scale, o[dh][4 * m4 + 1] * scale); w.y = pk2(o[dh][4 * m4 + 2] * scale, o[dh][4 * m4 + 3] * scale);
            *(uint2*)(dst + 32 * dh + 8 * m4 + 4 * hi) = w;
        }
}

__device__ __forceinline__ void cmp2_unit(unsigned char* ws, const float* knorm, int unit, int lane) {
    const int kv = unit >> 6, hi = lane >> 5, row = (unit & 63) * 32 + (lane & 31), n = row & 511, grp = row >> 9;
    const float* hrow = (const float*)(ws + OFF_HID) + ((size_t)kv * 2048 + row) * 256 + 8 * hi;
    const bf16_t* w2t = (const bf16_t*)(ws + OFF_W2T) + (size_t)kv * 64 * 256 + (size_t)(lane & 31) * 256 + 8 * hi;
    f32x16 o[2];
#pragma unroll
    for (int r = 0; r < 16; ++r) { o[0][r] = 0.f; o[1][r] = 0.f; }
#pragma unroll 4
    for (int c = 0; c < 16; ++c) {
        const f32x4 a = *(const f32x4*)(hrow + 16 * c), b = *(const f32x4*)(hrow + 16 * c + 4);
        u32x4 w; w.x = pk2(a[0], a[1]); w.y = pk2(a[2], a[3]); w.z = pk2(b[0], b[1]); w.w = pk2(b[2], b[3]);
        const bf16x8 hb = __builtin_bit_cast(bf16x8, w);
#pragma unroll
        for (int dh = 0; dh < 2; ++dh) { const bf16x8 wf = *(const bf16x8*)(w2t + (size_t)dh * 32 * 256 + 16 * c); o[dh] = __builtin_amdgcn_mfma_f32_32x32x16_bf16(wf, hb, o[dh], 0, 0, 0); }
    }
    const bool valid = n < NCMP;
    if (kv == 0) {
        float ss = 0.f;
#pragma unroll
        for (int r = 0; r < 16; ++r) ss += o[0][r] * o[0][r] + o[1][r] * o[1][r];
        ss = xhalf_sum(ss);
        const float rn = valid ? rsqrtf(ss * (1.f / 64.f) + EPS) : 0.f;
        bf16_t* dst = (bf16_t*)(ws + OFF_KCN) + ((size_t)grp * 512 + n) * 64;
#pragma unroll
        for (int dh = 0; dh < 2; ++dh)
#pragma unroll
            for (int m4 = 0; m4 < 4; ++m4) { const int d = 32 * dh + 8 * m4 + 4 * hi; const f32x4 kn = *(const f32x4*)(knorm + d);
                uint2 w; w.x = pk2(o[dh][4 * m4] * rn * kn[0], o[dh][4 * m4 + 1] * rn * kn[1]); w.y = pk2(o[dh][4 * m4 + 2] * rn * kn[2], o[dh][4 * m4 + 3] * rn * kn[3]);
                *(uint2*)(dst + d) = w; }
    } else {
        bf16_t* dst = (bf16_t*)(ws + OFF_VCT) + (size_t)grp * 64 * 512 + vt_pos(n);
#pragma unroll
        for (int dh = 0; dh < 2; ++dh)
#pragma unroll
            for (int r = 0; r < 16; ++r) dst[(size_t)(32 * dh + crow(r, hi)) * 512] = f2bf(valid ? o[dh][r] : 0.f);
    }
}

__device__ __forceinline__ void ldk_global(bf16x8 (&kf)[8], const bf16_t* K, int lane) {
    const bf16_t* kp = K + (size_t)(lane & 31) * 64 + 8 * (lane >> 5);
#pragma unroll
    for (int c = 0; c < 4; ++c) { kf[2 * c] = *(const bf16x8*)(kp + 16 * c); kf[2 * c + 1] = *(const bf16x8*)(kp + 32 * 64 + 16 * c); }
}
__device__ __forceinline__ void ldv_global(bf16x8 (&vf)[8], const bf16_t* VT, size_t pitch, int lane) {
    const bf16_t* vp = VT + (size_t)(lane & 31) * pitch + 8 * (lane >> 5);
#pragma unroll
    for (int q = 0; q < 4; ++q)
#pragma unroll
        for (int dh = 0; dh < 2; ++dh) vf[2 * q + dh] = *(const bf16x8*)(vp + (size_t)(32 * dh) * pitch + 16 * q);
}
__device__ __forceinline__ void mm_qk(f32x16& p0, f32x16& p1, const bf16x8 (&kf)[8], const bf16x8 (&qf)[4]) {
    f32x16 z;
#pragma unroll
    for (int r = 0; r < 16; ++r) z[r] = 0.f;
    p0 = z; p1 = z;
#pragma unroll
    for (int c = 0; c < 4; ++c) { p0 = __builtin_amdgcn_mfma_f32_32x32x16_bf16(kf[2 * c], qf[c], p0, 0, 0, 0); p1 = __builtin_amdgcn_mfma_f32_32x32x16_bf16(kf[2 * c + 1], qf[c], p1, 0, 0, 0); }
}
__device__ __forceinline__ void mm_pv(f32x16 (&o)[2], const bf16x8 (&vf)[8], const f32x16& p0, const f32x16& p1) {
#pragma unroll
    for (int q = 0; q < 4; ++q) { const bf16x8 pf = pack8((q >> 1) ? p1 : p0, q & 1);
#pragma unroll
        for (int dh = 0; dh < 2; ++dh) o[dh] = __builtin_amdgcn_mfma_f32_32x32x16_bf16(vf[2 * q + dh], pf, o[dh], 0, 0, 0); }
}
__device__ __forceinline__ void swa_unit(unsigned char* ws, const LAS float* tabW, const float* sinks, int unit, int lane, bool do_store) {
    const int t0 = (unit & 255) * 32, h = (unit >> 8) & 3, b = unit >> 10, g = h >> 1, hi = lane >> 5, t = t0 + (lane & 31);
    bf16_t* qrow = (bf16_t*)(ws + OFF_Q16) + (((size_t)b * 16 + 12 + h) * S + t) * 64;
    const bf16_t* K = (const bf16_t*)(ws + OFF_WK) + ((size_t)b * 2 + g) * S * 64; const bf16_t* VT = (const bf16_t*)(ws + OFF_WVT) + ((size_t)b * 2 + g) * 64 * S;
    bf16x8 qf[4];
#pragma unroll
    for (int c = 0; c < 4; ++c) qf[c] = *(const bf16x8*)(qrow + 16 * c + 8 * hi);
    const float sink = sinks[h] * LOG2E;
    float m = sink, l = hi == 0 ? 1.f : 0.f;
    f32x16 o[2];
#pragma unroll
    for (int r = 0; r < 16; ++r) { o[0][r] = 0.f; o[1][r] = 0.f; }
    const LAS float* tb = tabW + h * TAB_N;
    const int jlo = t0 >= 127 ? (t0 - 127) >> 6 : 0, jhi = (t0 + 31) >> 6;
    bf16x8 kf[8], vf[8];
    ldk_global(kf, K + (size_t)jlo * 4096, lane);
    for (int j = jlo; j <= jhi; ++j) {
        ldv_global(vf, VT + (size_t)j * 64, S, lane);
        f32x16 p0, p1;
        mm_qk(p0, p1, kf, qf);
        if (j < jhi) ldk_global(kf, K + (size_t)(j + 1) * 4096, lane);
#pragma unroll
        for (int r = 0; r < 16; ++r) { const int d0 = t - (j * 64 + crow(r, hi)); p0[r] += tb[tab_idx(d0)]; p1[r] += tb[tab_idx(d0 - 32)]; }
        softmax_step(p0, p1, m, l, o);
        mm_pv(o, vf, p0, p1);
    }
    l = xhalf_sum(l);
    if (do_store) store_ot(qrow, o, 1.f / l, hi);
}

constexpr float SB_CUT = 64.f;
__device__ __forceinline__ void sb_unit(unsigned char* ws, int unit, int lane, bool do_store) {
    const int t0 = (unit & 255) * 32, h = (unit >> 8) & 3, b = unit >> 10, hi = lane >> 5, t = t0 + (lane & 31);
    bf16_t* qrow = (bf16_t*)(ws + OFF_Q16) + (((size_t)b * 16 + 8 + h) * S + t) * 64;
    const bf16_t* K = (const bf16_t*)(ws + OFF_SBK) + ((size_t)b * 4 + h) * S * 64; const bf16_t* VT = (const bf16_t*)(ws + OFF_SBVT) + ((size_t)b * 4 + h) * 64 * S;
    bf16x8 qf[4];
#pragma unroll
    for (int c = 0; c < 4; ++c) qf[c] = *(const bf16x8*)(qrow + 16 * c + 8 * hi);
    f32x16 o[2];
#pragma unroll
    for (int r = 0; r < 16; ++r) { o[0][r] = 0.f; o[1][r] = 0.f; }
    float carry = 0.f;
    bf16x8 kf[8], vf[8];
    const int jd = (t0 + 31) >> 6;
    ldk_global(kf, K + (size_t)jd * 4096, lane);
    for (int j = jd; j >= 0; --j) {
        f32x16 z0, z1, f0, f1;
        mm_qk(z0, z1, kf, qf);
        if (j > 0) ldk_global(kf, K + (size_t)(j - 1) * 4096, lane);
        float gs[8];
#pragma unroll
        for (int u = 0; u < 8; ++u) gs[u] = 0.f;
        const int kb = j * 64;
#pragma unroll
        for (int r = 0; r < 16; ++r) {
            { const float z = z0[r]; const bool ok = kb + crow(r, hi) < t; const float sp = fmaxf(z, 0.f) + __builtin_amdgcn_logf(1.f + __builtin_amdgcn_exp2f(-fabsf(z))); f0[r] = ok ? -sp : 0.f; gs[r >> 2] += f0[r]; }
            { const float z = z1[r]; const bool ok = kb + 32 + crow(r, hi) < t; const float sp = fmaxf(z, 0.f) + __builtin_amdgcn_logf(1.f + __builtin_amdgcn_exp2f(-fabsf(z))); f1[r] = ok ? -sp : 0.f; gs[4 + (r >> 2)] += f1[r]; }
        }
        ldv_global(vf, VT + (size_t)j * 64, S, lane);
        float T = 0.f, A[8];
#pragma unroll
        for (int u = 7; u >= 0; --u) { const float pg = xhalf_other(gs[u], hi); A[u] = T + (hi == 0 ? pg : 0.f); T += gs[u] + pg; }
#pragma unroll
        for (int u = 0; u < 8; ++u) {
            float run = carry + A[u];
#pragma unroll
            for (int i = 3; i >= 0; --i) {
                const int r = 4 * (u & 3) + i;
                if (u < 4) { const bool ok = kb + crow(r, hi) < t; const float lf = f0[r]; z0[r] = ok ? __builtin_amdgcn_exp2f(z0[r] + lf + run) : 0.f; run += lf; }
                else { const bool ok = kb + 32 + crow(r, hi) < t; const float lf = f1[r]; z1[r] = ok ? __builtin_amdgcn_exp2f(z1[r] + lf + run) : 0.f; run += lf; }
            }
        }
        carry += T;
        mm_pv(o, vf, z0, z1);
        if (__all(carry < -SB_CUT)) break;
    }
    if (do_store) store_ot(qrow, o, 1.f, hi);
}


constexpr int NSA_STAGE = 16384, NSA_IMPG = 32768, NSA_IMPL = 65536, NSA_SEL = 98304;
struct TileSrc { const bf16_t* K; const bf16_t* VT; size_t vpitch; };
__device__ __forceinline__ void nsa_issue(LAS unsigned char* stage, const TileSrc& ts, int j, int tid, int wave) {
    const int row = tid >> 3, chunk = (tid & 7) ^ ((row >> 1) & 7);
    __builtin_amdgcn_global_load_lds((const unsigned*)(ts.K + ((size_t)j * 64 + row) * 64 + chunk * 8), (LAS unsigned*)(stage + wave * 1024), 16, 0, 0);
    __builtin_amdgcn_global_load_lds((const unsigned*)(ts.VT + (size_t)row * ts.vpitch + (size_t)j * 64 + chunk * 8), (LAS unsigned*)(stage + 8192 + wave * 1024), 16, 0, 0);
}
__device__ __forceinline__ void qk_lds(f32x16& p0, f32x16& p1, const LAS unsigned char* Kst, const bf16x8 (&qf)[4], float cinit, int lrow, int swz, int hi) {
    bf16x8 kf[8];
#pragma unroll
    for (int c = 0; c < 4; ++c) { const int off = lrow + (((2 * c + hi) ^ swz) << 4); kf[2 * c] = *(const LAS bf16x8*)(Kst + off); kf[2 * c + 1] = *(const LAS bf16x8*)(Kst + 4096 + off); }
    f32x16 z;
#pragma unroll
    for (int r = 0; r < 16; ++r) z[r] = cinit;
    p0 = z; p1 = z;
    __builtin_amdgcn_sched_barrier(0);
#pragma unroll
    for (int c = 0; c < 4; ++c) {
        p0 = __builtin_amdgcn_mfma_f32_32x32x16_bf16(kf[2 * c], qf[c], p0, 0, 0, 0);
        p1 = __builtin_amdgcn_mfma_f32_32x32x16_bf16(kf[2 * c + 1], qf[c], p1, 0, 0, 0);
    }
}
__device__ __forceinline__ void pv_lds(f32x16 (&o)[2], const LAS unsigned char* Vst, const f32x16& p0, const f32x16& p1, int lrow, int swz, int hi) {
    bf16x8 vf[8];
#pragma unroll
    for (int kh = 0; kh < 2; ++kh)
#pragma unroll
        for (int s = 0; s < 2; ++s) { const int off = lrow + (((4 * kh + 2 * s + hi) ^ swz) << 4);
#pragma unroll
            for (int dh = 0; dh < 2; ++dh) vf[4 * kh + 2 * s + dh] = *(const LAS bf16x8*)(Vst + dh * 4096 + off); }
    bf16x8 pf[4];
#pragma unroll
    for (int kh = 0; kh < 2; ++kh)
#pragma unroll
        for (int s = 0; s < 2; ++s) pf[2 * kh + s] = pack8(kh ? p1 : p0, s);
    __builtin_amdgcn_sched_barrier(0);
#pragma unroll
    for (int q = 0; q < 4; ++q)
#pragma unroll
        for (int dh = 0; dh < 2; ++dh) o[dh] = __builtin_amdgcn_mfma_f32_32x32x16_bf16(vf[2 * q + dh], pf[q], o[dh], 0, 0, 0);
}
__device__ __forceinline__ float quad_sum(float v) {
    v += __int_as_float(__builtin_amdgcn_mov_dpp(__float_as_int(v), 0xB1, 0xf, 0xf, true));
    v += __int_as_float(__builtin_amdgcn_mov_dpp(__float_as_int(v), 0x4E, 0xf, 0xf, true));
    return v;
}
#define NSA_WAITBAR() do { asm volatile("s_waitcnt vmcnt(0) lgkmcnt(0)" ::: "memory"); __builtin_amdgcn_s_barrier(); asm volatile("" ::: "memory"); } while (0)

__device__ __forceinline__ void nsa_unit(LAS unsigned char* lds, const LAS float* tabN, unsigned char* ws, int b, int g, int qt, int tid_in, bool do_store) {
    int tid = tid_in; asm volatile("" : "+v"(tid));
    const int lane = tid & 63, wave = __builtin_amdgcn_readfirstlane(tid >> 6), hi = lane >> 5, col = lane & 31, qi = col >> 2, r = col & 3;
    const int t0 = qt * 64, qloc = 8 * wave + qi, t = t0 + qloc, h = 4 * g + r, grp = b * 2 + g;
    const int lrow = col * 128, swz = (col >> 1) & 7;
    bf16_t* qrow = (bf16_t*)(ws + OFF_Q16) + (((size_t)b * 16 + h) * S + t) * 64;
    bf16x8 qf[4];
#pragma unroll
    for (int c = 0; c < 4; ++c) qf[c] = *(const bf16x8*)(qrow + 16 * c + 8 * hi);
    const LAS float* tb = tabN + h * TAB_N;
    LAS float* impG = (LAS float*)(lds + NSA_IMPG); LAS float* impL = (LAS float*)(lds + NSA_IMPL); LAS unsigned* selm = (LAS unsigned*)(lds + NSA_SEL);
    const float* NG = (const float*)(ws + OFF_NGATE) + (size_t)(b * S + t) * 24;
    f32x16 out[2];
#pragma unroll
    for (int rr = 0; rr < 16; ++rr) { out[0][rr] = 0.f; out[1][rr] = 0.f; }

    {
        TileSrc ts; ts.K = (const bf16_t*)(ws + OFF_KCN) + (size_t)grp * 512 * 64; ts.VT = (const bf16_t*)(ws + OFF_VCT) + (size_t)grp * 64 * 512; ts.vpitch = 512;
        const int nmax = min((t0 + 32) >> 4, 510), nct = (nmax >> 6) + 1;
        float m = -INFINITY, l = 0.f;
        if (tid < 64) impL[tid * 128] = 0.f;
        NSA_WAITBAR();
        nsa_issue(lds, ts, 0, tid, wave);
        for (int i = 0; i < nct; ++i) {
            NSA_WAITBAR();
            if (i + 1 < nct) nsa_issue(lds + ((i + 1) & 1) * NSA_STAGE, ts, i + 1, tid, wave);
            const LAS unsigned char* st = lds + (i & 1) * NSA_STAGE;
            f32x16 p0, p1;
            qk_lds(p0, p1, st, qf, 0.f, lrow, swz, hi);
            float mx = -INFINITY;
#pragma unroll
            for (int rr = 0; rr < 16; ++rr) { const int dc = t - 16 * (i * 64 + crow(rr, hi)) - 31; p0[rr] += tb[tab_idx(dc)]; p1[rr] += tb[tab_idx(dc - 512)]; mx = fmaxf(mx, fmaxf(p0[rr], p1[rr])); }
            mx = xhalf_max(mx);
            const float mn = fmaxf(m, mx), ms = (mn == -INFINITY) ? 0.f : mn;
            float sum = 0.f;
#pragma unroll
            for (int rr = 0; rr < 16; ++rr) sum += __builtin_amdgcn_exp2f(p0[rr] - ms) + __builtin_amdgcn_exp2f(p1[rr] - ms);
            l = l * __builtin_amdgcn_exp2f(m - ms) + sum; m = mn;
        }
        l = xhalf_sum(l);
        const float ms = (m == -INFINITY) ? 0.f : m, il = l > 0.f ? 1.f / l : 0.f;
        f32x16 o[2];
#pragma unroll
        for (int rr = 0; rr < 16; ++rr) { o[0][rr] = 0.f; o[1][rr] = 0.f; }
        NSA_WAITBAR();
        nsa_issue(lds, ts, 0, tid, wave);
        for (int i = 0; i < nct; ++i) {
            NSA_WAITBAR();
            if (i + 1 < nct) nsa_issue(lds + ((i + 1) & 1) * NSA_STAGE, ts, i + 1, tid, wave);
            const LAS unsigned char* st = lds + (i & 1) * NSA_STAGE;
            f32x16 p0, p1;
            qk_lds(p0, p1, st, qf, 0.f, lrow, swz, hi);
#pragma unroll
            for (int rr = 0; rr < 16; ++rr) { const int dc = t - 16 * (i * 64 + crow(rr, hi)) - 31;
                p0[rr] = __builtin_amdgcn_exp2f(p0[rr] + tb[tab_idx(dc)] - ms) * il; p1[rr] = __builtin_amdgcn_exp2f(p1[rr] + tb[tab_idx(dc - 512)] - ms) * il; }
#pragma unroll
            for (int u = 0; u < 8; ++u) {
                const f32x16& pp = u < 4 ? p0 : p1; const int r0 = 4 * (u & 3);
                const float G = quad_sum((pp[r0] + pp[r0 + 1]) + (pp[r0 + 2] + pp[r0 + 3])), L = quad_sum(pp[r0 + 3]);
                const int j = 16 * i + 8 * (u >> 2) + 2 * (u & 3) + hi;
                if (r == 0) { impG[qloc * 128 + j] = G; if (j + 1 < 128) impL[qloc * 128 + j + 1] = L; }
            }
            pv_lds(o, st + 8192, p0, p1, lrow, swz, hi);
        }
        const float gc = NG[h];
#pragma unroll
        for (int rr = 0; rr < 16; ++rr) { out[0][rr] += gc * o[0][rr]; out[1][rr] += gc * o[1][rr]; }
    }
    NSA_WAITBAR();
    {
        int tid2 = tid_in; asm volatile("" : "+v"(tid2));
        const int q = tid2 >> 3, sub = tid2 & 7;
        unsigned mw[4] = {0u, 0u, 0u, 0u};
        if (qt <= 15) { if (sub == 0) mw[0] = (qt == 31) ? 0xffffffffu : ((2u << qt) - 1u); }
        else {
            unsigned vb[16];
#pragma unroll
            for (int i = 0; i < 16; ++i) { const int j = sub + 8 * i; const bool cand = j >= 1 && j <= qt - 2; vb[i] = cand ? __float_as_uint(impG[q * 128 + j] + impL[q * 128 + j]) + 1u : 0u; }
            unsigned T = 0u;
#pragma unroll 1
            for (int bit = 30; bit >= 0; --bit) {
                const unsigned trial = T | (1u << bit); unsigned c = 0u;
#pragma unroll
                for (int i = 0; i < 16; ++i) c += vb[i] >= trial ? 1u : 0u;
                c += swz_xor_u<1>(c); c += swz_xor_u<2>(c); c += swz_xor_u<4>(c);
                if (c >= 13u) T = trial;
            }
            unsigned cge = 0u;
#pragma unroll
            for (int i = 0; i < 16; ++i) cge += vb[i] >= T ? 1u : 0u;
            cge += swz_xor_u<1>(cge); cge += swz_xor_u<2>(cge); cge += swz_xor_u<4>(cge);
            if (cge == 13u) {
#pragma unroll
                for (int i = 0; i < 16; ++i) { const int j = sub + 8 * i; if (vb[i] >= T && vb[i] != 0u) mw[j >> 5] |= 1u << (j & 31); }
            } else {
                for (int i = 0; i < 16; ++i) { const int j = sub + 8 * i; if (vb[i] == 0u) continue; int rk = 0;
                    for (int kk = 1; kk <= qt - 2; ++kk) { const unsigned vk = __float_as_uint(impG[q * 128 + kk] + impL[q * 128 + kk]) + 1u; rk += (vk > vb[i]) || (vk == vb[i] && kk < j); }
                    if (rk < 13) mw[j >> 5] |= 1u << (j & 31); }
            }
            if (sub == 0) mw[0] |= 1u;
#pragma unroll
            for (int i = 0; i < 16; ++i) { const int j = sub + 8 * i; if (j == qt || j == qt - 1) mw[j >> 5] |= 1u << (j & 31); }
        }
#pragma unroll
        for (int wd = 0; wd < 4; ++wd) { unsigned x = mw[wd]; x |= swz_xor_u<1>(x); x |= swz_xor_u<2>(x); x |= swz_xor_u<4>(x); if (sub == 0) selm[q * 4 + wd] = x; }
    }
    NSA_WAITBAR();
    unsigned sm0 = selm[qloc * 4 + 0], sm1 = selm[qloc * 4 + 1], sm2 = selm[qloc * 4 + 2], sm3 = selm[qloc * 4 + 3];
    {
        TileSrc ts; ts.K = (const bf16_t*)(ws + OFF_KSLC) + (size_t)grp * S * 64; ts.VT = (const bf16_t*)(ws + OFF_VSLCT) + (size_t)grp * 64 * S; ts.vpitch = S;
        float m = 0.f, l = 0.f;
        f32x16 o[2];
#pragma unroll
        for (int rr = 0; rr < 16; ++rr) { o[0][rr] = 0.f; o[1][rr] = 0.f; }
        nsa_issue(lds, ts, 0, tid, wave);
        for (int j = 0; j <= qt; ++j) {
            NSA_WAITBAR();
            if (j + 1 <= qt) nsa_issue(lds + ((j + 1) & 1) * NSA_STAGE, ts, j + 1, tid, wave);
            const LAS unsigned char* st = lds + (j & 1) * NSA_STAGE;
            const unsigned mword = j < 32 ? sm0 : j < 64 ? sm1 : j < 96 ? sm2 : sm3;
            const bool selb = (mword >> (j & 31)) & 1u;
            if (!__any(selb)) continue;
            const float cinit = selb ? -m : -INFINITY;
            f32x16 p0, p1;
            qk_lds(p0, p1, st, qf, cinit, lrow, swz, hi);
            if (j >= qt - 2) {
#pragma unroll
                for (int rr = 0; rr < 16; ++rr) { const int d0 = t - (j * 64 + crow(rr, hi)); p0[rr] += tb[tab_idx(d0)]; p1[rr] += tb[tab_idx(d0 - 32)]; }
            }
            softmax_rel(p0, p1, m, l, o, j == 0);
            pv_lds(o, st + 8192, p0, p1, lrow, swz, hi);
        }
        l = xhalf_sum(l);
        const float gs = NG[8 + h] / l;
#pragma unroll
        for (int rr = 0; rr < 16; ++rr) { out[0][rr] += gs * o[0][rr]; out[1][rr] += gs * o[1][rr]; }
    }
    {
        TileSrc ts; ts.K = (const bf16_t*)(ws + OFF_KWIN) + (size_t)grp * S * 64; ts.VT = (const bf16_t*)(ws + OFF_VWINT) + (size_t)grp * 64 * S; ts.vpitch = S;
        float m = 0.f, l = 0.f;
        f32x16 o[2];
#pragma unroll
        for (int rr = 0; rr < 16; ++rr) { o[0][rr] = 0.f; o[1][rr] = 0.f; }
        const int j0 = qt >= 8 ? qt - 8 : 0, nt = qt - j0 + 1;
        NSA_WAITBAR();
        nsa_issue(lds, ts, j0, tid, wave);
        for (int i = 0; i < nt; ++i) {
            const int j = j0 + i;
            NSA_WAITBAR();
            if (i + 1 < nt) nsa_issue(lds + ((i + 1) & 1) * NSA_STAGE, ts, j + 1, tid, wave);
            const LAS unsigned char* st = lds + (i & 1) * NSA_STAGE;
            f32x16 p0, p1;
            qk_lds(p0, p1, st, qf, -m, lrow, swz, hi);
            if (j >= qt - 2) {
#pragma unroll
                for (int rr = 0; rr < 16; ++rr) { const int d0 = t - (j * 64 + crow(rr, hi)); p0[rr] += tb[tab_idx(d0)]; p1[rr] += tb[tab_idx(d0 - 32)]; }
            } else if (j == qt - 8) {
#pragma unroll
                for (int rr = 0; rr < 16; ++rr) { const int d0 = t - (j * 64 + crow(rr, hi)); if (d0 >= 512) p0[rr] = -INFINITY; if (d0 - 32 >= 512) p1[rr] = -INFINITY; }
            }
            softmax_rel(p0, p1, m, l, o, i == 0);
            pv_lds(o, st + 8192, p0, p1, lrow, swz, hi);
        }
        l = xhalf_sum(l);
        const float gw = NG[16 + h] / l;
#pragma unroll
        for (int rr = 0; rr < 16; ++rr) { out[0][rr] += gw * o[0][rr]; out[1][rr] += gw * o[1][rr]; }
    }
    if (do_store) store_ot(qrow, out, 1.f, hi);
    NSA_WAITBAR();
}


#define XB_TMO      128
#define XB_XCNT(j)  (256  + 64 * (j))
#define XB_XSUB(j)  (1280 + 64 * (j))
#define XB_XGEN(j)  (2304 + 64 * (j))
#define XB_TOP      3328
#define XB_TOPGEN   3392
#define XCD_BAR_WORDS 3456
#define XB_SPIN_CAP (1u << 18)
constexpr size_t CTL_ZERO_BYTES = 65536, CTL_BAR_OFF = 16384;
constexpr int LDS_XB_OFF = 131072 + 8192;
__device__ __forceinline__ unsigned xb_ld(unsigned* p)              { return __hip_atomic_load(p, __ATOMIC_RELAXED, __HIP_MEMORY_SCOPE_AGENT); }
__device__ __forceinline__ unsigned xb_add(unsigned* p, unsigned v) { return __hip_atomic_fetch_add(p, v, __ATOMIC_RELAXED, __HIP_MEMORY_SCOPE_AGENT); }
__device__ __forceinline__ unsigned xb_xcc_id() { return (unsigned)__builtin_amdgcn_s_getreg((3 << 11) | 20) & 0xFu; }
#define XB_SPIN(cond, bar) do { unsigned _sp = 0; while (cond) { __builtin_amdgcn_s_sleep(1); \
    if ((++_sp & 255u) == 0u) { if (xb_ld(&(bar)[XB_TMO])) break; if (_sp > XB_SPIN_CAP) { atomicAdd(&(bar)[XB_TMO], 1u); break; } } } } while (0)
__device__ __forceinline__ void xcd_barrier_complete(unsigned* bar, unsigned x, unsigned G, unsigned& nloc, unsigned& nx) {
    unsigned sum, cnt, mine, sp = 0u;
    for (;;) {
        sum = 0u; cnt = 0u; mine = 0u;
#pragma unroll
        for (unsigned j = 0; j < 16; ++j) { const unsigned c = xb_ld(&bar[XB_XCNT(j)]); sum += c; cnt += (c > 0u) ? 1u : 0u; mine = (j == x) ? c : mine; }
        if (sum == G) break;
        __builtin_amdgcn_s_sleep(1);
        if ((++sp & 255u) == 0u) { if (xb_ld(&bar[XB_TMO])) break; if (sp > XB_SPIN_CAP) { atomicAdd(&bar[XB_TMO], 1u); break; } }
    }
    nloc = mine > 0u ? mine : 1u; nx = cnt > 0u ? cnt : 1u;
}
__device__ __forceinline__ void xcd_barrier(unsigned* bar, volatile LAS unsigned* st, unsigned G, bool leader) {
    asm volatile("s_waitcnt vmcnt(0)" ::: "memory");
    __syncthreads();
    if (leader) {
        const unsigned x = xb_xcc_id();
        __builtin_amdgcn_s_waitcnt(0);
        unsigned nloc = st[0], nx = st[1];
        if (nloc == 0u) { xcd_barrier_complete(bar, x, G, nloc, nx); st[0] = nloc; st[1] = nx; }
        const unsigned old = xb_add(&bar[XB_XSUB(x)], 1u);
        const unsigned gen = old / nloc;
        if (old + 1u == (gen + 1u) * nloc) {
            __builtin_amdgcn_fence(__ATOMIC_RELEASE, "agent");
            asm volatile("s_waitcnt vmcnt(0)" ::: "memory");
            const unsigned og = xb_add(&bar[XB_TOP], 1u);
            const unsigned tg = og / nx;
            if (og + 1u == (tg + 1u) * nx) xb_add(&bar[XB_TOPGEN], 1u);
            else XB_SPIN(xb_ld(&bar[XB_TOPGEN]) == tg, bar);
            __builtin_amdgcn_fence(__ATOMIC_ACQUIRE, "agent");
            xb_add(&bar[XB_XGEN(x)], 1u);
            asm volatile("s_waitcnt vmcnt(0)" ::: "memory");
        } else {
            XB_SPIN(xb_ld(&bar[XB_XGEN(x)]) == gen, bar);
            __builtin_amdgcn_fence(__ATOMIC_ACQUIRE, "agent");
            asm volatile("s_waitcnt vmcnt(0)" ::: "memory");
        }
    }
    __syncthreads();
}

struct Params { const float* in[26]; float* out; unsigned char* ws; };
constexpr int LDS_BYTES = 147456;
__device__ __forceinline__ const float* inptr(const Params& p, int i) { asm volatile("" : "+s"(i)); return p.in[i]; }
#define PH_BEGIN(lexpr) int lq = (lexpr); asm volatile("" : "+s"(lq)); unsigned char* ws = p.ws; asm volatile("" : "+s"(ws)); float* X = p.out; asm volatile("" : "+s"(X)); \
    bf16_t* XB = (bf16_t*)(ws + OFF_XB); float* SSQ = (float*)(ws + OFF_SSQ); (void)XB; (void)SSQ; (void)X; (void)lq
#define IN(i) inptr(p, i)
#define CCX() ConvCtx{ldsr, nullptr, 0, (int)gridDim.x * 8, MYTID()}
#define CCS(b0) ConvCtx{ldsr, nullptr, (b0), ((int)gridDim.x - (b0)) * 8, MYTID()}
#define CCS(b0) ConvCtx{ldsr, nullptr, (b0), ((int)gridDim.x - (b0)) * 8, MYTID()}
#define FFN_SRC(l, base) IN(base) + (size_t)(l) * D, IN((base) + 1) + (size_t)(l) * D * F, IN((base) + 2) + (size_t)(l) * D * F, IN((base) + 3) + (size_t)(l) * F * D
__device__ __forceinline__ MixW mixw_of(const Params& p, int l) { MixW w; w.mixn = IN(6) + (size_t)l * D; w.win = IN(7) + (size_t)l * D * DIN; w.w1k = IN(11) + (size_t)l * 2048 * 256; w.w1v = IN(13) + (size_t)l * 2048 * 256;
    w.ua = IN(18) + (size_t)l * 512 * D; w.ub = IN(19) + (size_t)l * 256 * D; w.uc = IN(20) + (size_t)l * 256 * D; w.wo = IN(21) + (size_t)l * D * D; w.pos = IN(10) + (size_t)l * 2048; w.w2k = IN(12) + (size_t)l * 256 * 64; w.w2v = IN(14) + (size_t)l * 256 * 64; return w; }

__global__ void __launch_bounds__(512) mega_fwd(Params p) {
    extern __shared__ __attribute__((aligned(16))) char lds_base[];
    cg::grid_group grid = cg::this_grid();
    LAS unsigned char* ldsr = (LAS unsigned char*)lds_base;
    const int wave_s = __builtin_amdgcn_readfirstlane(threadIdx.x >> 6);
    const int G_ = gridDim.x, bid = blockIdx.x;
    unsigned long long ts_t0 = 0, ts_acc = 0; (void)ts_t0; int ts_inst = 0; (void)ts_inst;
    if (threadIdx.x == 0) { volatile LAS unsigned* st_ = (volatile LAS unsigned*)(ldsr + LDS_XB_OFF); st_[0] = 0u; st_[1] = 0u;
        (void)xb_add((unsigned*)(p.ws + OFF_CTL + CTL_BAR_OFF) + XB_XCNT(xb_xcc_id()), 1u); }
    __syncthreads();
#define GSYNC_CG() do { TS_B(27); grid.sync(); TS_E(27); } while (0)
#define GSYNC(id) do { if (PROBE == 40) { unsigned char* wsb2_ = p.ws; asm volatile("" : "+s"(wsb2_)); xcd_barrier((unsigned*)(wsb2_ + OFF_CTL + CTL_BAR_OFF), (volatile LAS unsigned*)(ldsr + LDS_XB_OFF), (unsigned)G_, MYTID() == 0); } TS_B(27); TS_B(100 + (id)); { unsigned char* wsb_ = p.ws; asm volatile("" : "+s"(wsb_)); xcd_barrier((unsigned*)(wsb_ + OFF_CTL + CTL_BAR_OFF), (volatile LAS unsigned*)(ldsr + LDS_XB_OFF), (unsigned)G_, MYTID() == 0); } TS_E(27); TS_E(100 + (id)); } while (0)
    REP(9) {
        PH_BEGIN(0);
        TS_B(21); conv_ffn(CCX(), FFN_SRC(lq, 2), ws + OFF_FFN1W); __syncthreads(); TS_E(21);
        TS_B(23); ph_prep(MYTID(), IN(0), XB, SSQ); __syncthreads(); TS_E(23);
        GSYNC_CG();
    }
#pragma unroll 1
    for (int l = 0; l < 2; ++l) {
#pragma unroll 1
        for (int f = 0; f < 2; ++f) {
            ts_inst = l * 2 + f;
            if (f == 1) {
                REP(3) {
                    PH_BEGIN(l);
                    pg8::Ops g; g.A = (const char*)XB; g.Bt = (const char*)(ws + OFF_BT_IN); g.lda_b = D * 2; g.ldb_b = D * 2; g.a_kstep = 128; g.nt = D / 64; g.a_mode = 0;
                    pg8::StaticOrder so; so.init(M, 5888, G_, bid);
                    pg8::EpiWin E{ws, SSQ, IN(8) + lq * 64, IN(9) + lq * 64, IN(15) + lq * 64, IN(16) + lq * 64};
                    TS_B(25); pg8::gemm_phase(ldsr, MYTID(), g, so, E); TS_E(25);
                    GSYNC(2);
                }
                {
                    PH_BEGIN(l);
                    if (bid < 16) {
                        pg8::Ops g; g.A = (const char*)(ws + OFF_KCMP); g.Bt = (const char*)(ws + OFF_BT_C1); g.lda_b = 2048; g.ldb_b = 4096; g.a_kstep = 128; g.nt = 32; g.a_mode = 2;
                        pg8::StaticOrder so; so.init(2048, 512, G_, bid);
                        pg8::EpiCmp1 E{(float*)(ws + OFF_HID), (const float*)(ws + OFF_BIASC)};
                        TS_B(29); pg8::gemm_phase(ldsr, MYTID(), g, so, E); TS_E(29);
                    } else {
                        LAS float* tabs = (LAS float*)(ldsr + 131072);
                        build_tabs(tabs, IN(1), MYTID());
                        __syncthreads();
                        int t_ = MYTID(); asm volatile("" : "+v"(t_));
                        const int lane_ = t_ & 63, gw_ = (bid - 16) * 8 + __builtin_amdgcn_readfirstlane(t_ >> 6), ngw_ = (G_ - 16) * 8;
                        REP(6) {
                            for (int u = gw_; u < 4096; u += ngw_) {
                                if (u < 2048) sb_unit(ws, u, lane_, LASTREP(6));
                                else swa_unit(ws, tabs + 8 * TAB_N, IN(17) + lq * 4, u - 2048, lane_, LASTREP(6));
                            }
                        }
                    }
                }
                GSYNC(3);
                {
                    PH_BEGIN(l);
                    int t_ = MYTID(); asm volatile("" : "+v"(t_));
                    const int lane_ = t_ & 63, gw_ = bid * 8 + __builtin_amdgcn_readfirstlane(t_ >> 6);
                    TS_B(30);
                    for (int u = gw_; u < 128; u += G_ * 8) cmp2_unit(ws, IN(9) + lq * 64, u, lane_);
                    TS_E(30);
                }
                GSYNC(4);
                {
                    PH_BEGIN(l);
                    LAS float* tabs = (LAS float*)(ldsr + 131072);
                    build_tabs(tabs, IN(1), MYTID());
                    __syncthreads();
                    int t_ = MYTID(); asm volatile("" : "+v"(t_));
                    TS_B(32);
                    REP(5) {
                        for (int ps = bid; ps < 256; ps += G_) {
                            const int bg = (ps & 7) >> 1, i = (ps & 1) * 32 + (ps >> 3);
#pragma unroll 1
                            for (int k2 = 0; k2 < 2; ++k2) nsa_unit(ldsr, tabs, ws, bg >> 1, bg & 1, k2 ? 127 - i : i, t_, LASTREP(5));
                        }
                    }
                    TS_E(32);
                }
                GSYNC(5);
                REP(7) {
                    PH_BEGIN(l);
                    if (lq == 0) { TS_B(21); conv_ffn(CCX(), FFN_SRC(0, 22), ws + OFF_FFN2W); __syncthreads(); TS_E(21); }
                    bf16_t* GATES = (bf16_t*)(ws + OFF_A);
                    pg8::Ops g; g.A = (const char*)(ws + OFF_Q16); g.Bt = (const char*)(ws + OFF_BT_M); g.lda_b = 128; g.ldb_b = D * 2; g.a_kstep = (size_t)S * 128; g.nt = 16; g.a_mode = 1;
                    pg8::StaticOrder so; so.init(M, D, G_, bid);
                    pg8::EpiMerge E{GATES, GATES + (size_t)M * D, GATES + (size_t)2 * M * D, (bf16_t*)(ws + OFF_MERGED)};
                    TS_B(28); pg8::gemm_phase(ldsr, MYTID(), g, so, E); TS_E(28);
                    GSYNC(6);
                }
                REP(8) {
                    PH_BEGIN(l);
                    if (lq == 0) { TS_B(21); conv_ffn(CCX(), FFN_SRC(1, 2), ws + OFF_FFN1W); __syncthreads(); TS_E(21); }
                    pg8::Ops g; g.A = (const char*)(ws + OFF_MERGED); g.Bt = (const char*)(ws + OFF_BT_O); g.lda_b = D * 2; g.ldb_b = D * 2; g.a_kstep = 128; g.nt = 16; g.a_mode = 0;
                    pg8::StaticOrder so; so.init(M, D, G_, bid);
                    pg8::EpiResid E{X, X, XB, SSQ, LASTREP(8) ? 1.0f : 0.f};
                    TS_B(26); pg8::gemm_phase(ldsr, MYTID(), g, so, E); TS_E(26);
                    GSYNC(7);
                }
            }
            REP(1) {
                PH_BEGIN(l);
                int fq_ = f; asm volatile("" : "+s"(fq_));
                unsigned char* wbase = ws + (fq_ == 0 ? OFF_FFN1W : OFF_FFN2W);
                {
                    const int b0 = (1408 - 5 * G_ > 0 && 1408 - 5 * G_ < G_) ? 1408 - 5 * G_ : 0;
                    if (bid >= b0) {
                        const int inst = lq * 2 + fq_;
                        TS_B(22);
                        if (inst == 0) conv_mix(CCS(b0), mixw_of(p, 0), ws);
                        else if (inst == 1) conv_mix(CCS(b0), mixw_of(p, 1), ws);
                        else if (inst == 2) conv_ffn(CCS(b0), FFN_SRC(1, 22), ws + OFF_FFN2W);
                        __syncthreads(); TS_E(22);
                    }
                }
                pg8::Ops g; g.A = (const char*)XB; g.Bt = (const char*)wbase; g.lda_b = D * 2; g.ldb_b = D * 2; g.a_kstep = 128; g.nt = 16; g.a_mode = 0;
                pg8::StaticOrder so; so.init(M, 2 * F, G_, bid);
                pg8::EpiFfnUp E{(bf16_t*)(ws + OFF_A), SSQ};
                TS_B(24); pg8::gemm_phase(ldsr, MYTID(), g, so, E); TS_E(24);
                GSYNC(8);
            }
            REP(2) {
                PH_BEGIN(l);
                int fq_ = f; asm volatile("" : "+s"(fq_));
                unsigned char* wbase = ws + (fq_ == 0 ? OFF_FFN1W : OFF_FFN2W);
                pg8::Ops g; g.A = (const char*)(ws + OFF_A); g.Bt = (const char*)(wbase + FFNW_D); g.lda_b = F * 2; g.ldb_b = F * 2; g.a_kstep = 128; g.nt = F / 64; g.a_mode = 0;
                pg8::StaticOrder so; so.init(M, D, G_, bid);
                pg8::EpiResid E{(lq == 0 && fq_ == 0) ? IN(0) : (const float*)X, X, XB, SSQ, LASTREP(2) ? 0.5f : 0.f};
                TS_B(31); pg8::gemm_phase(ldsr, MYTID(), g, so, E); TS_E(31);
                if (!(l == 1 && f == 1)) GSYNC(9);
            }
        }
    }
#ifdef TSPMAX
    if (TSP != 0) {
        unsigned* mx_ = (unsigned*)(p.ws + OFF_CTL) + 8192;
        if (MYTID() == 0) atomicMax(mx_, (unsigned)ts_acc);
        xcd_barrier((unsigned*)(p.ws + OFF_CTL + CTL_BAR_OFF), (volatile LAS unsigned*)(ldsr + LDS_XB_OFF), (unsigned)G_, MYTID() == 0);
        if (bid == 0) { const unsigned long long mxv = __hip_atomic_load(mx_, __ATOMIC_RELAXED, __HIP_MEMORY_SCOPE_AGENT); const unsigned long long te = __builtin_amdgcn_s_memrealtime(); while (__builtin_amdgcn_s_memrealtime() - te < 10ull * mxv) __builtin_amdgcn_s_sleep(8); }
    }
#else
    if (TSP != 0 && bid == 0) { const unsigned long long te = __builtin_amdgcn_s_memrealtime(); while (__builtin_amdgcn_s_memrealtime() - te < 10ull * ts_acc) __builtin_amdgcn_s_sleep(8); }
#endif
}

extern "C" void kernel_launch(void* const* d_in, const int* in_sizes, int n_in, void* d_out, int out_size, void* d_ws, size_t ws_size, hipStream_t stream) {
    static int grid_blocks = 0;
    if (grid_blocks == 0) {
        if (ws_size < WS_END || n_in != 26) { fprintf(stderr, "kernel_launch: bad sizes (ws %zu)\n", ws_size); grid_blocks = -1; return; }
        int dev = 0, cus = 0, per_cu = 0;
        (void)hipGetDevice(&dev); (void)hipDeviceGetAttribute(&cus, hipDeviceAttributeMultiprocessorCount, dev);
        (void)hipFuncSetAttribute((const void*)mega_fwd, hipFuncAttributeMaxDynamicSharedMemorySize, LDS_BYTES);
        (void)hipOccupancyMaxActiveBlocksPerMultiprocessor(&per_cu, (const void*)mega_fwd, 512, LDS_BYTES);
        if (per_cu < 1) { fprintf(stderr, "kernel_launch: occupancy query says %d\n", per_cu); per_cu = 1; }
        grid_blocks = cus * (per_cu > 1 ? 1 : per_cu);
        (void)hipGetLastError();
    }
    if (grid_blocks < 0) return;
    if (hipMemsetAsync((char*)d_ws + OFF_CTL, 0, CTL_ZERO_BYTES, stream) != hipSuccess) { fprintf(stderr, "kernel_launch: memset failed\n"); return; }
    Params p{}; for (int i = 0; i < 26; ++i) p.in[i] = (const float*)d_in[i]; p.out = (float*)d_out; p.ws = (unsigned char*)d_ws;
    void* args[] = {&p};
    hipError_t e = hipLaunchCooperativeKernel((void*)mega_fwd, dim3(grid_blocks), dim3(512), args, LDS_BYTES, stream);
    if (e != hipSuccess) fprintf(stderr, "cooperative launch failed: %s (grid %d)\n", hipGetErrorString(e), grid_blocks);
}
```

```cpp
#include <hip/hip_runtime.h>
#include <hip/hip_cooperative_groups.h>
#include <stdint.h>
#include <cstdio>
namespace cg = cooperative_groups;
#ifndef PROBE
#define PROBE 0
#endif
#ifndef TSP
#define TSP 0
#endif
#ifndef TSF
#define TSF -1
#endif
#define TS_B(k) if (TSP == (k) && (TSF < 0 || TSF == ts_inst)) { ts_t0 = __builtin_amdgcn_s_memrealtime(); }
#define TS_E(k) if (TSP == (k) && (TSF < 0 || TSF == ts_inst)) { ts_acc += __builtin_amdgcn_s_memrealtime() - ts_t0; }
#define REP(k) for (int rep_ = 0; rep_ < (PROBE == (k) ? 2 : 1); ++rep_)
#define LASTREP(k) (rep_ == (PROBE == (k) ? 1 : 0))
__device__ __forceinline__ int lane_id() { int r; asm volatile("v_mbcnt_lo_u32_b32 %0, -1, 0\n\tv_mbcnt_hi_u32_b32 %0, -1, %0" : "=v"(r)); return r; }
#define MYTID() (wave_s * 64 + lane_id())
#define VB_SETUP int tidx_ = tid_in; asm volatile("" : "+v"(tidx_)); const int tid = tidx_ & 255, vhalf = tidx_ >> 8; const int vb0 = blockIdx.x * 2 + vhalf, nvb = gridDim.x * 2; char* lds = lds_base + vhalf * 32768; (void)tid; (void)lds; (void)vb0; (void)nvb
#define LAS __attribute__((address_space(3)))

typedef unsigned short bf16_t;
typedef short bf16x8 __attribute__((ext_vector_type(8)));
typedef float f32x4 __attribute__((ext_vector_type(4)));
typedef unsigned u32x4 __attribute__((ext_vector_type(4)));
__device__ __forceinline__ float bf2f(bf16_t v) { return __uint_as_float(((unsigned)v) << 16); }
__device__ __forceinline__ bf16_t f2bf(float f) { unsigned u = __float_as_uint(f); return (bf16_t)((u + 0x7fffu + ((u >> 16) & 1u)) >> 16); }
typedef float f32x2_t __attribute__((ext_vector_type(2))); typedef __bf16 bf16x2_t __attribute__((ext_vector_type(2)));
__device__ __forceinline__ unsigned pk2(float lo, float hi) { f32x2_t v = {lo, hi}; bf16x2_t b = __builtin_convertvector(v, bf16x2_t); return __builtin_bit_cast(unsigned, b); }

__host__ __device__ __forceinline__ int vperm16(int k) { return 8 * ((k >> 2) & 1) + 4 * (k >> 3) + (k & 3); }
__device__ __forceinline__ size_t vt_pos(int s) { return (size_t)((s & ~15) + vperm16(s & 15)); }
constexpr int NB = 2, S = 8192, M = NB * S, D = 1024, F = 2816, HD = 64, DIN = 5656;
constexpr int NCMP = 511, NSLC = 128;
constexpr float LOG2E = 1.4426950408889634f;
constexpr float C2 = 0.125f * LOG2E;
constexpr float EPS = 1e-6f;

constexpr size_t MiB = 1u << 20;
constexpr size_t OFF_CTL = 0;
constexpr size_t OFF_SSQ = 1 * MiB;
constexpr size_t OFF_XB = 2 * MiB;
constexpr size_t OFF_A = 34 * MiB;
constexpr size_t OFF_MIXW = 130 * MiB;
constexpr size_t OFF_BT_IN = OFF_MIXW, OFF_BT_C1 = OFF_MIXW + 12 * MiB, OFF_BT_M = OFF_MIXW + 14 * MiB, OFF_BT_O = OFF_MIXW + 16 * MiB;
constexpr size_t OFF_W2T = OFF_MIXW + 11 * MiB + 768 * 1024;
constexpr size_t OFF_Q16 = 148 * MiB;
constexpr size_t OFF_KV = 180 * MiB;
constexpr size_t KV2 = 4 * MiB, KV4 = 8 * MiB;
constexpr size_t OFF_KCMP = OFF_KV, OFF_VCMP = OFF_KCMP + KV2, OFF_KSLC = OFF_VCMP + KV2, OFF_VSLCT = OFF_KSLC + KV2,
                 OFF_KWIN = OFF_VSLCT + KV2, OFF_VWINT = OFF_KWIN + KV2, OFF_WK = OFF_VWINT + KV2, OFF_WVT = OFF_WK + KV2,
                 OFF_SBK = OFF_WVT + KV2, OFF_SBVT = OFF_SBK + KV4;
constexpr size_t OFF_MERGED = OFF_KV;
constexpr size_t OFF_FFN1W = OFF_Q16, OFF_FFN2W = 237 * MiB;
constexpr size_t FFNW_D = 11 * MiB;
constexpr size_t OFF_SMALL = 229 * MiB;
constexpr size_t OFF_NGATE = OFF_SMALL;
constexpr size_t OFF_KCN = OFF_NGATE + 2 * MiB;
constexpr size_t OFF_VCT = OFF_KCN + MiB / 4;
constexpr size_t OFF_HID = OFF_VCT + MiB / 4;
constexpr size_t OFF_BIASC = OFF_HID + 4 * MiB;
constexpr size_t WS_END = OFF_FFN2W + 17 * MiB;
static_assert(OFF_SBVT + KV4 <= OFF_SMALL && OFF_BIASC + MiB <= OFF_FFN2W, "ws map");

__device__ const unsigned char T5B[128] = {
    0, 1, 2, 3, 4, 5, 6, 7, 8, 9, 10, 11, 12, 13, 14, 15, 16, 16, 16, 17, 17, 18, 18, 18, 19, 19, 19, 20, 20, 20, 20, 21, 21, 21, 21, 22, 22, 22, 22, 22, 23, 23, 23, 23, 23, 23, 24, 24, 24, 24, 24, 24, 25, 25, 25, 25, 25, 25, 25, 26, 26, 26, 26, 26, 26, 26, 26, 27, 27, 27, 27, 27, 27, 27, 27, 27, 27, 28, 28, 28, 28, 28, 28, 28, 28, 28, 28, 29, 29, 29, 29, 29, 29, 29, 29, 29, 29, 29, 29, 30, 30, 30, 30, 30, 30, 30, 30, 30, 30, 30, 30, 30, 30, 31, 31, 31, 31, 31, 31, 31, 31, 31, 31, 31, 31, 31, 31, 31};
__device__ __forceinline__ int t5b(int dist) { return dist >= 128 ? 31 : (int)T5B[dist < 0 ? 0 : dist]; }

template <int K> __device__ __forceinline__ float swz_xor(float v) { return __int_as_float(__builtin_amdgcn_ds_swizzle(__float_as_int(v), (K << 10) | 0x1f)); }
template <int K> __device__ __forceinline__ unsigned swz_xor_u(unsigned v) { return (unsigned)__builtin_amdgcn_ds_swizzle((int)v, (K << 10) | 0x1f); }
__device__ __forceinline__ float xhalf_sum(float v) { auto rr = __builtin_amdgcn_permlane32_swap(__float_as_uint(v), __float_as_uint(v), false, false); return __uint_as_float(rr[0]) + __uint_as_float(rr[1]); }
__device__ __forceinline__ float xhalf_max(float v) { auto rr = __builtin_amdgcn_permlane32_swap(__float_as_uint(v), __float_as_uint(v), false, false); return fmaxf(__uint_as_float(rr[0]), __uint_as_float(rr[1])); }
__device__ __forceinline__ float xhalf_other(float v, int hi) { auto rr = __builtin_amdgcn_permlane32_swap(__float_as_uint(v), __float_as_uint(v), false, false); return __uint_as_float(hi ? rr[0] : rr[1]); }
__device__ __forceinline__ float wave_sum(float v) {
    v += swz_xor<1>(v); v += swz_xor<2>(v); v += swz_xor<4>(v); v += swz_xor<8>(v); v += swz_xor<16>(v);
    return xhalf_sum(v);
}
__device__ __forceinline__ float sigmoidf_(float x) { return 1.f / (1.f + __expf(-x)); }
__device__ __forceinline__ float siluf_(float x) { return x / (1.f + __expf(-x)); }
__device__ __forceinline__ float fast_sigmoid(float x) { return __builtin_amdgcn_rcpf(1.f + __builtin_amdgcn_exp2f(-x * LOG2E)); }

__device__ __forceinline__ void ph_prep(int tid_in, const float* xin, bf16_t* XB, float* SSQ) {
    int t_ = tid_in; asm volatile("" : "+v"(t_));
    const int lane = t_ & 63, gw = blockIdx.x * 8 + __builtin_amdgcn_readfirstlane(t_ >> 6);
    for (int row = gw; row < M; row += gridDim.x * 8) {
        const f32x4* xr = (const f32x4*)(xin + (size_t)row * D) + lane; float ss = 0.f;
        f32x4 v[4];
#pragma unroll
        for (int j = 0; j < 4; ++j) v[j] = xr[64 * j];
#pragma unroll
        for (int j = 0; j < 4; ++j) { ss += (v[j][0] * v[j][0] + v[j][1] * v[j][1]) + (v[j][2] * v[j][2] + v[j][3] * v[j][3]);
            uint2 w; w.x = pk2(v[j][0], v[j][1]); w.y = pk2(v[j][2], v[j][3]); *((uint2*)(XB + (size_t)row * D) + lane + 64 * j) = w; }
        ss = wave_sum(ss);
        if (lane < 16) SSQ[(size_t)row * 16 + lane] = lane == 0 ? ss : 0.f;
    }
}

namespace pg8 {
constexpr int BM = 256, BK = 64, HALF = 128, HTB = HALF * BK * 2, STAGE_BYTES = 8 * HTB, NXCD = 8, WGM = 8;
__host__ __device__ __forceinline__ int lds_byte(int r, int c) { const int st = (r >> 4) * 2 + (c >> 5), rr = r & 15, cc = c & 31, ob = rr * 64 + cc * 2; return st * 1024 + (ob ^ (((ob >> 9) & 1) << 5)); }
__host__ __device__ __forceinline__ void stage_rc(int b, int& R, int& C) { const int st = b / 1024, sb = b % 1024, swz = sb ^ (((sb >> 9) & 1) << 5); R = (st >> 1) * 16 + swz / 64; C = (st & 1) * 32 + (swz % 64) / 2; }
__host__ __device__ __forceinline__ int perm32(int rho) { const int n = rho >> 4, i = rho & 15; return 8 * (i >> 2) + 4 * n + (i & 3); }
struct Unit { int pm, pn; };
struct StaticOrder {
    int nM, nN, nwg, G, c;
    __device__ __forceinline__ void init(int M_, int N_, int G_, int c_) { nM = M_ / BM; nN = N_ / BM; nwg = nM * nN; G = G_; c = c_; }
    __device__ __forceinline__ bool next(int i, Unit& u) const {
        const long L = (long)i * G + c; if (L >= nwg) return false;
        int wgid = (int)L; { const int q = nwg / NXCD, r = nwg % NXCD, xcd = wgid % NXCD, off = wgid / NXCD; wgid = (xcd < r ? xcd * (q + 1) : r * (q + 1) + (xcd - r) * q) + off; }
        const int nig = WGM * nN, gid = wgid / nig, fm = gid * WGM, gsz = (nM - fm) < WGM ? (nM - fm) : WGM;
        u.pm = fm + ((wgid % nig) % gsz); u.pn = (wgid % nig) / gsz; return true;
    }
};
struct Ops {
    const char* A; const char* Bt; unsigned lda_b, ldb_b; size_t a_kstep; int nt;
    int a_mode;
    __device__ __forceinline__ const char* a_base(const Unit& u) const {
        if (a_mode == 1) return A + (size_t)(u.pm >> 5) * (16ull * S * 128) + (size_t)(u.pm & 31) * (256 * 128);
        if (a_mode == 2) return A + (size_t)u.pn * KV2 + (size_t)u.pm * 256 * lda_b;
        return A + (size_t)u.pm * 256 * lda_b;
    }
    __device__ __forceinline__ const char* b_base(const Unit& u) const { return Bt + (size_t)u.pn * 256 * ldb_b; }
};

template <class Epi, class Sched>
__device__ __forceinline__ void gemm_phase(LAS unsigned char* lds, int tid_in, const Ops& G, const Sched& S_, const Epi& E) {
    int tid_ = tid_in; asm volatile("" : "+v"(tid_));
    const int tid = tid_, wid = __builtin_amdgcn_readfirstlane(tid >> 6), lane = tid & 63, wr = wid >> 2, wc = wid & 3, fr = lane & 15, fq = lane >> 4;
    const int nt = G.nt;
    unsigned voffA[2], voffB[2];
#pragma unroll
    for (int i = 0; i < 2; ++i) { int R, C; stage_rc(tid * 16 + i * 8192, R, C); const int Rb = Epi::PERM ? ((R & ~31) + perm32(R & 31)) : R;
        voffA[i] = (unsigned)R * G.lda_b + (unsigned)C * 2u; voffB[i] = (unsigned)Rb * G.ldb_b + (unsigned)C * 2u; }
    const size_t kstepA = G.a_kstep, kstepB = (size_t)(BK * 2);
    const size_t hstepA = (size_t)HALF * G.lda_b, hstepB = (size_t)HALF * G.ldb_b;
    const unsigned ldsw = (unsigned)wid * 1024u;
    const int aoff = lds_byte(wr * 64 + fr, fq * 8), boff = lds_byte(wc * 32 + fr, fq * 8);
#define PG8_SA(b, h) (((b) * 2 + (h)) * HTB)
#define PG8_SB(b, h) ((4 + (b) * 2 + (h)) * HTB)
#define PG8_STAGE(bufoff, gbase, voff) do { _Pragma("unroll") for (int _i = 0; _i < 2; ++_i) \
        __builtin_amdgcn_global_load_lds((const unsigned*)((const char*)(gbase) + (voff)[_i]), (LAS unsigned*)(lds + (bufoff) + ldsw + _i * 8192), 16, 0, 0); } while (0)
#define PG8_LDA(dst, b, h) do { _Pragma("unroll") for (int m = 0; m < 4; ++m) _Pragma("unroll") for (int k = 0; k < 2; ++k) dst[m][k] = *(const LAS bf16x8*)(lds + PG8_SA(b, h) + aoff + m * 2048 + k * 1024); } while (0)
#define PG8_LDB(dst, b, h) do { _Pragma("unroll") for (int n = 0; n < 2; ++n) _Pragma("unroll") for (int k = 0; k < 2; ++k) dst[n][k] = *(const LAS bf16x8*)(lds + PG8_SB(b, h) + boff + n * 2048 + k * 1024); } while (0)
#define PG8_MMA(ai, bj, At, Bt) do { __builtin_amdgcn_s_setprio(1); _Pragma("unroll") for (int m = 0; m < 4; ++m) _Pragma("unroll") for (int n = 0; n < 2; ++n) _Pragma("unroll") for (int k = 0; k < 2; ++k) \
        acc[ai][bj][m][n] = __builtin_amdgcn_mfma_f32_16x16x32_bf16(Bt[n][k], At[m][k], acc[ai][bj][m][n], 0, 0, 0); __builtin_amdgcn_s_setprio(0); } while (0)
#define PG8_WAIT_V(n) asm volatile("s_waitcnt vmcnt(" #n ")" ::: "memory")
#define PG8_WAIT_L(n) asm volatile("s_waitcnt lgkmcnt(" #n ")" ::: "memory")
#define PG8_BAR __builtin_amdgcn_s_barrier()
#define PG8_SCHED __builtin_amdgcn_sched_barrier(0)
    Unit cur, nxt; int ui = 0;
    if (!S_.next(0, cur)) return;
    f32x4 acc[2][2][4][2];
#pragma unroll
    for (int a = 0; a < 2; ++a)
#pragma unroll
        for (int b = 0; b < 2; ++b)
#pragma unroll
            for (int m = 0; m < 4; ++m)
#pragma unroll
                for (int n = 0; n < 2; ++n) acc[a][b][m][n] = (f32x4){0.f, 0.f, 0.f, 0.f};
    bf16x8 At[4][2], B0[2][2], B1[2][2];
    const char* cA = G.a_base(cur); const char* cB = G.b_base(cur);
    PG8_STAGE(PG8_SB(0, 0), cB, voffB); PG8_STAGE(PG8_SB(0, 1), cB + hstepB, voffB); PG8_STAGE(PG8_SA(0, 0), cA, voffA); PG8_STAGE(PG8_SA(0, 1), cA + hstepA, voffA);
    if (wr == 1) PG8_BAR;
    PG8_WAIT_V(2); PG8_BAR;
    PG8_STAGE(PG8_SB(1, 0), cB + kstepB, voffB); PG8_STAGE(PG8_SA(1, 0), cA + kstepA, voffA); PG8_STAGE(PG8_SB(1, 1), cB + hstepB + kstepB, voffB);
    PG8_WAIT_V(6); PG8_BAR;
    for (;;) {
        const bool has_next = S_.next(ui + 1, nxt);
        const char* nA = has_next ? G.a_base(nxt) : cA; const char* nB = has_next ? G.b_base(nxt) : cB;
        for (int t = 0; t < nt; t += 2) {
            const bool last = (t == nt - 2);
            const char* a1 = cA + (size_t)(t + 1) * kstepA;
            const char* a2 = last ? nA : cA + (size_t)(t + 2) * kstepA; const char* b2 = last ? nB : cB + (size_t)(t + 2) * kstepB;
            const char* a3 = a2 + kstepA; const char* b3 = b2 + kstepB;
            if constexpr (Epi::KHOOK) E.khook(acc, cur, t, wr, wc, fr, fq);
            PG8_LDB(B0, 0, 0); PG8_LDB(B1, 0, 1); PG8_SCHED; PG8_LDA(At, 0, 0); PG8_STAGE(PG8_SA(1, 1), a1 + hstepA, voffA);
            PG8_WAIT_V(8); PG8_WAIT_L(0); PG8_BAR; PG8_MMA(0, 0, At, B0); PG8_MMA(0, 1, At, B1); PG8_BAR; PG8_SCHED;
            PG8_LDA(At, 0, 1); PG8_STAGE(PG8_SB(0, 0), b2, voffB); PG8_STAGE(PG8_SB(0, 1), b2 + hstepB, voffB); PG8_STAGE(PG8_SA(0, 0), a2, voffA);
            PG8_WAIT_V(8); PG8_WAIT_L(0); PG8_BAR; PG8_MMA(1, 0, At, B0); PG8_MMA(1, 1, At, B1); PG8_BAR; PG8_SCHED;
            PG8_LDB(B0, 1, 0); PG8_LDB(B1, 1, 1); PG8_SCHED; PG8_LDA(At, 1, 0); PG8_STAGE(PG8_SA(0, 1), a2 + hstepA, voffA);
            PG8_WAIT_V(8); PG8_WAIT_L(0); PG8_BAR; PG8_MMA(0, 0, At, B0); PG8_MMA(0, 1, At, B1); PG8_BAR; PG8_SCHED;
            PG8_LDA(At, 1, 1); PG8_STAGE(PG8_SB(1, 0), b3, voffB); PG8_STAGE(PG8_SB(1, 1), b3 + hstepB, voffB); PG8_STAGE(PG8_SA(1, 0), a3, voffA);
            PG8_WAIT_V(8); PG8_WAIT_L(0); PG8_BAR; PG8_MMA(1, 0, At, B0); PG8_MMA(1, 1, At, B1); PG8_BAR; PG8_SCHED;
        }
        if (wr == 0) PG8_BAR;
        E(acc, cur, wr, wc, fr, fq);
        if (!has_next) break;
#pragma unroll
        for (int a = 0; a < 2; ++a)
#pragma unroll
            for (int b = 0; b < 2; ++b)
#pragma unroll
                for (int m = 0; m < 4; ++m)
#pragma unroll
                    for (int n = 0; n < 2; ++n) acc[a][b][m][n] = (f32x4){0.f, 0.f, 0.f, 0.f};
        cur = nxt; cA = nA; cB = nB; ++ui;
        if (wr == 1) PG8_BAR;
    }
    PG8_WAIT_V(0);
    PG8_BAR;
#undef PG8_SA
#undef PG8_SB
#undef PG8_STAGE
#undef PG8_LDA
#undef PG8_LDB
#undef PG8_MMA
#undef PG8_WAIT_V
#undef PG8_WAIT_L
#undef PG8_BAR
#undef PG8_SCHED
}

__device__ __forceinline__ float rstd_of(const float* ssq, int row) {
    const f32x4* p = (const f32x4*)(ssq + (size_t)row * 16); const f32x4 a = p[0], b = p[1], c = p[2], d = p[3];
    const float s = ((a[0] + a[1]) + (a[2] + a[3])) + ((b[0] + b[1]) + (b[2] + b[3])) + ((c[0] + c[1]) + (c[2] + c[3])) + ((d[0] + d[1]) + (d[2] + d[3]));
    return rsqrtf(s * (1.f / D) + EPS);
}
__device__ __forceinline__ float silu_fast(float x) { return x * __builtin_amdgcn_rcpf(1.f + __builtin_amdgcn_exp2f(-x * LOG2E)); }

struct EpiFfnUp {
    static constexpr bool PERM = true, KHOOK = false;
    bf16_t* H; const float* ssq;
    __device__ __forceinline__ void operator()(const f32x4 (&acc)[2][2][4][2], const Unit& u, int wr, int wc, int fr, int fq) const {
#pragma unroll
        for (int ai = 0; ai < 2; ++ai)
#pragma unroll
            for (int m = 0; m < 4; ++m) {
                const int row = u.pm * BM + ai * HALF + wr * 64 + m * 16 + fr; const float r = rstd_of(ssq, row);
                float h[8];
#pragma unroll
                for (int n = 0; n < 2; ++n)
#pragma unroll
                    for (int j = 0; j < 4; ++j) h[n * 4 + j] = silu_fast(r * acc[ai][0][m][n][j]) * (r * acc[ai][1][m][n][j]);
                u32x4 w; w.x = pk2(h[0], h[1]); w.y = pk2(h[2], h[3]); w.z = pk2(h[4], h[5]); w.w = pk2(h[6], h[7]);
                *(u32x4*)(H + (size_t)row * F + u.pn * 128 + wc * 32 + fq * 8) = w;
                asm volatile("" ::: "memory");
            }
    }
};
struct EpiResid {
    static constexpr bool PERM = true, KHOOK = false;
    const float* XI; float* XO; bf16_t* XB; float* ssq; float alpha;
    __device__ __forceinline__ void operator()(const f32x4 (&acc)[2][2][4][2], const Unit& u, int wr, int wc, int fr, int fq) const {
#pragma unroll
        for (int ai = 0; ai < 2; ++ai)
#pragma unroll
            for (int m = 0; m < 4; ++m) {
                const int row = u.pm * BM + ai * HALF + wr * 64 + m * 16 + fr; float ss = 0.f;
#pragma unroll
                for (int bj = 0; bj < 2; ++bj) {
                    const size_t o = (size_t)row * D + u.pn * BM + bj * HALF + wc * 32 + fq * 8;
                    f32x4 x0, x1;
                    if (XI) { x0 = *(const f32x4*)(XI + o); x1 = *(const f32x4*)(XI + o + 4); }
                    else { const u32x4 xb = *(const u32x4*)(XB + o);
                        x0 = (f32x4){__uint_as_float(xb.x << 16), __uint_as_float(xb.x & 0xffff0000u), __uint_as_float(xb.y << 16), __uint_as_float(xb.y & 0xffff0000u)};
                        x1 = (f32x4){__uint_as_float(xb.z << 16), __uint_as_float(xb.z & 0xffff0000u), __uint_as_float(xb.w << 16), __uint_as_float(xb.w & 0xffff0000u)}; }
                    x0 += acc[ai][bj][m][0] * alpha; x1 += acc[ai][bj][m][1] * alpha;
                    if (XO) { *(f32x4*)(XO + o) = x0; *(f32x4*)(XO + o + 4) = x1; }
                    else { u32x4 w; w.x = pk2(x0[0], x0[1]); w.y = pk2(x0[2], x0[3]); w.z = pk2(x1[0], x1[1]); w.w = pk2(x1[2], x1[3]); *(u32x4*)(XB + o) = w; }
                    ss += (x0[0] * x0[0] + x0[1] * x0[1]) + (x0[2] * x0[2] + x0[3] * x0[3]) + (x1[0] * x1[0] + x1[1] * x1[1]) + (x1[2] * x1[2] + x1[3] * x1[3]);
                }
                ss += swz_xor<16>(ss); ss = xhalf_sum(ss);
                if (fq == 0) ssq[(size_t)row * 16 + u.pn * 4 + wc] = ss;
                asm volatile("" ::: "memory");
            }
    }
};
__host__ __device__ __forceinline__ int win_slot_col(int slot) {
    if (slot < 8) return 64 * slot;
    if (slot < 20) return 512 + 64 * (slot - 8);
    if (slot < 40) return 1304 + 64 * (slot - 20);
    if (slot < 88) return 2584 + 64 * (slot - 40);
    if (slot == 88) return 1280;
    return -1;
}
struct EpiWin {
    static constexpr bool PERM = true, KHOOK = false;
    unsigned char* ws; const float* ssq; const float *nsa_qn, *nsa_kn, *swa_qn, *swa_kn;
    __device__ __forceinline__ void operator()(const f32x4 (&acc)[2][2][4][2], const Unit& u, int wr, int wc, int fr, int fq) const {
        const int slot = u.pn * 4 + wc;
        if (slot >= 89) return;
        int kind = 0; const float* nw = nullptr; float scale = 1.f; bf16_t* dst = nullptr; int nh = 2, h = 0;
        if (slot < 8) { nw = nsa_qn; scale = C2; dst = (bf16_t*)(ws + OFF_Q16); nh = 16; h = slot; }
        else if (slot < 10) { dst = (bf16_t*)(ws + OFF_KCMP); h = slot - 8; }
        else if (slot < 12) { dst = (bf16_t*)(ws + OFF_VCMP); h = slot - 10; }
        else if (slot < 14) { nw = nsa_kn; dst = (bf16_t*)(ws + OFF_KSLC); h = slot - 12; }
        else if (slot < 16) { kind = 1; dst = (bf16_t*)(ws + OFF_VSLCT); h = slot - 14; }
        else if (slot < 18) { nw = nsa_kn; dst = (bf16_t*)(ws + OFF_KWIN); h = slot - 16; }
        else if (slot < 20) { kind = 1; dst = (bf16_t*)(ws + OFF_VWINT); h = slot - 18; }
        else if (slot < 24) { scale = C2; dst = (bf16_t*)(ws + OFF_Q16); nh = 16; h = 8 + slot - 20; }
        else if (slot < 28) { dst = (bf16_t*)(ws + OFF_SBK); nh = 4; h = slot - 24; }
        else if (slot < 32) { kind = 1; dst = (bf16_t*)(ws + OFF_SBVT); nh = 4; h = slot - 28; }
        else if (slot < 36) { nw = swa_qn; scale = C2; dst = (bf16_t*)(ws + OFF_Q16); nh = 16; h = 12 + slot - 32; }
        else if (slot < 38) { nw = swa_kn; dst = (bf16_t*)(ws + OFF_WK); h = slot - 36; }
        else if (slot < 40) { kind = 1; dst = (bf16_t*)(ws + OFF_WVT); h = slot - 38; }
        else if (slot < 88) { kind = 2; dst = (bf16_t*)(ws + OFF_A) + (size_t)((slot - 40) >> 4) * M * D + ((slot - 40) & 15) * 64; }
        else { kind = 3; }
#pragma unroll
        for (int ai = 0; ai < 2; ++ai)
#pragma unroll
            for (int m = 0; m < 4; ++m) {
                const int row = u.pm * BM + ai * HALF + wr * 64 + m * 16 + fr; const float r = rstd_of(ssq, row);
                const int b = row / S, s = row % S;
                float v[2][2][4]; float ss = 0.f;
#pragma unroll
                for (int bj = 0; bj < 2; ++bj)
#pragma unroll
                    for (int n = 0; n < 2; ++n)
#pragma unroll
                        for (int j = 0; j < 4; ++j) { const float x = r * acc[ai][bj][m][n][j]; v[bj][n][j] = x; ss += x * x; }
                float rn = scale;
                if (nw) { ss += swz_xor<16>(ss); ss = xhalf_sum(ss); rn = rsqrtf(ss * (1.f / 64.f) + EPS) * scale; }
#pragma unroll
                for (int bj = 0; bj < 2; ++bj)
#pragma unroll
                    for (int n = 0; n < 2; ++n) {
                        f32x4 wv = (f32x4){1.f, 1.f, 1.f, 1.f}; if (nw) wv = *(const f32x4*)(nw + 32 * bj + 8 * fq + 4 * n);
#pragma unroll
                        for (int j = 0; j < 4; ++j) v[bj][n][j] *= rn * wv[j];
                    }
                if (kind == 0) {
                    bf16_t* o = dst + (((size_t)b * nh + h) * S + s) * 64 + 8 * fq;
#pragma unroll
                    for (int bj = 0; bj < 2; ++bj) { u32x4 pw; pw.x = pk2(v[bj][0][0], v[bj][0][1]); pw.y = pk2(v[bj][0][2], v[bj][0][3]); pw.z = pk2(v[bj][1][0], v[bj][1][1]); pw.w = pk2(v[bj][1][2], v[bj][1][3]);
                        *(u32x4*)(o + 32 * bj) = pw; }
                } else if (kind == 1) {
                    bf16_t* o = dst + ((size_t)b * nh + h) * 64 * S + vt_pos(s);
#pragma unroll
                    for (int bj = 0; bj < 2; ++bj)
#pragma unroll
                        for (int n = 0; n < 2; ++n)
#pragma unroll
                            for (int j = 0; j < 4; ++j) o[(size_t)(32 * bj + 8 * fq + 4 * n + j) * S] = f2bf(v[bj][n][j]);
                } else if (kind == 2) {
                    bf16_t* o = dst + (size_t)row * D + 8 * fq;
#pragma unroll
                    for (int bj = 0; bj < 2; ++bj) { u32x4 pw; pw.x = pk2(fast_sigmoid(v[bj][0][0]), fast_sigmoid(v[bj][0][1])); pw.y = pk2(fast_sigmoid(v[bj][0][2]), fast_sigmoid(v[bj][0][3]));
                        pw.z = pk2(fast_sigmoid(v[bj][1][0]), fast_sigmoid(v[bj][1][1])); pw.w = pk2(fast_sigmoid(v[bj][1][2]), fast_sigmoid(v[bj][1][3])); *(u32x4*)(o + 32 * bj) = pw; }
                } else {
                    float* o = (float*)(ws + OFF_NGATE) + (size_t)row * 24;
#pragma unroll
                    for (int n = 0; n < 2; ++n)
#pragma unroll
                        for (int j = 0; j < 4; ++j) { const int d = 8 * fq + 4 * n + j; if (d < 24) o[d] = fast_sigmoid(v[0][n][j]); }
                }
                asm volatile("" ::: "memory");
            }
    }
};
struct EpiCmp1 {
    static constexpr bool PERM = true, KHOOK = false;
    float* HID; const float* bias;
    __device__ __forceinline__ void operator()(const f32x4 (&acc)[2][2][4][2], const Unit& u, int wr, int wc, int fr, int fq) const {
#pragma unroll
        for (int ai = 0; ai < 2; ++ai)
#pragma unroll
            for (int m = 0; m < 4; ++m) {
                const int row = u.pm * BM + ai * HALF + wr * 64 + m * 16 + fr;
#pragma unroll
                for (int bj = 0; bj < 2; ++bj)
#pragma unroll
                    for (int n = 0; n < 2; ++n) {
                        const int col = bj * HALF + wc * 32 + fq * 8 + 4 * n; const f32x4 bv = *(const f32x4*)(bias + u.pn * 256 + col);
                        f32x4 o;
#pragma unroll
                        for (int j = 0; j < 4; ++j) o[j] = silu_fast(acc[ai][bj][m][n][j] + bv[j]);
                        *(f32x4*)(HID + ((size_t)u.pn * 2048 + row) * 256 + col) = o;
                    }
                asm volatile("" ::: "memory");
            }
    }
};
struct EpiMerge {
    static constexpr bool PERM = true, KHOOK = true;
    const bf16_t* G0; const bf16_t* G1; const bf16_t* G2; bf16_t* OUT;
    __device__ __forceinline__ void khook(f32x4 (&acc)[2][2][4][2], const Unit& u, int t, int wr, int wc, int fr, int fq) const {
        if (t != 8 && t != 12) return;
        const bf16_t* NUM = t == 8 ? G0 : G1; const bf16_t* DEN = t == 8 ? G1 : G2;
#pragma unroll
        for (int ai = 0; ai < 2; ++ai)
#pragma unroll
            for (int m = 0; m < 4; ++m) {
                const int row = u.pm * BM + ai * HALF + wr * 64 + m * 16 + fr;
#pragma unroll
                for (int bj = 0; bj < 2; ++bj) {
                    const size_t o = (size_t)row * D + u.pn * BM + bj * HALF + wc * 32 + fq * 8;
                    const u32x4 nu = *(const u32x4*)(NUM + o), de = *(const u32x4*)(DEN + o);
#pragma unroll
                    for (int q = 0; q < 4; ++q) {
                        const float n0 = __uint_as_float(nu[q] << 16), n1 = __uint_as_float(nu[q] & 0xffff0000u), d0 = __uint_as_float(de[q] << 16), d1 = __uint_as_float(de[q] & 0xffff0000u);
                        acc[ai][bj][m][q >> 1][(q & 1) * 2] *= n0 * __builtin_amdgcn_rcpf(d0); acc[ai][bj][m][q >> 1][(q & 1) * 2 + 1] *= n1 * __builtin_amdgcn_rcpf(d1);
                    }
                }
                asm volatile("" : "+v"(acc[ai][0][m][0]), "+v"(acc[ai][0][m][1]), "+v"(acc[ai][1][m][0]), "+v"(acc[ai][1][m][1]) :: "memory");
            }
    }
    __device__ __forceinline__ void operator()(const f32x4 (&acc)[2][2][4][2], const Unit& u, int wr, int wc, int fr, int fq) const {
#pragma unroll
        for (int ai = 0; ai < 2; ++ai)
#pragma unroll
            for (int m = 0; m < 4; ++m) {
                const int row = u.pm * BM + ai * HALF + wr * 64 + m * 16 + fr;
#pragma unroll
                for (int bj = 0; bj < 2; ++bj) {
                    const size_t o = (size_t)row * D + u.pn * BM + bj * HALF + wc * 32 + fq * 8;
                    const u32x4 ge = *(const u32x4*)(G2 + o); u32x4 pw;
#pragma unroll
                    for (int q = 0; q < 4; ++q) {
                        const float g0 = __uint_as_float(ge[q] << 16), g1 = __uint_as_float(ge[q] & 0xffff0000u);
                        pw[q] = pk2(acc[ai][bj][m][q >> 1][(q & 1) * 2] * g0, acc[ai][bj][m][q >> 1][(q & 1) * 2 + 1] * g1);
                    }
                    *(u32x4*)(OUT + o) = pw;
                }
                asm volatile("" ::: "memory");
            }
    }
};
}

__device__ __forceinline__ void conv_item4(const float* W, int ldw, int col0, int nvalid, int ksrc, const float* wn, bf16_t* Bt, size_t ldbt, int row0, int kofs, LAS float* scr, int lane) {
    const int n4 = (lane & 7) * 4, kr = lane >> 3, c = lane & 7;
    f32x4 v[4][8];
#pragma unroll
    for (int q = 0; q < 4; ++q)
#pragma unroll
        for (int i = 0; i < 8; ++i) { const int kk = ksrc + 64 * q + 8 * i + kr; v[q][i] = (f32x4){0.f, 0.f, 0.f, 0.f};
            if (n4 < nvalid) { v[q][i] = *(const f32x4*)(W + (size_t)kk * ldw + col0 + n4); if (wn) v[q][i] *= wn[kk]; } }
#pragma unroll
    for (int q = 0; q < 4; ++q) {
#pragma unroll
        for (int i = 0; i < 8; ++i) { const int kk = 8 * i + kr; scr[kk * 33 + n4] = v[q][i][0]; scr[kk * 33 + n4 + 1] = v[q][i][1]; scr[kk * 33 + n4 + 2] = v[q][i][2]; scr[kk * 33 + n4 + 3] = v[q][i][3]; }
        asm volatile("s_waitcnt lgkmcnt(0)" ::: "memory");
#pragma unroll
        for (int j = 0; j < 4; ++j) { const int n = (lane >> 3) + 8 * j; const LAS float* s = scr + (8 * c) * 33 + n;
            u32x4 o; o.x = pk2(s[0 * 33], s[1 * 33]); o.y = pk2(s[2 * 33], s[3 * 33]); o.z = pk2(s[4 * 33], s[5 * 33]); o.w = pk2(s[6 * 33], s[7 * 33]);
            *(u32x4*)(Bt + (size_t)(row0 + n) * ldbt + kofs + 64 * q + 8 * c) = o; }
        asm volatile("s_waitcnt lgkmcnt(0)" ::: "memory");
    }
}
__device__ __forceinline__ void conv_wide(const float* W, int ldw, int col0, int ksrc, const float* wn, bf16_t* Bt, size_t ldbt, int r0, int r1, int r2, int r3, int kofs, LAS float* scr, int lane) {
    const int cg = lane & 31, rh = lane >> 5;
    f32x4 v[16];
#pragma unroll
    for (int i = 0; i < 16; ++i) { const int kk = ksrc + 2 * i + rh; v[i] = *(const f32x4*)(W + (size_t)kk * ldw + col0 + 4 * cg); if (wn) v[i] *= wn[kk]; }
#pragma unroll
    for (int c = 0; c < 2; ++c) {
#pragma unroll
        for (int i = 0; i < 8; ++i) { LAS float* d = scr + (2 * i + rh) * 129 + 4 * cg; d[0] = v[8 * c + i][0]; d[1] = v[8 * c + i][1]; d[2] = v[8 * c + i][2]; d[3] = v[8 * c + i][3]; }
        asm volatile("s_waitcnt lgkmcnt(0)" ::: "memory");
#pragma unroll
        for (int j = 0; j < 4; ++j) { const int t = lane + 64 * j, n = t >> 1, half = t & 1, sub = n >> 5; const LAS float* s = scr + (8 * half) * 129 + n;
            const int row = (sub == 0 ? r0 : sub == 1 ? r1 : sub == 2 ? r2 : r3) + (n & 31);
            u32x4 o; o.x = pk2(s[0 * 129], s[1 * 129]); o.y = pk2(s[2 * 129], s[3 * 129]); o.z = pk2(s[4 * 129], s[5 * 129]); o.w = pk2(s[6 * 129], s[7 * 129]);
            *(u32x4*)(Bt + (size_t)row * ldbt + kofs + 16 * c + 8 * half) = o; }
        asm volatile("s_waitcnt lgkmcnt(0)" ::: "memory");
    }
}
struct ConvCtx { LAS unsigned char* ldsr; LAS float* scr; int gw, ngw, lane; };
#define CONV_LAUNDER ConvCtx c = c_; { int t_ = c_.lane; asm volatile("" : "+v"(t_)); c.lane = t_ & 63; const int wv_ = __builtin_amdgcn_readfirstlane(t_ >> 6); c.gw = ((int)blockIdx.x - c_.gw) * 8 + wv_; c.scr = (LAS float*)(c.ldsr + wv_ * 8448); }
__device__ __forceinline__ void conv_ffn(const ConvCtx& c_, const float* nw, const float* wg, const float* wu, const float* wd, unsigned char* dstbase) {
    CONV_LAUNDER;
    bf16_t* GU = (bf16_t*)dstbase; bf16_t* DN = (bf16_t*)(dstbase + FFNW_D);
    constexpr int I_GU = 2 * 22 * 32, I_D = 8 * 88;
    for (int it = c.gw; it < I_GU + I_D; it += c.ngw) {
        if (it < I_GU) { const int kb = it / 44, cb = it % 44, isup = cb / 22, tile = cb % 22, rb = tile * 256 + isup * 128;
            conv_wide(isup ? wu : wg, F, tile * 128, kb * 32, nw, GU, D, rb, rb + 32, rb + 64, rb + 96, kb * 32, c.scr, c.lane); }
        else { const int r = it - I_GU, kb = r / 8, cb = r % 8, rb = cb * 128; conv_wide(wd, D, rb, kb * 32, nullptr, DN, F, rb, rb + 32, rb + 64, rb + 96, kb * 32, c.scr, c.lane); }
    }
}
struct MixW { const float *mixn, *win, *w1k, *w1v, *ua, *ub, *uc, *wo, *pos, *w2k, *w2v; };
__device__ __forceinline__ void conv_mix(const ConvCtx& c_, const MixW& w, unsigned char* ws) {
    CONV_LAUNDER;
    bf16_t* BIN = (bf16_t*)(ws + OFF_BT_IN); bf16_t* BC1 = (bf16_t*)(ws + OFF_BT_C1); bf16_t* BM_ = (bf16_t*)(ws + OFF_BT_M); bf16_t* BO = (bf16_t*)(ws + OFF_BT_O);
    constexpr int I_IN = 184 * 4, I_C1 = 16 * 8, I_M = 32 * 4, I_O = 32 * 4, I_B = 512, I_W2 = 4;
    bf16_t* W2T = (bf16_t*)(ws + OFF_W2T);
    for (int it = c.gw; it < I_IN + I_C1 + I_M + I_O + I_B + I_W2; it += c.ngw) {
        int r = it;
        if (r < I_IN) { const int rb = r / 4, kb = r % 4, tile = rb >> 3, r32 = rb & 7, bj = r32 >> 2, slot = tile * 4 + (r32 & 3);
            const int sc = pg8::win_slot_col(slot); int nvalid = sc < 0 ? 0 : 32; if (slot == 88) nvalid = bj == 0 ? 24 : 0;
            conv_item4(w.win, DIN, sc + 32 * bj, nvalid, kb * 256, w.mixn, BIN, D, rb * 32, kb * 256, c.scr, c.lane); continue; }
        r -= I_IN;
        if (r < I_C1) { const int rb = r / 8, kb = r % 8; conv_item4(rb >= 8 ? w.w1v : w.w1k, 256, (rb & 7) * 32, 32, kb * 256, nullptr, BC1, 2048, rb * 32, kb * 256, c.scr, c.lane); continue; }
        r -= I_C1;
        if (r < I_M) { const int rb = r / 4, kb = r % 4;
            if (kb < 2) conv_item4(w.ua, D, rb * 32, 32, kb * 256, nullptr, BM_, D, rb * 32, kb * 256, c.scr, c.lane);
            else if (kb == 2) conv_item4(w.ub, D, rb * 32, 32, 0, nullptr, BM_, D, rb * 32, 512, c.scr, c.lane);
            else conv_item4(w.uc, D, rb * 32, 32, 0, nullptr, BM_, D, rb * 32, 768, c.scr, c.lane);
            continue; }
        r -= I_M;
        if (r < I_O) { const int rb = r / 4, kb = r % 4; conv_item4(w.wo, D, rb * 32, 32, kb * 256, nullptr, BO, D, rb * 32, kb * 256, c.scr, c.lane); continue; }
        r -= I_O;
        if (r >= I_B) { r -= I_B; const int kv = r >> 1, rb = r & 1;
            conv_item4(kv ? w.w2v : w.w2k, 64, rb * 32, 32, 0, nullptr, W2T + (size_t)kv * 64 * 256, 256, rb * 32, 0, c.scr, c.lane); continue; }
        { const int kv = r >> 8, j = r & 255; const float* w1 = kv ? w.w1v : w.w1k; float s = 0.f;
#pragma unroll 8
          for (int i = 0; i < 32; ++i) { const int kk = c.lane + 64 * i; s += w.pos[kk] * w1[(size_t)kk * 256 + j]; }
          s = wave_sum(s);
          if (c.lane == 0) ((float*)(ws + OFF_BIASC))[kv * 256 + j] = s; }
    }
}

typedef float f32x16 __attribute__((ext_vector_type(16)));
__host__ __device__ __forceinline__ int crow(int r, int hi) { return (r & 3) + 8 * (r >> 2) + 4 * hi; }
__device__ __forceinline__ bf16x8 pack8(const f32x16& p, int s) {
    u32x4 w; w.x = pk2(p[8 * s + 0], p[8 * s + 1]); w.y = pk2(p[8 * s + 2], p[8 * s + 3]); w.z = pk2(p[8 * s + 4], p[8 * s + 5]); w.w = pk2(p[8 * s + 6], p[8 * s + 7]);
    return __builtin_bit_cast(bf16x8, w);
}
constexpr int TAB_N = 130;
__device__ __forceinline__ int tab_idx(int dist) { return min(max(dist, -1), 128) + 1; }
__device__ __forceinline__ void build_tabs(LAS float* tab, const float* rel_bias, int tid) {
    for (int i = tid; i < 12 * TAB_N; i += 512) {
        const int hh = i / TAB_N, e = i % TAB_N; float v;
        if (e == 0) v = -INFINITY;
        else if (hh < 8) v = e == 129 ? 0.f : (rel_bias[t5b(e - 1) * 12 + hh] - rel_bias[31 * 12 + hh]) * LOG2E;
        else v = e == 129 ? -INFINITY : rel_bias[t5b(e - 1) * 12 + hh] * LOG2E;
        tab[i] = v;
    }
}
__device__ __forceinline__ void qk_global(f32x16& p0, f32x16& p1, const bf16_t* K, const bf16x8 (&qf)[4], int lane) {
    const bf16_t* kp = K + (size_t)(lane & 31) * 64 + 8 * (lane >> 5);
    bf16x8 kf[8];
#pragma unroll
    for (int c = 0; c < 4; ++c) { kf[2 * c] = *(const bf16x8*)(kp + 16 * c); kf[2 * c + 1] = *(const bf16x8*)(kp + 32 * 64 + 16 * c); }
    f32x16 z;
#pragma unroll
    for (int r = 0; r < 16; ++r) z[r] = 0.f;
    p0 = z; p1 = z;
#pragma unroll
    for (int c = 0; c < 4; ++c) {
        p0 = __builtin_amdgcn_mfma_f32_32x32x16_bf16(kf[2 * c], qf[c], p0, 0, 0, 0);
        p1 = __builtin_amdgcn_mfma_f32_32x32x16_bf16(kf[2 * c + 1], qf[c], p1, 0, 0, 0);
    }
}
__device__ __forceinline__ void pv_global(f32x16 (&o)[2], const bf16_t* VT, size_t pitch, const f32x16& p0, const f32x16& p1, int lane) {
    const bf16_t* vp = VT + (size_t)(lane & 31) * pitch + 8 * (lane >> 5);
    bf16x8 vf[8];
#pragma unroll
    for (int q = 0; q < 4; ++q)
#pragma unroll
        for (int dh = 0; dh < 2; ++dh) vf[2 * q + dh] = *(const bf16x8*)(vp + (size_t)(32 * dh) * pitch + 16 * q);
#pragma unroll
    for (int q = 0; q < 4; ++q) {
        const bf16x8 pf = pack8((q >> 1) ? p1 : p0, q & 1);
#pragma unroll
        for (int dh = 0; dh < 2; ++dh) o[dh] = __builtin_amdgcn_mfma_f32_32x32x16_bf16(vf[2 * q + dh], pf, o[dh], 0, 0, 0);
    }
}
__device__ __forceinline__ void softmax_step(f32x16& p0, f32x16& p1, float& m, float& l, f32x16 (&o)[2]) {
    float mx = fmaxf(p0[0], p1[0]);
#pragma unroll
    for (int r = 1; r < 16; ++r) mx = fmaxf(mx, fmaxf(p0[r], p1[r]));
    mx = xhalf_max(mx);
    const float mn = fmaxf(m, mx);
    const float ms = (mn == -INFINITY) ? 0.f : mn;
    const float alpha = __builtin_amdgcn_exp2f(m - ms);
    float sum = 0.f;
#pragma unroll
    for (int r = 0; r < 16; ++r) { p0[r] = __builtin_amdgcn_exp2f(p0[r] - ms); p1[r] = __builtin_amdgcn_exp2f(p1[r] - ms); sum += p0[r] + p1[r]; }
    l = l * alpha + sum; m = mn;
    if (__any(alpha != 1.f)) {
#pragma unroll
        for (int r = 0; r < 16; ++r) { o[0][r] *= alpha; o[1][r] *= alpha; }
    }
}
constexpr float SM_THR = 6.f;
__device__ __forceinline__ float max3f(float a, float b, float c) { return fmaxf(fmaxf(a, b), c); }
__device__ __forceinline__ void softmax_rel(f32x16& p0, f32x16& p1, float& mref, float& l, f32x16 (&o)[2], bool first) {
    float a = max3f(p0[0], p0[1], p1[0]), b = max3f(p0[2], p0[3], p1[1]);
    a = max3f(a, p1[2], p1[3]);
#pragma unroll
    for (int r = 4; r < 16; r += 4) { a = max3f(a, p0[r], p0[r + 1]); b = max3f(b, p0[r + 2], p0[r + 3]); a = max3f(a, p1[r], p1[r + 1]); b = max3f(b, p1[r + 2], p1[r + 3]); }
    const float mx = xhalf_max(fmaxf(a, b));
    if (first || __any(mx > SM_THR)) {
        const float d = first ? (mx == -INFINITY ? 0.f : mx) : fmaxf(mx, 0.f); const f32x2_t d2 = {d, d};
        mref += d;
        const float f = first ? 1.f : __builtin_amdgcn_exp2f(-d); const f32x2_t f2 = {f, f};
        l *= f;
#pragma unroll
        for (int r = 0; r < 16; r += 2) {
            f32x2_t x = {p0[r], p0[r + 1]}; x = x - d2; p0[r] = x[0]; p0[r + 1] = x[1];
            f32x2_t y = {p1[r], p1[r + 1]}; y = y - d2; p1[r] = y[0]; p1[r + 1] = y[1];
            f32x2_t u = {o[0][r], o[0][r + 1]}; u = u * f2; o[0][r] = u[0]; o[0][r + 1] = u[1];
            f32x2_t v = {o[1][r], o[1][r + 1]}; v = v * f2; o[1][r] = v[0]; o[1][r + 1] = v[1];
        }
    }
    f32x2_t s2 = {0.f, 0.f};
#pragma unroll
    for (int r = 0; r < 16; r += 2) {
        p0[r] = __builtin_amdgcn_exp2f(p0[r]); p0[r + 1] = __builtin_amdgcn_exp2f(p0[r + 1]); p1[r] = __builtin_amdgcn_exp2f(p1[r]); p1[r + 1] = __builtin_amdgcn_exp2f(p1[r + 1]);
        const f32x2_t x = {p0[r], p0[r + 1]}, y = {p1[r], p1[r + 1]}; s2 = s2 + x; s2 = s2 + y;
    }
    l += s2[0] + s2[1];
}
__device__ __forceinline__ void store_ot(bf16_t* dst, const f32x16 (&o)[2], float scale, int hi) {
#pragma unroll
    for (int dh = 0; dh < 2; ++dh)
#pragma unroll
        for (int m4 = 0; m4 < 4; ++m4) {
            uint2 w; w.x = pk2(o[dh][4 * m4] * scale, o[dh][4 * m4 + 1] * scale); w.y = pk2(o[dh][4 * m4 + 2] * scale, o[dh][4 * m4 + 3] * scale);
            *(uint2*)(dst + 32 * dh + 8 * m4 + 4 * hi) = w;
        }
}

__device__ __forceinline__ void cmp2_unit(unsigned char* ws, const float* knorm, int unit, int lane) {
    const int kv = unit >> 6, hi = lane >> 5, row = (unit & 63) * 32 + (lane & 31), n = row & 511, grp = row >> 9;
    const float* hrow = (const float*)(ws + OFF_HID) + ((size_t)kv * 2048 + row) * 256 + 8 * hi;
    const bf16_t* w2t = (const bf16_t*)(ws + OFF_W2T) + (size_t)kv * 64 * 256 + (size_t)(lane & 31) * 256 + 8 * hi;
    f32x16 o[2];
#pragma unroll
    for (int r = 0; r < 16; ++r) { o[0][r] = 0.f; o[1][r] = 0.f; }
#pragma unroll 4
    for (int c = 0; c < 16; ++c) {
        const f32x4 a = *(const f32x4*)(hrow + 16 * c), b = *(const f32x4*)(hrow + 16 * c + 4);
        u32x4 w; w.x = pk2(a[0], a[1]); w.y = pk2(a[2], a[3]); w.z = pk2(b[0], b[1]); w.w = pk2(b[2], b[3]);
        const bf16x8 hb = __builtin_bit_cast(bf16x8, w);
#pragma unroll
        for (int dh = 0; dh < 2; ++dh) { const bf16x8 wf = *(const bf16x8*)(w2t + (size_t)dh * 32 * 256 + 16 * c); o[dh] = __builtin_amdgcn_mfma_f32_32x32x16_bf16(wf, hb, o[dh], 0, 0, 0); }
    }
    const bool valid = n < NCMP;
    if (kv == 0) {
        float ss = 0.f;
#pragma unroll
        for (int r = 0; r < 16; ++r) ss += o[0][r] * o[0][r] + o[1][r] * o[1][r];
        ss = xhalf_sum(ss);
        const float rn = valid ? rsqrtf(ss * (1.f / 64.f) + EPS) : 0.f;
        bf16_t* dst = (bf16_t*)(ws + OFF_KCN) + ((size_t)grp * 512 + n) * 64;
#pragma unroll
        for (int dh = 0; dh < 2; ++dh)
#pragma unroll
            for (int m4 = 0; m4 < 4; ++m4) { const int d = 32 * dh + 8 * m4 + 4 * hi; const f32x4 kn = *(const f32x4*)(knorm + d);
                uint2 w; w.x = pk2(o[dh][4 * m4] * rn * kn[0], o[dh][4 * m4 + 1] * rn * kn[1]); w.y = pk2(o[dh][4 * m4 + 2] * rn * kn[2], o[dh][4 * m4 + 3] * rn * kn[3]);
                *(uint2*)(dst + d) = w; }
    } else {
        bf16_t* dst = (bf16_t*)(ws + OFF_VCT) + (size_t)grp * 64 * 512 + vt_pos(n);
#pragma unroll
        for (int dh = 0; dh < 2; ++dh)
#pragma unroll
            for (int r = 0; r < 16; ++r) dst[(size_t)(32 * dh + crow(r, hi)) * 512] = f2bf(valid ? o[dh][r] : 0.f);
    }
}

__device__ __forceinline__ void ldk_global(bf16x8 (&kf)[8], const bf16_t* K, int lane) {
    const bf16_t* kp = K + (size_t)(lane & 31) * 64 + 8 * (lane >> 5);
#pragma unroll
    for (int c = 0; c < 4; ++c) { kf[2 * c] = *(const bf16x8*)(kp + 16 * c); kf[2 * c + 1] = *(const bf16x8*)(kp + 32 * 64 + 16 * c); }
}
__device__ __forceinline__ void ldv_global(bf16x8 (&vf)[8], const bf16_t* VT, size_t pitch, int lane) {
    const bf16_t* vp = VT + (size_t)(lane & 31) * pitch + 8 * (lane >> 5);
#pragma unroll
    for (int q = 0; q < 4; ++q)
#pragma unroll
        for (int dh = 0; dh < 2; ++dh) vf[2 * q + dh] = *(const bf16x8*)(vp + (size_t)(32 * dh) * pitch + 16 * q);
}
__device__ __forceinline__ void mm_qk(f32x16& p0, f32x16& p1, const bf16x8 (&kf)[8], const bf16x8 (&qf)[4]) {
    f32x16 z;
#pragma unroll
    for (int r = 0; r < 16; ++r) z[r] = 0.f;
    p0 = z; p1 = z;
#pragma unroll
    for (int c = 0; c < 4; ++c) { p0 = __builtin_amdgcn_mfma_f32_32x32x16_bf16(kf[2 * c], qf[c], p0, 0, 0, 0); p1 = __builtin_amdgcn_mfma_f32_32x32x16_bf16(kf[2 * c + 1], qf[c], p1, 0, 0, 0); }
}
__device__ __forceinline__ void mm_pv(f32x16 (&o)[2], const bf16x8 (&vf)[8], const f32x16& p0, const f32x16& p1) {
#pragma unroll
    for (int q = 0; q < 4; ++q) { const bf16x8 pf = pack8((q >> 1) ? p1 : p0, q & 1);
#pragma unroll
        for (int dh = 0; dh < 2; ++dh) o[dh] = __builtin_amdgcn_mfma_f32_32x32x16_bf16(vf[2 * q + dh], pf, o[dh], 0, 0, 0); }
}
__device__ __forceinline__ void swa_unit(unsigned char* ws, const LAS float* tabW, const float* sinks, int unit, int lane, bool do_store) {
    const int t0 = (unit & 255) * 32, h = (unit >> 8) & 3, b = unit >> 10, g = h >> 1, hi = lane >> 5, t = t0 + (lane & 31);
    bf16_t* qrow = (bf16_t*)(ws + OFF_Q16) + (((size_t)b * 16 + 12 + h) * S + t) * 64;
    const bf16_t* K = (const bf16_t*)(ws + OFF_WK) + ((size_t)b * 2 + g) * S * 64; const bf16_t* VT = (const bf16_t*)(ws + OFF_WVT) + ((size_t)b * 2 + g) * 64 * S;
    bf16x8 qf[4];
#pragma unroll
    for (int c = 0; c < 4; ++c) qf[c] = *(const bf16x8*)(qrow + 16 * c + 8 * hi);
    const float sink = sinks[h] * LOG2E;
    float m = sink, l = hi == 0 ? 1.f : 0.f;
    f32x16 o[2];
#pragma unroll
    for (int r = 0; r < 16; ++r) { o[0][r] = 0.f; o[1][r] = 0.f; }
    const LAS float* tb = tabW + h * TAB_N;
    const int jlo = t0 >= 127 ? (t0 - 127) >> 6 : 0, jhi = (t0 + 31) >> 6;
    bf16x8 kf[8], vf[8];
    ldk_global(kf, K + (size_t)jlo * 4096, lane);
    for (int j = jlo; j <= jhi; ++j) {
        ldv_global(vf, VT + (size_t)j * 64, S, lane);
        f32x16 p0, p1;
        mm_qk(p0, p1, kf, qf);
        if (j < jhi) ldk_global(kf, K + (size_t)(j + 1) * 4096, lane);
#pragma unroll
        for (int r = 0; r < 16; ++r) { const int d0 = t - (j * 64 + crow(r, hi)); p0[r] += tb[tab_idx(d0)]; p1[r] += tb[tab_idx(d0 - 32)]; }
        softmax_step(p0, p1, m, l, o);
        mm_pv(o, vf, p0, p1);
    }
    l = xhalf_sum(l);
    if (do_store) store_ot(qrow, o, 1.f / l, hi);
}

constexpr float SB_CUT = 64.f;
__device__ __forceinline__ void sb_unit(unsigned char* ws, int unit, int lane, bool do_store) {
    const int t0 = (unit & 255) * 32, h = (unit >> 8) & 3, b = unit >> 10, hi = lane >> 5, t = t0 + (lane & 31);
    bf16_t* qrow = (bf16_t*)(ws + OFF_Q16) + (((size_t)b * 16 + 8 + h) * S + t) * 64;
    const bf16_t* K = (const bf16_t*)(ws + OFF_SBK) + ((size_t)b * 4 + h) * S * 64; const bf16_t* VT = (const bf16_t*)(ws + OFF_SBVT) + ((size_t)b * 4 + h) * 64 * S;
    bf16x8 qf[4];
#pragma unroll
    for (int c = 0; c < 4; ++c) qf[c] = *(const bf16x8*)(qrow + 16 * c + 8 * hi);
    f32x16 o[2];
#pragma unroll
    for (int r = 0; r < 16; ++r) { o[0][r] = 0.f; o[1][r] = 0.f; }
    float carry = 0.f;
    bf16x8 kf[8], vf[8];
    const int jd = (t0 + 31) >> 6;
    ldk_global(kf, K + (size_t)jd * 4096, lane);
    for (int j = jd; j >= 0; --j) {
        f32x16 z0, z1, f0, f1;
        mm_qk(z0, z1, kf, qf);
        if (j > 0) ldk_global(kf, K + (size_t)(j - 1) * 4096, lane);
        float gs[8];
#pragma unroll
        for (int u = 0; u < 8; ++u) gs[u] = 0.f;
        const int kb = j * 64;
#pragma unroll
        for (int r = 0; r < 16; ++r) {
            { const float z = z0[r]; const bool ok = kb + crow(r, hi) < t; const float sp = fmaxf(z, 0.f) + __builtin_amdgcn_logf(1.f + __builtin_amdgcn_exp2f(-fabsf(z))); f0[r] = ok ? -sp : 0.f; gs[r >> 2] += f0[r]; }
            { const float z = z1[r]; const bool ok = kb + 32 + crow(r, hi) < t; const float sp = fmaxf(z, 0.f) + __builtin_amdgcn_logf(1.f + __builtin_amdgcn_exp2f(-fabsf(z))); f1[r] = ok ? -sp : 0.f; gs[4 + (r >> 2)] += f1[r]; }
        }
        ldv_global(vf, VT + (size_t)j * 64, S, lane);
        float T = 0.f, A[8];
#pragma unroll
        for (int u = 7; u >= 0; --u) { const float pg = xhalf_other(gs[u], hi); A[u] = T + (hi == 0 ? pg : 0.f); T += gs[u] + pg; }
#pragma unroll
        for (int u = 0; u < 8; ++u) {
            float run = carry + A[u];
#pragma unroll
            for (int i = 3; i >= 0; --i) {
                const int r = 4 * (u & 3) + i;
                if (u < 4) { const bool ok = kb + crow(r, hi) < t; const float lf = f0[r]; z0[r] = ok ? __builtin_amdgcn_exp2f(z0[r] + lf + run) : 0.f; run += lf; }
                else { const bool ok = kb + 32 + crow(r, hi) < t; const float lf = f1[r]; z1[r] = ok ? __builtin_amdgcn_exp2f(z1[r] + lf + run) : 0.f; run += lf; }
            }
        }
        carry += T;
        mm_pv(o, vf, z0, z1);
        if (__all(carry < -SB_CUT)) break;
    }
    if (do_store) store_ot(qrow, o, 1.f, hi);
}


constexpr int NSA_STAGE = 16384, NSA_IMPG = 32768, NSA_IMPL = 65536, NSA_SEL = 98304;
struct TileSrc { const bf16_t* K; const bf16_t* VT; size_t vpitch; };
__device__ __forceinline__ void nsa_issue(LAS unsigned char* stage, const TileSrc& ts, int j, int tid, int wave) {
    const int row = tid >> 3, chunk = (tid & 7) ^ ((row >> 1) & 7);
    __builtin_amdgcn_global_load_lds((const unsigned*)(ts.K + ((size_t)j * 64 + row) * 64 + chunk * 8), (LAS unsigned*)(stage + wave * 1024), 16, 0, 0);
    __builtin_amdgcn_global_load_lds((const unsigned*)(ts.VT + (size_t)row * ts.vpitch + (size_t)j * 64 + chunk * 8), (LAS unsigned*)(stage + 8192 + wave * 1024), 16, 0, 0);
}
__device__ __forceinline__ void qk_lds(f32x16& p0, f32x16& p1, const LAS unsigned char* Kst, const bf16x8 (&qf)[4], float cinit, int lrow, int swz, int hi) {
    bf16x8 kf[8];
#pragma unroll
    for (int c = 0; c < 4; ++c) { const int off = lrow + (((2 * c + hi) ^ swz) << 4); kf[2 * c] = *(const LAS bf16x8*)(Kst + off); kf[2 * c + 1] = *(const LAS bf16x8*)(Kst + 4096 + off); }
    f32x16 z;
#pragma unroll
    for (int r = 0; r < 16; ++r) z[r] = cinit;
    p0 = z; p1 = z;
    __builtin_amdgcn_sched_barrier(0);
#pragma unroll
    for (int c = 0; c < 4; ++c) {
        p0 = __builtin_amdgcn_mfma_f32_32x32x16_bf16(kf[2 * c], qf[c], p0, 0, 0, 0);
        p1 = __builtin_amdgcn_mfma_f32_32x32x16_bf16(kf[2 * c + 1], qf[c], p1, 0, 0, 0);
    }
}
__device__ __forceinline__ void pv_lds(f32x16 (&o)[2], const LAS unsigned char* Vst, const f32x16& p0, const f32x16& p1, int lrow, int swz, int hi) {
    bf16x8 vf[8];
#pragma unroll
    for (int kh = 0; kh < 2; ++kh)
#pragma unroll
        for (int s = 0; s < 2; ++s) { const int off = lrow + (((4 * kh + 2 * s + hi) ^ swz) << 4);
#pragma unroll
            for (int dh = 0; dh < 2; ++dh) vf[4 * kh + 2 * s + dh] = *(const LAS bf16x8*)(Vst + dh * 4096 + off); }
    bf16x8 pf[4];
#pragma unroll
    for (int kh = 0; kh < 2; ++kh)
#pragma unroll
        for (int s = 0; s < 2; ++s) pf[2 * kh + s] = pack8(kh ? p1 : p0, s);
    __builtin_amdgcn_sched_barrier(0);
#pragma unroll
    for (int q = 0; q < 4; ++q)
#pragma unroll
        for (int dh = 0; dh < 2; ++dh) o[dh] = __builtin_amdgcn_mfma_f32_32x32x16_bf16(vf[2 * q + dh], pf[q], o[dh], 0, 0, 0);
}
__device__ __forceinline__ float quad_sum(float v) {
    v += __int_as_float(__builtin_amdgcn_mov_dpp(__float_as_int(v), 0xB1, 0xf, 0xf, true));
    v += __int_as_float(__builtin_amdgcn_mov_dpp(__float_as_int(v), 0x4E, 0xf, 0xf, true));
    return v;
}
#define NSA_WAITBAR() do { asm volatile("s_waitcnt vmcnt(0) lgkmcnt(0)" ::: "memory"); __builtin_amdgcn_s_barrier(); asm volatile("" ::: "memory"); } while (0)

__device__ __forceinline__ void nsa_unit(LAS unsigned char* lds, const LAS float* tabN, unsigned char* ws, int b, int g, int qt, int tid_in, bool do_store) {
    int tid = tid_in; asm volatile("" : "+v"(tid));
    const int lane = tid & 63, wave = __builtin_amdgcn_readfirstlane(tid >> 6), hi = lane >> 5, col = lane & 31, qi = col >> 2, r = col & 3;
    const int t0 = qt * 64, qloc = 8 * wave + qi, t = t0 + qloc, h = 4 * g + r, grp = b * 2 + g;
    const int lrow = col * 128, swz = (col >> 1) & 7;
    bf16_t* qrow = (bf16_t*)(ws + OFF_Q16) + (((size_t)b * 16 + h) * S + t) * 64;
    bf16x8 qf[4];
#pragma unroll
    for (int c = 0; c < 4; ++c) qf[c] = *(const bf16x8*)(qrow + 16 * c + 8 * hi);
    const LAS float* tb = tabN + h * TAB_N;
    LAS float* impG = (LAS float*)(lds + NSA_IMPG); LAS float* impL = (LAS float*)(lds + NSA_IMPL); LAS unsigned* selm = (LAS unsigned*)(lds + NSA_SEL);
    const float* NG = (const float*)(ws + OFF_NGATE) + (size_t)(b * S + t) * 24;
    f32x16 out[2];
#pragma unroll
    for (int rr = 0; rr < 16; ++rr) { out[0][rr] = 0.f; out[1][rr] = 0.f; }

    {
        TileSrc ts; ts.K = (const bf16_t*)(ws + OFF_KCN) + (size_t)grp * 512 * 64; ts.VT = (const bf16_t*)(ws + OFF_VCT) + (size_t)grp * 64 * 512; ts.vpitch = 512;
        const int nmax = min((t0 + 32) >> 4, 510), nct = (nmax >> 6) + 1;
        float m = -INFINITY, l = 0.f;
        if (tid < 64) impL[tid * 128] = 0.f;
        NSA_WAITBAR();
        nsa_issue(lds, ts, 0, tid, wave);
        for (int i = 0; i < nct; ++i) {
            NSA_WAITBAR();
            if (i + 1 < nct) nsa_issue(lds + ((i + 1) & 1) * NSA_STAGE, ts, i + 1, tid, wave);
            const LAS unsigned char* st = lds + (i & 1) * NSA_STAGE;
            f32x16 p0, p1;
            qk_lds(p0, p1, st, qf, 0.f, lrow, swz, hi);
            float mx = -INFINITY;
#pragma unroll
            for (int rr = 0; rr < 16; ++rr) { const int dc = t - 16 * (i * 64 + crow(rr, hi)) - 31; p0[rr] += tb[tab_idx(dc)]; p1[rr] += tb[tab_idx(dc - 512)]; mx = fmaxf(mx, fmaxf(p0[rr], p1[rr])); }
            mx = xhalf_max(mx);
            const float mn = fmaxf(m, mx), ms = (mn == -INFINITY) ? 0.f : mn;
            float sum = 0.f;
#pragma unroll
            for (int rr = 0; rr < 16; ++rr) sum += __builtin_amdgcn_exp2f(p0[rr] - ms) + __builtin_amdgcn_exp2f(p1[rr] - ms);
            l = l * __builtin_amdgcn_exp2f(m - ms) + sum; m = mn;
        }
        l = xhalf_sum(l);
        const float ms = (m == -INFINITY) ? 0.f : m, il = l > 0.f ? 1.f / l : 0.f;
        f32x16 o[2];
#pragma unroll
        for (int rr = 0; rr < 16; ++rr) { o[0][rr] = 0.f; o[1][rr] = 0.f; }
        NSA_WAITBAR();
        nsa_issue(lds, ts, 0, tid, wave);
        for (int i = 0; i < nct; ++i) {
            NSA_WAITBAR();
            if (i + 1 < nct) nsa_issue(lds + ((i + 1) & 1) * NSA_STAGE, ts, i + 1, tid, wave);
            const LAS unsigned char* st = lds + (i & 1) * NSA_STAGE;
            f32x16 p0, p1;
            qk_lds(p0, p1, st, qf, 0.f, lrow, swz, hi);
#pragma unroll
            for (int rr = 0; rr < 16; ++rr) { const int dc = t - 16 * (i * 64 + crow(rr, hi)) - 31;
                p0[rr] = __builtin_amdgcn_exp2f(p0[rr] + tb[tab_idx(dc)] - ms) * il; p1[rr] = __builtin_amdgcn_exp2f(p1[rr] + tb[tab_idx(dc - 512)] - ms) * il; }
#pragma unroll
            for (int u = 0; u < 8; ++u) {
                const f32x16& pp = u < 4 ? p0 : p1; const int r0 = 4 * (u & 3);
                const float G = quad_sum((pp[r0] + pp[r0 + 1]) + (pp[r0 + 2] + pp[r0 + 3])), L = quad_sum(pp[r0 + 3]);
                const int j = 16 * i + 8 * (u >> 2) + 2 * (u & 3) + hi;
                if (r == 0) { impG[qloc * 128 + j] = G; if (j + 1 < 128) impL[qloc * 128 + j + 1] = L; }
            }
            pv_lds(o, st + 8192, p0, p1, lrow, swz, hi);
        }
        const float gc = NG[h];
#pragma unroll
        for (int rr = 0; rr < 16; ++rr) { out[0][rr] += gc * o[0][rr]; out[1][rr] += gc * o[1][rr]; }
    }
    NSA_WAITBAR();
    {
        int tid2 = tid_in; asm volatile("" : "+v"(tid2));
        const int q = tid2 >> 3, sub = tid2 & 7;
        unsigned mw[4] = {0u, 0u, 0u, 0u};
        if (qt <= 15) { if (sub == 0) mw[0] = (qt == 31) ? 0xffffffffu : ((2u << qt) - 1u); }
        else {
            unsigned vb[16];
#pragma unroll
            for (int i = 0; i < 16; ++i) { const int j = sub + 8 * i; const bool cand = j >= 1 && j <= qt - 2; vb[i] = cand ? __float_as_uint(impG[q * 128 + j] + impL[q * 128 + j]) + 1u : 0u; }
            unsigned T = 0u;
#pragma unroll 1
            for (int bit = 30; bit >= 0; --bit) {
                const unsigned trial = T | (1u << bit); unsigned c = 0u;
#pragma unroll
                for (int i = 0; i < 16; ++i) c += vb[i] >= trial ? 1u : 0u;
                c += swz_xor_u<1>(c); c += swz_xor_u<2>(c); c += swz_xor_u<4>(c);
                if (c >= 13u) T = trial;
            }
            unsigned cge = 0u;
#pragma unroll
            for (int i = 0; i < 16; ++i) cge += vb[i] >= T ? 1u : 0u;
            cge += swz_xor_u<1>(cge); cge += swz_xor_u<2>(cge); cge += swz_xor_u<4>(cge);
            if (cge == 13u) {
#pragma unroll
                for (int i = 0; i < 16; ++i) { const int j = sub + 8 * i; if (vb[i] >= T && vb[i] != 0u) mw[j >> 5] |= 1u << (j & 31); }
            } else {
                for (int i = 0; i < 16; ++i) { const int j = sub + 8 * i; if (vb[i] == 0u) continue; int rk = 0;
                    for (int kk = 1; kk <= qt - 2; ++kk) { const unsigned vk = __float_as_uint(impG[q * 128 + kk] + impL[q * 128 + kk]) + 1u; rk += (vk > vb[i]) || (vk == vb[i] && kk < j); }
                    if (rk < 13) mw[j >> 5] |= 1u << (j & 31); }
            }
            if (sub == 0) mw[0] |= 1u;
#pragma unroll
            for (int i = 0; i < 16; ++i) { const int j = sub + 8 * i; if (j == qt || j == qt - 1) mw[j >> 5] |= 1u << (j & 31); }
        }
#pragma unroll
        for (int wd = 0; wd < 4; ++wd) { unsigned x = mw[wd]; x |= swz_xor_u<1>(x); x |= swz_xor_u<2>(x); x |= swz_xor_u<4>(x); if (sub == 0) selm[q * 4 + wd] = x; }
    }
    NSA_WAITBAR();
    unsigned sm0 = selm[qloc * 4 + 0], sm1 = selm[qloc * 4 + 1], sm2 = selm[qloc * 4 + 2], sm3 = selm[qloc * 4 + 3];
    {
        TileSrc ts; ts.K = (const bf16_t*)(ws + OFF_KSLC) + (size_t)grp * S * 64; ts.VT = (const bf16_t*)(ws + OFF_VSLCT) + (size_t)grp * 64 * S; ts.vpitch = S;
        float m = 0.f, l = 0.f;
        f32x16 o[2];
#pragma unroll
        for (int rr = 0; rr < 16; ++rr) { o[0][rr] = 0.f; o[1][rr] = 0.f; }
        nsa_issue(lds, ts, 0, tid, wave);
        for (int j = 0; j <= qt; ++j) {
            NSA_WAITBAR();
            if (j + 1 <= qt) nsa_issue(lds + ((j + 1) & 1) * NSA_STAGE, ts, j + 1, tid, wave);
            const LAS unsigned char* st = lds + (j & 1) * NSA_STAGE;
            const unsigned mword = j < 32 ? sm0 : j < 64 ? sm1 : j < 96 ? sm2 : sm3;
            const bool selb = (mword >> (j & 31)) & 1u;
            if (!__any(selb)) continue;
            const float cinit = selb ? -m : -INFINITY;
            f32x16 p0, p1;
            qk_lds(p0, p1, st, qf, cinit, lrow, swz, hi);
            if (j >= qt - 2) {
#pragma unroll
                for (int rr = 0; rr < 16; ++rr) { const int d0 = t - (j * 64 + crow(rr, hi)); p0[rr] += tb[tab_idx(d0)]; p1[rr] += tb[tab_idx(d0 - 32)]; }
            }
            softmax_rel(p0, p1, m, l, o, j == 0);
            pv_lds(o, st + 8192, p0, p1, lrow, swz, hi);
        }
        l = xhalf_sum(l);
        const float gs = NG[8 + h] / l;
#pragma unroll
        for (int rr = 0; rr < 16; ++rr) { out[0][rr] += gs * o[0][rr]; out[1][rr] += gs * o[1][rr]; }
    }
    {
        TileSrc ts; ts.K = (const bf16_t*)(ws + OFF_KWIN) + (size_t)grp * S * 64; ts.VT = (const bf16_t*)(ws + OFF_VWINT) + (size_t)grp * 64 * S; ts.vpitch = S;
        float m = 0.f, l = 0.f;
        f32x16 o[2];
#pragma unroll
        for (int rr = 0; rr < 16; ++rr) { o[0][rr] = 0.f; o[1][rr] = 0.f; }
        const int j0 = qt >= 8 ? qt - 8 : 0, nt = qt - j0 + 1;
        NSA_WAITBAR();
        nsa_issue(lds, ts, j0, tid, wave);
        for (int i = 0; i < nt; ++i) {
            const int j = j0 + i;
            NSA_WAITBAR();
            if (i + 1 < nt) nsa_issue(lds + ((i + 1) & 1) * NSA_STAGE, ts, j + 1, tid, wave);
            const LAS unsigned char* st = lds + (i & 1) * NSA_STAGE;
            f32x16 p0, p1;
            qk_lds(p0, p1, st, qf, -m, lrow, swz, hi);
            if (j >= qt - 2) {
#pragma unroll
                for (int rr = 0; rr < 16; ++rr) { const int d0 = t - (j * 64 + crow(rr, hi)); p0[rr] += tb[tab_idx(d0)]; p1[rr] += tb[tab_idx(d0 - 32)]; }
            } else if (j == qt - 8) {
#pragma unroll
                for (int rr = 0; rr < 16; ++rr) { const int d0 = t - (j * 64 + crow(rr, hi)); if (d0 >= 512) p0[rr] = -INFINITY; if (d0 - 32 >= 512) p1[rr] = -INFINITY; }
            }
            softmax_rel(p0, p1, m, l, o, i == 0);
            pv_lds(o, st + 8192, p0, p1, lrow, swz, hi);
        }
        l = xhalf_sum(l);
        const float gw = NG[16 + h] / l;
#pragma unroll
        for (int rr = 0; rr < 16; ++rr) { out[0][rr] += gw * o[0][rr]; out[1][rr] += gw * o[1][rr]; }
    }
    if (do_store) store_ot(qrow, out, 1.f, hi);
    NSA_WAITBAR();
}


#define XB_TMO      128
#define XB_XCNT(j)  (256  + 64 * (j))
#define XB_XSUB(j)  (1280 + 64 * (j))
#define XB_XGEN(j)  (2304 + 64 * (j))
#define XB_TOP      3328
#define XB_TOPGEN   3392
#define XCD_BAR_WORDS 3456
#define XB_SPIN_CAP (1u << 18)
constexpr size_t CTL_ZERO_BYTES = 65536, CTL_BAR_OFF = 16384;
constexpr int LDS_XB_OFF = 131072 + 8192;
__device__ __forceinline__ unsigned xb_ld(unsigned* p)              { return __hip_atomic_load(p, __ATOMIC_RELAXED, __HIP_MEMORY_SCOPE_AGENT); }
__device__ __forceinline__ unsigned xb_add(unsigned* p, unsigned v) { return __hip_atomic_fetch_add(p, v, __ATOMIC_RELAXED, __HIP_MEMORY_SCOPE_AGENT); }
__device__ __forceinline__ unsigned xb_xcc_id() { return (unsigned)__builtin_amdgcn_s_getreg((3 << 11) | 20) & 0xFu; }
#define XB_SPIN(cond, bar) do { unsigned _sp = 0; while (cond) { __builtin_amdgcn_s_sleep(1); \
    if ((++_sp & 255u) == 0u) { if (xb_ld(&(bar)[XB_TMO])) break; if (_sp > XB_SPIN_CAP) { atomicAdd(&(bar)[XB_TMO], 1u); break; } } } } while (0)
__device__ __forceinline__ void xcd_barrier_complete(unsigned* bar, unsigned x, unsigned G, unsigned& nloc, unsigned& nx) {
    unsigned sum, cnt, mine, sp = 0u;
    for (;;) {
        sum = 0u; cnt = 0u; mine = 0u;
#pragma unroll
        for (unsigned j = 0; j < 16; ++j) { const unsigned c = xb_ld(&bar[XB_XCNT(j)]); sum += c; cnt += (c > 0u) ? 1u : 0u; mine = (j == x) ? c : mine; }
        if (sum == G) break;
        __builtin_amdgcn_s_sleep(1);
        if ((++sp & 255u) == 0u) { if (xb_ld(&bar[XB_TMO])) break; if (sp > XB_SPIN_CAP) { atomicAdd(&bar[XB_TMO], 1u); break; } }
    }
    nloc = mine > 0u ? mine : 1u; nx = cnt > 0u ? cnt : 1u;
}
__device__ __forceinline__ void xcd_barrier(unsigned* bar, volatile LAS unsigned* st, unsigned G, bool leader) {
    asm volatile("s_waitcnt vmcnt(0)" ::: "memory");
    __syncthreads();
    if (leader) {
        const unsigned x = xb_xcc_id();
        __builtin_amdgcn_s_waitcnt(0);
        unsigned nloc = st[0], nx = st[1];
        if (nloc == 0u) { xcd_barrier_complete(bar, x, G, nloc, nx); st[0] = nloc; st[1] = nx; }
        const unsigned old = xb_add(&bar[XB_XSUB(x)], 1u);
        const unsigned gen = old / nloc;
        if (old + 1u == (gen + 1u) * nloc) {
            __builtin_amdgcn_fence(__ATOMIC_RELEASE, "agent");
            asm volatile("s_waitcnt vmcnt(0)" ::: "memory");
            const unsigned og = xb_add(&bar[XB_TOP], 1u);
            const unsigned tg = og / nx;
            if (og + 1u == (tg + 1u) * nx) xb_add(&bar[XB_TOPGEN], 1u);
            else XB_SPIN(xb_ld(&bar[XB_TOPGEN]) == tg, bar);
            __builtin_amdgcn_fence(__ATOMIC_ACQUIRE, "agent");
            xb_add(&bar[XB_XGEN(x)], 1u);
            asm volatile("s_waitcnt vmcnt(0)" ::: "memory");
        } else {
            XB_SPIN(xb_ld(&bar[XB_XGEN(x)]) == gen, bar);
            __builtin_amdgcn_fence(__ATOMIC_ACQUIRE, "agent");
            asm volatile("s_waitcnt vmcnt(0)" ::: "memory");
        }
    }
    __syncthreads();
}

struct Params { const float* in[26]; float* out; unsigned char* ws; };
constexpr int LDS_BYTES = 147456;
__device__ __forceinline__ const float* inptr(const Params& p, int i) { asm volatile("" : "+s"(i)); return p.in[i]; }
#define PH_BEGIN(lexpr) int lq = (lexpr); asm volatile("" : "+s"(lq)); unsigned char* ws = p.ws; asm volatile("" : "+s"(ws)); float* X = p.out; asm volatile("" : "+s"(X)); \
    bf16_t* XB = (bf16_t*)(ws + OFF_XB); float* SSQ = (float*)(ws + OFF_SSQ); (void)XB; (void)SSQ; (void)X; (void)lq
#define IN(i) inptr(p, i)
#define CCX() ConvCtx{ldsr, nullptr, 0, (int)gridDim.x * 8, MYTID()}
#define CCS(b0) ConvCtx{ldsr, nullptr, (b0), ((int)gridDim.x - (b0)) * 8, MYTID()}
#define CCS(b0) ConvCtx{ldsr, nullptr, (b0), ((int)gridDim.x - (b0)) * 8, MYTID()}
#define FFN_SRC(l, base) IN(base) + (size_t)(l) * D, IN((base) + 1) + (size_t)(l) * D * F, IN((base) + 2) + (size_t)(l) * D * F, IN((base) + 3) + (size_t)(l) * F * D
__device__ __forceinline__ MixW mixw_of(const Params& p, int l) { MixW w; w.mixn = IN(6) + (size_t)l * D; w.win = IN(7) + (size_t)l * D * DIN; w.w1k = IN(11) + (size_t)l * 2048 * 256; w.w1v = IN(13) + (size_t)l * 2048 * 256;
    w.ua = IN(18) + (size_t)l * 512 * D; w.ub = IN(19) + (size_t)l * 256 * D; w.uc = IN(20) + (size_t)l * 256 * D; w.wo = IN(21) + (size_t)l * D * D; w.pos = IN(10) + (size_t)l * 2048; w.w2k = IN(12) + (size_t)l * 256 * 64; w.w2v = IN(14) + (size_t)l * 256 * 64; return w; }

__global__ void __launch_bounds__(512) mega_fwd(Params p) {
    extern __shared__ __attribute__((aligned(16))) char lds_base[];
    cg::grid_group grid = cg::this_grid();
    LAS unsigned char* ldsr = (LAS unsigned char*)lds_base;
    const int wave_s = __builtin_amdgcn_readfirstlane(threadIdx.x >> 6);
    const int G_ = gridDim.x, bid = blockIdx.x;
    unsigned long long ts_t0 = 0, ts_acc = 0; (void)ts_t0; int ts_inst = 0; (void)ts_inst;
    if (threadIdx.x == 0) { volatile LAS unsigned* st_ = (volatile LAS unsigned*)(ldsr + LDS_XB_OFF); st_[0] = 0u; st_[1] = 0u;
        (void)xb_add((unsigned*)(p.ws + OFF_CTL + CTL_BAR_OFF) + XB_XCNT(xb_xcc_id()), 1u); }
    __syncthreads();
#define GSYNC_CG() do { TS_B(27); grid.sync(); TS_E(27); } while (0)
#define GSYNC(id) do { if (PROBE == 40) { unsigned char* wsb2_ = p.ws; asm volatile("" : "+s"(wsb2_)); xcd_barrier((unsigned*)(wsb2_ + OFF_CTL + CTL_BAR_OFF), (volatile LAS unsigned*)(ldsr + LDS_XB_OFF), (unsigned)G_, MYTID() == 0); } TS_B(27); TS_B(100 + (id)); { unsigned char* wsb_ = p.ws; asm volatile("" : "+s"(wsb_)); xcd_barrier((unsigned*)(wsb_ + OFF_CTL + CTL_BAR_OFF), (volatile LAS unsigned*)(ldsr + LDS_XB_OFF), (unsigned)G_, MYTID() == 0); } TS_E(27); TS_E(100 + (id)); } while (0)
    REP(9) {
        PH_BEGIN(0);
        TS_B(21); conv_ffn(CCX(), FFN_SRC(lq, 2), ws + OFF_FFN1W); __syncthreads(); TS_E(21);
        TS_B(23); ph_prep(MYTID(), IN(0), XB, SSQ); __syncthreads(); TS_E(23);
        GSYNC_CG();
    }
#pragma unroll 1
    for (int l = 0; l < 2; ++l) {
#pragma unroll 1
        for (int f = 0; f < 2; ++f) {
            ts_inst = l * 2 + f;
            if (f == 1) {
                REP(3) {
                    PH_BEGIN(l);
                    pg8::Ops g; g.A = (const char*)XB; g.Bt = (const char*)(ws + OFF_BT_IN); g.lda_b = D * 2; g.ldb_b = D * 2; g.a_kstep = 128; g.nt = D / 64; g.a_mode = 0;
                    pg8::StaticOrder so; so.init(M, 5888, G_, bid);
                    pg8::EpiWin E{ws, SSQ, IN(8) + lq * 64, IN(9) + lq * 64, IN(15) + lq * 64, IN(16) + lq * 64};
                    TS_B(25); pg8::gemm_phase(ldsr, MYTID(), g, so, E); TS_E(25);
                    GSYNC(2);
                }
                {
                    PH_BEGIN(l);
                    if (bid < 16) {
                        pg8::Ops g; g.A = (const char*)(ws + OFF_KCMP); g.Bt = (const char*)(ws + OFF_BT_C1); g.lda_b = 2048; g.ldb_b = 4096; g.a_kstep = 128; g.nt = 32; g.a_mode = 2;
                        pg8::StaticOrder so; so.init(2048, 512, G_, bid);
                        pg8::EpiCmp1 E{(float*)(ws + OFF_HID), (const float*)(ws + OFF_BIASC)};
                        TS_B(29); pg8::gemm_phase(ldsr, MYTID(), g, so, E); TS_E(29);
                    } else {
                        LAS float* tabs = (LAS float*)(ldsr + 131072);
                        build_tabs(tabs, IN(1), MYTID());
                        __syncthreads();
                        int t_ = MYTID(); asm volatile("" : "+v"(t_));
                        const int lane_ = t_ & 63, gw_ = (bid - 16) * 8 + __builtin_amdgcn_readfirstlane(t_ >> 6), ngw_ = (G_ - 16) * 8;
                        REP(6) {
                            for (int u = gw_; u < 4096; u += ngw_) {
                                if (u < 2048) sb_unit(ws, u, lane_, LASTREP(6));
                                else swa_unit(ws, tabs + 8 * TAB_N, IN(17) + lq * 4, u - 2048, lane_, LASTREP(6));
                            }
                        }
                    }
                }
                GSYNC(3);
                {
                    PH_BEGIN(l);
                    int t_ = MYTID(); asm volatile("" : "+v"(t_));
                    const int lane_ = t_ & 63, gw_ = bid * 8 + __builtin_amdgcn_readfirstlane(t_ >> 6);
                    TS_B(30);
                    for (int u = gw_; u < 128; u += G_ * 8) cmp2_unit(ws, IN(9) + lq * 64, u, lane_);
                    TS_E(30);
                }
                GSYNC(4);
                {
                    PH_BEGIN(l);
                    LAS float* tabs = (LAS float*)(ldsr + 131072);
                    build_tabs(tabs, IN(1), MYTID());
                    __syncthreads();
                    int t_ = MYTID(); asm volatile("" : "+v"(t_));
                    TS_B(32);
                    REP(5) {
                        for (int ps = bid; ps < 256; ps += G_) {
                            const int bg = (ps & 7) >> 1, i = (ps & 1) * 32 + (ps >> 3);
#pragma unroll 1
                            for (int k2 = 0; k2 < 2; ++k2) nsa_unit(ldsr, tabs, ws, bg >> 1, bg & 1, k2 ? 127 - i : i, t_, LASTREP(5));
                        }
                    }
                    TS_E(32);
                }
                GSYNC(5);
                REP(7) {
                    PH_BEGIN(l);
                    if (lq == 0) { TS_B(21); conv_ffn(CCX(), FFN_SRC(0, 22), ws + OFF_FFN2W); __syncthreads(); TS_E(21); }
                    bf16_t* GATES = (bf16_t*)(ws + OFF_A);
                    pg8::Ops g; g.A = (const char*)(ws + OFF_Q16); g.Bt = (const char*)(ws + OFF_BT_M); g.lda_b = 128; g.ldb_b = D * 2; g.a_kstep = (size_t)S * 128; g.nt = 16; g.a_mode = 1;
                    pg8::StaticOrder so; so.init(M, D, G_, bid);
                    pg8::EpiMerge E{GATES, GATES + (size_t)M * D, GATES + (size_t)2 * M * D, (bf16_t*)(ws + OFF_MERGED)};
                    TS_B(28); pg8::gemm_phase(ldsr, MYTID(), g, so, E); TS_E(28);
                    GSYNC(6);
                }
                REP(8) {
                    PH_BEGIN(l);
                    if (lq == 0) { TS_B(21); conv_ffn(CCX(), FFN_SRC(1, 2), ws + OFF_FFN1W); __syncthreads(); TS_E(21); }
                    pg8::Ops g; g.A = (const char*)(ws + OFF_MERGED); g.Bt = (const char*)(ws + OFF_BT_O); g.lda_b = D * 2; g.ldb_b = D * 2; g.a_kstep = 128; g.nt = 16; g.a_mode = 0;
                    pg8::StaticOrder so; so.init(M, D, G_, bid);
                    pg8::EpiResid E{nullptr, nullptr, XB, SSQ, LASTREP(8) ? 1.0f : 0.f};
                    TS_B(26); pg8::gemm_phase(ldsr, MYTID(), g, so, E); TS_E(26);
                    GSYNC(7);
                }
            }
            REP(1) {
                PH_BEGIN(l);
                int fq_ = f; asm volatile("" : "+s"(fq_));
                unsigned char* wbase = ws + (fq_ == 0 ? OFF_FFN1W : OFF_FFN2W);
                {
                    const int b0 = (1408 - 5 * G_ > 0 && 1408 - 5 * G_ < G_) ? 1408 - 5 * G_ : 0;
                    if (bid >= b0) {
                        const int inst = lq * 2 + fq_;
                        TS_B(22);
                        if (inst == 0) conv_mix(CCS(b0), mixw_of(p, 0), ws);
                        else if (inst == 1) conv_mix(CCS(b0), mixw_of(p, 1), ws);
                        else if (inst == 2) conv_ffn(CCS(b0), FFN_SRC(1, 22), ws + OFF_FFN2W);
                        __syncthreads(); TS_E(22);
                    }
                }
                pg8::Ops g; g.A = (const char*)XB; g.Bt = (const char*)wbase; g.lda_b = D * 2; g.ldb_b = D * 2; g.a_kstep = 128; g.nt = 16; g.a_mode = 0;
                pg8::StaticOrder so; so.init(M, 2 * F, G_, bid);
                pg8::EpiFfnUp E{(bf16_t*)(ws + OFF_A), SSQ};
                TS_B(24); pg8::gemm_phase(ldsr, MYTID(), g, so, E); TS_E(24);
                GSYNC(8);
            }
            REP(2) {
                PH_BEGIN(l);
                int fq_ = f; asm volatile("" : "+s"(fq_));
                unsigned char* wbase = ws + (fq_ == 0 ? OFF_FFN1W : OFF_FFN2W);
                pg8::Ops g; g.A = (const char*)(ws + OFF_A); g.Bt = (const char*)(wbase + FFNW_D); g.lda_b = F * 2; g.ldb_b = F * 2; g.a_kstep = 128; g.nt = F / 64; g.a_mode = 0;
                pg8::StaticOrder so; so.init(M, D, G_, bid);
                pg8::EpiResid E{(lq == 0 && fq_ == 0) ? IN(0) : (const float*)nullptr, (lq == 1 && fq_ == 1) ? X : (float*)nullptr, XB, SSQ, LASTREP(2) ? 0.5f : 0.f};
                TS_B(31); pg8::gemm_phase(ldsr, MYTID(), g, so, E); TS_E(31);
                if (!(l == 1 && f == 1)) GSYNC(9);
            }
        }
    }
#ifdef TSPMAX
    if (TSP != 0) {
        unsigned* mx_ = (unsigned*)(p.ws + OFF_CTL) + 8192;
        if (MYTID() == 0) atomicMax(mx_, (unsigned)ts_acc);
        xcd_barrier((unsigned*)(p.ws + OFF_CTL + CTL_BAR_OFF), (volatile LAS unsigned*)(ldsr + LDS_XB_OFF), (unsigned)G_, MYTID() == 0);
        if (bid == 0) { const unsigned long long mxv = __hip_atomic_load(mx_, __ATOMIC_RELAXED, __HIP_MEMORY_SCOPE_AGENT); const unsigned long long te = __builtin_amdgcn_s_memrealtime(); while (__builtin_amdgcn_s_memrealtime() - te < 10ull * mxv) __builtin_amdgcn_s_sleep(8); }
    }
#else
    if (TSP != 0 && bid == 0) { const unsigned long long te = __builtin_amdgcn_s_memrealtime(); while (__builtin_amdgcn_s_memrealtime() - te < 10ull * ts_acc) __builtin_amdgcn_s_sleep(8); }
#endif
}

extern "C" void kernel_launch(void* const* d_in, const int* in_sizes, int n_in, void* d_out, int out_size, void* d_ws, size_t ws_size, hipStream_t stream) {
    static int grid_blocks = 0;
    if (grid_blocks == 0) {
        if (ws_size < WS_END || n_in != 26) { fprintf(stderr, "kernel_launch: bad sizes (ws %zu)\n", ws_size); grid_blocks = -1; return; }
        int dev = 0, cus = 0, per_cu = 0;
        (void)hipGetDevice(&dev); (void)hipDeviceGetAttribute(&cus, hipDeviceAttributeMultiprocessorCount, dev);
        (void)hipFuncSetAttribute((const void*)mega_fwd, hipFuncAttributeMaxDynamicSharedMemorySize, LDS_BYTES);
        (void)hipOccupancyMaxActiveBlocksPerMultiprocessor(&per_cu, (const void*)mega_fwd, 512, LDS_BYTES);
        if (per_cu < 1) { fprintf(stderr, "kernel_launch: occupancy query says %d\n", per_cu); per_cu = 1; }
        grid_blocks = cus * (per_cu > 1 ? 1 : per_cu);
        (void)hipGetLastError();
    }
    if (grid_blocks < 0) return;
    if (hipMemsetAsync((char*)d_ws + OFF_CTL, 0, CTL_ZERO_BYTES, stream) != hipSuccess) { fprintf(stderr, "kernel_launch: memset failed\n"); return; }
    Params p{}; for (int i = 0; i < 26; ++i) p.in[i] = (const float*)d_in[i]; p.out = (float*)d_out; p.ws = (unsigned char*)d_ws;
    void* args[] = {&p};
    hipError_t e = hipLaunchCooperativeKernel((void*)mega_fwd, dim3(grid_blocks), dim3(512), args, LDS_BYTES, stream);
    if (e != hipSuccess) fprintf(stderr, "cooperative launch failed: %s (grid %d)\n", hipGetErrorString(e), grid_blocks);
}
```

```cpp
#include <hip/hip_runtime.h>
#include <hip/hip_cooperative_groups.h>
#include <stdint.h>
#include <cstdio>
namespace cg = cooperative_groups;
#ifndef PROBE
#define PROBE 0
#endif
#ifndef TSP
#define TSP 0
#endif
#ifndef TSF
#define TSF -1
#endif
#define TS_B(k) if (TSP == (k) && (TSF < 0 || TSF == ts_inst)) { ts_t0 = __builtin_amdgcn_s_memrealtime(); }
#define TS_E(k) if (TSP == (k) && (TSF < 0 || TSF == ts_inst)) { ts_acc += __builtin_amdgcn_s_memrealtime() - ts_t0; }
#define REP(k) for (int rep_ = 0; rep_ < (PROBE == (k) ? 2 : 1); ++rep_)
#define LASTREP(k) (rep_ == (PROBE == (k) ? 1 : 0))
__device__ __forceinline__ int lane_id() { int r; asm volatile("v_mbcnt_lo_u32_b32 %0, -1, 0\n\tv_mbcnt_hi_u32_b32 %0, -1, %0" : "=v"(r)); return r; }
#define MYTID() (wave_s * 64 + lane_id())
#define VB_SETUP int tidx_ = tid_in; asm volatile("" : "+v"(tidx_)); const int tid = tidx_ & 255, vhalf = tidx_ >> 8; const int vb0 = blockIdx.x * 2 + vhalf, nvb = gridDim.x * 2; char* lds = lds_base + vhalf * 32768; (void)tid; (void)lds; (void)vb0; (void)nvb
#define LAS __attribute__((address_space(3)))

typedef unsigned short bf16_t;
typedef short bf16x8 __attribute__((ext_vector_type(8)));
typedef float f32x4 __attribute__((ext_vector_type(4)));
typedef unsigned u32x4 __attribute__((ext_vector_type(4)));
__device__ __forceinline__ float bf2f(bf16_t v) { return __uint_as_float(((unsigned)v) << 16); }
__device__ __forceinline__ bf16_t f2bf(float f) { unsigned u = __float_as_uint(f); return (bf16_t)((u + 0x7fffu + ((u >> 16) & 1u)) >> 16); }
typedef float f32x2_t __attribute__((ext_vector_type(2))); typedef __bf16 bf16x2_t __attribute__((ext_vector_type(2)));
__device__ __forceinline__ unsigned pk2(float lo, float hi) { f32x2_t v = {lo, hi}; bf16x2_t b = __builtin_convertvector(v, bf16x2_t); return __builtin_bit_cast(unsigned, b); }

__host__ __device__ __forceinline__ int vperm16(int k) { return 8 * ((k >> 2) & 1) + 4 * (k >> 3) + (k & 3); }
__device__ __forceinline__ size_t vt_pos(int s) { return (size_t)((s & ~15) + vperm16(s & 15)); }
constexpr int NB = 2, S = 8192, M = NB * S, D = 1024, F = 2816, HD = 64, DIN = 5656;
constexpr int NCMP = 511, NSLC = 128;
constexpr float LOG2E = 1.4426950408889634f;
constexpr float C2 = 0.125f * LOG2E;
constexpr float EPS = 1e-6f;

constexpr size_t MiB = 1u << 20;
constexpr size_t OFF_CTL = 0;
constexpr size_t OFF_SSQ = 1 * MiB;
constexpr size_t OFF_XB = 2 * MiB;
constexpr size_t OFF_A = 34 * MiB;
constexpr size_t OFF_MIXW = 130 * MiB;
constexpr size_t OFF_BT_IN = OFF_MIXW, OFF_BT_C1 = OFF_MIXW + 12 * MiB, OFF_BT_M = OFF_MIXW + 14 * MiB, OFF_BT_O = OFF_MIXW + 16 * MiB;
constexpr size_t OFF_W2T = OFF_MIXW + 11 * MiB + 768 * 1024;
constexpr size_t OFF_Q16 = 148 * MiB;
constexpr size_t OFF_KV = 180 * MiB;
constexpr size_t KV2 = 4 * MiB, KV4 = 8 * MiB;
constexpr size_t OFF_KCMP = OFF_KV, OFF_VCMP = OFF_KCMP + KV2, OFF_KSLC = OFF_VCMP + KV2, OFF_VSLCT = OFF_KSLC + KV2,
                 OFF_KWIN = OFF_VSLCT + KV2, OFF_VWINT = OFF_KWIN + KV2, OFF_WK = OFF_VWINT + KV2, OFF_WVT = OFF_WK + KV2,
                 OFF_SBK = OFF_WVT + KV2, OFF_SBVT = OFF_SBK + KV4;
constexpr size_t OFF_MERGED = OFF_KV;
constexpr size_t OFF_FFN1W = OFF_Q16, OFF_FFN2W = 237 * MiB;
constexpr size_t FFNW_D = 11 * MiB;
constexpr size_t OFF_SMALL = 229 * MiB;
constexpr size_t OFF_NGATE = OFF_SMALL;
constexpr size_t OFF_KCN = OFF_NGATE + 2 * MiB;
constexpr size_t OFF_VCT = OFF_KCN + MiB / 4;
constexpr size_t OFF_HID = OFF_VCT + MiB / 4;
constexpr size_t OFF_BIASC = OFF_HID + 4 * MiB;
constexpr size_t WS_END = OFF_FFN2W + 17 * MiB;
static_assert(OFF_SBVT + KV4 <= OFF_SMALL && OFF_BIASC + MiB <= OFF_FFN2W, "ws map");

__device__ const unsigned char T5B[128] = {
    0, 1, 2, 3, 4, 5, 6, 7, 8, 9, 10, 11, 12, 13, 14, 15, 16, 16, 16, 17, 17, 18, 18, 18, 19, 19, 19, 20, 20, 20, 20, 21, 21, 21, 21, 22, 22, 22, 22, 22, 23, 23, 23, 23, 23, 23, 24, 24, 24, 24, 24, 24, 25, 25, 25, 25, 25, 25, 25, 26, 26, 26, 26, 26, 26, 26, 26, 27, 27, 27, 27, 27, 27, 27, 27, 27, 27, 28, 28, 28, 28, 28, 28, 28, 28, 28, 28, 29, 29, 29, 29, 29, 29, 29, 29, 29, 29, 29, 29, 30, 30, 30, 30, 30, 30, 30, 30, 30, 30, 30, 30, 30, 30, 31, 31, 31, 31, 31, 31, 31, 31, 31, 31, 31, 31, 31, 31, 31};
__device__ __forceinline__ int t5b(int dist) { return dist >= 128 ? 31 : (int)T5B[dist < 0 ? 0 : dist]; }

template <int K> __device__ __forceinline__ float swz_xor(float v) { return __int_as_float(__builtin_amdgcn_ds_swizzle(__float_as_int(v), (K << 10) | 0x1f)); }
template <int K> __device__ __forceinline__ unsigned swz_xor_u(unsigned v) { return (unsigned)__builtin_amdgcn_ds_swizzle((int)v, (K << 10) | 0x1f); }
__device__ __forceinline__ float xhalf_sum(float v) { auto rr = __builtin_amdgcn_permlane32_swap(__float_as_uint(v), __float_as_uint(v), false, false); return __uint_as_float(rr[0]) + __uint_as_float(rr[1]); }
__device__ __forceinline__ float xhalf_max(float v) { auto rr = __builtin_amdgcn_permlane32_swap(__float_as_uint(v), __float_as_uint(v), false, false); return fmaxf(__uint_as_float(rr[0]), __uint_as_float(rr[1])); }
__device__ __forceinline__ float xhalf_other(float v, int hi) { auto rr = __builtin_amdgcn_permlane32_swap(__float_as_uint(v), __float_as_uint(v), false, false); return __uint_as_float(hi ? rr[0] : rr[1]); }
__device__ __forceinline__ float wave_sum(float v) {
    v += swz_xor<1>(v); v += swz_xor<2>(v); v += swz_xor<4>(v); v += swz_xor<8>(v); v += swz_xor<16>(v);
    return xhalf_sum(v);
}
__device__ __forceinline__ float sigmoidf_(float x) { return 1.f / (1.f + __expf(-x)); }
__device__ __forceinline__ float siluf_(float x) { return x / (1.f + __expf(-x)); }
__device__ __forceinline__ float fast_sigmoid(float x) { return __builtin_amdgcn_rcpf(1.f + __builtin_amdgcn_exp2f(-x * LOG2E)); }

__device__ __forceinline__ void ph_prep(int tid_in, const float* xin, bf16_t* XB, float* SSQ) {
    int t_ = tid_in; asm volatile("" : "+v"(t_));
    const int lane = t_ & 63, gw = blockIdx.x * 8 + __builtin_amdgcn_readfirstlane(t_ >> 6);
    for (int row = gw; row < M; row += gridDim.x * 8) {
        const f32x4* xr = (const f32x4*)(xin + (size_t)row * D) + lane; float ss = 0.f;
        f32x4 v[4];
#pragma unroll
        for (int j = 0; j < 4; ++j) v[j] = __builtin_nontemporal_load(xr + 64 * j);
#pragma unroll
        for (int j = 0; j < 4; ++j) { ss += (v[j][0] * v[j][0] + v[j][1] * v[j][1]) + (v[j][2] * v[j][2] + v[j][3] * v[j][3]);
            uint2 w; w.x = pk2(v[j][0], v[j][1]); w.y = pk2(v[j][2], v[j][3]); *((uint2*)(XB + (size_t)row * D) + lane + 64 * j) = w; }
        ss = wave_sum(ss);
        if (lane < 16) SSQ[(size_t)row * 16 + lane] = lane == 0 ? ss : 0.f;
    }
}

namespace pg8 {
constexpr int BM = 256, BK = 64, HALF = 128, HTB = HALF * BK * 2, STAGE_BYTES = 8 * HTB, NXCD = 8, WGM = 8;
__host__ __device__ __forceinline__ int lds_byte(int r, int c) { const int st = (r >> 4) * 2 + (c >> 5), rr = r & 15, cc = c & 31, ob = rr * 64 + cc * 2; return st * 1024 + (ob ^ (((ob >> 9) & 1) << 5)); }
__host__ __device__ __forceinline__ void stage_rc(int b, int& R, int& C) { const int st = b / 1024, sb = b % 1024, swz = sb ^ (((sb >> 9) & 1) << 5); R = (st >> 1) * 16 + swz / 64; C = (st & 1) * 32 + (swz % 64) / 2; }
__host__ __device__ __forceinline__ int perm32(int rho) { const int n = rho >> 4, i = rho & 15; return 8 * (i >> 2) + 4 * n + (i & 3); }
struct Unit { int pm, pn; };
struct StaticOrder {
    int nM, nN, nwg, G, c;
    __device__ __forceinline__ void init(int M_, int N_, int G_, int c_) { nM = M_ / BM; nN = N_ / BM; nwg = nM * nN; G = G_; c = c_; }
    __device__ __forceinline__ bool next(int i, Unit& u) const {
        const long L = (long)i * G + c; if (L >= nwg) return false;
        int wgid = (int)L; { const int q = nwg / NXCD, r = nwg % NXCD, xcd = wgid % NXCD, off = wgid / NXCD; wgid = (xcd < r ? xcd * (q + 1) : r * (q + 1) + (xcd - r) * q) + off; }
        const int nig = WGM * nN, gid = wgid / nig, fm = gid * WGM, gsz = (nM - fm) < WGM ? (nM - fm) : WGM;
        u.pm = fm + ((wgid % nig) % gsz); u.pn = (wgid % nig) / gsz; return true;
    }
};
struct Ops {
    const char* A; const char* Bt; unsigned lda_b, ldb_b; size_t a_kstep; int nt;
    int a_mode;
    __device__ __forceinline__ const char* a_base(const Unit& u) const {
        if (a_mode == 1) return A + (size_t)(u.pm >> 5) * (16ull * S * 128) + (size_t)(u.pm & 31) * (256 * 128);
        if (a_mode == 2) return A + (size_t)u.pn * KV2 + (size_t)u.pm * 256 * lda_b;
        return A + (size_t)u.pm * 256 * lda_b;
    }
    __device__ __forceinline__ const char* b_base(const Unit& u) const { return Bt + (size_t)u.pn * 256 * ldb_b; }
};

constexpr int RSTD_LDS = 131072;
__device__ __forceinline__ float rstd_of(const float* ssq, int row) {
    const f32x4* p = (const f32x4*)(ssq + (size_t)row * 16); const f32x4 a = p[0], b = p[1], c = p[2], d = p[3];
    const float s = ((a[0] + a[1]) + (a[2] + a[3])) + ((b[0] + b[1]) + (b[2] + b[3])) + ((c[0] + c[1]) + (c[2] + c[3])) + ((d[0] + d[1]) + (d[2] + d[3]));
    return rsqrtf(s * (1.f / D) + EPS);
}
template <class Epi, class Sched>
__device__ __forceinline__ void gemm_phase(LAS unsigned char* lds, int tid_in, const Ops& G, const Sched& S_, const Epi& E) {
    int tid_ = tid_in; asm volatile("" : "+v"(tid_));
    const int tid = tid_, wid = __builtin_amdgcn_readfirstlane(tid >> 6), lane = tid & 63, wr = wid >> 2, wc = wid & 3, fr = lane & 15, fq = lane >> 4;
    const int nt = G.nt;
    unsigned voffA[2], voffB[2];
#pragma unroll
    for (int i = 0; i < 2; ++i) { int R, C; stage_rc(tid * 16 + i * 8192, R, C); const int Rb = Epi::PERM ? ((R & ~31) + perm32(R & 31)) : R;
        voffA[i] = (unsigned)R * G.lda_b + (unsigned)C * 2u; voffB[i] = (unsigned)Rb * G.ldb_b + (unsigned)C * 2u; }
    const size_t kstepA = G.a_kstep, kstepB = (size_t)(BK * 2);
    const size_t hstepA = (size_t)HALF * G.lda_b, hstepB = (size_t)HALF * G.ldb_b;
    const unsigned ldsw = (unsigned)wid * 1024u;
    const int aoff = lds_byte(wr * 64 + fr, fq * 8), boff = lds_byte(wc * 32 + fr, fq * 8);
#define PG8_SA(b, h) (((b) * 2 + (h)) * HTB)
#define PG8_SB(b, h) ((4 + (b) * 2 + (h)) * HTB)
#define PG8_STAGE(bufoff, gbase, voff) do { _Pragma("unroll") for (int _i = 0; _i < 2; ++_i) \
        __builtin_amdgcn_global_load_lds((const unsigned*)((const char*)(gbase) + (voff)[_i]), (LAS unsigned*)(lds + (bufoff) + ldsw + _i * 8192), 16, 0, 0); } while (0)
#define PG8_LDA(dst, b, h) do { _Pragma("unroll") for (int m = 0; m < 4; ++m) _Pragma("unroll") for (int k = 0; k < 2; ++k) dst[m][k] = *(const LAS bf16x8*)(lds + PG8_SA(b, h) + aoff + m * 2048 + k * 1024); } while (0)
#define PG8_LDB(dst, b, h) do { _Pragma("unroll") for (int n = 0; n < 2; ++n) _Pragma("unroll") for (int k = 0; k < 2; ++k) dst[n][k] = *(const LAS bf16x8*)(lds + PG8_SB(b, h) + boff + n * 2048 + k * 1024); } while (0)
#define PG8_MMA(ai, bj, At, Bt) do { __builtin_amdgcn_s_setprio(1); _Pragma("unroll") for (int m = 0; m < 4; ++m) _Pragma("unroll") for (int n = 0; n < 2; ++n) _Pragma("unroll") for (int k = 0; k < 2; ++k) \
        acc[ai][bj][m][n] = __builtin_amdgcn_mfma_f32_16x16x32_bf16(Bt[n][k], At[m][k], acc[ai][bj][m][n], 0, 0, 0); __builtin_amdgcn_s_setprio(0); } while (0)
#define PG8_WAIT_V(n) asm volatile("s_waitcnt vmcnt(" #n ")" ::: "memory")
#define PG8_WAIT_L(n) asm volatile("s_waitcnt lgkmcnt(" #n ")" ::: "memory")
#define PG8_BAR __builtin_amdgcn_s_barrier()
#define PG8_SCHED __builtin_amdgcn_sched_barrier(0)
    Unit cur, nxt; int ui = 0;
    if (!S_.next(0, cur)) return;
    f32x4 acc[2][2][4][2];
#pragma unroll
    for (int a = 0; a < 2; ++a)
#pragma unroll
        for (int b = 0; b < 2; ++b)
#pragma unroll
            for (int m = 0; m < 4; ++m)
#pragma unroll
                for (int n = 0; n < 2; ++n) acc[a][b][m][n] = (f32x4){0.f, 0.f, 0.f, 0.f};
    bf16x8 At[4][2], B0[2][2], B1[2][2];
    const char* cA = G.a_base(cur); const char* cB = G.b_base(cur);
    PG8_STAGE(PG8_SB(0, 0), cB, voffB); PG8_STAGE(PG8_SB(0, 1), cB + hstepB, voffB); PG8_STAGE(PG8_SA(0, 0), cA, voffA); PG8_STAGE(PG8_SA(0, 1), cA + hstepA, voffA);
    if (wr == 1) PG8_BAR;
    PG8_WAIT_V(2); PG8_BAR;
    PG8_STAGE(PG8_SB(1, 0), cB + kstepB, voffB); PG8_STAGE(PG8_SA(1, 0), cA + kstepA, voffA); PG8_STAGE(PG8_SB(1, 1), cB + hstepB + kstepB, voffB);
    PG8_WAIT_V(6); PG8_BAR;
    for (;;) {
        const bool has_next = S_.next(ui + 1, nxt);
        if constexpr (Epi::RSTD) { if (wid < 4) ((LAS float*)(lds + RSTD_LDS))[(ui & 1) * 256 + tid] = rstd_of(E.ssq, cur.pm * BM + tid); }
        const char* nA = has_next ? G.a_base(nxt) : cA; const char* nB = has_next ? G.b_base(nxt) : cB;
        for (int t = 0; t < nt; t += 2) {
            const bool last = (t == nt - 2);
            const char* a1 = cA + (size_t)(t + 1) * kstepA;
            const char* a2 = last ? nA : cA + (size_t)(t + 2) * kstepA; const char* b2 = last ? nB : cB + (size_t)(t + 2) * kstepB;
            const char* a3 = a2 + kstepA; const char* b3 = b2 + kstepB;
            if constexpr (Epi::KHOOK) E.khook(acc, cur, t, wr, wc, fr, fq);
            PG8_LDB(B0, 0, 0); PG8_LDB(B1, 0, 1); PG8_SCHED; PG8_LDA(At, 0, 0); PG8_STAGE(PG8_SA(1, 1), a1 + hstepA, voffA);
            PG8_WAIT_V(8); PG8_WAIT_L(0); PG8_BAR; PG8_MMA(0, 0, At, B0); PG8_MMA(0, 1, At, B1); PG8_BAR; PG8_SCHED;
            PG8_LDA(At, 0, 1); PG8_STAGE(PG8_SB(0, 0), b2, voffB); PG8_STAGE(PG8_SB(0, 1), b2 + hstepB, voffB); PG8_STAGE(PG8_SA(0, 0), a2, voffA);
            PG8_WAIT_V(8); PG8_WAIT_L(0); PG8_BAR; PG8_MMA(1, 0, At, B0); PG8_MMA(1, 1, At, B1); PG8_BAR; PG8_SCHED;
            PG8_LDB(B0, 1, 0); PG8_LDB(B1, 1, 1); PG8_SCHED; PG8_LDA(At, 1, 0); PG8_STAGE(PG8_SA(0, 1), a2 + hstepA, voffA);
            PG8_WAIT_V(8); PG8_WAIT_L(0); PG8_BAR; PG8_MMA(0, 0, At, B0); PG8_MMA(0, 1, At, B1); PG8_BAR; PG8_SCHED;
            PG8_LDA(At, 1, 1); PG8_STAGE(PG8_SB(1, 0), b3, voffB); PG8_STAGE(PG8_SB(1, 1), b3 + hstepB, voffB); PG8_STAGE(PG8_SA(1, 0), a3, voffA);
            PG8_WAIT_V(8); PG8_WAIT_L(0); PG8_BAR; PG8_MMA(1, 0, At, B0); PG8_MMA(1, 1, At, B1); PG8_BAR; PG8_SCHED;
        }
        if (wr == 0) PG8_BAR;
        E(acc, cur, wr, wc, fr, fq, (const LAS float*)(lds + RSTD_LDS) + (ui & 1) * 256);
        if (!has_next) break;
#pragma unroll
        for (int a = 0; a < 2; ++a)
#pragma unroll
            for (int b = 0; b < 2; ++b)
#pragma unroll
                for (int m = 0; m < 4; ++m)
#pragma unroll
                    for (int n = 0; n < 2; ++n) acc[a][b][m][n] = (f32x4){0.f, 0.f, 0.f, 0.f};
        cur = nxt; cA = nA; cB = nB; ++ui;
        if (wr == 1) PG8_BAR;
    }
    PG8_WAIT_V(0);
    PG8_BAR;
#undef PG8_SA
#undef PG8_SB
#undef PG8_STAGE
#undef PG8_LDA
#undef PG8_LDB
#undef PG8_MMA
#undef PG8_WAIT_V
#undef PG8_WAIT_L
#undef PG8_BAR
#undef PG8_SCHED
}

__device__ __forceinline__ float silu_fast(float x) { return x * __builtin_amdgcn_rcpf(1.f + __builtin_amdgcn_exp2f(-x * LOG2E)); }

struct EpiFfnUp {
    static constexpr bool PERM = true, KHOOK = false, RSTD = true;
    bf16_t* H; const float* ssq;
    __device__ __forceinline__ void operator()(const f32x4 (&acc)[2][2][4][2], const Unit& u, int wr, int wc, int fr, int fq, const LAS float* rs) const {
#pragma unroll
        for (int ai = 0; ai < 2; ++ai)
#pragma unroll
            for (int m = 0; m < 4; ++m) {
                const int row = u.pm * BM + ai * HALF + wr * 64 + m * 16 + fr; const float r = rs[ai * HALF + wr * 64 + m * 16 + fr];
                const float rl = -LOG2E * r, r2 = r * r;
                float h[8];
#pragma unroll
                for (int n = 0; n < 2; ++n)
#pragma unroll
                    for (int j = 0; j < 4; ++j) { const float g = acc[ai][0][m][n][j]; h[n * 4 + j] = (g * acc[ai][1][m][n][j]) * (r2 * __builtin_amdgcn_rcpf(1.f + __builtin_amdgcn_exp2f(g * rl))); }
                u32x4 w; w.x = pk2(h[0], h[1]); w.y = pk2(h[2], h[3]); w.z = pk2(h[4], h[5]); w.w = pk2(h[6], h[7]);
                *(u32x4*)(H + (size_t)row * F + u.pn * 128 + wc * 32 + fq * 8) = w;
                asm volatile("" ::: "memory");
            }
    }
};
struct EpiResid {
    static constexpr bool PERM = true, KHOOK = false, RSTD = false;
    const float* XI; float* XO; bf16_t* XB; float* ssq; float alpha;
    __device__ __forceinline__ void operator()(const f32x4 (&acc)[2][2][4][2], const Unit& u, int wr, int wc, int fr, int fq, const LAS float* rs) const {
        if (XI) {
#pragma unroll
            for (int ai = 0; ai < 2; ++ai) {
                f32x4 xi[4][2][2];
#pragma unroll
                for (int m = 0; m < 4; ++m)
#pragma unroll
                    for (int bj = 0; bj < 2; ++bj) {
                        const unsigned off = ((unsigned)(u.pm * BM + ai * HALF + wr * 64 + m * 16 + fr) * (unsigned)D + (unsigned)(u.pn * BM + bj * HALF + wc * 32 + fq * 8)) * 4u;
                        xi[m][bj][0] = __builtin_nontemporal_load((const f32x4*)((const char*)XI + off)); xi[m][bj][1] = __builtin_nontemporal_load((const f32x4*)((const char*)XI + off + 16));
                    }
#pragma unroll
                for (int m = 0; m < 4; ++m) {
                    const int row = u.pm * BM + ai * HALF + wr * 64 + m * 16 + fr; float ss = 0.f;
#pragma unroll
                    for (int bj = 0; bj < 2; ++bj) {
                        const size_t o = (size_t)row * D + u.pn * BM + bj * HALF + wc * 32 + fq * 8;
                        const f32x4 x0 = xi[m][bj][0] + acc[ai][bj][m][0] * alpha, x1 = xi[m][bj][1] + acc[ai][bj][m][1] * alpha;
                        u32x4 w; w.x = pk2(x0[0], x0[1]); w.y = pk2(x0[2], x0[3]); w.z = pk2(x1[0], x1[1]); w.w = pk2(x1[2], x1[3]); *(u32x4*)(XB + o) = w;
                        ss += (x0[0] * x0[0] + x0[1] * x0[1]) + (x0[2] * x0[2] + x0[3] * x0[3]) + (x1[0] * x1[0] + x1[1] * x1[1]) + (x1[2] * x1[2] + x1[3] * x1[3]);
                    }
                    ss += swz_xor<16>(ss); ss = xhalf_sum(ss);
                    if (fq == 0) ssq[(size_t)row * 16 + u.pn * 4 + wc] = ss;
                }
                asm volatile("" ::: "memory");
            }
            return;
        }
        u32x4 xb[2][4][2];
#pragma unroll
        for (int ai = 0; ai < 2; ++ai)
#pragma unroll
            for (int m = 0; m < 4; ++m)
#pragma unroll
                for (int bj = 0; bj < 2; ++bj) {
                    const unsigned off = ((unsigned)(u.pm * BM + ai * HALF + wr * 64 + m * 16 + fr) * (unsigned)D + (unsigned)(u.pn * BM + bj * HALF + wc * 32 + fq * 8)) * 2u;
                    xb[ai][m][bj] = *(const u32x4*)((const char*)XB + off);
                }
#pragma unroll
        for (int ai = 0; ai < 2; ++ai) {
#pragma unroll
            for (int m = 0; m < 4; ++m) {
                const int row = u.pm * BM + ai * HALF + wr * 64 + m * 16 + fr; float ss = 0.f;
#pragma unroll
                for (int bj = 0; bj < 2; ++bj) {
                    const size_t o = (size_t)row * D + u.pn * BM + bj * HALF + wc * 32 + fq * 8;
                    const u32x4 v = xb[ai][m][bj];
                    f32x4 x0 = (f32x4){__uint_as_float(v.x << 16), __uint_as_float(v.x & 0xffff0000u), __uint_as_float(v.y << 16), __uint_as_float(v.y & 0xffff0000u)};
                    f32x4 x1 = (f32x4){__uint_as_float(v.z << 16), __uint_as_float(v.z & 0xffff0000u), __uint_as_float(v.w << 16), __uint_as_float(v.w & 0xffff0000u)};
                    x0 += acc[ai][bj][m][0] * alpha; x1 += acc[ai][bj][m][1] * alpha;
                    if (XO) { *(f32x4*)(XO + o) = x0; *(f32x4*)(XO + o + 4) = x1; }
                    else { u32x4 w; w.x = pk2(x0[0], x0[1]); w.y = pk2(x0[2], x0[3]); w.z = pk2(x1[0], x1[1]); w.w = pk2(x1[2], x1[3]); *(u32x4*)(XB + o) = w; }
                    ss += (x0[0] * x0[0] + x0[1] * x0[1]) + (x0[2] * x0[2] + x0[3] * x0[3]) + (x1[0] * x1[0] + x1[1] * x1[1]) + (x1[2] * x1[2] + x1[3] * x1[3]);
                }
                ss += swz_xor<16>(ss); ss = xhalf_sum(ss);
                if (fq == 0) ssq[(size_t)row * 16 + u.pn * 4 + wc] = ss;
            }
            asm volatile("" ::: "memory");
        }
    }
};
__host__ __device__ __forceinline__ int win_slot_col(int slot) {
    if (slot < 8) return 64 * slot;
    if (slot < 20) return 512 + 64 * (slot - 8);
    if (slot < 40) return 1304 + 64 * (slot - 20);
    if (slot < 88) return 2584 + 64 * (slot - 40);
    if (slot == 88) return 1280;
    return -1;
}
__device__ __forceinline__ int gate8_pos(int c) { const int cc = c & 255; return (c & ~255) + ((((cc >> 5) & 3) * 4 + ((cc >> 3) & 3)) * 2 + (cc >> 7)) * 8; }
struct EpiWin {
    static constexpr bool PERM = true, KHOOK = false, RSTD = true;
    unsigned char* ws; const float* ssq; const float *nsa_qn, *nsa_kn, *swa_qn, *swa_kn;
    __device__ __forceinline__ void operator()(const f32x4 (&acc)[2][2][4][2], const Unit& u, int wr, int wc, int fr, int fq, const LAS float* rs) const {
        const int slot = u.pn * 4 + wc;
        if (slot >= 89) return;
        int kind = 0; const float* nw = nullptr; float scale = 1.f; bf16_t* dst = nullptr; int nh = 2, h = 0;
        if (slot < 8) { nw = nsa_qn; scale = C2; dst = (bf16_t*)(ws + OFF_Q16); nh = 16; h = slot; }
        else if (slot < 10) { dst = (bf16_t*)(ws + OFF_KCMP); h = slot - 8; }
        else if (slot < 12) { dst = (bf16_t*)(ws + OFF_VCMP); h = slot - 10; }
        else if (slot < 14) { nw = nsa_kn; dst = (bf16_t*)(ws + OFF_KSLC); h = slot - 12; }
        else if (slot < 16) { kind = 1; dst = (bf16_t*)(ws + OFF_VSLCT); h = slot - 14; }
        else if (slot < 18) { nw = nsa_kn; dst = (bf16_t*)(ws + OFF_KWIN); h = slot - 16; }
        else if (slot < 20) { kind = 1; dst = (bf16_t*)(ws + OFF_VWINT); h = slot - 18; }
        else if (slot < 24) { scale = C2; dst = (bf16_t*)(ws + OFF_Q16); nh = 16; h = 8 + slot - 20; }
        else if (slot < 28) { dst = (bf16_t*)(ws + OFF_SBK); nh = 4; h = slot - 24; }
        else if (slot < 32) { kind = 1; dst = (bf16_t*)(ws + OFF_SBVT); nh = 4; h = slot - 28; }
        else if (slot < 36) { nw = swa_qn; scale = C2; dst = (bf16_t*)(ws + OFF_Q16); nh = 16; h = 12 + slot - 32; }
        else if (slot < 38) { nw = swa_kn; dst = (bf16_t*)(ws + OFF_WK); h = slot - 36; }
        else if (slot < 40) { kind = 1; dst = (bf16_t*)(ws + OFF_WVT); h = slot - 38; }
        else if (slot < 88) { kind = 2; dst = (bf16_t*)(ws + OFF_A) + (size_t)((slot - 40) >> 4) * M * D + ((slot - 40) & 15) * 64; }
        else { kind = 3; }
        if (kind == 2) {
            unsigned char* gb = ws + OFF_A + (size_t)((slot - 40) >> 4) * M * D; const int sc = (slot - 40) & 15;
#pragma unroll
            for (int ai = 0; ai < 2; ++ai)
#pragma unroll
                for (int m = 0; m < 4; ++m) {
                    const int row = u.pm * BM + ai * HALF + wr * 64 + m * 16 + fr; const float rl = -LOG2E * rs[ai * HALF + wr * 64 + m * 16 + fr];
#pragma unroll
                    for (int bj = 0; bj < 2; ++bj) { unsigned w0 = 0u, w1 = 0u;
#pragma unroll
                        for (int j = 0; j < 4; ++j) {
                            w0 = __builtin_amdgcn_cvt_pk_u8_f32(__builtin_rintf(fmaxf(255.f * __builtin_amdgcn_rcpf(1.f + __builtin_amdgcn_exp2f(acc[ai][bj][m][0][j] * rl)), 1.f)), j, w0);
                            w1 = __builtin_amdgcn_cvt_pk_u8_f32(__builtin_rintf(fmaxf(255.f * __builtin_amdgcn_rcpf(1.f + __builtin_amdgcn_exp2f(acc[ai][bj][m][1][j] * rl)), 1.f)), j, w1);
                        }
                        uint2 pw; pw.x = w0; pw.y = w1;
                        *(uint2*)(gb + (size_t)row * D + gate8_pos(sc * 64 + 32 * bj + 8 * fq)) = pw; }
                    asm volatile("" ::: "memory");
                }
            return;
        }
        f32x4 wv[2][2];
#pragma unroll
        for (int bj = 0; bj < 2; ++bj)
#pragma unroll
            for (int n = 0; n < 2; ++n) { wv[bj][n] = (f32x4){scale, scale, scale, scale}; if (nw) wv[bj][n] = *(const f32x4*)(nw + 32 * bj + 8 * fq + 4 * n) * scale; }
#pragma unroll
        for (int ai = 0; ai < 2; ++ai)
#pragma unroll
            for (int m = 0; m < 4; ++m) {
                const int row = u.pm * BM + ai * HALF + wr * 64 + m * 16 + fr; const float r = rs[ai * HALF + wr * 64 + m * 16 + fr];
                const int b = row / S, s = row % S;
                float v[2][2][4]; float ss = 0.f;
#pragma unroll
                for (int bj = 0; bj < 2; ++bj)
#pragma unroll
                    for (int n = 0; n < 2; ++n)
#pragma unroll
                        for (int j = 0; j < 4; ++j) { const float x = r * acc[ai][bj][m][n][j]; v[bj][n][j] = x; ss += x * x; }
                float rn = 1.f;
                if (nw) { ss += swz_xor<16>(ss); ss = xhalf_sum(ss); rn = rsqrtf(ss * (1.f / 64.f) + EPS); }
#pragma unroll
                for (int bj = 0; bj < 2; ++bj)
#pragma unroll
                    for (int n = 0; n < 2; ++n)
#pragma unroll
                        for (int j = 0; j < 4; ++j) v[bj][n][j] *= rn * wv[bj][n][j];
                if (kind == 0) {
                    bf16_t* o = dst + (((size_t)b * nh + h) * S + s) * 64 + 8 * fq;
#pragma unroll
                    for (int bj = 0; bj < 2; ++bj) { u32x4 pw; pw.x = pk2(v[bj][0][0], v[bj][0][1]); pw.y = pk2(v[bj][0][2], v[bj][0][3]); pw.z = pk2(v[bj][1][0], v[bj][1][1]); pw.w = pk2(v[bj][1][2], v[bj][1][3]);
                        *(u32x4*)(o + 32 * bj) = pw; }
                } else if (kind == 1) {
                    bf16_t* o = dst + ((size_t)b * nh + h) * 64 * S + vt_pos(s);
#pragma unroll
                    for (int bj = 0; bj < 2; ++bj)
#pragma unroll
                        for (int n = 0; n < 2; ++n)
#pragma unroll
                            for (int j = 0; j < 4; ++j) o[(size_t)(32 * bj + 8 * fq + 4 * n + j) * S] = f2bf(v[bj][n][j]);
                } else if (kind == 2) {
                    bf16_t* o = dst + (size_t)row * D + 8 * fq;
#pragma unroll
                    for (int bj = 0; bj < 2; ++bj) { u32x4 pw; pw.x = pk2(fast_sigmoid(v[bj][0][0]), fast_sigmoid(v[bj][0][1])); pw.y = pk2(fast_sigmoid(v[bj][0][2]), fast_sigmoid(v[bj][0][3]));
                        pw.z = pk2(fast_sigmoid(v[bj][1][0]), fast_sigmoid(v[bj][1][1])); pw.w = pk2(fast_sigmoid(v[bj][1][2]), fast_sigmoid(v[bj][1][3])); *(u32x4*)(o + 32 * bj) = pw; }
                } else {
                    float* o = (float*)(ws + OFF_NGATE) + (size_t)row * 24;
#pragma unroll
                    for (int n = 0; n < 2; ++n)
#pragma unroll
                        for (int j = 0; j < 4; ++j) { const int d = 8 * fq + 4 * n + j; if (d < 24) o[d] = fast_sigmoid(v[0][n][j]); }
                }
                asm volatile("" ::: "memory");
            }
    }
};
struct EpiCmp1 {
    static constexpr bool PERM = true, KHOOK = false, RSTD = false;
    bf16_t* HID; const float* bias;
    __device__ __forceinline__ void operator()(const f32x4 (&acc)[2][2][4][2], const Unit& u, int wr, int wc, int fr, int fq, const LAS float* rs) const {
        f32x4 bv[2][2];
#pragma unroll
        for (int bj = 0; bj < 2; ++bj)
#pragma unroll
            for (int n = 0; n < 2; ++n) bv[bj][n] = *(const f32x4*)(bias + u.pn * 256 + bj * HALF + wc * 32 + fq * 8 + 4 * n);
#pragma unroll
        for (int ai = 0; ai < 2; ++ai)
#pragma unroll
            for (int m = 0; m < 4; ++m) {
                const int row = u.pm * BM + ai * HALF + wr * 64 + m * 16 + fr;
#pragma unroll
                for (int bj = 0; bj < 2; ++bj) {
                    float o[8];
#pragma unroll
                    for (int n = 0; n < 2; ++n)
#pragma unroll
                        for (int j = 0; j < 4; ++j) o[4 * n + j] = silu_fast(acc[ai][bj][m][n][j] + bv[bj][n][j]);
                    u32x4 w; w.x = pk2(o[0], o[1]); w.y = pk2(o[2], o[3]); w.z = pk2(o[4], o[5]); w.w = pk2(o[6], o[7]);
                    *(u32x4*)(HID + ((size_t)u.pn * 2048 + row) * 256 + bj * HALF + wc * 32 + fq * 8) = w;
                }
                asm volatile("" ::: "memory");
            }
    }
};
struct EpiMerge {
    static constexpr bool PERM = true, KHOOK = true, RSTD = false;
    const unsigned char* G0; const unsigned char* G1; const unsigned char* G2; bf16_t* OUT;
    static __device__ __forceinline__ float ub(unsigned w, int kk) { return (float)((w >> (8 * kk)) & 0xffu); }
    __device__ __forceinline__ void khook(f32x4 (&acc)[2][2][4][2], const Unit& u, int t, int wr, int wc, int fr, int fq) const {
        if (t != 8 && t != 12) return;
        const unsigned char* NUM = t == 8 ? G0 : G1; const unsigned char* DEN = t == 8 ? G1 : G2;
#pragma unroll
        for (int ai = 0; ai < 2; ++ai) {
            u32x4 nu[4], de[4];
#pragma unroll
            for (int m = 0; m < 4; ++m) {
                const unsigned off = (unsigned)(u.pm * BM + ai * HALF + wr * 64 + m * 16 + fr) * (unsigned)D + (unsigned)(u.pn * BM + (wc * 4 + fq) * 16);
                nu[m] = *(const u32x4*)(NUM + off); de[m] = *(const u32x4*)(DEN + off);
            }
#pragma unroll
            for (int m = 0; m < 4; ++m)
#pragma unroll
                for (int bj = 0; bj < 2; ++bj)
#pragma unroll
                    for (int n = 0; n < 2; ++n)
#pragma unroll
                        for (int j = 0; j < 4; ++j) acc[ai][bj][m][n][j] *= ub(nu[m][2 * bj + n], j) * __builtin_amdgcn_rcpf(ub(de[m][2 * bj + n], j));
#pragma unroll
            for (int m = 0; m < 4; ++m) asm volatile("" : "+v"(acc[ai][0][m][0]), "+v"(acc[ai][0][m][1]), "+v"(acc[ai][1][m][0]), "+v"(acc[ai][1][m][1]) :: "memory");
        }
    }
    __device__ __forceinline__ void operator()(const f32x4 (&acc)[2][2][4][2], const Unit& u, int wr, int wc, int fr, int fq, const LAS float* rs) const {
        u32x4 ge2[2][4];
#pragma unroll
        for (int ai = 0; ai < 2; ++ai)
#pragma unroll
            for (int m = 0; m < 4; ++m) ge2[ai][m] = *(const u32x4*)(G2 + (size_t)(u.pm * BM + ai * HALF + wr * 64 + m * 16 + fr) * D + u.pn * BM + (wc * 4 + fq) * 16);
#pragma unroll
        for (int ai = 0; ai < 2; ++ai) {
            u32x4 ge[4];
#pragma unroll
            for (int m = 0; m < 4; ++m) ge[m] = ge2[ai][m];
#pragma unroll
            for (int m = 0; m < 4; ++m)
#pragma unroll
                for (int bj = 0; bj < 2; ++bj) {
                    const size_t o = (size_t)(u.pm * BM + ai * HALF + wr * 64 + m * 16 + fr) * D + u.pn * BM + bj * HALF + wc * 32 + fq * 8;
                    u32x4 pw;
#pragma unroll
                    for (int n = 0; n < 2; ++n) {
                        const unsigned gw = ge[m][2 * bj + n];
                        pw[2 * n] = pk2(acc[ai][bj][m][n][0] * (ub(gw, 0) * (1.f / 255.f)), acc[ai][bj][m][n][1] * (ub(gw, 1) * (1.f / 255.f)));
                        pw[2 * n + 1] = pk2(acc[ai][bj][m][n][2] * (ub(gw, 2) * (1.f / 255.f)), acc[ai][bj][m][n][3] * (ub(gw, 3) * (1.f / 255.f)));
                    }
                    *(u32x4*)(OUT + o) = pw;
                }
            asm volatile("" ::: "memory");
        }
    }
};
}

struct ConvCtx { LAS unsigned char* ldsr; LAS float* scr; int gw, ngw, lane; };
#define CONV_LAUNDER ConvCtx c = c_; { int t_ = c_.lane; asm volatile("" : "+v"(t_)); c.lane = t_ & 63; const int wv_ = __builtin_amdgcn_readfirstlane(t_ >> 6); c.gw = ((int)blockIdx.x - c_.gw) * 8 + wv_; c.scr = (LAS float*)(c.ldsr + wv_ * 8448); }
struct FfnItem { const float* W; const float* wn; bf16_t* Bt; int ldw, ldbt; };
__device__ __forceinline__ FfnItem ffn_item(int it, const float* nw, const float* wg, const float* wu, const float* wd, bf16_t* GU, bf16_t* DN) {
    constexpr int I_GU = 16 * 176;
    FfnItem r;
    if (it < I_GU) { const int kb = it / 176, cb = it % 176, isup = cb / 88, c32 = cb % 88, tile = c32 >> 2;
        r.W = (isup ? wu : wg) + (size_t)(kb * 64) * F + c32 * 32; r.wn = nw + kb * 64; r.Bt = GU + (size_t)(tile * 256 + isup * 128 + (c32 & 3) * 32) * D + kb * 64; r.ldw = F; r.ldbt = D; }
    else { const int q = it - I_GU, kb = q >> 5, cb = q & 31;
        r.W = wd + (size_t)(kb * 64) * D + cb * 32; r.wn = nullptr; r.Bt = DN + (size_t)(cb * 32) * F + kb * 64; r.ldw = D; r.ldbt = F; }
    return r;
}
constexpr int FFN_GU_ITEMS = 16 * 176, FFN_ITEMS = FFN_GU_ITEMS + 44 * 32;
#define CW_LOAD(v, wq, it_) do { if ((it_) < it_hi) { const FfnItem fi_ = ffn_item((it_), nw, wg, wu, wd, GU, DN); \
        _Pragma("unroll") for (int i_ = 0; i_ < 8; ++i_) v[i_] = __builtin_nontemporal_load((const f32x4*)(fi_.W + (size_t)(8 * i_ + kr) * fi_.ldw + n4)); \
        wq[0] = (f32x4){1.f, 1.f, 1.f, 1.f}; wq[1] = wq[0]; if (fi_.wn) { wq[0] = *(const f32x4*)(fi_.wn + 8 * c8); wq[1] = *(const f32x4*)(fi_.wn + 8 * c8 + 4); } } } while (0)
#define CW_PROC(v, wq, it_) do { if ((it_) < it_hi) { const FfnItem fi_ = ffn_item((it_), nw, wg, wu, wd, GU, DN); \
        _Pragma("unroll") for (int i_ = 0; i_ < 8; ++i_) { LAS float* d_ = c.scr + (8 * i_ + kr) * 33 + n4; d_[0] = v[i_][0]; d_[1] = v[i_][1]; d_[2] = v[i_][2]; d_[3] = v[i_][3]; } \
        asm volatile("s_waitcnt lgkmcnt(0)" ::: "memory"); \
        _Pragma("unroll") for (int j_ = 0; j_ < 4; ++j_) { const int n_ = kr + 8 * j_; const LAS float* s_ = c.scr + (8 * c8) * 33 + n_; \
            u32x4 o_; o_.x = pk2(s_[0 * 33] * wq[0][0], s_[1 * 33] * wq[0][1]); o_.y = pk2(s_[2 * 33] * wq[0][2], s_[3 * 33] * wq[0][3]); \
            o_.z = pk2(s_[4 * 33] * wq[1][0], s_[5 * 33] * wq[1][1]); o_.w = pk2(s_[6 * 33] * wq[1][2], s_[7 * 33] * wq[1][3]); \
            *(u32x4*)(fi_.Bt + (size_t)n_ * fi_.ldbt + 8 * c8) = o_; } \
        asm volatile("s_waitcnt lgkmcnt(0)" ::: "memory"); } } while (0)
__device__ __forceinline__ void conv_ffn(const ConvCtx& c_, const float* nw, const float* wg, const float* wu, const float* wd, unsigned char* dstbase, int it_lo, int it_hi) {
    CONV_LAUNDER;
    bf16_t* GU = (bf16_t*)dstbase; bf16_t* DN = (bf16_t*)(dstbase + FFNW_D);
    const int n4 = (c.lane & 7) * 4, kr = c.lane >> 3, c8 = c.lane & 7, st = c.ngw;
    f32x4 v0[8], v1[8], w0[2], w1[2];
    int it = it_lo + c.gw;
    CW_LOAD(v0, w0, it); CW_LOAD(v1, w1, it + st);
#pragma unroll 1
    for (; it < it_hi; it += 2 * st) {
        CW_PROC(v0, w0, it);      CW_LOAD(v0, w0, it + 2 * st);
        CW_PROC(v1, w1, it + st); CW_LOAD(v1, w1, it + 3 * st);
    }
}
#undef CW_LOAD
#undef CW_PROC
struct MixW { const float *mixn, *win, *w1k, *w1v, *ua, *ub, *uc, *wo, *pos, *w2k, *w2v; };
struct MixItem { const float* W; const float* wn; bf16_t* Bt; int ldw, ldbt, nvalid; };
constexpr int MIX_I_IN = 184 * 4, MIX_I_C1 = 16 * 8, MIX_I_M = 32 * 4, MIX_I_O = 32 * 4, MIX_I_W2 = 4, MIX_I_B = 512;
constexpr int MIX_CONV_ITEMS = (MIX_I_IN + MIX_I_C1 + MIX_I_M + MIX_I_O + MIX_I_W2) * 4;
__device__ __forceinline__ void mix_item(int it4, const MixW& w, unsigned char* ws, const float*& oW, const float*& own, bf16_t*& oBt, int& oldw, int& oldbt, int& onvalid) {
    const int q = it4 & 3; int r = it4 >> 2;
    const float* W; const float* wn = nullptr; bf16_t* Bt; int ldw, ldbt, nvalid = 32, col0, ksrc, row0, kofs;
    if (r < MIX_I_IN) { const int rb = r / 4, kb = r % 4, tile = rb >> 3, r32 = rb & 7, bj = r32 >> 2, slot = tile * 4 + (r32 & 3);
        const int sc = pg8::win_slot_col(slot); nvalid = sc < 0 ? 0 : 32; if (slot == 88) nvalid = bj == 0 ? 24 : 0;
        W = w.win; ldw = DIN; col0 = sc + 32 * bj; ksrc = kb * 256; wn = w.mixn; Bt = (bf16_t*)(ws + OFF_BT_IN); ldbt = D; row0 = rb * 32; kofs = kb * 256; }
    else if ((r -= MIX_I_IN) < MIX_I_C1) { const int rb = r / 8, kb = r % 8; { const float* a_ = w.w1k; const float* b_ = w.w1v; W = a_; if (rb >= 8) W = b_; } ldw = 256; col0 = (rb & 7) * 32; ksrc = kb * 256; Bt = (bf16_t*)(ws + OFF_BT_C1); ldbt = 2048; row0 = rb * 32; kofs = kb * 256; }
    else if ((r -= MIX_I_C1) < MIX_I_M) { const int rb = r / 4, kb = r % 4;
        { const float* ua_ = w.ua; const float* ub_ = w.ub; const float* uc_ = w.uc; W = ua_; if (kb == 2) W = ub_; if (kb == 3) W = uc_; } ldw = D; col0 = rb * 32; ksrc = kb < 2 ? kb * 256 : 0; Bt = (bf16_t*)(ws + OFF_BT_M); ldbt = D; row0 = rb * 32; kofs = kb * 256; }
    else if ((r -= MIX_I_M) < MIX_I_O) { const int rb = r / 4, kb = r % 4; W = w.wo; ldw = D; col0 = rb * 32; ksrc = kb * 256; Bt = (bf16_t*)(ws + OFF_BT_O); ldbt = D; row0 = rb * 32; kofs = kb * 256; }
    else { r -= MIX_I_O; const int kv = r >> 1, rb = r & 1;
        { const float* a_ = w.w2k; const float* b_ = w.w2v; W = a_; if (kv) W = b_; } ldw = 64; col0 = rb * 32; ksrc = 0; Bt = (bf16_t*)(ws + OFF_W2T) + (size_t)kv * 64 * 256; ldbt = 256; row0 = rb * 32; kofs = 0; }
    if (nvalid == 0) col0 = 0;
    oW = W + (size_t)(ksrc + 64 * q) * ldw + col0; own = wn ? wn + ksrc + 64 * q : nullptr; oBt = Bt + (size_t)row0 * ldbt + kofs + 64 * q; oldw = ldw; oldbt = ldbt; onvalid = nvalid;
}
#define CM_LOAD(v, wq, it_) do { if ((it_) < MIX_CONV_ITEMS) { MixItem fi_; mix_item((it_), w, ws, fi_.W, fi_.wn, fi_.Bt, fi_.ldw, fi_.ldbt, fi_.nvalid); \
        _Pragma("unroll") for (int i_ = 0; i_ < 8; ++i_) { v[i_] = (f32x4){0.f, 0.f, 0.f, 0.f}; if (n4 < fi_.nvalid) v[i_] = __builtin_nontemporal_load((const f32x4*)(fi_.W + (size_t)(8 * i_ + kr) * fi_.ldw + n4)); } \
        wq[0] = (f32x4){1.f, 1.f, 1.f, 1.f}; wq[1] = wq[0]; if (fi_.wn) { wq[0] = *(const f32x4*)(fi_.wn + 8 * c8); wq[1] = *(const f32x4*)(fi_.wn + 8 * c8 + 4); } } } while (0)
#define CM_PROC(v, wq, it_) do { if ((it_) < MIX_CONV_ITEMS) { MixItem fi_; mix_item((it_), w, ws, fi_.W, fi_.wn, fi_.Bt, fi_.ldw, fi_.ldbt, fi_.nvalid); \
        _Pragma("unroll") for (int i_ = 0; i_ < 8; ++i_) { LAS float* d_ = c.scr + (8 * i_ + kr) * 33 + n4; d_[0] = v[i_][0]; d_[1] = v[i_][1]; d_[2] = v[i_][2]; d_[3] = v[i_][3]; } \
        asm volatile("s_waitcnt lgkmcnt(0)" ::: "memory"); \
        _Pragma("unroll") for (int j_ = 0; j_ < 4; ++j_) { const int n_ = kr + 8 * j_; const LAS float* s_ = c.scr + (8 * c8) * 33 + n_; \
            u32x4 o_; o_.x = pk2(s_[0 * 33] * wq[0][0], s_[1 * 33] * wq[0][1]); o_.y = pk2(s_[2 * 33] * wq[0][2], s_[3 * 33] * wq[0][3]); \
            o_.z = pk2(s_[4 * 33] * wq[1][0], s_[5 * 33] * wq[1][1]); o_.w = pk2(s_[6 * 33] * wq[1][2], s_[7 * 33] * wq[1][3]); \
            *(u32x4*)(fi_.Bt + (size_t)n_ * fi_.ldbt + 8 * c8) = o_; } \
        asm volatile("s_waitcnt lgkmcnt(0)" ::: "memory"); } } while (0)
__device__ __forceinline__ void conv_mix(const ConvCtx& c_, const MixW& w, unsigned char* ws) {
    CONV_LAUNDER;
    const int n4 = (c.lane & 7) * 4, kr = c.lane >> 3, c8 = c.lane & 7, st = c.ngw;
    {
        f32x4 v0[8], v1[8], w0[2], w1[2];
        int it = c.gw;
        CM_LOAD(v0, w0, it); CM_LOAD(v1, w1, it + st);
#pragma unroll 1
        for (; it < MIX_CONV_ITEMS; it += 2 * st) {
            CM_PROC(v0, w0, it);      CM_LOAD(v0, w0, it + 2 * st);
            CM_PROC(v1, w1, it + st); CM_LOAD(v1, w1, it + 3 * st);
        }
    }
#pragma unroll 1
    for (int r = c.gw; r < MIX_I_B; r += c.ngw) {
        const int kv = r >> 8, j = r & 255; const float* w1 = kv ? w.w1v : w.w1k; float s = 0.f;
#pragma unroll 8
        for (int i = 0; i < 32; ++i) { const int kk = c.lane + 64 * i; s += w.pos[kk] * w1[(size_t)kk * 256 + j]; }
        s = wave_sum(s);
        if (c.lane == 0) ((float*)(ws + OFF_BIASC))[kv * 256 + j] = s;
    }
}
#undef CM_LOAD
#undef CM_PROC

typedef float f32x16 __attribute__((ext_vector_type(16)));
__host__ __device__ __forceinline__ int crow(int r, int hi) { return (r & 3) + 8 * (r >> 2) + 4 * hi; }
__device__ __forceinline__ bf16x8 pack8(const f32x16& p, int s) {
    u32x4 w; w.x = pk2(p[8 * s + 0], p[8 * s + 1]); w.y = pk2(p[8 * s + 2], p[8 * s + 3]); w.z = pk2(p[8 * s + 4], p[8 * s + 5]); w.w = pk2(p[8 * s + 6], p[8 * s + 7]);
    return __builtin_bit_cast(bf16x8, w);
}
constexpr int TAB_N = 130;
__device__ __forceinline__ int tab_idx(int dist) { return min(max(dist, -1), 128) + 1; }
__device__ __forceinline__ void build_tabs(LAS float* tab, const float* rel_bias, int tid) {
    for (int i = tid; i < 12 * TAB_N; i += 512) {
        const int hh = i / TAB_N, e = i % TAB_N; float v;
        if (e == 0) v = -INFINITY;
        else if (hh < 8) v = e == 129 ? 0.f : (rel_bias[t5b(e - 1) * 12 + hh] - rel_bias[31 * 12 + hh]) * LOG2E;
        else v = e == 129 ? -INFINITY : rel_bias[t5b(e - 1) * 12 + hh] * LOG2E;
        tab[i] = v;
    }
}
__device__ __forceinline__ void qk_global(f32x16& p0, f32x16& p1, const bf16_t* K, const bf16x8 (&qf)[4], int lane) {
    const bf16_t* kp = K + (size_t)(lane & 31) * 64 + 8 * (lane >> 5);
    bf16x8 kf[8];
#pragma unroll
    for (int c = 0; c < 4; ++c) { kf[2 * c] = *(const bf16x8*)(kp + 16 * c); kf[2 * c + 1] = *(const bf16x8*)(kp + 32 * 64 + 16 * c); }
    f32x16 z;
#pragma unroll
    for (int r = 0; r < 16; ++r) z[r] = 0.f;
    p0 = z; p1 = z;
#pragma unroll
    for (int c = 0; c < 4; ++c) {
        p0 = __builtin_amdgcn_mfma_f32_32x32x16_bf16(kf[2 * c], qf[c], p0, 0, 0, 0);
        p1 = __builtin_amdgcn_mfma_f32_32x32x16_bf16(kf[2 * c + 1], qf[c], p1, 0, 0, 0);
    }
}
__device__ __forceinline__ void pv_global(f32x16 (&o)[2], const bf16_t* VT, size_t pitch, const f32x16& p0, const f32x16& p1, int lane) {
    const bf16_t* vp = VT + (size_t)(lane & 31) * pitch + 8 * (lane >> 5);
    bf16x8 vf[8];
#pragma unroll
    for (int q = 0; q < 4; ++q)
#pragma unroll
        for (int dh = 0; dh < 2; ++dh) vf[2 * q + dh] = *(const bf16x8*)(vp + (size_t)(32 * dh) * pitch + 16 * q);
#pragma unroll
    for (int q = 0; q < 4; ++q) {
        const bf16x8 pf = pack8((q >> 1) ? p1 : p0, q & 1);
#pragma unroll
        for (int dh = 0; dh < 2; ++dh) o[dh] = __builtin_amdgcn_mfma_f32_32x32x16_bf16(vf[2 * q + dh], pf, o[dh], 0, 0, 0);
    }
}
__device__ __forceinline__ void softmax_step(f32x16& p0, f32x16& p1, float& m, float& l, f32x16 (&o)[2]) {
    float mx = fmaxf(p0[0], p1[0]);
#pragma unroll
    for (int r = 1; r < 16; ++r) mx = fmaxf(mx, fmaxf(p0[r], p1[r]));
    mx = xhalf_max(mx);
    const float mn = fmaxf(m, mx);
    const float ms = (mn == -INFINITY) ? 0.f : mn;
    const float alpha = __builtin_amdgcn_exp2f(m - ms);
    float sum = 0.f;
#pragma unroll
    for (int r = 0; r < 16; ++r) { p0[r] = __builtin_amdgcn_exp2f(p0[r] - ms); p1[r] = __builtin_amdgcn_exp2f(p1[r] - ms); sum += p0[r] + p1[r]; }
    l = l * alpha + sum; m = mn;
    if (__any(alpha != 1.f)) {
#pragma unroll
        for (int r = 0; r < 16; ++r) { o[0][r] *= alpha; o[1][r] *= alpha; }
    }
}
constexpr float SM_THR = 6.f;
__device__ __forceinline__ float max3f(float a, float b, float c) { return fmaxf(fmaxf(a, b), c); }
__device__ __forceinline__ void softmax_rel(f32x16& p0, f32x16& p1, float& mref, float& l, f32x16 (&o)[2], bool first) {
    float a = max3f(p0[0], p0[1], p1[0]), b = max3f(p0[2], p0[3], p1[1]);
    a = max3f(a, p1[2], p1[3]);
#pragma unroll
    for (int r = 4; r < 16; r += 4) { a = max3f(a, p0[r], p0[r + 1]); b = max3f(b, p0[r + 2], p0[r + 3]); a = max3f(a, p1[r], p1[r + 1]); b = max3f(b, p1[r + 2], p1[r + 3]); }
    const float mx = xhalf_max(fmaxf(a, b));
    if (first || __any(mx > SM_THR)) {
        const float d = first ? (mx == -INFINITY ? 0.f : mx) : fmaxf(mx, 0.f); const f32x2_t d2 = {d, d};
        mref += d;
        const float f = first ? 1.f : __builtin_amdgcn_exp2f(-d); const f32x2_t f2 = {f, f};
        l *= f;
#pragma unroll
        for (int r = 0; r < 16; r += 2) {
            f32x2_t x = {p0[r], p0[r + 1]}; x = x - d2; p0[r] = x[0]; p0[r + 1] = x[1];
            f32x2_t y = {p1[r], p1[r + 1]}; y = y - d2; p1[r] = y[0]; p1[r + 1] = y[1];
            f32x2_t u = {o[0][r], o[0][r + 1]}; u = u * f2; o[0][r] = u[0]; o[0][r + 1] = u[1];
            f32x2_t v = {o[1][r], o[1][r + 1]}; v = v * f2; o[1][r] = v[0]; o[1][r + 1] = v[1];
        }
    }
    f32x2_t s2 = {0.f, 0.f};
#pragma unroll
    for (int r = 0; r < 16; r += 2) {
        p0[r] = __builtin_amdgcn_exp2f(p0[r]); p0[r + 1] = __builtin_amdgcn_exp2f(p0[r + 1]); p1[r] = __builtin_amdgcn_exp2f(p1[r]); p1[r + 1] = __builtin_amdgcn_exp2f(p1[r + 1]);
        const f32x2_t x = {p0[r], p0[r + 1]}, y = {p1[r], p1[r + 1]}; s2 = s2 + x; s2 = s2 + y;
    }
    l += s2[0] + s2[1];
}
__device__ __forceinline__ void store_ot(bf16_t* dst, const f32x16 (&o)[2], float scale, int hi) {
#pragma unroll
    for (int dh = 0; dh < 2; ++dh)
#pragma unroll
        for (int m4 = 0; m4 < 4; ++m4) {
            uint2 w; w.x = pk2(o[dh][4 * m4] * scale, o[dh][4 * m4 + 1] * scale); w.y = pk2(o[dh][4 * m4 + 2] * scale, o[dh][4 * m4 + 3] * scale);
            *(uint2*)(dst + 32 * dh + 8 * m4 + 4 * hi) = w;
        }
}

__device__ __forceinline__ void cmp2_unit(unsigned char* ws, const float* knorm, int unit, int lane) {
    const int kv = unit >> 6, hi = lane >> 5, row = (unit & 63) * 32 + (lane & 31), n = row & 511, grp = row >> 9;
    const bf16_t* hrow = (const bf16_t*)(ws + OFF_HID) + ((size_t)kv * 2048 + row) * 256 + 8 * hi;
    const bf16_t* w2t = (const bf16_t*)(ws + OFF_W2T) + (size_t)kv * 64 * 256 + (size_t)(lane & 31) * 256 + 8 * hi;
    f32x16 o[2];
#pragma unroll
    for (int r = 0; r < 16; ++r) { o[0][r] = 0.f; o[1][r] = 0.f; }
#pragma unroll
    for (int cb = 0; cb < 16; cb += 8) {
        bf16x8 hb[8], wf[2][8];
#pragma unroll
        for (int c = 0; c < 8; ++c) { hb[c] = *(const bf16x8*)(hrow + 16 * (cb + c));
#pragma unroll
            for (int dh = 0; dh < 2; ++dh) wf[dh][c] = *(const bf16x8*)(w2t + (size_t)dh * 32 * 256 + 16 * (cb + c)); }
#pragma unroll
        for (int c = 0; c < 8; ++c)
#pragma unroll
            for (int dh = 0; dh < 2; ++dh) o[dh] = __builtin_amdgcn_mfma_f32_32x32x16_bf16(wf[dh][c], hb[c], o[dh], 0, 0, 0);
    }
    const bool valid = n < NCMP;
    if (kv == 0) {
        float ss = 0.f;
#pragma unroll
        for (int r = 0; r < 16; ++r) ss += o[0][r] * o[0][r] + o[1][r] * o[1][r];
        ss = xhalf_sum(ss);
        const float rn = valid ? rsqrtf(ss * (1.f / 64.f) + EPS) : 0.f;
        bf16_t* dst = (bf16_t*)(ws + OFF_KCN) + ((size_t)grp * 512 + n) * 64;
#pragma unroll
        for (int dh = 0; dh < 2; ++dh)
#pragma unroll
            for (int m4 = 0; m4 < 4; ++m4) { const int d = 32 * dh + 8 * m4 + 4 * hi; const f32x4 kn = *(const f32x4*)(knorm + d);
                uint2 w; w.x = pk2(o[dh][4 * m4] * rn * kn[0], o[dh][4 * m4 + 1] * rn * kn[1]); w.y = pk2(o[dh][4 * m4 + 2] * rn * kn[2], o[dh][4 * m4 + 3] * rn * kn[3]);
                *(uint2*)(dst + d) = w; }
    } else {
        bf16_t* dst = (bf16_t*)(ws + OFF_VCT) + (size_t)grp * 64 * 512 + vt_pos(n);
#pragma unroll
        for (int dh = 0; dh < 2; ++dh)
#pragma unroll
            for (int r = 0; r < 16; ++r) dst[(size_t)(32 * dh + crow(r, hi)) * 512] = f2bf(valid ? o[dh][r] : 0.f);
    }
}

__device__ __forceinline__ void ldk_global(bf16x8 (&kf)[8], const bf16_t* K, int lane) {
    const bf16_t* kp = K + (size_t)(lane & 31) * 64 + 8 * (lane >> 5);
#pragma unroll
    for (int c = 0; c < 4; ++c) { kf[2 * c] = *(const bf16x8*)(kp + 16 * c); kf[2 * c + 1] = *(const bf16x8*)(kp + 32 * 64 + 16 * c); }
}
__device__ __forceinline__ void ldv_global(bf16x8 (&vf)[8], const bf16_t* VT, size_t pitch, int lane) {
    const bf16_t* vp = VT + (size_t)(lane & 31) * pitch + 8 * (lane >> 5);
#pragma unroll
    for (int q = 0; q < 4; ++q)
#pragma unroll
        for (int dh = 0; dh < 2; ++dh) vf[2 * q + dh] = *(const bf16x8*)(vp + (size_t)(32 * dh) * pitch + 16 * q);
}
__device__ __forceinline__ void mm_qk(f32x16& p0, f32x16& p1, const bf16x8 (&kf)[8], const bf16x8 (&qf)[4]) {
    f32x16 z;
#pragma unroll
    for (int r = 0; r < 16; ++r) z[r] = 0.f;
    p0 = z; p1 = z;
#pragma unroll
    for (int c = 0; c < 4; ++c) { p0 = __builtin_amdgcn_mfma_f32_32x32x16_bf16(kf[2 * c], qf[c], p0, 0, 0, 0); p1 = __builtin_amdgcn_mfma_f32_32x32x16_bf16(kf[2 * c + 1], qf[c], p1, 0, 0, 0); }
}
__device__ __forceinline__ void mm_pv(f32x16 (&o)[2], const bf16x8 (&vf)[8], const f32x16& p0, const f32x16& p1) {
#pragma unroll
    for (int q = 0; q < 4; ++q) { const bf16x8 pf = pack8((q >> 1) ? p1 : p0, q & 1);
#pragma unroll
        for (int dh = 0; dh < 2; ++dh) o[dh] = __builtin_amdgcn_mfma_f32_32x32x16_bf16(vf[2 * q + dh], pf, o[dh], 0, 0, 0); }
}
__device__ __forceinline__ void swa_unit(unsigned char* ws, const LAS float* tabW, const float* sinks, int unit, int lane, bool do_store) {
    const int t0 = (unit & 255) * 32, h = (unit >> 8) & 3, b = unit >> 10, g = h >> 1, hi = lane >> 5, t = t0 + (lane & 31);
    bf16_t* qrow = (bf16_t*)(ws + OFF_Q16) + (((size_t)b * 16 + 12 + h) * S + t) * 64;
    const bf16_t* K = (const bf16_t*)(ws + OFF_WK) + ((size_t)b * 2 + g) * S * 64; const bf16_t* VT = (const bf16_t*)(ws + OFF_WVT) + ((size_t)b * 2 + g) * 64 * S;
    bf16x8 qf[4];
#pragma unroll
    for (int c = 0; c < 4; ++c) qf[c] = *(const bf16x8*)(qrow + 16 * c + 8 * hi);
    const float sink = sinks[h] * LOG2E;
    float m = sink, l = hi == 0 ? 1.f : 0.f;
    f32x16 o[2];
#pragma unroll
    for (int r = 0; r < 16; ++r) { o[0][r] = 0.f; o[1][r] = 0.f; }
    const LAS float* tb = tabW + h * TAB_N;
    const int jlo = t0 >= 127 ? (t0 - 127) >> 6 : 0, jhi = (t0 + 31) >> 6;
    bf16x8 kf[8], vf[8];
    ldk_global(kf, K + (size_t)jlo * 4096, lane);
    for (int j = jlo; j <= jhi; ++j) {
        ldv_global(vf, VT + (size_t)j * 64, S, lane);
        f32x16 p0, p1;
        mm_qk(p0, p1, kf, qf);
        if (j < jhi) ldk_global(kf, K + (size_t)(j + 1) * 4096, lane);
#pragma unroll
        for (int r = 0; r < 16; ++r) { const int d0 = t - (j * 64 + crow(r, hi)); p0[r] += tb[tab_idx(d0)]; p1[r] += tb[tab_idx(d0 - 32)]; }
        softmax_step(p0, p1, m, l, o);
        mm_pv(o, vf, p0, p1);
    }
    l = xhalf_sum(l);
    if (do_store) store_ot(qrow, o, 1.f / l, hi);
}

constexpr float SB_CUT = 64.f;
__device__ __forceinline__ void sb_unit(unsigned char* ws, int unit, int lane, bool do_store) {
    const int t0 = (unit & 255) * 32, h = (unit >> 8) & 3, b = unit >> 10, hi = lane >> 5, t = t0 + (lane & 31);
    bf16_t* qrow = (bf16_t*)(ws + OFF_Q16) + (((size_t)b * 16 + 8 + h) * S + t) * 64;
    const bf16_t* K = (const bf16_t*)(ws + OFF_SBK) + ((size_t)b * 4 + h) * S * 64; const bf16_t* VT = (const bf16_t*)(ws + OFF_SBVT) + ((size_t)b * 4 + h) * 64 * S;
    bf16x8 qf[4];
#pragma unroll
    for (int c = 0; c < 4; ++c) qf[c] = *(const bf16x8*)(qrow + 16 * c + 8 * hi);
    f32x16 o[2];
#pragma unroll
    for (int r = 0; r < 16; ++r) { o[0][r] = 0.f; o[1][r] = 0.f; }
    float carry = 0.f;
    bf16x8 kf[8], vf[8];
    const int jd = (t0 + 31) >> 6;
    ldk_global(kf, K + (size_t)jd * 4096, lane);
    for (int j = jd; j >= 0; --j) {
        f32x16 z0, z1, f0, f1;
        mm_qk(z0, z1, kf, qf);
        if (j > 0) ldk_global(kf, K + (size_t)(j - 1) * 4096, lane);
        float gs[8];
#pragma unroll
        for (int u = 0; u < 8; ++u) gs[u] = 0.f;
        const int kb = j * 64;
#pragma unroll
        for (int r = 0; r < 16; ++r) {
            { const float z = z0[r]; const bool ok = kb + crow(r, hi) < t; const float sp = fmaxf(z, 0.f) + __builtin_amdgcn_logf(1.f + __builtin_amdgcn_exp2f(-fabsf(z))); f0[r] = ok ? -sp : 0.f; gs[r >> 2] += f0[r]; }
            { const float z = z1[r]; const bool ok = kb + 32 + crow(r, hi) < t; const float sp = fmaxf(z, 0.f) + __builtin_amdgcn_logf(1.f + __builtin_amdgcn_exp2f(-fabsf(z))); f1[r] = ok ? -sp : 0.f; gs[4 + (r >> 2)] += f1[r]; }
        }
        ldv_global(vf, VT + (size_t)j * 64, S, lane);
        float T = 0.f, A[8];
#pragma unroll
        for (int u = 7; u >= 0; --u) { const float pg = xhalf_other(gs[u], hi); A[u] = T + (hi == 0 ? pg : 0.f); T += gs[u] + pg; }
#pragma unroll
        for (int u = 0; u < 8; ++u) {
            float run = carry + A[u];
#pragma unroll
            for (int i = 3; i >= 0; --i) {
                const int r = 4 * (u & 3) + i;
                if (u < 4) { const bool ok = kb + crow(r, hi) < t; const float lf = f0[r]; z0[r] = ok ? __builtin_amdgcn_exp2f(z0[r] + lf + run) : 0.f; run += lf; }
                else { const bool ok = kb + 32 + crow(r, hi) < t; const float lf = f1[r]; z1[r] = ok ? __builtin_amdgcn_exp2f(z1[r] + lf + run) : 0.f; run += lf; }
            }
        }
        carry += T;
        mm_pv(o, vf, z0, z1);
        if (__all(carry < -SB_CUT)) break;
    }
    if (do_store) store_ot(qrow, o, 1.f, hi);
}


constexpr int NSA_STAGE = 16384, NSA_IMPG = 32768, NSA_IMPL = 65536, NSA_SEL = 98304;
struct TileSrc { const bf16_t* K; const bf16_t* VT; size_t vpitch; };
__device__ __forceinline__ void nsa_issue(LAS unsigned char* stage, const TileSrc& ts, int j, int tid, int wave) {
    const int row = tid >> 3, chunk = (tid & 7) ^ ((row >> 1) & 7);
    __builtin_amdgcn_global_load_lds((const unsigned*)(ts.K + ((size_t)j * 64 + row) * 64 + chunk * 8), (LAS unsigned*)(stage + wave * 1024), 16, 0, 0);
    __builtin_amdgcn_global_load_lds((const unsigned*)(ts.VT + (size_t)row * ts.vpitch + (size_t)j * 64 + chunk * 8), (LAS unsigned*)(stage + 8192 + wave * 1024), 16, 0, 0);
}
__device__ __forceinline__ void qk_lds(f32x16& p0, f32x16& p1, const LAS unsigned char* Kst, const bf16x8 (&qf)[4], float cinit, int lrow, int swz, int hi) {
    bf16x8 kf[8];
#pragma unroll
    for (int c = 0; c < 4; ++c) { const int off = lrow + (((2 * c + hi) ^ swz) << 4); kf[2 * c] = *(const LAS bf16x8*)(Kst + off); kf[2 * c + 1] = *(const LAS bf16x8*)(Kst + 4096 + off); }
    f32x16 z;
#pragma unroll
    for (int r = 0; r < 16; ++r) z[r] = cinit;
    p0 = z; p1 = z;
    __builtin_amdgcn_sched_barrier(0);
#pragma unroll
    for (int c = 0; c < 4; ++c) {
        p0 = __builtin_amdgcn_mfma_f32_32x32x16_bf16(kf[2 * c], qf[c], p0, 0, 0, 0);
        p1 = __builtin_amdgcn_mfma_f32_32x32x16_bf16(kf[2 * c + 1], qf[c], p1, 0, 0, 0);
    }
}
__device__ __forceinline__ void pv_lds(f32x16 (&o)[2], const LAS unsigned char* Vst, const f32x16& p0, const f32x16& p1, int lrow, int swz, int hi) {
    bf16x8 vf[8];
#pragma unroll
    for (int kh = 0; kh < 2; ++kh)
#pragma unroll
        for (int s = 0; s < 2; ++s) { const int off = lrow + (((4 * kh + 2 * s + hi) ^ swz) << 4);
#pragma unroll
            for (int dh = 0; dh < 2; ++dh) vf[4 * kh + 2 * s + dh] = *(const LAS bf16x8*)(Vst + dh * 4096 + off); }
    bf16x8 pf[4];
#pragma unroll
    for (int kh = 0; kh < 2; ++kh)
#pragma unroll
        for (int s = 0; s < 2; ++s) pf[2 * kh + s] = pack8(kh ? p1 : p0, s);
    __builtin_amdgcn_sched_barrier(0);
#pragma unroll
    for (int q = 0; q < 4; ++q)
#pragma unroll
        for (int dh = 0; dh < 2; ++dh) o[dh] = __builtin_amdgcn_mfma_f32_32x32x16_bf16(vf[2 * q + dh], pf[q], o[dh], 0, 0, 0);
}
__device__ __forceinline__ float quad_sum(float v) {
    v += __int_as_float(__builtin_amdgcn_mov_dpp(__float_as_int(v), 0xB1, 0xf, 0xf, true));
    v += __int_as_float(__builtin_amdgcn_mov_dpp(__float_as_int(v), 0x4E, 0xf, 0xf, true));
    return v;
}
#define NSA_WAITBAR() do { asm volatile("s_waitcnt vmcnt(0) lgkmcnt(0)" ::: "memory"); __builtin_amdgcn_s_barrier(); asm volatile("" ::: "memory"); } while (0)

__device__ __forceinline__ void nsa_unit(LAS unsigned char* lds, const LAS float* tabN, unsigned char* ws, int b, int g, int qt, int tid_in, bool do_store) {
    int tid = tid_in; asm volatile("" : "+v"(tid));
    const int lane = tid & 63, wave = __builtin_amdgcn_readfirstlane(tid >> 6), hi = lane >> 5, col = lane & 31, qi = col >> 2, r = col & 3;
    const int t0 = qt * 64, qloc = 8 * wave + qi, t = t0 + qloc, h = 4 * g + r, grp = b * 2 + g;
    const int lrow = col * 128, swz = (col >> 1) & 7;
    bf16_t* qrow = (bf16_t*)(ws + OFF_Q16) + (((size_t)b * 16 + h) * S + t) * 64;
    bf16x8 qf[4];
#pragma unroll
    for (int c = 0; c < 4; ++c) qf[c] = *(const bf16x8*)(qrow + 16 * c + 8 * hi);
    const LAS float* tb = tabN + h * TAB_N;
    LAS float* impG = (LAS float*)(lds + NSA_IMPG); LAS float* impL = (LAS float*)(lds + NSA_IMPL); LAS unsigned* selm = (LAS unsigned*)(lds + NSA_SEL);
    const float* NG = (const float*)(ws + OFF_NGATE) + (size_t)(b * S + t) * 24;
    const float g_cmp = NG[h], g_slc = NG[8 + h], g_win = NG[16 + h];
    f32x16 out[2];
#pragma unroll
    for (int rr = 0; rr < 16; ++rr) { out[0][rr] = 0.f; out[1][rr] = 0.f; }

    {
        TileSrc ts; ts.K = (const bf16_t*)(ws + OFF_KCN) + (size_t)grp * 512 * 64; ts.VT = (const bf16_t*)(ws + OFF_VCT) + (size_t)grp * 64 * 512; ts.vpitch = 512;
        const int nmax = min((t0 + 32) >> 4, 510), nct = (nmax >> 6) + 1;
        float m = -INFINITY, l = 0.f;
        if (tid < 64) impL[tid * 128] = 0.f;
        NSA_WAITBAR();
        nsa_issue(lds, ts, 0, tid, wave);
        for (int i = 0; i < nct; ++i) {
            NSA_WAITBAR();
            if (i + 1 < nct) nsa_issue(lds + ((i + 1) & 1) * NSA_STAGE, ts, i + 1, tid, wave);
            const LAS unsigned char* st = lds + (i & 1) * NSA_STAGE;
            f32x16 p0, p1;
            qk_lds(p0, p1, st, qf, 0.f, lrow, swz, hi);
            float mx = -INFINITY;
#pragma unroll
            for (int rr = 0; rr < 16; ++rr) { const int dc = t - 16 * (i * 64 + crow(rr, hi)) - 31; p0[rr] += tb[tab_idx(dc)]; p1[rr] += tb[tab_idx(dc - 512)]; mx = fmaxf(mx, fmaxf(p0[rr], p1[rr])); }
            mx = xhalf_max(mx);
            const float mn = fmaxf(m, mx), ms = (mn == -INFINITY) ? 0.f : mn;
            float sum = 0.f;
#pragma unroll
            for (int rr = 0; rr < 16; ++rr) sum += __builtin_amdgcn_exp2f(p0[rr] - ms) + __builtin_amdgcn_exp2f(p1[rr] - ms);
            l = l * __builtin_amdgcn_exp2f(m - ms) + sum; m = mn;
        }
        l = xhalf_sum(l);
        const float ms = (m == -INFINITY) ? 0.f : m, il = l > 0.f ? 1.f / l : 0.f;
        f32x16 o[2];
#pragma unroll
        for (int rr = 0; rr < 16; ++rr) { o[0][rr] = 0.f; o[1][rr] = 0.f; }
        NSA_WAITBAR();
        nsa_issue(lds, ts, 0, tid, wave);
        for (int i = 0; i < nct; ++i) {
            NSA_WAITBAR();
            if (i + 1 < nct) nsa_issue(lds + ((i + 1) & 1) * NSA_STAGE, ts, i + 1, tid, wave);
            const LAS unsigned char* st = lds + (i & 1) * NSA_STAGE;
            f32x16 p0, p1;
            qk_lds(p0, p1, st, qf, 0.f, lrow, swz, hi);
#pragma unroll
            for (int rr = 0; rr < 16; ++rr) { const int dc = t - 16 * (i * 64 + crow(rr, hi)) - 31;
                p0[rr] = __builtin_amdgcn_exp2f(p0[rr] + tb[tab_idx(dc)] - ms) * il; p1[rr] = __builtin_amdgcn_exp2f(p1[rr] + tb[tab_idx(dc - 512)] - ms) * il; }
#pragma unroll
            for (int u = 0; u < 8; ++u) {
                const f32x16& pp = u < 4 ? p0 : p1; const int r0 = 4 * (u & 3);
                const float G = quad_sum((pp[r0] + pp[r0 + 1]) + (pp[r0 + 2] + pp[r0 + 3])), L = quad_sum(pp[r0 + 3]);
                const int j = 16 * i + 8 * (u >> 2) + 2 * (u & 3) + hi;
                if (r == 0) { impG[qloc * 128 + j] = G; if (j + 1 < 128) impL[qloc * 128 + j + 1] = L; }
            }
            pv_lds(o, st + 8192, p0, p1, lrow, swz, hi);
        }
        const float gc = g_cmp;
#pragma unroll
        for (int rr = 0; rr < 16; ++rr) { out[0][rr] += gc * o[0][rr]; out[1][rr] += gc * o[1][rr]; }
    }
    NSA_WAITBAR();
    {
        int tid2 = tid_in; asm volatile("" : "+v"(tid2));
        const int q = tid2 >> 3, sub = tid2 & 7;
        unsigned mw[4] = {0u, 0u, 0u, 0u};
        if (qt <= 15) { if (sub == 0) mw[0] = (qt == 31) ? 0xffffffffu : ((2u << qt) - 1u); }
        else {
            unsigned vb[16];
#pragma unroll
            for (int i = 0; i < 16; ++i) { const int j = sub + 8 * i; const bool cand = j >= 1 && j <= qt - 2; vb[i] = cand ? __float_as_uint(impG[q * 128 + j] + impL[q * 128 + j]) + 1u : 0u; }
            unsigned T = 0u;
#pragma unroll 1
            for (int bit = 30; bit >= 0; --bit) {
                const unsigned trial = T | (1u << bit); unsigned c = 0u;
#pragma unroll
                for (int i = 0; i < 16; ++i) c += vb[i] >= trial ? 1u : 0u;
                c += swz_xor_u<1>(c); c += swz_xor_u<2>(c); c += swz_xor_u<4>(c);
                if (c >= 13u) T = trial;
            }
            unsigned cge = 0u;
#pragma unroll
            for (int i = 0; i < 16; ++i) cge += vb[i] >= T ? 1u : 0u;
            cge += swz_xor_u<1>(cge); cge += swz_xor_u<2>(cge); cge += swz_xor_u<4>(cge);
            if (cge == 13u) {
#pragma unroll
                for (int i = 0; i < 16; ++i) { const int j = sub + 8 * i; if (vb[i] >= T && vb[i] != 0u) mw[j >> 5] |= 1u << (j & 31); }
            } else {
                for (int i = 0; i < 16; ++i) { const int j = sub + 8 * i; if (vb[i] == 0u) continue; int rk = 0;
                    for (int kk = 1; kk <= qt - 2; ++kk) { const unsigned vk = __float_as_uint(impG[q * 128 + kk] + impL[q * 128 + kk]) + 1u; rk += (vk > vb[i]) || (vk == vb[i] && kk < j); }
                    if (rk < 13) mw[j >> 5] |= 1u << (j & 31); }
            }
            if (sub == 0) mw[0] |= 1u;
#pragma unroll
            for (int i = 0; i < 16; ++i) { const int j = sub + 8 * i; if (j == qt || j == qt - 1) mw[j >> 5] |= 1u << (j & 31); }
        }
#pragma unroll
        for (int wd = 0; wd < 4; ++wd) { unsigned x = mw[wd]; x |= swz_xor_u<1>(x); x |= swz_xor_u<2>(x); x |= swz_xor_u<4>(x); if (sub == 0) selm[q * 4 + wd] = x; }
    }
    NSA_WAITBAR();
    unsigned sm0 = selm[qloc * 4 + 0], sm1 = selm[qloc * 4 + 1], sm2 = selm[qloc * 4 + 2], sm3 = selm[qloc * 4 + 3];
    {
        TileSrc ts; ts.K = (const bf16_t*)(ws + OFF_KSLC) + (size_t)grp * S * 64; ts.VT = (const bf16_t*)(ws + OFF_VSLCT) + (size_t)grp * 64 * S; ts.vpitch = S;
        float m = 0.f, l = 0.f;
        f32x16 o[2];
#pragma unroll
        for (int rr = 0; rr < 16; ++rr) { o[0][rr] = 0.f; o[1][rr] = 0.f; }
        nsa_issue(lds, ts, 0, tid, wave);
        for (int j = 0; j <= qt; ++j) {
            NSA_WAITBAR();
            if (j + 1 <= qt) nsa_issue(lds + ((j + 1) & 1) * NSA_STAGE, ts, j + 1, tid, wave);
            const LAS unsigned char* st = lds + (j & 1) * NSA_STAGE;
            const unsigned mword = j < 32 ? sm0 : j < 64 ? sm1 : j < 96 ? sm2 : sm3;
            const bool selb = (mword >> (j & 31)) & 1u;
            if (!__any(selb)) continue;
            const float cinit = selb ? -m : -INFINITY;
            f32x16 p0, p1;
            qk_lds(p0, p1, st, qf, cinit, lrow, swz, hi);
            if (j >= qt - 2) {
#pragma unroll
                for (int rr = 0; rr < 16; ++rr) { const int d0 = t - (j * 64 + crow(rr, hi)); p0[rr] += tb[tab_idx(d0)]; p1[rr] += tb[tab_idx(d0 - 32)]; }
            }
            softmax_rel(p0, p1, m, l, o, j == 0);
            pv_lds(o, st + 8192, p0, p1, lrow, swz, hi);
        }
        l = xhalf_sum(l);
        const float gs = g_slc / l;
#pragma unroll
        for (int rr = 0; rr < 16; ++rr) { out[0][rr] += gs * o[0][rr]; out[1][rr] += gs * o[1][rr]; }
    }
    {
        TileSrc ts; ts.K = (const bf16_t*)(ws + OFF_KWIN) + (size_t)grp * S * 64; ts.VT = (const bf16_t*)(ws + OFF_VWINT) + (size_t)grp * 64 * S; ts.vpitch = S;
        float m = 0.f, l = 0.f;
        f32x16 o[2];
#pragma unroll
        for (int rr = 0; rr < 16; ++rr) { o[0][rr] = 0.f; o[1][rr] = 0.f; }
        const int j0 = qt >= 8 ? qt - 8 : 0, nt = qt - j0 + 1;
        NSA_WAITBAR();
        nsa_issue(lds, ts, j0, tid, wave);
        for (int i = 0; i < nt; ++i) {
            const int j = j0 + i;
            NSA_WAITBAR();
            if (i + 1 < nt) nsa_issue(lds + ((i + 1) & 1) * NSA_STAGE, ts, j + 1, tid, wave);
            const LAS unsigned char* st = lds + (i & 1) * NSA_STAGE;
            f32x16 p0, p1;
            qk_lds(p0, p1, st, qf, -m, lrow, swz, hi);
            if (j >= qt - 2) {
#pragma unroll
                for (int rr = 0; rr < 16; ++rr) { const int d0 = t - (j * 64 + crow(rr, hi)); p0[rr] += tb[tab_idx(d0)]; p1[rr] += tb[tab_idx(d0 - 32)]; }
            } else if (j == qt - 8) {
#pragma unroll
                for (int rr = 0; rr < 16; ++rr) { const int d0 = t - (j * 64 + crow(rr, hi)); if (d0 >= 512) p0[rr] = -INFINITY; if (d0 - 32 >= 512) p1[rr] = -INFINITY; }
            }
            softmax_rel(p0, p1, m, l, o, i == 0);
            pv_lds(o, st + 8192, p0, p1, lrow, swz, hi);
        }
        l = xhalf_sum(l);
        const float gw = g_win / l;
#pragma unroll
        for (int rr = 0; rr < 16; ++rr) { out[0][rr] += gw * o[0][rr]; out[1][rr] += gw * o[1][rr]; }
    }
    if (do_store) store_ot(qrow, out, 1.f, hi);
    NSA_WAITBAR();
}


#define XB_TMO      128
#define XB_XCNT(j)  (256  + 64 * (j))
#define XB_XSUB(j)  (1280 + 64 * (j))
#define XB_XGEN(j)  (2304 + 64 * (j))
#define XB_TOP      3328
#define XB_TOPGEN   3392
#define XCD_BAR_WORDS 3456
#define XB_SPIN_CAP (1u << 18)
constexpr size_t CTL_ZERO_BYTES = 65536, CTL_BAR_OFF = 16384;
constexpr int LDS_XB_OFF = 131072 + 8192;
__device__ __forceinline__ unsigned xb_ld(unsigned* p)              { return __hip_atomic_load(p, __ATOMIC_RELAXED, __HIP_MEMORY_SCOPE_AGENT); }
__device__ __forceinline__ unsigned xb_add(unsigned* p, unsigned v) { return __hip_atomic_fetch_add(p, v, __ATOMIC_RELAXED, __HIP_MEMORY_SCOPE_AGENT); }
__device__ __forceinline__ unsigned xb_xcc_id() { return (unsigned)__builtin_amdgcn_s_getreg((3 << 11) | 20) & 0xFu; }
#define XB_SPIN(cond, bar) do { unsigned _sp = 0; while (cond) { __builtin_amdgcn_s_sleep(3); \
    if ((++_sp & 255u) == 0u) { if (xb_ld(&(bar)[XB_TMO])) break; if (_sp > XB_SPIN_CAP) { atomicAdd(&(bar)[XB_TMO], 1u); break; } } } } while (0)
__device__ __forceinline__ void xcd_barrier_complete(unsigned* bar, unsigned x, unsigned G, unsigned& nloc, unsigned& nx) {
    unsigned sum, cnt, mine, sp = 0u;
    for (;;) {
        sum = 0u; cnt = 0u; mine = 0u;
#pragma unroll
        for (unsigned j = 0; j < 16; ++j) { const unsigned c = xb_ld(&bar[XB_XCNT(j)]); sum += c; cnt += (c > 0u) ? 1u : 0u; mine = (j == x) ? c : mine; }
        if (sum == G) break;
        __builtin_amdgcn_s_sleep(1);
        if ((++sp & 255u) == 0u) { if (xb_ld(&bar[XB_TMO])) break; if (sp > XB_SPIN_CAP) { atomicAdd(&bar[XB_TMO], 1u); break; } }
    }
    nloc = mine > 0u ? mine : 1u; nx = cnt > 0u ? cnt : 1u;
}
__device__ __forceinline__ void xcd_barrier(unsigned* bar, volatile LAS unsigned* st, unsigned G, bool leader) {
    asm volatile("s_waitcnt vmcnt(0)" ::: "memory");
    __syncthreads();
    if (leader) {
        const unsigned x = xb_xcc_id();
        __builtin_amdgcn_s_waitcnt(0);
        unsigned nloc = st[0], nx = st[1];
        if (nloc == 0u) { xcd_barrier_complete(bar, x, G, nloc, nx); st[0] = nloc; st[1] = nx; }
        const unsigned old = xb_add(&bar[XB_XSUB(x)], 1u);
        const unsigned gen = old / nloc;
        if (old + 1u == (gen + 1u) * nloc) {
            __builtin_amdgcn_fence(__ATOMIC_RELEASE, "agent");
            asm volatile("s_waitcnt vmcnt(0)" ::: "memory");
            const unsigned og = xb_add(&bar[XB_TOP], 1u);
            const unsigned tg = og / nx;
            if (og + 1u == (tg + 1u) * nx) xb_add(&bar[XB_TOPGEN], 1u);
            else XB_SPIN(xb_ld(&bar[XB_TOPGEN]) == tg, bar);
            __builtin_amdgcn_fence(__ATOMIC_ACQUIRE, "agent");
            xb_add(&bar[XB_XGEN(x)], 1u);
            asm volatile("s_waitcnt vmcnt(0)" ::: "memory");
        } else {
            XB_SPIN(xb_ld(&bar[XB_XGEN(x)]) == gen, bar);
            __builtin_amdgcn_fence(__ATOMIC_ACQUIRE, "agent");
            asm volatile("s_waitcnt vmcnt(0)" ::: "memory");
        }
    }
    __syncthreads();
}

struct Params { const float* in[26]; float* out; unsigned char* ws; };
constexpr int LDS_BYTES = 147456;
__device__ __forceinline__ const float* inptr(const Params& p, int i) { asm volatile("" : "+s"(i)); return p.in[i]; }
#define PH_BEGIN(lexpr) int lq = (lexpr); asm volatile("" : "+s"(lq)); unsigned char* ws = p.ws; asm volatile("" : "+s"(ws)); float* X = p.out; asm volatile("" : "+s"(X)); \
    bf16_t* XB = (bf16_t*)(ws + OFF_XB); float* SSQ = (float*)(ws + OFF_SSQ); (void)XB; (void)SSQ; (void)X; (void)lq
#define IN(i) inptr(p, i)
#define CCX() ConvCtx{ldsr, nullptr, 0, (int)gridDim.x * 8, MYTID()}
#define CCS(b0) ConvCtx{ldsr, nullptr, (b0), ((int)gridDim.x - (b0)) * 8, MYTID()}
#define CCS(b0) ConvCtx{ldsr, nullptr, (b0), ((int)gridDim.x - (b0)) * 8, MYTID()}
#define FFN_SRC(l, base) IN(base) + (size_t)(l) * D, IN((base) + 1) + (size_t)(l) * D * F, IN((base) + 2) + (size_t)(l) * D * F, IN((base) + 3) + (size_t)(l) * F * D
__device__ __forceinline__ MixW mixw_of(const Params& p, int l) { MixW w; w.mixn = IN(6) + (size_t)l * D; w.win = IN(7) + (size_t)l * D * DIN; w.w1k = IN(11) + (size_t)l * 2048 * 256; w.w1v = IN(13) + (size_t)l * 2048 * 256;
    w.ua = IN(18) + (size_t)l * 512 * D; w.ub = IN(19) + (size_t)l * 256 * D; w.uc = IN(20) + (size_t)l * 256 * D; w.wo = IN(21) + (size_t)l * D * D; w.pos = IN(10) + (size_t)l * 2048; w.w2k = IN(12) + (size_t)l * 256 * 64; w.w2v = IN(14) + (size_t)l * 256 * 64; return w; }

__global__ void __launch_bounds__(512) mega_fwd(Params p) {
    extern __shared__ __attribute__((aligned(16))) char lds_base[];
    cg::grid_group grid = cg::this_grid();
    LAS unsigned char* ldsr = (LAS unsigned char*)lds_base;
    const int wave_s = __builtin_amdgcn_readfirstlane(threadIdx.x >> 6);
    const int G_ = gridDim.x, bid = blockIdx.x;
    unsigned long long ts_t0 = 0, ts_acc = 0; (void)ts_t0; int ts_inst = 0; (void)ts_inst;
    if (threadIdx.x == 0) { volatile LAS unsigned* st_ = (volatile LAS unsigned*)(ldsr + LDS_XB_OFF); st_[0] = 0u; st_[1] = 0u;
        (void)xb_add((unsigned*)(p.ws + OFF_CTL + CTL_BAR_OFF) + XB_XCNT(xb_xcc_id()), 1u); }
    __syncthreads();
#define GSYNC_CG() do { TS_B(27); grid.sync(); TS_E(27); } while (0)
#define GSYNC(id) do { if (PROBE == 40) { unsigned char* wsb2_ = p.ws; asm volatile("" : "+s"(wsb2_)); xcd_barrier((unsigned*)(wsb2_ + OFF_CTL + CTL_BAR_OFF), (volatile LAS unsigned*)(ldsr + LDS_XB_OFF), (unsigned)G_, MYTID() == 0); } TS_B(27); TS_B(100 + (id)); { unsigned char* wsb_ = p.ws; asm volatile("" : "+s"(wsb_)); xcd_barrier((unsigned*)(wsb_ + OFF_CTL + CTL_BAR_OFF), (volatile LAS unsigned*)(ldsr + LDS_XB_OFF), (unsigned)G_, MYTID() == 0); } TS_E(27); TS_E(100 + (id)); } while (0)
    REP(9) {
        PH_BEGIN(0);
        TS_B(21); conv_ffn(CCX(), FFN_SRC(lq, 2), ws + OFF_FFN1W, 0, FFN_GU_ITEMS); TS_E(21);
        TS_B(23); ph_prep(MYTID(), IN(0), XB, SSQ); __syncthreads(); TS_E(23);
        GSYNC_CG();
    }
#pragma unroll 1
    for (int l = 0; l < 2; ++l) {
#pragma unroll 1
        for (int f = 0; f < 2; ++f) {
            ts_inst = l * 2 + f;
            if (f == 1) {
                REP(3) {
                    PH_BEGIN(l);
                    {
                        const int b0w = (1472 - 5 * G_ > 0 && 1472 - 5 * G_ < G_) ? 1472 - 5 * G_ : 0;
                        if (bid >= b0w) { TS_B(22); conv_ffn(CCS(b0w), FFN_SRC(lq, 22), ws + OFF_FFN2W, 0, FFN_GU_ITEMS); __syncthreads(); TS_E(22); }
                    }
                    pg8::Ops g; g.A = (const char*)XB; g.Bt = (const char*)(ws + OFF_BT_IN); g.lda_b = D * 2; g.ldb_b = D * 2; g.a_kstep = 128; g.nt = D / 64; g.a_mode = 0;
                    pg8::StaticOrder so; so.init(M, 5888, G_, bid);
                    pg8::EpiWin E{ws, SSQ, IN(8) + lq * 64, IN(9) + lq * 64, IN(15) + lq * 64, IN(16) + lq * 64};
                    TS_B(25); pg8::gemm_phase(ldsr, MYTID(), g, so, E); TS_E(25);
                    GSYNC(2);
                }
                {
                    PH_BEGIN(l);
                    LAS float* tabs = (LAS float*)(ldsr + 131072);
                    if (bid >= 16) { build_tabs(tabs, IN(1), MYTID()); __syncthreads(); }
                    if (bid < 16) {
                        pg8::Ops g; g.A = (const char*)(ws + OFF_KCMP); g.Bt = (const char*)(ws + OFF_BT_C1); g.lda_b = 2048; g.ldb_b = 4096; g.a_kstep = 128; g.nt = 32; g.a_mode = 2;
                        pg8::StaticOrder so; so.init(2048, 512, G_, bid);
                        pg8::EpiCmp1 E{(bf16_t*)(ws + OFF_HID), (const float*)(ws + OFF_BIASC)};
                        TS_B(29); pg8::gemm_phase(ldsr, MYTID(), g, so, E); TS_E(29);
                        pg8::Unit cu_;
                        asm volatile("s_waitcnt vmcnt(0)" ::: "memory");
                        __builtin_amdgcn_fence(__ATOMIC_SEQ_CST, "workgroup");
                        __syncthreads();
#pragma unroll 1
                        for (int ui_ = 0; so.next(ui_, cu_); ++ui_) {
                            int t2_ = MYTID(); asm volatile("" : "+v"(t2_));
                            TS_B(30);
                            cmp2_unit(ws, IN(9) + lq * 64, cu_.pn * 64 + cu_.pm * 8 + __builtin_amdgcn_readfirstlane(t2_ >> 6), t2_ & 63);
                            TS_E(30);
                        }
                    } else {
                        int t_ = MYTID(); asm volatile("" : "+v"(t_));
                        const int lane_ = t_ & 63, gw_ = (bid - 16) * 8 + __builtin_amdgcn_readfirstlane(t_ >> 6), ngw_ = (G_ - 16) * 8;
                        REP(6) {
                            for (int u = gw_; u < 4096; u += ngw_) {
                                if (u < 2048) sb_unit(ws, u, lane_, LASTREP(6));
                                else swa_unit(ws, tabs + 8 * TAB_N, IN(17) + lq * 4, u - 2048, lane_, LASTREP(6));
                            }
                        }
                    }
                }
                GSYNC(3);
                {
                    PH_BEGIN(l);
                    LAS float* tabs = (LAS float*)(ldsr + 131072);
                    if (bid < 16) { build_tabs(tabs, IN(1), MYTID()); __syncthreads(); }
                    int t_ = MYTID(); asm volatile("" : "+v"(t_));
                    TS_B(32);
                    REP(5) {
                        for (int ps = bid; ps < 256; ps += G_) {
                            const int bg = (ps & 7) >> 1, i = (ps & 1) * 32 + (ps >> 3);
#pragma unroll 1
                            for (int k2 = 0; k2 < 2; ++k2) nsa_unit(ldsr, tabs, ws, bg >> 1, bg & 1, k2 ? 127 - i : i, t_, LASTREP(5));
                        }
                    }
                    TS_E(32);
                }
                GSYNC(5);
                REP(7) {
                    PH_BEGIN(l);
                    const unsigned char* GATES = ws + OFF_A;
                    pg8::Ops g; g.A = (const char*)(ws + OFF_Q16); g.Bt = (const char*)(ws + OFF_BT_M); g.lda_b = 128; g.ldb_b = D * 2; g.a_kstep = (size_t)S * 128; g.nt = 16; g.a_mode = 1;
                    pg8::StaticOrder so; so.init(M, D, G_, bid);
                    pg8::EpiMerge E{GATES, GATES + (size_t)M * D, GATES + (size_t)2 * M * D, (bf16_t*)(ws + OFF_MERGED)};
                    TS_B(28); pg8::gemm_phase(ldsr, MYTID(), g, so, E); TS_E(28);
                    GSYNC(6);
                }
                REP(8) {
                    PH_BEGIN(l);
                    pg8::Ops g; g.A = (const char*)(ws + OFF_MERGED); g.Bt = (const char*)(ws + OFF_BT_O); g.lda_b = D * 2; g.ldb_b = D * 2; g.a_kstep = 128; g.nt = 16; g.a_mode = 0;
                    pg8::StaticOrder so; so.init(M, D, G_, bid);
                    pg8::EpiResid E{nullptr, nullptr, XB, SSQ, LASTREP(8) ? 1.0f : 0.f};
                    TS_B(26); pg8::gemm_phase(ldsr, MYTID(), g, so, E); TS_E(26);
                    GSYNC(7);
                }
            }
            REP(1) {
                PH_BEGIN(l);
                int fq_ = f; asm volatile("" : "+s"(fq_));
                unsigned char* wbase = ws + (fq_ == 0 ? OFF_FFN1W : OFF_FFN2W);
                {
                    const int b0 = (1408 - 5 * G_ > 0 && 1408 - 5 * G_ < G_) ? 1408 - 5 * G_ : 0;
                    if (bid >= b0) {
                        const int inst = lq * 2 + fq_;
                        TS_B(22);
                        if (inst == 0) { conv_mix(CCS(b0), mixw_of(p, 0), ws); conv_ffn(CCS(b0), FFN_SRC(0, 2), ws + OFF_FFN1W, FFN_GU_ITEMS, FFN_ITEMS); }
                        else if (inst == 1) { conv_ffn(CCS(b0), FFN_SRC(1, 2), ws + OFF_FFN1W, 0, FFN_ITEMS); conv_ffn(CCS(b0), FFN_SRC(0, 22), ws + OFF_FFN2W, FFN_GU_ITEMS, FFN_ITEMS); }
                        else if (inst == 2) conv_mix(CCS(b0), mixw_of(p, 1), ws);
                        else conv_ffn(CCS(b0), FFN_SRC(1, 22), ws + OFF_FFN2W, FFN_GU_ITEMS, FFN_ITEMS);
                        __syncthreads(); TS_E(22);
                    }
                }
                pg8::Ops g; g.A = (const char*)XB; g.Bt = (const char*)wbase; g.lda_b = D * 2; g.ldb_b = D * 2; g.a_kstep = 128; g.nt = 16; g.a_mode = 0;
                pg8::StaticOrder so; so.init(M, 2 * F, G_, bid);
                pg8::EpiFfnUp E{(bf16_t*)(ws + OFF_A), SSQ};
                TS_B(24); pg8::gemm_phase(ldsr, MYTID(), g, so, E); TS_E(24);
                GSYNC(8);
            }
            REP(2) {
                PH_BEGIN(l);
                int fq_ = f; asm volatile("" : "+s"(fq_));
                unsigned char* wbase = ws + (fq_ == 0 ? OFF_FFN1W : OFF_FFN2W);
                pg8::Ops g; g.A = (const char*)(ws + OFF_A); g.Bt = (const char*)(wbase + FFNW_D); g.lda_b = F * 2; g.ldb_b = F * 2; g.a_kstep = 128; g.nt = F / 64; g.a_mode = 0;
                pg8::StaticOrder so; so.init(M, D, G_, bid);
                pg8::EpiResid E{(lq == 0 && fq_ == 0) ? IN(0) : (const float*)nullptr, (lq == 1 && fq_ == 1) ? X : (float*)nullptr, XB, SSQ, LASTREP(2) ? 0.5f : 0.f};
                TS_B(31); pg8::gemm_phase(ldsr, MYTID(), g, so, E); TS_E(31);
                if (!(l == 1 && f == 1)) GSYNC(9);
            }
        }
    }
#ifdef TSPMAX
    if (TSP != 0) {
        unsigned* mx_ = (unsigned*)(p.ws + OFF_CTL) + 8192;
        if (MYTID() == 0) atomicMax(mx_, (unsigned)ts_acc);
        xcd_barrier((unsigned*)(p.ws + OFF_CTL + CTL_BAR_OFF), (volatile LAS unsigned*)(ldsr + LDS_XB_OFF), (unsigned)G_, MYTID() == 0);
        if (bid == 0) { const unsigned long long mxv = __hip_atomic_load(mx_, __ATOMIC_RELAXED, __HIP_MEMORY_SCOPE_AGENT); const unsigned long long te = __builtin_amdgcn_s_memrealtime(); while (__builtin_amdgcn_s_memrealtime() - te < 10ull * mxv) __builtin_amdgcn_s_sleep(8); }
    }
#else
    if (TSP != 0 && bid == 0) { const unsigned long long te = __builtin_amdgcn_s_memrealtime(); while (__builtin_amdgcn_s_memrealtime() - te < 10ull * ts_acc) __builtin_amdgcn_s_sleep(8); }
#endif
}

extern "C" void kernel_launch(void* const* d_in, const int* in_sizes, int n_in, void* d_out, int out_size, void* d_ws, size_t ws_size, hipStream_t stream) {
    static int grid_blocks = 0;
    if (grid_blocks == 0) {
        if (ws_size < WS_END || n_in != 26) { fprintf(stderr, "kernel_launch: bad sizes (ws %zu)\n", ws_size); grid_blocks = -1; return; }
        int dev = 0, cus = 0, per_cu = 0;
        (void)hipGetDevice(&dev); (void)hipDeviceGetAttribute(&cus, hipDeviceAttributeMultiprocessorCount, dev);
        (void)hipFuncSetAttribute((const void*)mega_fwd, hipFuncAttributeMaxDynamicSharedMemorySize, LDS_BYTES);
        (void)hipOccupancyMaxActiveBlocksPerMultiprocessor(&per_cu, (const void*)mega_fwd, 512, LDS_BYTES);
        if (per_cu < 1) { fprintf(stderr, "kernel_launch: occupancy query says %d\n", per_cu); per_cu = 1; }
        grid_blocks = cus * (per_cu > 1 ? 1 : per_cu);
        (void)hipGetLastError();
    }
    if (grid_blocks < 0) return;
    if (hipMemsetAsync((char*)d_ws + OFF_CTL, 0, CTL_ZERO_BYTES, stream) != hipSuccess) { fprintf(stderr, "kernel_launch: memset failed\n"); return; }
    Params p{}; for (int i = 0; i < 26; ++i) p.in[i] = (const float*)d_in[i]; p.out = (float*)d_out; p.ws = (unsigned char*)d_ws;
    void* args[] = {&p};
    hipError_t e = hipLaunchCooperativeKernel((void*)mega_fwd, dim3(grid_blocks), dim3(512), args, LDS_BYTES, stream);
    if (e != hipSuccess) fprintf(stderr, "cooperative launch failed: %s (grid %d)\n", hipGetErrorString(e), grid_blocks);
}
```
